# Optimizing an MI355X kernel written in HIP

```python
import functools
import math
import jax, jax.numpy as jnp
from jax import lax
import numpy as np

D_MODEL = 2048
BATCH = 2
SEQ = 4096
DEPTH = 1
DEC_BATCH = 8
DEC_SEQ = 4
PAST_LEN = 16384
PAGE_SIZE = 128

D_SSM = D_MODEL // 2
SSM_GROUP = 16
N_GROUPS = D_SSM // SSM_GROUP
SSM_STATE = 64
HEAD_DIM = 128
N_HEADS = (D_MODEL // 2) // HEAD_DIM
D_ATT = N_HEADS * HEAD_DIM
D_FF = ((8 * D_MODEL + 3 * 256 - 1) // (3 * 256)) * 256
Q_BLOCK = 128
N_IN = D_SSM + 3 * D_ATT + N_HEADS + 2 * D_MODEL
SPLIT_POINTS = [D_SSM, D_SSM + D_ATT, D_SSM + 2 * D_ATT, D_SSM + 3 * D_ATT,
                D_SSM + 3 * D_ATT + N_HEADS, D_SSM + 3 * D_ATT + N_HEADS + D_MODEL]
RMS_EPS = 1e-6
DT_MIN = 1e-3
DT_MAX = 1e-1
NEG_INF = -1e30
FGATE_BIAS_LO = 2.0
FGATE_BIAS_HI = 12.0

kernel_name = 'hybrid_s5_fox_gated_decode_step'


def rms_norm(x, g):
    xf = x.astype(jnp.float32)
    y = xf * lax.rsqrt(jnp.mean(xf * xf, axis=-1, keepdims=True) + RMS_EPS)
    return (y * g.astype(jnp.float32)).astype(x.dtype)


def project_inputs(x, norm_g, w_in, b_f, q_g, k_g):
    b, l = x.shape[0], x.shape[1]
    z = rms_norm(x, norm_g) @ w_in
    u, q, k, v, f_logit, gate_ssm, gate_att = jnp.split(z, SPLIT_POINTS, axis=-1)
    q = rms_norm(q.reshape(b, l, N_HEADS, HEAD_DIM), q_g)
    k = rms_norm(k.reshape(b, l, N_HEADS, HEAD_DIM), k_g)
    v = v.reshape(b, l, N_HEADS, HEAD_DIM)
    logf = jax.nn.log_sigmoid((f_logit + b_f).astype(jnp.float32))
    return u, q, k, v, logf, gate_ssm, gate_att


def s5_discretise(a_re, a_im, log_dt, b_re, b_im):
    a_re = a_re.astype(jnp.float32)
    a_im = a_im.astype(jnp.float32)
    dt = jnp.exp(log_dt.astype(jnp.float32))[:, None]
    mag = jnp.exp(dt * a_re)
    ang = dt * a_im
    abar_re = mag * jnp.cos(ang)
    abar_im = mag * jnp.sin(ang)
    e_re = abar_re - 1.0
    e_im = abar_im
    inv_den = 1.0 / (a_re * a_re + a_im * a_im)
    f_re = (e_re * a_re + e_im * a_im) * inv_den
    f_im = (e_im * a_re - e_re * a_im) * inv_den
    b_re = b_re.astype(jnp.float32)
    b_im = b_im.astype(jnp.float32)
    bbar_re = f_re[..., None] * b_re - f_im[..., None] * b_im
    bbar_im = f_re[..., None] * b_im + f_im[..., None] * b_re
    return abar_re, abar_im, bbar_re, bbar_im


def complex_affine_combine(e1, e2):
    a1r, a1i, b1r, b1i = e1
    a2r, a2i, b2r, b2i = e2
    return (a2r * a1r - a2i * a1i,
            a2r * a1i + a2i * a1r,
            a2r * b1r - a2i * b1i + b2r,
            a2r * b1i + a2i * b1r + b2i)


def s5_branch(u, h0_re, h0_im, a_re, a_im, log_dt, b_re, b_im, c_re, c_im, d, w_glu, b_glu):
    b, l = u.shape[0], u.shape[1]
    uf = u.astype(jnp.float32)
    abar_re, abar_im, bbar_re, bbar_im = s5_discretise(a_re, a_im, log_dt, b_re, b_im)
    ug = uf.reshape(b, l, N_GROUPS, SSM_GROUP)
    bu_re = jnp.einsum('blgc,gpc->blgp', ug, bbar_re)
    bu_im = jnp.einsum('blgc,gpc->blgp', ug, bbar_im)
    a_seq_re = jnp.broadcast_to(abar_re, (1, l, N_GROUPS, SSM_STATE))
    a_seq_im = jnp.broadcast_to(abar_im, (1, l, N_GROUPS, SSM_STATE))
    acum_re, acum_im, bcum_re, bcum_im = lax.associative_scan(
        complex_affine_combine, (a_seq_re, a_seq_im, bu_re, bu_im), axis=1)
    h0r = h0_re.astype(jnp.float32)[:, None]
    h0i = h0_im.astype(jnp.float32)[:, None]
    h_re = acum_re * h0r - acum_im * h0i + bcum_re
    h_im = acum_re * h0i + acum_im * h0r + bcum_im
    y = (jnp.einsum('blgp,gcp->blgc', h_re, c_re.astype(jnp.float32))
         - jnp.einsum('blgp,gcp->blgc', h_im, c_im.astype(jnp.float32)))
    y = y.reshape(b, l, D_SSM) + d.astype(jnp.float32) * uf
    y = jax.nn.gelu(y, approximate=False)
    y = y * jax.nn.sigmoid(y @ w_glu.astype(jnp.float32) + b_glu.astype(jnp.float32))
    return y.astype(u.dtype), h_re[:, -1], h_im[:, -1]


def fox_prompt(q, k, v, logf):
    b, l = q.shape[0], q.shape[1]
    n_blocks = l // Q_BLOCK
    scale = HEAD_DIM ** -0.5
    c_t = lax.cumsum(logf, axis=1).transpose(0, 2, 1)
    q_blocks = q.reshape(b, n_blocks, Q_BLOCK, N_HEADS, HEAD_DIM).swapaxes(0, 1)
    c_blocks = c_t.reshape(b, N_HEADS, n_blocks, Q_BLOCK).transpose(2, 0, 1, 3)
    k_pos = jnp.arange(l)

    def one_block(args):
        i, qb, cb = args
        q_pos = i * Q_BLOCK + jnp.arange(Q_BLOCK)
        s = jnp.einsum('bqhd,bkhd->bhqk', qb, k).astype(jnp.float32) * scale
        s = s + cb[..., :, None] - c_t[:, :, None, :]
        s = jnp.where(k_pos[None, :] <= q_pos[:, None], s, NEG_INF)
        p = jax.nn.softmax(s, axis=-1)
        return jnp.einsum('bhqk,bkhd->bqhd', p.astype(v.dtype), v)

    out = lax.map(one_block, (jnp.arange(n_blocks), q_blocks, c_blocks))
    return out.swapaxes(0, 1).reshape(b, l, D_ATT)


def fox_sample(q, k, v, logf, k_past, v_past, logf_past):
    b, t = q.shape[0], q.shape[1]
    n_past = k_past.shape[1]
    scale = HEAD_DIM ** -0.5
    lp = logf_past.astype(jnp.float32)
    r_past = (lax.cumsum(lp, axis=1, reverse=True) - lp).transpose(0, 2, 1)
    c_new = lax.cumsum(logf, axis=1).transpose(0, 2, 1)
    s_past = (jnp.einsum('bqhd,bkhd->bhqk', q, k_past).astype(jnp.float32) * scale
              + r_past[:, :, None, :] + c_new[:, :, :, None])
    s_new = (jnp.einsum('bqhd,bkhd->bhqk', q, k).astype(jnp.float32) * scale
             + c_new[:, :, :, None] - c_new[:, :, None, :])
    causal = jnp.tril(jnp.ones((t, t), dtype=bool))
    s_new = jnp.where(causal, s_new, NEG_INF)
    p = jax.nn.softmax(jnp.concatenate([s_past, s_new], axis=-1), axis=-1)
    out = (jnp.einsum('bhqk,bkhd->bqhd', p[..., :n_past].astype(v.dtype), v_past)
           + jnp.einsum('bhqk,bkhd->bqhd', p[..., n_past:].astype(v.dtype), v))
    return out.reshape(b, t, D_ATT)


def trunk_layer(x, h0_re, h0_im, attn_fn, norm_mix_g, w_in, b_f, q_norm_g, k_norm_g,
                ssm_a_re, ssm_a_im, ssm_log_dt, ssm_b_re, ssm_b_im, ssm_c_re, ssm_c_im, ssm_d,
                w_glu, b_glu, w_br_ssm, w_br_att, w_out, norm_ffn_g, w_ffn_gate, w_ffn_up, w_ffn_down):
    u, q, k, v, logf, gate_ssm, gate_att = project_inputs(x, norm_mix_g, w_in, b_f, q_norm_g, k_norm_g)
    y_ssm, h_re, h_im = s5_branch(u, h0_re, h0_im, ssm_a_re, ssm_a_im, ssm_log_dt, ssm_b_re, ssm_b_im,
                                  ssm_c_re, ssm_c_im, ssm_d, w_glu, b_glu)
    y_att = attn_fn(q, k, v, logf)
    merged = (jax.nn.sigmoid(gate_ssm) * (y_ssm @ w_br_ssm)
              + jax.nn.sigmoid(gate_att) * (y_att @ w_br_att))
    x = x + merged @ w_out
    xn = rms_norm(x, norm_ffn_g)
    x = x + (jax.nn.silu(xn @ w_ffn_gate) * (xn @ w_ffn_up)) @ w_ffn_down
    return x, k, v, logf, h_re, h_im


def setup_inputs(seed: int = 0) -> dict:
    key = jax.random.key(seed)
    ks = jax.random.split(key, 32)
    f32 = jnp.float32

    def nrm(k, shape, scale):
        return jax.random.normal(k, shape, f32) * scale

    n_pages = PAST_LEN // PAGE_SIZE
    n_used = DEC_BATCH * n_pages
    n_pool = n_used + max(1, n_used // 4)
    perm = jax.random.permutation(ks[0], n_pool)
    page_table = perm[:n_used].reshape(DEC_BATCH, n_pages).astype(jnp.int32)

    head_bias = jnp.linspace(FGATE_BIAS_LO, FGATE_BIAS_HI, N_HEADS, dtype=f32)
    x_prompt = nrm(ks[1], (BATCH, SEQ, D_MODEL), 1.0)
    x_sample = nrm(ks[2], (DEC_BATCH, DEC_SEQ, D_MODEL), 1.0)
    cache_k = nrm(ks[3], (DEPTH, n_pool, PAGE_SIZE, N_HEADS, HEAD_DIM), 1.0)
    cache_v = nrm(ks[4], (DEPTH, n_pool, PAGE_SIZE, N_HEADS, HEAD_DIM), 1.0)
    cache_logf = jax.nn.log_sigmoid(head_bias + nrm(ks[5], (DEPTH, n_pool, PAGE_SIZE, N_HEADS), 0.5))
    state_ssm_re = nrm(ks[6], (DEPTH, DEC_BATCH, N_GROUPS, SSM_STATE), 0.3)
    state_ssm_im = nrm(ks[7], (DEPTH, DEC_BATCH, N_GROUPS, SSM_STATE), 0.3)

    norm_mix_g = 1.0 + nrm(ks[8], (DEPTH, D_MODEL), 0.02)
    w_in = nrm(ks[9], (DEPTH, D_MODEL, N_IN), D_MODEL ** -0.5)
    b_f = head_bias[None, :] + nrm(ks[10], (DEPTH, N_HEADS), 0.1)
    q_norm_g = 1.0 + nrm(ks[11], (DEPTH, HEAD_DIM), 0.02)
    k_norm_g = 1.0 + nrm(ks[12], (DEPTH, HEAD_DIM), 0.02)
    ssm_a_re = -0.5 * jnp.exp(nrm(ks[13], (DEPTH, N_GROUPS, SSM_STATE), 0.05))
    ssm_a_im = (jnp.pi * jnp.arange(SSM_STATE, dtype=f32))[None, None, :] + nrm(ks[14], (DEPTH, N_GROUPS, SSM_STATE), 0.01)
    ssm_log_dt = jax.random.uniform(ks[15], (DEPTH, N_GROUPS), f32, math.log(DT_MIN), math.log(DT_MAX))
    ssm_b_re = nrm(ks[16], (DEPTH, N_GROUPS, SSM_STATE, SSM_GROUP), (2 * SSM_GROUP) ** -0.5)
    ssm_b_im = nrm(ks[17], (DEPTH, N_GROUPS, SSM_STATE, SSM_GROUP), (2 * SSM_GROUP) ** -0.5)
    ssm_c_re = nrm(ks[18], (DEPTH, N_GROUPS, SSM_GROUP, SSM_STATE), (2 * SSM_STATE) ** -0.5)
    ssm_c_im = nrm(ks[19], (DEPTH, N_GROUPS, SSM_GROUP, SSM_STATE), (2 * SSM_STATE) ** -0.5)
    ssm_d = nrm(ks[20], (DEPTH, D_SSM), 0.5)
    w_glu = nrm(ks[21], (DEPTH, D_SSM, D_SSM), D_SSM ** -0.5)
    b_glu = nrm(ks[22], (DEPTH, D_SSM), 0.01)
    w_br_ssm = nrm(ks[23], (DEPTH, D_SSM, D_MODEL), D_SSM ** -0.5)
    w_br_att = nrm(ks[24], (DEPTH, D_ATT, D_MODEL), D_ATT ** -0.5)
    w_out = nrm(ks[25], (DEPTH, D_MODEL, D_MODEL), D_MODEL ** -0.5)
    norm_ffn_g = 1.0 + nrm(ks[26], (DEPTH, D_MODEL), 0.02)
    w_ffn_gate = nrm(ks[27], (DEPTH, D_MODEL, D_FF), D_MODEL ** -0.5)
    w_ffn_up = nrm(ks[28], (DEPTH, D_MODEL, D_FF), D_MODEL ** -0.5)
    w_ffn_down = nrm(ks[29], (DEPTH, D_FF, D_MODEL), D_FF ** -0.5)
    return {'x_prompt': x_prompt, 'x_sample': x_sample, 'cache_k': cache_k, 'cache_v': cache_v,
            'cache_logf': cache_logf, 'state_ssm_re': state_ssm_re, 'state_ssm_im': state_ssm_im,
            'page_table': page_table, 'norm_mix_g': norm_mix_g, 'w_in': w_in, 'b_f': b_f,
            'q_norm_g': q_norm_g, 'k_norm_g': k_norm_g, 'ssm_a_re': ssm_a_re, 'ssm_a_im': ssm_a_im,
            'ssm_log_dt': ssm_log_dt, 'ssm_b_re': ssm_b_re, 'ssm_b_im': ssm_b_im, 'ssm_c_re': ssm_c_re,
            'ssm_c_im': ssm_c_im, 'ssm_d': ssm_d, 'w_glu': w_glu, 'b_glu': b_glu, 'w_br_ssm': w_br_ssm,
            'w_br_att': w_br_att, 'w_out': w_out, 'norm_ffn_g': norm_ffn_g, 'w_ffn_gate': w_ffn_gate,
            'w_ffn_up': w_ffn_up, 'w_ffn_down': w_ffn_down}


def reference(x_prompt, x_sample, cache_k, cache_v, cache_logf, state_ssm_re, state_ssm_im, page_table,
              norm_mix_g, w_in, b_f, q_norm_g, k_norm_g, ssm_a_re, ssm_a_im, ssm_log_dt, ssm_b_re, ssm_b_im,
              ssm_c_re, ssm_c_im, ssm_d, w_glu, b_glu, w_br_ssm, w_br_att, w_out, norm_ffn_g,
              w_ffn_gate, w_ffn_up, w_ffn_down):
    n_seq, n_pages = page_table.shape
    y_p, y_s = x_prompt, x_sample
    kp_l, vp_l, lfp_l, hrp_l, hip_l = [], [], [], [], []
    ks_l, vs_l, lfs_l, hrs_l, his_l = [], [], [], [], []
    for l in range(DEPTH):
        lp = (norm_mix_g[l], w_in[l], b_f[l], q_norm_g[l], k_norm_g[l], ssm_a_re[l], ssm_a_im[l],
              ssm_log_dt[l], ssm_b_re[l], ssm_b_im[l], ssm_c_re[l], ssm_c_im[l], ssm_d[l], w_glu[l],
              b_glu[l], w_br_ssm[l], w_br_att[l], w_out[l], norm_ffn_g[l], w_ffn_gate[l], w_ffn_up[l],
              w_ffn_down[l])
        h_zero = jnp.zeros((y_p.shape[0], N_GROUPS, SSM_STATE), jnp.float32)
        y_p, kp, vp, lfp, hrp, hip = trunk_layer(y_p, h_zero, h_zero, fox_prompt, *lp)
        k_past = cache_k[l][page_table].reshape(n_seq, n_pages * PAGE_SIZE, N_HEADS, HEAD_DIM)
        v_past = cache_v[l][page_table].reshape(n_seq, n_pages * PAGE_SIZE, N_HEADS, HEAD_DIM)
        lf_past = cache_logf[l][page_table].reshape(n_seq, n_pages * PAGE_SIZE, N_HEADS)
        attn_sample = functools.partial(fox_sample, k_past=k_past, v_past=v_past, logf_past=lf_past)
        y_s, ksn, vsn, lfs, hrs, his = trunk_layer(y_s, state_ssm_re[l], state_ssm_im[l], attn_sample, *lp)
        kp_l.append(kp); vp_l.append(vp); lfp_l.append(lfp); hrp_l.append(hrp); hip_l.append(hip)
        ks_l.append(ksn); vs_l.append(vsn); lfs_l.append(lfs); hrs_l.append(hrs); his_l.append(his)
    new_k_prompt = jnp.stack(kp_l)
    new_v_prompt = jnp.stack(vp_l)
    new_logf_prompt = jnp.stack(lfp_l)
    new_ssm_re_prompt = jnp.stack(hrp_l)
    new_ssm_im_prompt = jnp.stack(hip_l)
    new_k_sample = jnp.stack(ks_l)
    new_v_sample = jnp.stack(vs_l)
    new_logf_sample = jnp.stack(lfs_l)
    new_ssm_re_sample = jnp.stack(hrs_l)
    new_ssm_im_sample = jnp.stack(his_l)
    return (y_p, y_s, new_k_prompt, new_v_prompt, new_logf_prompt, new_ssm_re_prompt, new_ssm_im_prompt,
            new_k_sample, new_v_sample, new_logf_sample, new_ssm_re_sample, new_ssm_im_sample)
```

```cpp
#include <hip/hip_runtime.h>
#include <hip/hip_bf16.h>
#include <cstdio>
#include <cstdint>

#ifndef MK_SPLIT
#define MK_SPLIT 0
#endif

constexpr int DM = 2048, NB = 2, SEQ = 4096, MPR = NB * SEQ, DBT = 8, DSQ = 4, MSM = DBT * DSQ, MR = MPR + MSM, MPAD = 8448;
constexpr int DSSM = 1024, NG = 64, NST = 64, GC = 16, NH = 8, HD = 128, DATT = 1024, DFF = 5632, NIN = 8200;
constexpr int PAST = 16384, PAGE = 128, NPAGES = 128;
constexpr float RMS_EPS = 1e-6f;
constexpr float LOG2E = 1.4426950408889634f;
constexpr int TCH = 128, NCH = SEQ / TCH;

namespace pg8 {
#define PG8_LAS __attribute__((address_space(3)))
typedef unsigned short bf16_t;
typedef short bf16x8 __attribute__((ext_vector_type(8)));
typedef float f32x4 __attribute__((ext_vector_type(4)));
typedef unsigned u32x4 __attribute__((ext_vector_type(4)));
constexpr int BM = 256, BK = 64, HALF = 128, HTB = HALF * BK * 2  , STAGE_BYTES = 8 * HTB, NXCD = 8, WGM = 8;

__host__ __device__ __forceinline__ int lds_byte(int r, int c) { const int st = (r >> 4) * 2 + (c >> 5), rr = r & 15, cc = c & 31, ob = rr * 64 + cc * 2; return st * 1024 + (ob ^ (((ob >> 9) & 1) << 5)); }
__host__ __device__ __forceinline__ void stage_rc(int b, int& R, int& C) { const int st = b / 1024, sb = b % 1024, swz = sb ^ (((sb >> 9) & 1) << 5); R = (st >> 1) * 16 + swz / 64; C = (st & 1) * 32 + (swz % 64) / 2; }
__host__ __device__ __forceinline__ int perm32(int rho) { const int n = rho >> 4, i = rho & 15; return 8 * (i >> 2) + 4 * n + (i & 3); }

struct Unit { int pm, pn; };
struct Gemm { const bf16_t* A; const bf16_t* Bt; int M, N, K, lda, ldb; };

struct StaticOrder {
    int nM, nN, nwg, G, c;
    __host__ __device__ void init(int M, int N, int G_, int c_) { nM = M / BM; nN = N / BM; nwg = nM * nN; G = G_; c = c_; }
    __host__ __device__ bool next(int i, Unit& u) const {
        const long L = (long)i * G + c; if (L >= nwg) return false;
        int wgid = (int)L; { const int q = nwg / NXCD, r = nwg % NXCD, xcd = wgid % NXCD, off = wgid / NXCD; wgid = (xcd < r ? xcd * (q + 1) : r * (q + 1) + (xcd - r) * q) + off; }
        const int nig = WGM * nN, gid = wgid / nig, fm = gid * WGM, gsz = (nM - fm) < WGM ? (nM - fm) : WGM;
        u.pm = fm + ((wgid % nig) % gsz); u.pn = (wgid % nig) / gsz; return true;
    }
    __device__ __forceinline__ void a_ready(const Unit&) const {}
    __device__ __forceinline__ void done(const Unit&) const {}
};

__device__ __forceinline__ unsigned cvt_pk_bf16(float lo, float hi) { unsigned r; asm volatile("v_cvt_pk_bf16_f32 %0, %1, %2" : "=v"(r) : "v"(lo), "v"(hi)); return r; }
typedef float f32x2 __attribute__((ext_vector_type(2)));
__device__ __forceinline__ f32x2 gelu_pk(f32x2 v) {
    const f32x2 av = __builtin_elementwise_abs(v), d = av * 0.2316418882f + 1.0f;
    f32x2 t; t.x = __builtin_amdgcn_rcpf(d.x); t.y = __builtin_amdgcn_rcpf(d.y);
    f32x2 q = t * 0.5307027145f + (-0.7265760135f); q = q * t + 0.7107068705f; q = q * t + (-0.142248368f); q = q * t + 0.127414796f; q = q * t;
    const f32x2 s = (v * v) * (-0.72134752044f);
    f32x2 e; e.x = __builtin_amdgcn_exp2f(s.x); e.y = __builtin_amdgcn_exp2f(s.y);
    const f32x2 m = v * (q * e), r = v - m;
    f32x2 o; o.x = v.x < 0.f ? m.x : r.x; o.y = v.y < 0.f ? m.y : r.y; return o;
}

__device__ __forceinline__ float sigm(float x) { return 1.0f / (1.0f + __expf(-x)); }
__device__ __forceinline__ float bflo(unsigned w) { return __uint_as_float(w << 16); }
__device__ __forceinline__ float bfhi(unsigned w) { return __uint_as_float(w & 0xffff0000u); }
__device__ __forceinline__ u32x4 pack8(f32x4 a, f32x4 b) { u32x4 w; w.x = cvt_pk_bf16(a[0], a[1]); w.y = cvt_pk_bf16(a[2], a[3]); w.z = cvt_pk_bf16(b[0], b[1]); w.w = cvt_pk_bf16(b[2], b[3]); return w; }
__device__ __forceinline__ void unpack8(u32x4 w, f32x4& a, f32x4& b) { a = (f32x4){bflo(w.x), bfhi(w.x), bflo(w.y), bfhi(w.y)}; b = (f32x4){bflo(w.z), bfhi(w.z), bflo(w.w), bfhi(w.w)}; }
#define PG8_EPI_ROWS  for (int ai = 0; ai < 2; ++ai) _Pragma("unroll") for (int m = 0; m < 4; ++m)

struct EpiIn {
    static constexpr bool PERM = true, AFTER_DRAIN = false;
    float* Z; bf16_t* G; const float* R1;
    __device__ __forceinline__ void operator()(const f32x4 (&acc)[2][2][4][2], const Unit& u, int wr, int wc, int fr, int fq) const {
        const int row0 = u.pm * BM + wr * 64 + fr, col0 = u.pn * BM + wc * 32 + 8 * fq; const bool isz = u.pn < 16;
#pragma unroll
        PG8_EPI_ROWS { const int row = row0 + ai * HALF + m * 16; const float r1 = R1[row];
#pragma unroll
            for (int bj = 0; bj < 2; ++bj) { const int c = col0 + bj * HALF; f32x4 v0 = acc[ai][bj][m][0] * r1, v1 = acc[ai][bj][m][1] * r1;
                if (isz) { float* p = Z + (size_t)row * 4096 + c; *(f32x4*)p = v0; *(f32x4*)(p + 4) = v1; }
                else { v0 = (f32x4){sigm(v0[0]), sigm(v0[1]), sigm(v0[2]), sigm(v0[3])}; v1 = (f32x4){sigm(v1[0]), sigm(v1[1]), sigm(v1[2]), sigm(v1[3])};
                       *(u32x4*)(G + (size_t)row * 4096 + (c - 4096)) = pack8(v0, v1); } } }
    }
};
struct EpiGlu {
    static constexpr bool PERM = true, AFTER_DRAIN = false;
    const bf16_t* YP; bf16_t* YY; const float* bias;
    __device__ __forceinline__ void operator()(const f32x4 (&acc)[2][2][4][2], const Unit& u, int wr, int wc, int fr, int fq) const {
        const int row0 = u.pm * BM + wr * 64 + fr, col0 = u.pn * BM + wc * 32 + 8 * fq;
#pragma unroll
        PG8_EPI_ROWS { const int row = row0 + ai * HALF + m * 16;
#pragma unroll
            for (int bj = 0; bj < 2; ++bj) { const int c = col0 + bj * HALF; const f32x4 b0 = *(const f32x4*)(bias + c), b1 = *(const f32x4*)(bias + c + 4);
                f32x4 y0, y1; unpack8(*(const u32x4*)(YP + (size_t)row * 1024 + c), y0, y1);
                const f32x4 a0 = acc[ai][bj][m][0] + b0, a1 = acc[ai][bj][m][1] + b1;
                y0 = (f32x4){y0[0] * sigm(a0[0]), y0[1] * sigm(a0[1]), y0[2] * sigm(a0[2]), y0[3] * sigm(a0[3])};
                y1 = (f32x4){y1[0] * sigm(a1[0]), y1[1] * sigm(a1[1]), y1[2] * sigm(a1[2]), y1[3] * sigm(a1[3])};
                *(u32x4*)(YY + (size_t)row * 2048 + c) = pack8(y0, y1); } }
    }
};
struct EpiBrA {
    static constexpr bool PERM = true, AFTER_DRAIN = false;
    const bf16_t* G; float* T1;
    __device__ __forceinline__ void operator()(const f32x4 (&acc)[2][2][4][2], const Unit& u, int wr, int wc, int fr, int fq) const {
        const int row0 = u.pm * BM + wr * 64 + fr, col0 = u.pn * BM + wc * 32 + 8 * fq;
#pragma unroll
        PG8_EPI_ROWS { const int row = row0 + ai * HALF + m * 16;
#pragma unroll
            for (int bj = 0; bj < 2; ++bj) { const int c = col0 + bj * HALF; f32x4 g0, g1; unpack8(*(const u32x4*)(G + (size_t)row * 4096 + c), g0, g1);
                float* p = T1 + (size_t)row * 2048 + c; *(f32x4*)p = acc[ai][bj][m][0] * g0; *(f32x4*)(p + 4) = acc[ai][bj][m][1] * g1; } }
    }
};
struct EpiBrB {
    static constexpr bool PERM = true, AFTER_DRAIN = false;
    const bf16_t* G; const float* T1; bf16_t* MG;
    __device__ __forceinline__ void operator()(const f32x4 (&acc)[2][2][4][2], const Unit& u, int wr, int wc, int fr, int fq) const {
        const int row0 = u.pm * BM + wr * 64 + fr, col0 = u.pn * BM + wc * 32 + 8 * fq;
#pragma unroll
        PG8_EPI_ROWS { const int row = row0 + ai * HALF + m * 16;
#pragma unroll
            for (int bj = 0; bj < 2; ++bj) { const int c = col0 + bj * HALF; f32x4 g0, g1; unpack8(*(const u32x4*)(G + (size_t)row * 4096 + 2048 + c), g0, g1);
                const float* p = T1 + (size_t)row * 2048 + c; const f32x4 t0 = *(const f32x4*)p, t1 = *(const f32x4*)(p + 4);
                *(u32x4*)(MG + (size_t)row * 2048 + c) = pack8(t0 + acc[ai][bj][m][0] * g0, t1 + acc[ai][bj][m][1] * g1); } }
    }
};
struct EpiOut {
    static constexpr bool PERM = true, AFTER_DRAIN = false;
    const float* xp; const float* xs; float* X1; bf16_t* XB; float* SS;
    __device__ __forceinline__ void operator()(const f32x4 (&acc)[2][2][4][2], const Unit& u, int wr, int wc, int fr, int fq) const {
        const int row0 = u.pm * BM + wr * 64 + fr, col0 = u.pn * BM + wc * 32 + 8 * fq;
#pragma unroll
        PG8_EPI_ROWS { const int row = row0 + ai * HALF + m * 16;
            const float* xr = row < MPR ? xp + (size_t)row * 2048 : xs + (size_t)(row < MR ? row - MPR : 0) * 2048; const bool live = row < MR; float s = 0.f;
#pragma unroll
            for (int bj = 0; bj < 2; ++bj) { const int c = col0 + bj * HALF; f32x4 x0 = (f32x4){0.f, 0.f, 0.f, 0.f}, x1 = x0;
                if (live) { x0 = *(const f32x4*)(xr + c); x1 = *(const f32x4*)(xr + c + 4); }
                x0 = x0 + acc[ai][bj][m][0]; x1 = x1 + acc[ai][bj][m][1];
                s += (x0[0] * x0[0] + x0[1] * x0[1]) + (x0[2] * x0[2] + x0[3] * x0[3]) + (x1[0] * x1[0] + x1[1] * x1[1]) + (x1[2] * x1[2] + x1[3] * x1[3]);
                float* p = X1 + (size_t)row * 2048 + c; *(f32x4*)p = x0; *(f32x4*)(p + 4) = x1;
                *(u32x4*)(XB + (size_t)row * 2048 + c) = pack8(x0, x1); }
            s += __shfl_xor(s, 16); s += __shfl_xor(s, 32);
            if (fq == 0) SS[(size_t)row * 32 + u.pn * 4 + wc] = s; }
    }
};
struct EpiFF1 {
    static constexpr bool PERM = true, AFTER_DRAIN = false;
    const float* SS; bf16_t* H;
    __device__ __forceinline__ void operator()(const f32x4 (&acc)[2][2][4][2], const Unit& u, int wr, int wc, int fr, int fq) const {
        const int row0 = u.pm * BM + wr * 64 + fr, col0 = u.pn * HALF + wc * 32 + 8 * fq;
#pragma unroll
        PG8_EPI_ROWS { const int row = row0 + ai * HALF + m * 16; const f32x4* sp = (const f32x4*)(SS + (size_t)row * 32); f32x4 t = sp[0];
#pragma unroll
            for (int i = 1; i < 8; ++i) t = t + sp[i];
            const float r2 = 1.0f / sqrtf(((t[0] + t[1]) + (t[2] + t[3])) * (1.0f / 2048.0f) + RMS_EPS);
            f32x4 o[2];
#pragma unroll
            for (int n = 0; n < 2; ++n) { const f32x4 g = acc[ai][0][m][n] * r2, up = acc[ai][1][m][n] * r2;
                o[n] = (f32x4){g[0] * sigm(g[0]) * up[0], g[1] * sigm(g[1]) * up[1], g[2] * sigm(g[2]) * up[2], g[3] * sigm(g[3]) * up[3]}; }
            *(u32x4*)(H + (size_t)row * DFF + col0) = pack8(o[0], o[1]); }
    }
};
struct EpiFF2 {
    static constexpr bool PERM = true, AFTER_DRAIN = false;
    const float* X1; float* yp; float* ys;
    __device__ __forceinline__ void operator()(const f32x4 (&acc)[2][2][4][2], const Unit& u, int wr, int wc, int fr, int fq) const {
        const int row0 = u.pm * BM + wr * 64 + fr, col0 = u.pn * BM + wc * 32 + 8 * fq;
#pragma unroll
        PG8_EPI_ROWS { const int row = row0 + ai * HALF + m * 16; if (row >= MR) continue;
            float* orow = row < MPR ? yp + (size_t)row * 2048 : ys + (size_t)(row - MPR) * 2048;
#pragma unroll
            for (int bj = 0; bj < 2; ++bj) { const int c = col0 + bj * HALF; const float* p = X1 + (size_t)row * 2048 + c;
                *(f32x4*)(orow + c) = *(const f32x4*)p + acc[ai][bj][m][0]; *(f32x4*)(orow + c + 4) = *(const f32x4*)(p + 4) + acc[ai][bj][m][1]; } }
    }
};
template <class Epi, class Sched, bool ALIGN_EPI = false, bool SP2 = false>
__device__ __forceinline__ void gemm_phase(PG8_LAS unsigned char* lds, const Gemm g, const Sched& S, const Epi& E) {
    const int tid = threadIdx.x, wid = __builtin_amdgcn_readfirstlane(tid >> 6), lane = tid & 63, wr = wid >> 2, wc = wid & 3, fr = lane & 15, fq = lane >> 4;
    const int K = g.K, nt = K / BK;
    unsigned voffA[2], voffB[2];
#pragma unroll
    for (int i = 0; i < 2; ++i) { int R, C; stage_rc(tid * 16 + i * 8192, R, C); const int Rb = Epi::PERM ? ((R & ~31) + perm32(R & 31)) : R;
        voffA[i] = (unsigned)(R * g.lda + C) * 2u; voffB[i] = (unsigned)(Rb * g.ldb + C) * 2u; }
    const size_t kstep = (size_t)(BK * 2);
    const size_t hsA = (size_t)HALF * g.lda * 2, hsB = (size_t)HALF * g.ldb * 2;
    const size_t tsA = 2 * hsA, tsB = 2 * hsB;
    const unsigned ldsw = (unsigned)wid * 1024u;
    const int aoff = lds_byte(wr * 64 + fr, fq * 8), boff = lds_byte(wc * 32 + fr, fq * 8);
#define PG8_SA(b, h) (((b) * 2 + (h)) * HTB)
#define PG8_SB(b, h) ((4 + (b) * 2 + (h)) * HTB)
#define PG8_STAGE(bufoff, gbase, voff) do { _Pragma("unroll") for (int _i = 0; _i < 2; ++_i) \
        __builtin_amdgcn_global_load_lds((const unsigned*)((const char*)(gbase) + (voff)[_i]), (PG8_LAS unsigned*)(lds + (bufoff) + ldsw + _i * 8192), 16, 0, 0); } while (0)
#define PG8_LDA(dst, b, h) do { _Pragma("unroll") for (int m = 0; m < 4; ++m) _Pragma("unroll") for (int k = 0; k < 2; ++k) dst[m][k] = *(const PG8_LAS bf16x8*)(lds + PG8_SA(b, h) + aoff + m * 2048 + k * 1024); } while (0)
#define PG8_LDB(dst, b, h) do { _Pragma("unroll") for (int n = 0; n < 2; ++n) _Pragma("unroll") for (int k = 0; k < 2; ++k) dst[n][k] = *(const PG8_LAS bf16x8*)(lds + PG8_SB(b, h) + boff + n * 2048 + k * 1024); } while (0)
#define PG8_MMA(ai, bj, At, Bt) do { __builtin_amdgcn_s_setprio(1); _Pragma("unroll") for (int m = 0; m < 4; ++m) _Pragma("unroll") for (int n = 0; n < 2; ++n) _Pragma("unroll") for (int k = 0; k < 2; ++k) \
        acc[ai][bj][m][n] = __builtin_amdgcn_mfma_f32_16x16x32_bf16(Bt[n][k], At[m][k], acc[ai][bj][m][n], 0, 0, 0); __builtin_amdgcn_s_setprio(0); } while (0)
#define PG8_WAIT_V(n) asm volatile("s_waitcnt vmcnt(" #n ")" ::: "memory")
#define PG8_WAIT_L(n) asm volatile("s_waitcnt lgkmcnt(" #n ")" ::: "memory")
#define PG8_BAR __builtin_amdgcn_s_barrier()
#define PG8_SCHED __builtin_amdgcn_sched_barrier(0)
    Unit cur, nxt; int ui = 0;
    if (!S.next(0, cur)) return;
    f32x4 acc[2][2][4][2];
#pragma unroll
    for (int a = 0; a < 2; ++a)
#pragma unroll
        for (int b = 0; b < 2; ++b)
#pragma unroll
            for (int m = 0; m < 4; ++m)
#pragma unroll
                for (int n = 0; n < 2; ++n) acc[a][b][m][n] = (f32x4){0.f, 0.f, 0.f, 0.f};
    bf16x8 At[4][2], B0[2][2], B1[2][2];
    const char* cA = (const char*)g.A + (size_t)cur.pm * tsA; const char* cB = (const char*)g.Bt + (size_t)cur.pn * tsB;
    S.a_ready(cur);
    if constexpr (SP2) {
        PG8_STAGE(PG8_SB(0, 0), cB, voffB); PG8_STAGE(PG8_SB(0, 1), cB + hsB, voffB); PG8_STAGE(PG8_SA(0, 0), cA, voffA); PG8_STAGE(PG8_SA(0, 1), cA + hsA, voffA);
        if (wr == 1) PG8_BAR;
        PG8_WAIT_V(2); PG8_BAR;
        PG8_STAGE(PG8_SB(1, 0), cB + kstep, voffB); PG8_STAGE(PG8_SA(1, 0), cA + kstep, voffA); PG8_STAGE(PG8_SB(1, 1), cB + hsB + kstep, voffB);
        PG8_WAIT_V(6); PG8_BAR;
    } else {
        PG8_STAGE(PG8_SB(0, 0), cB, voffB); PG8_STAGE(PG8_SA(0, 0), cA, voffA); PG8_STAGE(PG8_SB(0, 1), cB + hsB, voffB); PG8_STAGE(PG8_SA(0, 1), cA + hsA, voffA);
        if (wr == 1) PG8_BAR;
        PG8_WAIT_V(4); PG8_BAR;
        PG8_STAGE(PG8_SB(1, 0), cB + kstep, voffB); PG8_STAGE(PG8_SA(1, 0), cA + kstep, voffA); PG8_STAGE(PG8_SB(1, 1), cB + hsB + kstep, voffB);
        PG8_WAIT_V(6); PG8_BAR;
    }
    for (;;) {
        const bool has_next = S.next(ui + 1, nxt);
        const char* nA = has_next ? (const char*)g.A + (size_t)nxt.pm * tsA : cA; const char* nB = has_next ? (const char*)g.Bt + (size_t)nxt.pn * tsB : cB;
        for (int t = 0; t < nt; t += 2) {
            const bool last = (t == nt - 2);
            const char* a1 = cA + (size_t)(t + 1) * kstep;
            const char* a2 = last ? nA : cA + (size_t)(t + 2) * kstep; const char* b2 = last ? nB : cB + (size_t)(t + 2) * kstep;
            const char* a3 = a2 + kstep; const char* b3 = b2 + kstep;
            if (last && has_next) S.a_ready(nxt);
            if constexpr (SP2) {
            PG8_LDB(B0, 0, 0); PG8_LDB(B1, 0, 1); PG8_SCHED; PG8_LDA(At, 0, 0); PG8_STAGE(PG8_SA(1, 1), a1 + hsA, voffA);
            PG8_WAIT_V(8); PG8_WAIT_L(0); PG8_BAR; PG8_MMA(0, 0, At, B0); PG8_MMA(0, 1, At, B1); PG8_BAR; PG8_SCHED;
            PG8_LDA(At, 0, 1); PG8_STAGE(PG8_SB(0, 0), b2, voffB); PG8_STAGE(PG8_SB(0, 1), b2 + hsB, voffB); PG8_STAGE(PG8_SA(0, 0), a2, voffA);
            PG8_WAIT_V(8); PG8_WAIT_L(0); PG8_BAR; PG8_MMA(1, 0, At, B0); PG8_MMA(1, 1, At, B1); PG8_BAR; PG8_SCHED;
            PG8_LDB(B0, 1, 0); PG8_LDB(B1, 1, 1); PG8_SCHED; PG8_LDA(At, 1, 0); PG8_STAGE(PG8_SA(0, 1), a2 + hsA, voffA);
            PG8_WAIT_V(8); PG8_WAIT_L(0); PG8_BAR; PG8_MMA(0, 0, At, B0); PG8_MMA(0, 1, At, B1); PG8_BAR; PG8_SCHED;
            PG8_LDA(At, 1, 1); PG8_STAGE(PG8_SB(1, 0), b3, voffB); PG8_STAGE(PG8_SB(1, 1), b3 + hsB, voffB); PG8_STAGE(PG8_SA(1, 0), a3, voffA);
            PG8_WAIT_V(8); PG8_WAIT_L(0); PG8_BAR; PG8_MMA(1, 0, At, B0); PG8_MMA(1, 1, At, B1); PG8_BAR; PG8_SCHED;
            } else {
            PG8_LDB(B0, 0, 0); PG8_SCHED; PG8_LDA(At, 0, 0); PG8_STAGE(PG8_SA(1, 1), a1 + hsA, voffA);
            PG8_WAIT_L(8); PG8_BAR; PG8_WAIT_L(0); PG8_MMA(0, 0, At, B0); PG8_BAR; PG8_SCHED;
            PG8_LDB(B1, 0, 1); PG8_STAGE(PG8_SB(0, 0), b2, voffB);
            PG8_BAR; PG8_WAIT_L(0); PG8_MMA(0, 1, At, B1); PG8_BAR;
            PG8_LDA(At, 0, 1); PG8_STAGE(PG8_SA(0, 0), a2, voffA);
            PG8_BAR; PG8_WAIT_L(0); PG8_MMA(1, 0, At, B0); PG8_BAR; PG8_SCHED;
            PG8_STAGE(PG8_SB(0, 1), b2 + hsB, voffB);
            PG8_WAIT_V(6); PG8_BAR; PG8_MMA(1, 1, At, B1); PG8_BAR;
            PG8_LDB(B0, 1, 0); PG8_SCHED; PG8_LDA(At, 1, 0); PG8_STAGE(PG8_SA(0, 1), a2 + hsA, voffA);
            PG8_WAIT_L(8); PG8_BAR; PG8_WAIT_L(0); PG8_MMA(0, 0, At, B0); PG8_BAR; PG8_SCHED;
            PG8_LDB(B1, 1, 1); PG8_STAGE(PG8_SB(1, 0), b3, voffB);
            PG8_BAR; PG8_WAIT_L(0); PG8_MMA(0, 1, At, B1); PG8_BAR;
            PG8_LDA(At, 1, 1); PG8_STAGE(PG8_SA(1, 0), a3, voffA);
            PG8_BAR; PG8_WAIT_L(0); PG8_MMA(1, 0, At, B0); PG8_BAR; PG8_SCHED;
            PG8_STAGE(PG8_SB(1, 1), b3 + hsB, voffB);
            PG8_WAIT_V(6); PG8_BAR; PG8_MMA(1, 1, At, B1); PG8_BAR;
            }
        }
        if constexpr (ALIGN_EPI) { if (wr == 0) PG8_BAR; }
        if constexpr (!Epi::AFTER_DRAIN) { E(acc, cur, wr, wc, fr, fq); S.done(cur); }
        if (!has_next) break;
#pragma unroll
        for (int a = 0; a < 2; ++a)
#pragma unroll
            for (int b = 0; b < 2; ++b)
#pragma unroll
                for (int m = 0; m < 4; ++m)
#pragma unroll
                    for (int n = 0; n < 2; ++n) acc[a][b][m][n] = (f32x4){0.f, 0.f, 0.f, 0.f};
        cur = nxt; cA = nA; cB = nB; ++ui;
        if constexpr (ALIGN_EPI) { if (wr == 1) PG8_BAR; }
    }
    PG8_WAIT_V(0);
    if constexpr (!ALIGN_EPI) { if (wr == 0) PG8_BAR; }
    PG8_BAR;
    if constexpr (Epi::AFTER_DRAIN) { E.fused(acc, cur, wr, wc, fr, fq, lds, wid, lane); S.done(cur); }
#undef PG8_SA
#undef PG8_SB
#undef PG8_STAGE
#undef PG8_LDA
#undef PG8_LDB
#undef PG8_MMA
#undef PG8_WAIT_V
#undef PG8_WAIT_L
#undef PG8_BAR
#undef PG8_SCHED
}
}
namespace pattn {
constexpr int D = 128; constexpr float THR = 8.f; constexpr bool WSKIP = false;
constexpr float SCALE = 0.08838834764831845f;
constexpr int NW = 8, QBLK = 32, KVBLK = 64, QB = NW * QBLK;
constexpr int SHM_V = KVBLK * D * 2, SHM_K = KVBLK * D * 2;
constexpr int LDS_CK = 2 * SHM_V + 2 * SHM_K + NW * 64 * 4;
constexpr int LDS_BYTES = LDS_CK + 2 * 2048;
constexpr int OSTR = 2048;
using bf16 = __hip_bfloat16;
typedef short bf16x8 __attribute__((ext_vector_type(8)));
typedef short s16x4 __attribute__((ext_vector_type(4)));
typedef float f32x16 __attribute__((ext_vector_type(16)));
typedef float f32x4 __attribute__((ext_vector_type(4)));
typedef unsigned u32x4 __attribute__((ext_vector_type(4)));
template <class A, class Bt> struct same_t { static constexpr bool v = false; };
template <class A> struct same_t<A, A> { static constexpr bool v = true; };

#define KSWZ(row, colB) ((row) * 256 + ((colB) ^ (((row) & 7) << 4)))
#define SBAR() __builtin_amdgcn_sched_barrier(0)
__device__ __forceinline__ int v_st(int k, int c) { const int kk = (k & ~0xC) | ((k & 4) << 1) | ((k & 8) >> 1); return ((kk >> 3) * 4 + (c >> 5)) * 512 + ((kk & 7) * 32 + (c & 31)) * 2; }
__device__ __forceinline__ int v_rd_base(int lane) { return ((lane & 3) << 3) | (((lane >> 2) & 3) << 6) | (((lane >> 4) & 1) << 5) | (((lane >> 5) & 1) << 8); }
constexpr int v_rd_off(int d0, int ks, int half) { return d0 * 512 + ks * 4096 + half * 2048; }
__device__ __forceinline__ int crow(int r, int hi) { return (r & 3) + 8 * (r >> 2) + 4 * hi; }
__device__ __forceinline__ unsigned cvtpk(float lo, float hi) {
    unsigned r; asm volatile("v_cvt_pk_bf16_f32 %0, %1, %2" : "=v"(r) : "v"(lo), "v"(hi)); return r;
}
__device__ __forceinline__ bf16x8 pack8(f32x4 a, f32x4 b) {
    u32x4 w = {cvtpk(a[0], a[1]), cvtpk(a[2], a[3]), cvtpk(b[0], b[1]), cvtpk(b[2], b[3])};
    return *reinterpret_cast<bf16x8*>(&w);
}
template <class T> __device__ __forceinline__ bf16x8 load8(const T* p) {
    if constexpr (same_t<T, float>::v) { return pack8(*(const f32x4*)p, *(const f32x4*)(p + 4)); }
    else { return *reinterpret_cast<const bf16x8*>(p); }
}
__device__ __forceinline__ void mask_tile(f32x16& p0, f32x16& p1, int dq, unsigned W) {
    const float NEG = -__builtin_inff();
#pragma unroll
    for (int r = 0; r < 16; ++r) {
        const int c = (r & 3) + 8 * (r >> 2);
        if ((unsigned)(dq - c) >= W) p0[r] = NEG;
        if ((unsigned)(dq - c - 32) >= W) p1[r] = NEG;
    }
}
__device__ __forceinline__ void partialSM(f32x16& p0, f32x16& p1, float& m_reg, float& mn, float& alpha) {
    float pmax = p0[0]; for (int r = 1; r < 16; ++r) pmax = fmaxf(pmax, p0[r]); for (int r = 0; r < 16; ++r) pmax = fmaxf(pmax, p1[r]);
    { auto rr = __builtin_amdgcn_permlane32_swap(__float_as_uint(pmax), __float_as_uint(pmax), false, false);
      pmax = fmaxf(__uint_as_float(rr[0]), __uint_as_float(rr[1])); }
    constexpr float C2 = 1.4426950408889634f * SCALE;
    if (__builtin_expect(__all((pmax - m_reg) * SCALE <= THR), 1)) { mn = m_reg; alpha = 1.f; }
    else { mn = fmaxf(m_reg, pmax); alpha = __builtin_amdgcn_exp2f((m_reg - mn) * C2); m_reg = mn; }
    const float mnL = -mn * C2;
    for (int r = 0; r < 16; ++r) p0[r] = fmaf(p0[r], C2, mnL); for (int r = 0; r < 16; ++r) p1[r] = fmaf(p1[r], C2, mnL);
    for (int r = 0; r < 16; ++r) p0[r] = __builtin_amdgcn_exp2f(p0[r]);
}
__device__ __forceinline__ void finishSM(f32x16& p0, f32x16& p1, float alpha, float& l_reg, bf16x8& pa0, bf16x8& pa1, bf16x8& pa2, bf16x8& pa3) {
    for (int r = 0; r < 16; ++r) p1[r] = __builtin_amdgcn_exp2f(p1[r]);
    float ps = 0; for (int r = 0; r < 16; ++r) ps += p0[r]; for (int r = 0; r < 16; ++r) ps += p1[r];
    { auto rr = __builtin_amdgcn_permlane32_swap(__float_as_uint(ps), __float_as_uint(ps), false, false);
      ps = __uint_as_float(rr[0]) + __uint_as_float(rr[1]); }
    l_reg = l_reg * alpha + ps;
#define PK4(P, B_, OUT) do { unsigned a0 = cvtpk(P[B_+0], P[B_+1]), a1 = cvtpk(P[B_+2], P[B_+3]);                          \
        unsigned b0 = cvtpk(P[B_+4], P[B_+5]), b1 = cvtpk(P[B_+6], P[B_+7]);                                             \
        auto r0 = __builtin_amdgcn_permlane32_swap(a0, b0, false, false); auto r1 = __builtin_amdgcn_permlane32_swap(a1, b1, false, false); \
        u32x4 w = {r0[0], r1[0], r0[1], r1[1]}; OUT = *reinterpret_cast<bf16x8*>(&w); } while (0)
    PK4(p0, 0, pa0); PK4(p0, 8, pa1); PK4(p1, 0, pa2); PK4(p1, 8, pa3);
#undef PK4
}
template <int KB, bool SK>
__device__ __forceinline__ void qkt(f32x16& p0, f32x16& p1, const char* K_lds, const char* CK_lds, int r32, int hi, const bf16x8* qr, bool act) {
    if (SK && !act) { const float NEG = -__builtin_inff();
#pragma unroll
        for (int r = 0; r < 16; ++r) { p0[r] = NEG; p1[r] = NEG; } return; }
    p0 = f32x16{}; p1 = f32x16{};
    const char* kb[4];
#pragma unroll
    for (int dd = 0; dd < 4; ++dd) kb[dd] = K_lds + KB * SHM_K + KSWZ(r32, (dd * 16 + hi * 8) * 2);
#pragma unroll
    for (int d0 = 0; d0 < 8; ++d0) { const char* a = kb[d0 & 3] + (d0 >> 2) * 128;
        bf16x8 b0 = *reinterpret_cast<const bf16x8*>(a);
        bf16x8 b1 = *reinterpret_cast<const bf16x8*>(a + 32 * 256);
        p0 = __builtin_amdgcn_mfma_f32_32x32x16_bf16(b0, qr[d0], p0, 0, 0, 0);
        p1 = __builtin_amdgcn_mfma_f32_32x32x16_bf16(b1, qr[d0], p1, 0, 0, 0); }
#ifndef NO_FOX
    {
        const char* a = CK_lds + KB * 2048 + r32 * 32 + hi * 16; const bf16x8 c0 = *reinterpret_cast<const bf16x8*>(a), c1 = *reinterpret_cast<const bf16x8*>(a + 1024);
        const short one = (short)0x3F80; const bf16x8 ones = {one, one, one, one, one, one, one, one};
        p0 = __builtin_amdgcn_mfma_f32_32x32x16_bf16(c0, ones, p0, 0, 0, 0); p1 = __builtin_amdgcn_mfma_f32_32x32x16_bf16(c1, ones, p1, 0, 0, 0); }
#endif
}
template <int VB, bool SK>
__device__ __forceinline__ void pv_tile(f32x16* o, int vb0, bf16x8 pa0, bf16x8 pa1, bf16x8 pa2, bf16x8 pa3, bool act) {
    if (SK && !act) return;
#define TRRD(dst, off) asm volatile("ds_read_b64_tr_b16 %0, %1 offset:%2" : "=&v"(dst) : "v"(vb0), "i"(off) : "memory")
#define PV_D0(d0) do { s16x4 l0, l1, l2, l3, h0, h1, h2, h3; constexpr int b_ = VB * SHM_V + v_rd_off(d0, 0, 0);     \
        TRRD(l0, b_); TRRD(h0, b_ + 2048); TRRD(l1, b_ + 4096); TRRD(h1, b_ + 6144); TRRD(l2, b_ + 8192); TRRD(h2, b_ + 10240); TRRD(l3, b_ + 12288); TRRD(h3, b_ + 14336); \
        asm volatile("s_waitcnt lgkmcnt(0)" ::: "memory"); SBAR();                 \
        o[d0] = __builtin_amdgcn_mfma_f32_32x32x16_bf16(pa0, (bf16x8){l0[0], l0[1], l0[2], l0[3], h0[0], h0[1], h0[2], h0[3]}, o[d0], 0, 0, 0);   \
        o[d0] = __builtin_amdgcn_mfma_f32_32x32x16_bf16(pa1, (bf16x8){l1[0], l1[1], l1[2], l1[3], h1[0], h1[1], h1[2], h1[3]}, o[d0], 0, 0, 0);   \
        o[d0] = __builtin_amdgcn_mfma_f32_32x32x16_bf16(pa2, (bf16x8){l2[0], l2[1], l2[2], l2[3], h2[0], h2[1], h2[2], h2[3]}, o[d0], 0, 0, 0);   \
        o[d0] = __builtin_amdgcn_mfma_f32_32x32x16_bf16(pa3, (bf16x8){l3[0], l3[1], l3[2], l3[3], h3[0], h3[1], h3[2], h3[3]}, o[d0], 0, 0, 0); } while (0)
    PV_D0(0); PV_D0(1); PV_D0(2); PV_D0(3);
#undef PV_D0
#undef TRRD
}

template <class TIn, class TOut> struct BlockRef { const TIn* Q; const TIn* K; const TIn* V; TOut* O; const unsigned short* CK; int P0; };
template <class TIn> struct Seam {
    bf16x8 qr[8];
    bf16x8 st_v0, st_v1, st_k0, st_k1; f32x4 sf0, sf1, sf2, sf3;
    f32x4 tq[16];
};
__device__ __forceinline__ int swa_jlo(int P0, int W) { const int lowk = P0 - W + 1; return lowk > 0 ? lowk / KVBLK : 0; }
#define ROW(p, k0, rr) ((p) + (int)(((k0) + (rr)) * D + sc))
#define VMW() asm volatile("s_waitcnt vmcnt(0)" ::: "memory")
#define VMWN(n) asm volatile("s_waitcnt vmcnt(%0)" :: "i"(n) : "memory")
#define SLOAD_H(Kp, Vp, CKp, k0, bf) do { S.st_v0 = load8<TIn>(ROW(Vp, k0, sr)); S.st_v1 = load8<TIn>(ROW(Vp, k0, 32 + sr));              \
                         S.st_k0 = load8<TIn>(ROW(Kp, k0, sr)); S.st_k1 = load8<TIn>(ROW(Kp, k0, 32 + sr)); if (wid < 2) __builtin_amdgcn_global_load_lds((const unsigned*)((CKp) + (int)(((k0) + wid * 32) * 16 + lane * 8)), (__attribute__((address_space(3))) unsigned*)(CK_lds + (bf) * 2048 + wid * 1024), 16, 0, 0); } while (0)
#define SWRITE_HK(bf) do { *(bf16x8*)(K_lds + (bf) * SHM_K + kws) = S.st_k0; *(bf16x8*)(K_lds + (bf) * SHM_K + kws + 32 * 256) = S.st_k1; } while (0)
#define SWRITE_HV(bf) do { *(bf16x8*)(V_lds + (bf) * SHM_V + vst0) = S.st_v0; *(bf16x8*)(V_lds + (bf) * SHM_V + vst1) = S.st_v1; } while (0)
#define SWRITE_H(bf) do { SWRITE_HV(bf); SWRITE_HK(bf); } while (0)
#define SLOAD_F(p, k0) do { S.sf0 = *(const f32x4*)ROW(p, k0, sr); S.sf1 = *(const f32x4*)(ROW(p, k0, sr) + 4);                \
                            S.sf2 = *(const f32x4*)ROW(p, k0, 32 + sr); S.sf3 = *(const f32x4*)(ROW(p, k0, 32 + sr) + 4); } while (0)
#define SWRITE_KF(bf) do { *(bf16x8*)(K_lds + (bf) * SHM_K + kws) = pack8(S.sf0, S.sf1); *(bf16x8*)(K_lds + (bf) * SHM_K + kws + 32 * 256) = pack8(S.sf2, S.sf3); } while (0)
#define SWRITE_VF(bf) do { *(bf16x8*)(V_lds + (bf) * SHM_V + vst0) = pack8(S.sf0, S.sf1); *(bf16x8*)(V_lds + (bf) * SHM_V + vst1) = pack8(S.sf2, S.sf3); } while (0)
template <class TIn, class TOut>
__device__ __forceinline__ void causal_swa_prime(const BlockRef<TIn, TOut>& cur, int W, char* lds, Seam<TIn>& S, int wid_in, int lane_in) {
    constexpr bool F32 = same_t<TIn, float>::v;
    const int wid = wid_in, lane = lane_in, tid = wid * 64 + lane, r32 = lane & 31, hi = lane >> 5;
    const int sr = tid >> 4, sc = (tid & 15) * 8, kws = KSWZ(sr, sc * 2); char* K_lds = lds + 2 * SHM_V; char* CK_lds = lds + LDS_CK;
    const int kb0 = swa_jlo(cur.P0, W) * KVBLK;
    for (int d0 = 0; d0 < 8; ++d0) S.qr[d0] = load8<TIn>(cur.Q + ((wid * QBLK + r32) * D + hi * 8) + d0 * 16);
    if constexpr (F32) { SLOAD_F((const float*)cur.K, kb0); VMW(); SWRITE_KF(0); SBAR(); SLOAD_F((const float*)cur.V, kb0); }
    else { SLOAD_H(cur.K, cur.V, cur.CK, kb0, 0); VMW(); SWRITE_HK(0); }
    __syncthreads();
}
template <class TIn, class TOut>
__device__ __forceinline__ void causal_swa_block(const BlockRef<TIn, TOut>& cur, const BlockRef<TIn, TOut>& nxt, int skv, int W, char* lds, Seam<TIn>& S, int wid_in, int lane_in) {
    constexpr bool F32 = same_t<TIn, float>::v;
    const int wid = wid_in, lane = lane_in, tid = wid * 64 + lane, r32 = lane & 31, hi = lane >> 5;
    const int j_lo = swa_jlo(cur.P0, W);
    int j_hi = (cur.P0 + QB - 1) / KVBLK + 1; if (j_hi > skv / KVBLK) j_hi = skv / KVBLK;
    const int NT = j_hi - j_lo;
    const int kbn = swa_jlo(nxt.P0, W) * KVBLK;
    const int qlo = cur.P0 + wid * QBLK, qm = qlo + r32 - 4 * hi;
    char* V_lds = lds; char* K_lds = lds + 2 * SHM_V; char* CK_lds = lds + LDS_CK;
    float* ws = (float*)(lds + 2 * SHM_V + 2 * SHM_K) + wid * 64; float* li_l = ws, * al_l = ws + 32;
    float m_reg = -1e30f, l_reg = 0; f32x16 o[4] = {};
    const int sr = tid >> 4, sc = (tid & 15) * 8, vst0 = v_st(sr, sc), vst1 = v_st(32 + sr, sc), kws = KSWZ(sr, sc * 2);
    const int vb0 = (int)(uintptr_t)V_lds + v_rd_base(lane);
    const TIn* Kh = cur.K; const TIn* Vh = cur.V; const unsigned short* CKh = cur.CK;
#define RESC(a) do { if (__any((a) < 1.f)) { if (hi == 0) al_l[r32] = (a); asm volatile("s_waitcnt lgkmcnt(0)" ::: "memory");              \
                     for (int d_ = 0; d_ < 4; ++d_) for (int r = 0; r < 16; ++r) o[d_][r] *= al_l[crow(r, hi)]; } } while (0)
#define KBASE(t) ((j_lo + (t)) * KVBLK)
#define ACT(t) (KBASE(t) <= qlo + QBLK - 1 && KBASE(t) + KVBLK - 1 >= qlo - W + 1)
#define MASKT(P0_, P1_, t) do { const int kb_ = KBASE(t); if ((!SK || ACT(t)) && (kb_ + KVBLK - 1 > qlo || kb_ <= qlo + QBLK - 1 - W)) mask_tile(P0_, P1_, qm - kb_, (unsigned)W); } while (0)
    constexpr int NQL = F32 ? 16 : 8;
    constexpr bool SK = WSKIP && !F32;
#define SEAM_K0() do { VMWN(NQL); if constexpr (F32) { SWRITE_KF(0); SBAR(); SLOAD_F((const float*)nxt.V, kbn); } else { SWRITE_HK(0); } SBAR(); } while (0)
    f32x16 pA0, pA1, pB0, pB1; float mnA, mnB, alA, alB; bf16x8 pa0, pa1, pa2, pa3;
    if constexpr (F32) { VMW(); SWRITE_VF(0); SBAR(); } else { SWRITE_HV(0); SBAR(); }
    if (NT > 1) { if constexpr (F32) SLOAD_F((const float*)Kh, KBASE(1)); else SLOAD_H(Kh, Vh, CKh, KBASE(1), 1); }
    SBAR(); qkt<0, SK>(pA0, pA1, K_lds, CK_lds, r32, hi, S.qr, ACT(0));
    if constexpr (F32) { if (NT > 1) { VMW(); SWRITE_KF(1); SBAR(); SLOAD_F((const float*)Vh, KBASE(1)); } }
    MASKT(pA0, pA1, 0); partialSM(pA0, pA1, m_reg, mnA, alA);
    if (NT > 1) { VMW(); if constexpr (F32) { SWRITE_VF(1); SBAR(); if (NT > 2) SLOAD_F((const float*)Kh, KBASE(2)); } else SWRITE_H(1); }
    __syncthreads();
#define HALF_STEP(PX0, PX1, mnX, alX, PY0, PY1, alY, t, KB, VB, SB) do {                                                      \
        SBAR(); qkt<KB, SK>(PX0, PX1, K_lds, CK_lds, r32, hi, S.qr, ACT(t));                                             \
        finishSM(PY0, PY1, alY, l_reg, pa0, pa1, pa2, pa3); SBAR();                                                           \
        if ((t) + 1 < NT) { if constexpr (F32) { VMW(); SWRITE_KF(SB); SBAR(); SLOAD_F((const float*)Vh, KBASE((t) + 1)); }  \
                            else { SLOAD_H(Kh, Vh, CKh, KBASE((t) + 1), SB); } SBAR(); }                                               \
        pv_tile<VB, SK>(o, vb0, pa0, pa1, pa2, pa3, ACT((t) - 1)); MASKT(PX0, PX1, (t)); partialSM(PX0, PX1, m_reg, mnX, alX);                                        \
        __syncthreads();                                                                                                      \
        if ((t) + 1 < NT) { VMW(); if constexpr (F32) { SWRITE_VF(SB); SBAR(); if ((t) + 2 < NT) SLOAD_F((const float*)Kh, KBASE((t) + 2)); } \
                            else { SWRITE_H(SB); } }                                                                          \
        RESC(alX); __syncthreads(); } while (0)
    for (int t = 1; t + 1 < NT; t += 2) {
        HALF_STEP(pB0, pB1, mnB, alB, pA0, pA1, alA, t, 1, 0, 0);
        HALF_STEP(pA0, pA1, mnA, alA, pB0, pB1, alB, t + 1, 0, 1, 1);
    }
    const bool even = (NT & 1) == 0;
    if (even) { SBAR(); qkt<1, SK>(pB0, pB1, K_lds, CK_lds, r32, hi, S.qr, ACT(NT - 1)); SBAR(); }
#define QROW(e) (nxt.Q + (size_t)(wid * QBLK + r32) * D + ((e) >> 1) * 16 + hi * 8 + ((e) & 1) * 4)
    if constexpr (F32) { SLOAD_F((const float*)nxt.K, kbn); SBAR();
#pragma unroll
        for (int e = 0; e < 8; ++e) S.tq[e] = *(const f32x4*)QROW(e); }
    else { SLOAD_H(nxt.K, nxt.V, nxt.CK, kbn, 0); SBAR();
#pragma unroll
        for (int d0 = 0; d0 < 8; ++d0) S.qr[d0] = load8<TIn>(nxt.Q + ((wid * QBLK + r32) * D + hi * 8) + d0 * 16); }
    SBAR();
    finishSM(pA0, pA1, alA, l_reg, pa0, pa1, pa2, pa3); SBAR();
    if constexpr (F32) {
#pragma unroll
        for (int e = 8; e < 16; ++e) S.tq[e] = *(const f32x4*)QROW(e); SBAR(); }
#undef QROW
    pv_tile<0, SK>(o, vb0, pa0, pa1, pa2, pa3, ACT(even ? NT - 2 : NT - 1));
    if (even) { MASKT(pB0, pB1, NT - 1); partialSM(pB0, pB1, m_reg, mnB, alB); __syncthreads(); RESC(alB);
        finishSM(pB0, pB1, alB, l_reg, pa0, pa1, pa2, pa3); SBAR(); pv_tile<1, SK>(o, vb0, pa0, pa1, pa2, pa3, ACT(NT - 1)); }
    SBAR(); SEAM_K0();
    if (hi == 0) li_l[r32] = l_reg; asm volatile("s_waitcnt lgkmcnt(0)" ::: "memory");
    float rli[16];
#pragma unroll
    for (int r = 0; r < 16; ++r) rli[r] = __builtin_amdgcn_rcpf(li_l[crow(r, hi)]);
    int oo = (wid * QBLK + 4 * hi) * OSTR + r32;
#pragma unroll
    for (int r = 0; r < 16; ++r) {
        asm volatile("" : "+v"(oo));
#pragma unroll
        for (int d0 = 0; d0 < 4; ++d0) { const float v = o[d0][r] * rli[r];
            if constexpr (same_t<TOut, float>::v) { cur.O[oo + d0 * 32] = v; }
            else { const float vn = __shfl_xor(v, 1);
                   if ((r32 & 1) == 0) *(unsigned*)(cur.O + (oo + d0 * 32)) = cvtpk(v, vn); } }
        oo += ((r & 3) == 3) ? 5 * OSTR : OSTR; }
    if constexpr (F32) {
#pragma unroll
        for (int d0 = 0; d0 < 8; ++d0) S.qr[d0] = pack8(S.tq[2 * d0], S.tq[2 * d0 + 1]); }
    __syncthreads();
#undef RESC
#undef KBASE
#undef ACT
#undef MASKT
#undef SEAM_K0
#undef HALF_STEP
}
#undef ROW
#undef VMW
#undef VMWN
#undef SLOAD_H
#undef SWRITE_HK
#undef SWRITE_HV
#undef SWRITE_H
#undef SLOAD_F
#undef SWRITE_KF
#undef SWRITE_VF
}
#define GAS __attribute__((address_space(1)))
#define LAS __attribute__((address_space(3)))
typedef unsigned short bf16;
typedef unsigned v4u __attribute__((ext_vector_type(4)));
typedef float f32x4 __attribute__((ext_vector_type(4)));
typedef short bf16x8 __attribute__((ext_vector_type(8)));
typedef GAS unsigned gu32;
typedef GAS unsigned long long gu64;
#define RLX_AGENT __ATOMIC_RELAXED, __HIP_MEMORY_SCOPE_AGENT
#define LDS_WAIT() asm volatile("s_waitcnt lgkmcnt(0)" ::: "memory")
#define VM_WAIT() asm volatile("s_waitcnt vmcnt(0)" ::: "memory")
__device__ __forceinline__ unsigned long long rt() { return __builtin_amdgcn_s_memrealtime(); }
__device__ __forceinline__ unsigned f2bf(float f) { unsigned u = __builtin_bit_cast(unsigned, f); return (u + 0x7fffu + ((u >> 16) & 1u)) >> 16; }
__device__ __forceinline__ unsigned pk2(float lo, float hi) { return f2bf(lo) | (f2bf(hi) << 16); }

#define XB_TMO      128
#define XB_XCNT(j)  (256  + 64 * (j))
#define XB_XSUB(j)  (1280 + 64 * (j))
#define XB_XGEN(j)  (2304 + 64 * (j))
#define XB_TOP      3328
#define XB_TOPGEN   3392
#define XCD_BAR_WORDS 3456
#define XB_SPIN_CAP (1u << 18)

__device__ __forceinline__ unsigned xb_ld(unsigned* p)              { return __hip_atomic_load(p, __ATOMIC_RELAXED, __HIP_MEMORY_SCOPE_AGENT); }
__device__ __forceinline__ unsigned xb_add(unsigned* p, unsigned v) { return __hip_atomic_fetch_add(p, v, __ATOMIC_RELAXED, __HIP_MEMORY_SCOPE_AGENT); }
__device__ __forceinline__ unsigned xb_xcc_id() { return (unsigned)__builtin_amdgcn_s_getreg((3 << 11) | 20) & 0xFu; }
#define XB_SPIN(cond, bar) do { unsigned _sp = 0; while (cond) { __builtin_amdgcn_s_sleep(1); \
    if ((++_sp & 255u) == 0u) { if (xb_ld(&(bar)[XB_TMO])) break; if (_sp > XB_SPIN_CAP) { atomicAdd(&(bar)[XB_TMO], 1u); break; } } } } while (0)

struct XcdBarrier {
    unsigned* bar; unsigned x;
    volatile LAS unsigned* st;
};

__device__ __forceinline__ XcdBarrier xcd_barrier_post(unsigned* bar, volatile LAS unsigned* st) {
    XcdBarrier b; b.bar = bar; b.x = xb_xcc_id(); b.st = st;
    if (threadIdx.x == 0) (void)xb_add(&bar[XB_XCNT(b.x)], 1u);
    return b;
}
__device__ __forceinline__ void xcd_barrier_complete(unsigned* bar, unsigned x, unsigned& nloc, unsigned& nx) {
    const unsigned G = gridDim.x * gridDim.y * gridDim.z;
    unsigned sum, cnt, mine, sp = 0u;
    for (;;) {
        sum = 0u; cnt = 0u; mine = 0u;
#pragma unroll
        for (unsigned j = 0; j < 16; ++j) { const unsigned c = xb_ld(&bar[XB_XCNT(j)]); sum += c; cnt += (c > 0u) ? 1u : 0u; mine = (j == x) ? c : mine; }
        if (sum == G) break;
        __builtin_amdgcn_s_sleep(1);
        if ((++sp & 255u) == 0u) { if (xb_ld(&bar[XB_TMO])) break; if (sp > XB_SPIN_CAP) { atomicAdd(&bar[XB_TMO], 1u); break; } }
    }
    nloc = mine > 0u ? mine : 1u; nx = cnt > 0u ? cnt : 1u;
}

__device__ __forceinline__ void xcd_barrier(const XcdBarrier& b) {
    asm volatile("s_waitcnt vmcnt(0)" ::: "memory");
    __syncthreads();
    if (threadIdx.x == 0) {
        unsigned* bar = b.bar;
        __builtin_amdgcn_s_waitcnt(0);
        unsigned nloc = b.st[0], nx = b.st[1];
        if (nloc == 0u) { xcd_barrier_complete(bar, b.x, nloc, nx); b.st[0] = nloc; b.st[1] = nx; }
        const unsigned old = xb_add(&bar[XB_XSUB(b.x)], 1u);
        const unsigned gen = old / nloc;
        if (old + 1u == (gen + 1u) * nloc) {
            __builtin_amdgcn_fence(__ATOMIC_RELEASE, "agent");
            asm volatile("s_waitcnt vmcnt(0)" ::: "memory");
            const unsigned og = xb_add(&bar[XB_TOP], 1u);
            const unsigned tg = og / nx;
            if (og + 1u == (tg + 1u) * nx) xb_add(&bar[XB_TOPGEN], 1u);
            else XB_SPIN(xb_ld(&bar[XB_TOPGEN]) == tg, bar);
            __builtin_amdgcn_fence(__ATOMIC_ACQUIRE, "agent");
            xb_add(&bar[XB_XGEN(b.x)], 1u);
            asm volatile("s_waitcnt vmcnt(0)" ::: "memory");
        } else {
            XB_SPIN(xb_ld(&bar[XB_XGEN(b.x)]) == gen, bar);
            __builtin_amdgcn_fence(__ATOMIC_ACQUIRE, "agent");
            asm volatile("s_waitcnt vmcnt(0)" ::: "memory");
        }
    }
    __syncthreads();
}
constexpr size_t O_YP = 0, O_YS = O_YP + (size_t)MPR * DM, O_KP = O_YS + (size_t)MSM * DM, O_VP = O_KP + (size_t)MPR * DATT, O_LFP = O_VP + (size_t)MPR * DATT,
                 O_HRP = O_LFP + (size_t)MPR * NH, O_HIP = O_HRP + (size_t)NB * NG * NST, O_KS = O_HIP + (size_t)NB * NG * NST, O_VS = O_KS + (size_t)MSM * DATT,
                 O_LFS = O_VS + (size_t)MSM * DATT, O_HRS = O_LFS + (size_t)MSM * NH, O_HIS = O_HRS + (size_t)DBT * NG * NST, O_END = O_HIS + (size_t)DBT * NG * NST;
static_assert(O_END == 33833216, "output size");

constexpr size_t al256(size_t x) { return (x + 255) & ~(size_t)255; }
constexpr size_t WS_CTL = 0, CTL_ZERO_BYTES = 1u << 20;
constexpr size_t WS_W1T  = CTL_ZERO_BYTES;
constexpr size_t WS_WGLU = WS_W1T  + (size_t)8192 * 2048 * 2;
constexpr size_t WS_WBR  = WS_WGLU + (size_t)1024 * 1024 * 2;
constexpr size_t WS_WOUT = WS_WBR  + (size_t)2048 * 2048 * 2;
constexpr size_t WS_WFF1 = WS_WOUT + (size_t)2048 * 2048 * 2;
constexpr size_t WS_WFF2 = WS_WFF1 + (size_t)11264 * 2048 * 2;
constexpr size_t WS_XA   = WS_WFF2 + (size_t)2048 * 5632 * 2;
constexpr size_t WS_R1   = WS_XA   + (size_t)MPAD * 2048 * 2;
constexpr size_t WS_Z    = al256(WS_R1 + (size_t)MPAD * 4);
constexpr size_t WS_G    = WS_Z    + (size_t)MPAD * 4096 * 4;
constexpr size_t WS_YP   = WS_G    + (size_t)MPAD * 4096 * 2;
constexpr size_t WS_YY   = WS_YP   + (size_t)MPAD * 1024 * 2;
constexpr size_t WS_T1   = WS_YY   + (size_t)MPAD * 2048 * 2;
constexpr size_t WS_MG   = WS_T1   + (size_t)MPAD * 2048 * 4;
constexpr size_t WS_X1   = WS_MG   + (size_t)MPAD * 2048 * 2;
constexpr size_t WS_XB   = WS_X1   + (size_t)MPAD * 2048 * 4;
constexpr size_t WS_SS   = WS_XB   + (size_t)MPAD * 2048 * 2;
constexpr size_t WS_H    = WS_SS   + (size_t)MPAD * 32 * 4;
constexpr size_t WS_QB   = WS_H    + (size_t)MPAD * DFF * 2;
constexpr size_t WS_KB   = WS_QB   + (size_t)MPR * 1024 * 2;
constexpr size_t WS_VB   = WS_KB   + (size_t)MPR * 1024 * 2;
constexpr size_t WS_NCK  = WS_VB   + (size_t)MPR * 1024 * 2;
constexpr size_t WS_QS   = WS_NCK  + (size_t)NB * NH * SEQ * 16 * 2;
constexpr size_t WS_AB   = WS_QS   + (size_t)DBT * NH * DSQ * HD * 4;
constexpr size_t WS_AT   = WS_AB   + (size_t)NG * NST * 2 * 4;
constexpr size_t WS_BBR  = WS_AT   + (size_t)NG * NST * 2 * 4;
constexpr size_t WS_BBI  = WS_BBR  + (size_t)NG * NST * GC * 4;
constexpr size_t WS_E    = WS_BBI  + (size_t)NG * NST * GC * 4;
constexpr size_t WS_RP   = WS_E    + (size_t)NB * NCH * NG * 2 * NST * 4;
constexpr size_t WS_TPG  = WS_RP   + (size_t)DBT * NH * PAST * 4;
constexpr size_t WS_PML  = WS_TPG  + (size_t)DBT * NH * NPAGES * 4;
constexpr size_t WS_PO   = WS_PML  + (size_t)256 * 8 * 2 * 4;
constexpr size_t WS_END  = WS_PO   + (size_t)256 * 8 * 128 * 4;
constexpr int CW_BAR = 4096;

constexpr int LDS_BYTES = 147456;
constexpr int MISC_OFF = LDS_BYTES - 512;
constexpr int NWAVES = 8;
struct Args { const void* in[30]; float* out; unsigned char* ws; int ph_lo, ph_hi; };
struct Frame {
    unsigned char* lds;
    int tid, lane, wave, G, gw, NGW;
    float* out; unsigned char* ws;
};
template <int OFF> __device__ __forceinline__ unsigned long long karg_load() {
    unsigned long long v; auto kp = __builtin_amdgcn_kernarg_segment_ptr();
    asm volatile("s_load_dwordx2 %0, %1, %2\n\ts_waitcnt lgkmcnt(0)" : "=s"(v) : "s"(kp), "n"(OFF) : "memory"); return v; }
#define INP(T, i) ((const T*)karg_load<8 * (i)>())
enum { I_XP = 0, I_XS, I_CK, I_CV, I_CLF, I_SRE, I_SIM, I_PT, I_G1, I_WIN, I_BF, I_GQ, I_GK, I_ARE, I_AIM, I_LDT, I_BRE, I_BIM, I_CRE, I_CIM, I_DSSM, I_WGLU, I_BGLU, I_WBRS, I_WBRA, I_WOUT, I_G2, I_WFG, I_WFU, I_WFD };
#define WSP(T, off) ((T*)(F.ws + (off)))

__device__ __forceinline__ float wave_sum(float v) {
#pragma unroll
    for (int o = 1; o < 64; o <<= 1) v += __shfl_xor(v, o);
    return v;
}
__device__ __forceinline__ unsigned cvtpk(float lo, float hi) { unsigned r; asm volatile("v_cvt_pk_bf16_f32 %0, %1, %2" : "=v"(r) : "v"(lo), "v"(hi)); return r; }

__device__ __forceinline__ void p0_transpose_item(const float* W, int ldw, int src_col, bf16* WT, int ldd, int dst_row, int k0, int dst_k0, const float* gs, float* scr, int lane) {
#pragma unroll 8
    for (int i = 0; i < 32; ++i) { const int kk = 2 * i + (lane >> 5); float v = W[(size_t)(k0 + kk) * ldw + src_col + (lane & 31)]; if (gs) v *= gs[k0 + kk]; scr[kk * 33 + (lane & 31)] = v; }
    LDS_WAIT(); asm volatile("" ::: "memory");
    const int c = lane & 7;
#pragma unroll
    for (int j = 0; j < 4; ++j) { const int n = (lane >> 3) + 8 * j; const float* s = scr + (8 * c) * 33 + n;
        v4u o; o.x = cvtpk(s[0 * 33], s[1 * 33]); o.y = cvtpk(s[2 * 33], s[3 * 33]); o.z = cvtpk(s[4 * 33], s[5 * 33]); o.w = cvtpk(s[6 * 33], s[7 * 33]);
        *(v4u*)(WT + (size_t)(dst_row + n) * ldd + dst_k0 + k0 + 8 * c) = o; }
    LDS_WAIT(); asm volatile("" ::: "memory");
}
__device__ __forceinline__ void sincos_d(double x, double& s, double& c) {
    const double k = __builtin_rint(x * 0.63661977236758134308);
    double r = __builtin_fma(-k, 1.57079632679489655800e+00, x); r = __builtin_fma(-k, 6.12323399573676603587e-17, r);
    const long long q = (long long)k; const double r2 = r * r;
    double sp = -1.0 / 1307674368000.0; sp = sp * r2 + 1.0 / 6227020800.0; sp = sp * r2 - 1.0 / 39916800.0; sp = sp * r2 + 1.0 / 362880.0; sp = sp * r2 - 1.0 / 5040.0; sp = sp * r2 + 1.0 / 120.0; sp = sp * r2 - 1.0 / 6.0; sp = sp * r2 + 1.0; sp *= r;
    double cp = 1.0 / 20922789888000.0; cp = cp * r2 - 1.0 / 87178291200.0; cp = cp * r2 + 1.0 / 479001600.0; cp = cp * r2 - 1.0 / 3628800.0; cp = cp * r2 + 1.0 / 40320.0; cp = cp * r2 - 1.0 / 720.0; cp = cp * r2 + 1.0 / 24.0; cp = cp * r2 - 0.5; cp = cp * r2 + 1.0;
    const int qq = (int)(q & 3);
    s = (qq == 0) ? sp : (qq == 1) ? cp : (qq == 2) ? -sp : -cp;
    c = (qq == 0) ? cp : (qq == 1) ? -sp : (qq == 2) ? -cp : sp;
}
__device__ __forceinline__ double exp_d(double x) {
    const double k = __builtin_rint(x * 1.44269504088896338700e+00);
    double r = __builtin_fma(-k, 6.93147180369123816490e-01, x); r = __builtin_fma(-k, 1.90821492927058770002e-10, r);
    double p = 1.0 / 6227020800.0; p = p * r + 1.0 / 479001600.0; p = p * r + 1.0 / 39916800.0; p = p * r + 1.0 / 3628800.0; p = p * r + 1.0 / 362880.0; p = p * r + 1.0 / 40320.0; p = p * r + 1.0 / 5040.0;
    p = p * r + 1.0 / 720.0; p = p * r + 1.0 / 120.0; p = p * r + 1.0 / 24.0; p = p * r + 1.0 / 6.0; p = p * r + 0.5; p = p * r + 1.0; p = p * r + 1.0;
    int ki = (int)k; if (ki < -1000) return 0.0;
    return __builtin_ldexp(p, ki);
}

__device__ __forceinline__ void phase0(Frame& F) {
    const float* const g1 = INP(float, I_G1); const float* const w_in = INP(float, I_WIN);
    float* WF = (float*)F.lds;
    for (int k = F.tid; k < DM; k += NWAVES * 64) { const float g = g1[k]; const float* wp = w_in + (size_t)k * NIN + 4096; const f32x4 a = *(const f32x4*)wp, b = *(const f32x4*)(wp + 4);
        WF[0 * DM + k] = g * a[0]; WF[1 * DM + k] = g * a[1]; WF[2 * DM + k] = g * a[2]; WF[3 * DM + k] = g * a[3];
        WF[4 * DM + k] = g * b[0]; WF[5 * DM + k] = g * b[1]; WF[6 * DM + k] = g * b[2]; WF[7 * DM + k] = g * b[3]; }
    __syncthreads();
    bf16* XA = WSP(bf16, WS_XA); float* R1 = WSP(float, WS_R1); const float* const xp = INP(float, I_XP); const float* const xs = INP(float, I_XS); const float* const b_f = INP(float, I_BF);
    for (int m = F.gw; m < MPAD; m += F.NGW) {
        unsigned long long* o8 = (unsigned long long*)(XA + (size_t)m * DM) + F.lane;
        if (m >= MR) {
#pragma unroll
            for (int j = 0; j < 8; ++j) o8[64 * j] = 0ull;
            if (F.lane == 0) R1[m] = 0.f; continue; }
        const f32x4* xr = (const f32x4*)(m < MPR ? xp + (size_t)m * DM : xs + (size_t)(m - MPR) * DM) + F.lane;
        f32x4 v[8]; float ss = 0.f;
#pragma unroll
        for (int j = 0; j < 8; ++j) { v[j] = xr[64 * j]; ss += (v[j][0] * v[j][0] + v[j][1] * v[j][1]) + (v[j][2] * v[j][2] + v[j][3] * v[j][3]); }
        const float r1 = 1.0f / sqrtf(wave_sum(ss) * (1.0f / DM) + RMS_EPS);
#pragma unroll
        for (int j = 0; j < 8; ++j) o8[64 * j] = (unsigned long long)cvtpk(v[j][0], v[j][1]) | ((unsigned long long)cvtpk(v[j][2], v[j][3]) << 32);
        float fl = 0.f;
#pragma unroll
        for (int h = 0; h < 8; ++h) { float a = 0.f;
#pragma unroll
            for (int j = 0; j < 8; ++j) { const f32x4 w = *(const f32x4*)(WF + h * DM + 256 * j + 4 * F.lane); a += (v[j][0] * w[0] + v[j][1] * w[1]) + (v[j][2] * w[2] + v[j][3] * w[3]); }
            a = wave_sum(a); if (F.lane == h) fl = a; }
        if (F.lane == 0) R1[m] = r1;
        if (F.lane < 8) { const float z = fl * r1 + b_f[F.lane]; const float lf = fminf(z, 0.f) - log1pf(expf(-fabsf(z)));
            if (m < MPR) F.out[O_LFP + (size_t)m * NH + F.lane] = lf; else F.out[O_LFS + (size_t)(m - MPR) * NH + F.lane] = lf; }
    }
    { const float* const ldt = INP(float, I_LDT); const float* const a_re = INP(float, I_ARE); const float* const a_im = INP(float, I_AIM); const float* const b_re = INP(float, I_BRE); const float* const b_im = INP(float, I_BIM);
    for (int g = F.gw; g < NG; g += F.NGW) { const int p = F.lane, gp = g * NST + p;
        const double dt = exp_d((double)ldt[g]), are = (double)a_re[gp], aim = (double)a_im[gp];
        double sn, cs; sincos_d(dt * aim, sn, cs); const double mag = exp_d(dt * are); const double abr = mag * cs, abi = mag * sn;
        double snT, csT; sincos_d((double)TCH * dt * aim, snT, csT); const double magT = exp_d((double)TCH * dt * are);
        float* AB = WSP(float, WS_AB); float* AT = WSP(float, WS_AT); AB[2 * gp] = (float)abr; AB[2 * gp + 1] = (float)abi; AT[2 * gp] = (float)(magT * csT); AT[2 * gp + 1] = (float)(magT * snT);
        const double er = abr - 1.0, ei = abi, inv = 1.0 / (are * are + aim * aim), fr = (er * are + ei * aim) * inv, fi = (ei * are - er * aim) * inv;
        float* BBR = WSP(float, WS_BBR) + (size_t)gp * GC; float* BBI = WSP(float, WS_BBI) + (size_t)gp * GC;
#pragma unroll
        for (int c = 0; c < GC; ++c) { const double br = (double)b_re[(size_t)gp * GC + c], bi = (double)b_im[(size_t)gp * GC + c]; BBR[c] = (float)(fr * br - fi * bi); BBI[c] = (float)(fr * bi + fi * br); }
    } }
    { const int* const pt = INP(int, I_PT); const float* const clf = INP(float, I_CLF);
    for (int it = F.gw; it < DBT * NPAGES; it += F.NGW) { const int b = it >> 7, j = it & 127, phys = pt[it]; const int seg = F.lane >> 3, h = F.lane & 7;
        const float* lp = clf + ((size_t)phys * PAGE + 16 * seg) * NH + h; float v[16];
#pragma unroll
        for (int i = 0; i < 16; ++i) v[i] = lp[i * NH];
        float s[16]; float run = 0.f;
#pragma unroll
        for (int i = 15; i >= 0; --i) { s[i] = run; run += v[i]; }
        float off = 0.f;
#pragma unroll
        for (int d = 1; d < 8; ++d) { const float t = __shfl(run, (F.lane + 8 * d) & 63); if (seg + d < 8) off += t; }
        float* rp = WSP(float, WS_RP) + ((size_t)(b * NH + h) * PAST) + j * PAGE + 16 * seg;
#pragma unroll
        for (int i = 0; i < 16; ++i) rp[i] = s[i] + off;
        if (seg == 0) WSP(float, WS_TPG)[(b * NH + h) * NPAGES + j] = off + run; } }
    float* scr = (float*)(F.lds + 65536 + F.wave * 8448);
    const float* const w_glu = INP(float, I_WGLU); const float* const w_brs = INP(float, I_WBRS); const float* const w_bra = INP(float, I_WBRA); const float* const w_out = INP(float, I_WOUT);
    const float* const g2 = INP(float, I_G2); const float* const w_fg = INP(float, I_WFG); const float* const w_fu = INP(float, I_WFU); const float* const w_fd = INP(float, I_WFD);
    constexpr int I_IN = 32 * 128, I_GLU = 16 * 32, I_BR = 16 * 64, I_OUT = 32 * 64, I_FF1 = 32 * 176, I_FF2 = 88 * 64;
    constexpr int NITEMS = 2 * I_IN + I_GLU + 2 * I_BR + I_OUT + 2 * I_FF1 + I_FF2;
    for (int it = F.gw; it < NITEMS; it += F.NGW) { int r = it;
        if (r < 2 * I_IN) { const int part = r / I_IN; r -= part * I_IN; const int kb = r / 128, nb = r % 128;
            p0_transpose_item(w_in, NIN, (part ? 4104 : 0) + 32 * nb, WSP(bf16, WS_W1T), 2048, part * 4096 + 32 * nb, 64 * kb, 0, g1, scr, F.lane); continue; } r -= 2 * I_IN;
        if (r < I_GLU) { const int kb = r / 32, nb = r % 32; p0_transpose_item(w_glu, 1024, 32 * nb, WSP(bf16, WS_WGLU), 1024, 32 * nb, 64 * kb, 0, nullptr, scr, F.lane); continue; } r -= I_GLU;
        if (r < 2 * I_BR) { const int part = r / I_BR; r -= part * I_BR; const int kb = r / 64, nb = r % 64;
            p0_transpose_item(part ? w_bra : w_brs, 2048, 32 * nb, WSP(bf16, WS_WBR), 2048, 32 * nb, 64 * kb, part * 1024, nullptr, scr, F.lane); continue; } r -= 2 * I_BR;
        if (r < I_OUT) { const int kb = r / 64, nb = r % 64; p0_transpose_item(w_out, 2048, 32 * nb, WSP(bf16, WS_WOUT), 2048, 32 * nb, 64 * kb, 0, nullptr, scr, F.lane); continue; } r -= I_OUT;
        if (r < 2 * I_FF1) { const int part = r / I_FF1; r -= part * I_FF1; const int kb = r / 176, nb = r % 176; const int n0 = 32 * nb;
            p0_transpose_item(part ? w_fu : w_fg, DFF, n0, WSP(bf16, WS_WFF1), 2048, 256 * (n0 >> 7) + (n0 & 127) + part * 128, 64 * kb, 0, g2, scr, F.lane); continue; } r -= 2 * I_FF1;
        { const int kb = r / 64, nb = r % 64; p0_transpose_item(w_fd, 2048, 32 * nb, WSP(bf16, WS_WFF2), DFF, 32 * nb, 64 * kb, 0, nullptr, scr, F.lane); }
    }
}
__device__ __forceinline__ void rowpass(Frame& F) {
    const int h = F.lane >> 3, sub = F.lane & 7, off = h * HD + sub * 16;
    float gq[16], gk[16]; { const float* const gqp = INP(float, I_GQ); const float* const gkp = INP(float, I_GK);
#pragma unroll
    for (int i = 0; i < 16; ++i) { gq[i] = gqp[sub * 16 + i]; gk[i] = gkp[sub * 16 + i]; } }
    const float* Z = WSP(float, WS_Z);
    for (int m = F.gw; m < MR; m += F.NGW) {
        const float* z = Z + (size_t)m * 4096 + off; float q[16], k[16], v[16];
#pragma unroll
        for (int i = 0; i < 4; ++i) { const f32x4 a = *(const f32x4*)(z + 1024 + 4 * i), b = *(const f32x4*)(z + 2048 + 4 * i), c = *(const f32x4*)(z + 3072 + 4 * i);
#pragma unroll
            for (int e = 0; e < 4; ++e) { q[4 * i + e] = a[e]; k[4 * i + e] = b[e]; v[4 * i + e] = c[e]; } }
        float sq = 0.f, sk = 0.f;
#pragma unroll
        for (int i = 0; i < 16; ++i) { sq += q[i] * q[i]; sk += k[i] * k[i]; }
        sq += __shfl_xor(sq, 1); sq += __shfl_xor(sq, 2); sq += __shfl_xor(sq, 4); sk += __shfl_xor(sk, 1); sk += __shfl_xor(sk, 2); sk += __shfl_xor(sk, 4);
        const float rq = 1.0f / sqrtf(sq * (1.0f / HD) + RMS_EPS), rk = 1.0f / sqrtf(sk * (1.0f / HD) + RMS_EPS);
#pragma unroll
        for (int i = 0; i < 16; ++i) { q[i] = q[i] * rq * gq[i]; k[i] = k[i] * rk * gk[i]; }
        float* ko; float* vo;
        if (m < MPR) { const int b = m >> 12, s = m & (SEQ - 1); const size_t ao = ((size_t)(b * NH + h) * SEQ + s) * HD + sub * 16;
            v4u w;
            w.x = cvtpk(q[0], q[1]); w.y = cvtpk(q[2], q[3]); w.z = cvtpk(q[4], q[5]); w.w = cvtpk(q[6], q[7]); *(v4u*)(WSP(bf16, WS_QB) + ao) = w;
            w.x = cvtpk(q[8], q[9]); w.y = cvtpk(q[10], q[11]); w.z = cvtpk(q[12], q[13]); w.w = cvtpk(q[14], q[15]); *(v4u*)(WSP(bf16, WS_QB) + ao + 8) = w;
            w.x = cvtpk(k[0], k[1]); w.y = cvtpk(k[2], k[3]); w.z = cvtpk(k[4], k[5]); w.w = cvtpk(k[6], k[7]); *(v4u*)(WSP(bf16, WS_KB) + ao) = w;
            w.x = cvtpk(k[8], k[9]); w.y = cvtpk(k[10], k[11]); w.z = cvtpk(k[12], k[13]); w.w = cvtpk(k[14], k[15]); *(v4u*)(WSP(bf16, WS_KB) + ao + 8) = w;
            w.x = cvtpk(v[0], v[1]); w.y = cvtpk(v[2], v[3]); w.z = cvtpk(v[4], v[5]); w.w = cvtpk(v[6], v[7]); *(v4u*)(WSP(bf16, WS_VB) + ao) = w;
            w.x = cvtpk(v[8], v[9]); w.y = cvtpk(v[10], v[11]); w.z = cvtpk(v[12], v[13]); w.w = cvtpk(v[14], v[15]); *(v4u*)(WSP(bf16, WS_VB) + ao + 8) = w;
            ko = F.out + O_KP + (size_t)m * DATT + off; vo = F.out + O_VP + (size_t)m * DATT + off;
        } else { const int ms = m - MPR, b = ms >> 2, t = ms & 3; float* qs = WSP(float, WS_QS) + ((size_t)((b * NH + h) * DSQ + t)) * HD + sub * 16;
#pragma unroll
            for (int i = 0; i < 4; ++i) *(f32x4*)(qs + 4 * i) = (f32x4){q[4 * i], q[4 * i + 1], q[4 * i + 2], q[4 * i + 3]};
            ko = F.out + O_KS + (size_t)ms * DATT + off; vo = F.out + O_VS + (size_t)ms * DATT + off; }
#pragma unroll
        for (int i = 0; i < 4; ++i) { *(f32x4*)(ko + 4 * i) = (f32x4){k[4 * i], k[4 * i + 1], k[4 * i + 2], k[4 * i + 3]}; *(f32x4*)(vo + 4 * i) = (f32x4){v[4 * i], v[4 * i + 1], v[4 * i + 2], v[4 * i + 3]}; }
    }
}
__device__ __forceinline__ void logf_cumsum(Frame& F) {
    for (int it = F.gw; it < NB * NH; it += F.NGW) { const int b = it >> 3, h = it & 7; const float* lf = F.out + O_LFP + (size_t)b * SEQ * NH + h; bf16* o = WSP(bf16, WS_NCK) + (size_t)it * SEQ * 16;
        double carry = 0.0;
        for (int i = 0; i < SEQ / 64; ++i) { const int s = 64 * i + F.lane; double v = (double)lf[(size_t)s * NH];
#pragma unroll
            for (int d = 1; d < 64; d <<= 1) { const double t = __shfl_up(v, d); if (F.lane >= d) v += t; }
            v += carry; carry = __shfl(v, 63);
            const float x = (float)(-v * 11.313708498984761);
            const unsigned h16 = cvtpk(x, 0.f) & 0xffffu; const float r1 = x - __uint_as_float(h16 << 16); const unsigned m16 = cvtpk(r1, 0.f) & 0xffffu; const float r2 = r1 - __uint_as_float(m16 << 16); const unsigned l16 = cvtpk(r2, 0.f) & 0xffffu;
            v4u w; w.x = h16 | (m16 << 16); w.y = l16; w.z = 0u; w.w = 0u; *(v4u*)(o + (size_t)s * 16) = w; *(v4u*)(o + (size_t)s * 16 + 8) = (v4u){0u, 0u, 0u, 0u}; } }
}
__device__ __forceinline__ void rpast_fix(Frame& F) {
    for (int it = F.gw; it < DBT * NH * NPAGES; it += F.NGW) { const int bh = it >> 7, j = it & 127; const float* tp = WSP(float, WS_TPG) + bh * NPAGES;
        float a = (F.lane > j ? tp[F.lane] : 0.f) + (F.lane + 64 > j ? tp[F.lane + 64] : 0.f); a = wave_sum(a);
        float* rp = WSP(float, WS_RP) + (size_t)bh * PAST + j * PAGE; rp[F.lane] = (rp[F.lane] + a) * LOG2E; rp[F.lane + 64] = (rp[F.lane + 64] + a) * LOG2E; }
}

namespace s5 {
constexpr int HS_STRIDE = 132, US_F = 256, HS_F = 16 * HS_STRIDE, CS_F = 64 * 32, WLDS_F = US_F + HS_F + CS_F;
__device__ __forceinline__ float gelu_erf(float y) { return 0.5f * y * (1.0f + erff(y * 0.70710678118654752440f)); }
template <int MODE>
__device__ __forceinline__ void unit(const float* U, int T, float& hre, float& him, const float* bbr, const float* bbi, float are, float aim, float* wl, int lane, bf16* YPr, const float* dv) {
    float br[16], bi[16];
#pragma unroll
    for (int i = 0; i < 4; ++i) { const f32x4 a = *(const f32x4*)(bbr + 4 * i), b = *(const f32x4*)(bbi + 4 * i);
#pragma unroll
        for (int e = 0; e < 4; ++e) { br[4 * i + e] = a[e]; bi[4 * i + e] = b[e]; } }
    float* Us = wl; float* Hs = wl + US_F; const float* Cs = wl + US_F + HS_F;
    for (int t0 = 0; t0 < T; t0 += 16) { const int nst = (T - t0) < 16 ? (T - t0) : 16;
        { const int row = lane >> 2, quad = lane & 3; f32x4 v = (f32x4){0.f, 0.f, 0.f, 0.f}; if (row < nst) v = *(const f32x4*)(U + (size_t)(t0 + row) * 4096 + quad * 4); *(f32x4*)(Us + row * 16 + quad * 4) = v; }
        LDS_WAIT(); asm volatile("" ::: "memory");
#pragma unroll 1
        for (int t = 0; t < nst; ++t) { float bur = 0.f, bui = 0.f;
#pragma unroll
            for (int i = 0; i < 4; ++i) { const f32x4 u = *(const f32x4*)(Us + t * 16 + 4 * i);
#pragma unroll
                for (int e = 0; e < 4; ++e) { bur = fmaf(br[4 * i + e], u[e], bur); bui = fmaf(bi[4 * i + e], u[e], bui); } }
            const float nre = fmaf(are, hre, fmaf(-aim, him, bur)), nim = fmaf(are, him, fmaf(aim, hre, bui)); hre = nre; him = nim;
            if (MODE == 1) { typedef float f32x2 __attribute__((ext_vector_type(2))); *(f32x2*)(Hs + t * HS_STRIDE + 2 * lane) = (f32x2){hre, him}; } }
        if (MODE == 1) { LDS_WAIT(); asm volatile("" ::: "memory");
            const int tl = lane >> 2, cq = lane & 3; float a0 = 0.f, a1 = 0.f, a2 = 0.f, a3 = 0.f;
#pragma unroll 4
            for (int pp = 0; pp < 32; ++pp) { const f32x4 h4 = *(const f32x4*)(Hs + tl * HS_STRIDE + 4 * pp);
                const f32x4 cA0 = *(const f32x4*)(Cs + (2 * pp) * 32 + cq * 8), cA1 = *(const f32x4*)(Cs + (2 * pp) * 32 + cq * 8 + 4);
                const f32x4 cB0 = *(const f32x4*)(Cs + (2 * pp + 1) * 32 + cq * 8), cB1 = *(const f32x4*)(Cs + (2 * pp + 1) * 32 + cq * 8 + 4);
                a0 += (cA0[0] * h4[0] - cA0[1] * h4[1]) + (cB0[0] * h4[2] - cB0[1] * h4[3]); a1 += (cA0[2] * h4[0] - cA0[3] * h4[1]) + (cB0[2] * h4[2] - cB0[3] * h4[3]);
                a2 += (cA1[0] * h4[0] - cA1[1] * h4[1]) + (cB1[0] * h4[2] - cB1[1] * h4[3]); a3 += (cA1[2] * h4[0] - cA1[3] * h4[1]) + (cB1[2] * h4[2] - cB1[3] * h4[3]); }
            if (tl < nst) { const f32x4 u = *(const f32x4*)(Us + tl * 16 + cq * 4), d = *(const f32x4*)(dv + cq * 4);
                const float y0 = gelu_erf(fmaf(d[0], u[0], a0)), y1 = gelu_erf(fmaf(d[1], u[1], a1)), y2 = gelu_erf(fmaf(d[2], u[2], a2)), y3 = gelu_erf(fmaf(d[3], u[3], a3));
                *(unsigned long long*)(YPr + (size_t)(t0 + tl) * 1024 + cq * 4) = (unsigned long long)cvtpk(y0, y1) | ((unsigned long long)cvtpk(y2, y3) << 32); }
            LDS_WAIT(); asm volatile("" ::: "memory"); }
    }
}
__device__ __forceinline__ void passA(Frame& F) {
    float* wl = (float*)F.lds + F.wave * WLDS_F; const float* Z = WSP(float, WS_Z); const float* AB = WSP(float, WS_AB);
    for (int it = F.gw; it < NB * NCH * NG; it += F.NGW) { const int g = it & 63, bc = it >> 6, gp = g * NST + F.lane;
        float hre = 0.f, him = 0.f;
        unit<0>(Z + (size_t)bc * TCH * 4096 + g * GC, TCH, hre, him, WSP(float, WS_BBR) + (size_t)gp * GC, WSP(float, WS_BBI) + (size_t)gp * GC, AB[2 * gp], AB[2 * gp + 1], wl, F.lane, nullptr, nullptr);
        float* e = WSP(float, WS_E) + (size_t)it * 128; e[F.lane] = hre; e[64 + F.lane] = him; }
}
__device__ __forceinline__ void passB(Frame& F) {
    float* wl = (float*)F.lds + F.wave * WLDS_F; const float* Z = WSP(float, WS_Z); const float* AB = WSP(float, WS_AB); const float* AT = WSP(float, WS_AT); float* Cs = wl + US_F + HS_F;
    constexpr int NPU = NB * NCH * NG, NSU = DBT * NG;
    const float* const c_re = INP(float, I_CRE); const float* const c_im = INP(float, I_CIM); const float* const sre = INP(float, I_SRE); const float* const sim = INP(float, I_SIM); const float* const dssm = INP(float, I_DSSM);
    for (int it = F.gw; it < NPU + NSU; it += F.NGW) { const bool smp = it >= NPU; const int g = it & 63, gp = g * NST + F.lane;
#pragma unroll 4
        for (int c = 0; c < GC; ++c) { typedef float f32x2 __attribute__((ext_vector_type(2))); *(f32x2*)(Cs + F.lane * 32 + c * 2) = (f32x2){c_re[(size_t)(g * GC + c) * NST + F.lane], c_im[(size_t)(g * GC + c) * NST + F.lane]}; }
        float hre, him; int row0, T; float* ore; float* oim; bool fin;
        if (!smp) { const int bc = it >> 6, b = bc >> 5, ch = bc & 31; hre = 0.f; him = 0.f; const float tr = AT[2 * gp], ti = AT[2 * gp + 1]; const float* e = WSP(float, WS_E) + ((size_t)(b * NCH) * NG + g) * 128;
            for (int j = 0; j < ch; ++j) { const float er = e[(size_t)j * NG * 128 + F.lane], ei = e[(size_t)j * NG * 128 + 64 + F.lane]; const float nr = fmaf(tr, hre, fmaf(-ti, him, er)), ni = fmaf(tr, him, fmaf(ti, hre, ei)); hre = nr; him = ni; }
            row0 = bc * TCH; T = TCH; fin = (ch == NCH - 1); ore = F.out + O_HRP + (size_t)b * NG * NST + gp; oim = F.out + O_HIP + (size_t)b * NG * NST + gp;
        } else { const int bs = (it - NPU) >> 6; hre = sre[(size_t)bs * NG * NST + gp]; him = sim[(size_t)bs * NG * NST + gp]; row0 = MPR + bs * DSQ; T = DSQ; fin = true;
            ore = F.out + O_HRS + (size_t)bs * NG * NST + gp; oim = F.out + O_HIS + (size_t)bs * NG * NST + gp; }
        unit<1>(Z + (size_t)row0 * 4096 + g * GC, T, hre, him, WSP(float, WS_BBR) + (size_t)gp * GC, WSP(float, WS_BBI) + (size_t)gp * GC, AB[2 * gp], AB[2 * gp + 1], wl, F.lane, WSP(bf16, WS_YP) + (size_t)row0 * 1024 + g * GC, dssm + g * GC);
        if (fin) { *ore = hre; *oim = him; } }
}
}
namespace sattn {
constexpr int D = 128, SPG = 16, WAVES = 4, GE = 4, NSPLIT = 8, NSUB = PAST / SPG, PPS = NSUB / NSPLIT, PPW = PPS / WAVES, TOK_STRIDE = NH * HD;
constexpr int LDS_P = 0, LDS_MRG = WAVES * 64, MRG_REC = 4 + D, HALF_FLOATS = 2560;
constexpr float SCALE = 0.088388347648318440f;
using bf16x2 = __attribute__((ext_vector_type(2))) __bf16;
using u32x4  = __attribute__((ext_vector_type(4))) unsigned;
using f32x4  = __attribute__((ext_vector_type(4))) float;
using f32x8  = __attribute__((ext_vector_type(8))) float;
__device__ __forceinline__ float dot2(unsigned k, unsigned q, float acc) { return __builtin_amdgcn_fdot2_f32_bf16(__builtin_bit_cast(bf16x2, k), __builtin_bit_cast(bf16x2, q), acc, false); }
template <int CTRL> __device__ __forceinline__ float dpp(float x) { return __builtin_bit_cast(float, __builtin_amdgcn_mov_dpp(__builtin_bit_cast(int, x), CTRL, 0xf, 0xf, true)); }
constexpr int XOR1 = 0xB1, XOR2 = 0x4E, XOR7 = 0x141, XOR8 = 0x128, ROR4 = 0x124;
__device__ __forceinline__ float xrow16_max(float x) {
  auto s = __builtin_amdgcn_permlane16_swap(__float_as_uint(x), __float_as_uint(x), false, false); x = fmaxf(__uint_as_float(s[0]), __uint_as_float(s[1]));
  auto t = __builtin_amdgcn_permlane32_swap(__float_as_uint(x), __float_as_uint(x), false, false); return fmaxf(__uint_as_float(t[0]), __uint_as_float(t[1])); }
__device__ __forceinline__ float xrow16_sum(float x) {
  auto s = __builtin_amdgcn_permlane16_swap(__float_as_uint(x), __float_as_uint(x), false, false); x = __uint_as_float(s[0]) + __uint_as_float(s[1]);
  auto t = __builtin_amdgcn_permlane32_swap(__float_as_uint(x), __float_as_uint(x), false, false); return __uint_as_float(t[0]) + __uint_as_float(t[1]); }
__device__ __forceinline__ u32x4 tobf(f32x8 x) { u32x4 w = {cvtpk(x[0], x[1]), cvtpk(x[2], x[3]), cvtpk(x[4], x[5]), cvtpk(x[6], x[7])}; return w; }

__device__ __forceinline__ void split_unit(int unit, float* lds, int wave, int lane, const float* QS, const float* ck, const float* cv, const int* pt, const float* RP, float* PML, float* PO) {
  const int s = unit & 7, kvh = (unit >> 3) & 7, b = unit >> 6, r = lane >> 4, c = lane & 15;
  constexpr float C2 = SCALE * 1.4426950408889634f;
  const int p0 = s * PPS;
  int btv = 0;
  if (lane < PPW) { const int pg = p0 + wave + 4 * lane; btv = pt[b * NPAGES + (pg >> 3)] * PAGE + (pg & 7) * SPG; }
  u32x4 qpk[GE];
#pragma unroll
  for (int g = 0; g < GE; ++g) qpk[g] = tobf(*reinterpret_cast<const f32x8*>(QS + ((size_t)((b * NH + kvh) * DSQ + g)) * D + 8 * c));
  const size_t loff = (size_t)r * TOK_STRIDE + (size_t)kvh * D + 8 * c;
  const float* rpb = RP + (size_t)(b * NH + kvh) * PAST + r + 4 * (c >> 2);
#define SA_ISSUE(i_) do { const int tb_ = __builtin_amdgcn_readlane(btv, (i_)); const float* kb_ = ck + (size_t)tb_ * TOK_STRIDE + loff; const float* vb_ = cv + (size_t)tb_ * TOK_STRIDE + loff; \
    _Pragma("unroll") for (int t_ = 0; t_ < 4; ++t_) { Kn[t_] = __builtin_nontemporal_load(reinterpret_cast<const f32x8*>(kb_ + (size_t)t_ * 4 * TOK_STRIDE)); Vn[t_] = __builtin_nontemporal_load(reinterpret_cast<const f32x8*>(vb_ + (size_t)t_ * 4 * TOK_STRIDE)); } \
    Bn = rpb[(p0 + wave + 4 * (i_)) * SPG]; } while (0)
  f32x8 Kn[4], Vn[4]; float Bn;
  float m = -INFINITY, l = 0.f, acc[GE * 8];
#pragma unroll
  for (int k = 0; k < GE * 8; ++k) acc[k] = 0.f;
  SA_ISSUE(0);
  for (int i = 0; i < PPW; ++i) {
    u32x4 Kc[4], Vc[4];
#pragma unroll
    for (int t = 0; t < 4; ++t) { Kc[t] = tobf(Kn[t]); Vc[t] = tobf(Vn[t]); }
    const float Bc = Bn;
    if (i + 1 < PPW) SA_ISSUE(i + 1);
    float x[4 * GE];
#pragma unroll
    for (int t = 0; t < 4; ++t)
#pragma unroll
      for (int g = 0; g < GE; ++g) { float d = 0.f;
#pragma unroll
        for (int k = 0; k < 4; ++k) d = dot2(Kc[t][k], qpk[g][k], d);
        x[t * GE + g] = d; }
#define SA_TR(HALF, CTRL, BIT) _Pragma("unroll") for (int h = 0; h < (HALF); ++h) { \
      const float lo_ = x[h], hi_ = x[h + (HALF)]; const float t1_ = lo_ + dpp<CTRL>(lo_), t2_ = hi_ + dpp<CTRL>(hi_); x[h] = (c & (BIT)) ? t2_ : t1_; }
    SA_TR(8, XOR8, 8) SA_TR(4, XOR7, 4) SA_TR(2, XOR2, 2) SA_TR(1, XOR1, 1)
#undef SA_TR
    const float sc = fmaf(x[0], C2, Bc);
    float pm = sc; pm = fmaxf(pm, dpp<ROR4>(pm)); pm = fmaxf(pm, dpp<XOR8>(pm)); pm = xrow16_max(pm);
    const float mn = fmaxf(m, pm), msub = (mn == -INFINITY) ? 0.f : mn;
    const float alpha = __builtin_amdgcn_exp2f(m - msub), p = __builtin_amdgcn_exp2f(sc - msub);
    l = fmaf(l, alpha, p); m = mn;
#pragma unroll
    for (int q4 = 0; q4 < 4; ++q4) { const float al = q4 == 0 ? dpp<0x00>(alpha) : q4 == 1 ? dpp<0x55>(alpha) : q4 == 2 ? dpp<0xAA>(alpha) : dpp<0xFF>(alpha);
#pragma unroll
      for (int k = 0; k < 8; ++k) acc[q4 * 8 + k] *= al; }
    float* prow = lds + LDS_P + (wave * 4 + r) * 16;
    prow[c] = p;
    asm volatile("s_waitcnt lgkmcnt(0)" ::: "memory");
    f32x4 pr[GE];
#pragma unroll
    for (int u = 0; u < GE; ++u) pr[u] = *reinterpret_cast<const f32x4*>(prow + 4 * u);
#pragma unroll
    for (int t = 0; t < 4; ++t) { float vf[8];
#pragma unroll
      for (int k = 0; k < 4; ++k) { vf[2 * k] = __builtin_bit_cast(float, Vc[t][k] << 16); vf[2 * k + 1] = __builtin_bit_cast(float, Vc[t][k] & 0xffff0000u); }
#pragma unroll
      for (int g = 0; g < GE; ++g) { const float pg_ = pr[t][g];
#pragma unroll
        for (int k = 0; k < 8; ++k) acc[g * 8 + k] = fmaf(pg_, vf[k], acc[g * 8 + k]); } }
  }
#undef SA_ISSUE
#pragma unroll
  for (int k = 0; k < GE * 8; ++k) acc[k] = xrow16_sum(acc[k]);
  { float t = l; t += dpp<ROR4>(t); t += dpp<XOR8>(t); l = xrow16_sum(t); }
  float* mrg = lds + LDS_MRG;
  if (r == 0) {
#pragma unroll
    for (int g = 0; g < GE; ++g) { float* rec = mrg + (wave * GE + g) * MRG_REC;
#pragma unroll
      for (int k = 0; k < 8; k += 4) *reinterpret_cast<f32x4*>(rec + 4 + 8 * c + k) = f32x4{acc[g * 8 + k], acc[g * 8 + k + 1], acc[g * 8 + k + 2], acc[g * 8 + k + 3]};
      if (c == g) { rec[0] = m; rec[1] = l; } } }
  __syncthreads();
  { const int g = wave, d0 = 2 * lane; const size_t row = (size_t)(b * NH + kvh) * DSQ + g;
    float M = -INFINITY;
#pragma unroll
    for (int w = 0; w < WAVES; ++w) M = fmaxf(M, mrg[(w * GE + g) * MRG_REC]);
    float L = 0.f, o0 = 0.f, o1 = 0.f;
#pragma unroll
    for (int w = 0; w < WAVES; ++w) { const float* rec = mrg + (w * GE + g) * MRG_REC; const float lw = rec[1]; const float wt = (lw > 0.f) ? __builtin_amdgcn_exp2f(rec[0] - M) : 0.f;
      L = fmaf(wt, lw, L); o0 = fmaf(wt, rec[4 + d0], o0); o1 = fmaf(wt, rec[4 + d0 + 1], o1); }
    const size_t slot = row * NSPLIT + s;
    *reinterpret_cast<float2*>(PO + slot * D + d0) = make_float2(o0, o1);
    if (lane == 0) *reinterpret_cast<float2*>(PML + 2 * slot) = make_float2(M, L); }
  __syncthreads();
}
}

__device__ __forceinline__ void sample_combine(Frame& F) {
    const float* PML = WSP(float, WS_PML); const float* PO = WSP(float, WS_PO); const float* QS = WSP(float, WS_QS);
    constexpr float C2 = 0.088388347648318440f * 1.4426950408889634f;
    for (int row = F.gw; row < DBT * NH * DSQ; row += F.NGW) { const int t = row & 3, h = (row >> 2) & 7, b = row >> 5, d0 = 2 * F.lane;
        const float2 q = *(const float2*)(QS + (size_t)row * HD + d0);
        float sn[DSQ]; float run = 0.f;
#pragma unroll
        for (int j = 0; j < DSQ; ++j) { const float2 k = *(const float2*)(F.out + O_KS + ((size_t)(b * DSQ + j) * NH + h) * HD + d0); const float d = wave_sum(q.x * k.x + q.y * k.y);
            run += F.out[O_LFS + (size_t)(b * DSQ + j) * NH + h]; sn[j] = (j <= t) ? fmaf(d, C2, -run * LOG2E) : -INFINITY; }
        float M = -INFINITY;
#pragma unroll
        for (int s = 0; s < 8; ++s) M = fmaxf(M, PML[2 * ((size_t)row * 8 + s)]);
#pragma unroll
        for (int j = 0; j < DSQ; ++j) M = fmaxf(M, sn[j]);
        float L = 0.f, o0 = 0.f, o1 = 0.f;
#pragma unroll
        for (int s = 0; s < 8; ++s) { const size_t slot = (size_t)row * 8 + s; const float ls = PML[2 * slot + 1], w = (ls > 0.f) ? __builtin_amdgcn_exp2f(PML[2 * slot] - M) : 0.f;
            const float2 a = *(const float2*)(PO + slot * HD + d0); L = fmaf(w, ls, L); o0 = fmaf(w, a.x, o0); o1 = fmaf(w, a.y, o1); }
#pragma unroll
        for (int j = 0; j < DSQ; ++j) { const float p = __builtin_amdgcn_exp2f(sn[j] - M); const float2 v = *(const float2*)(F.out + O_VS + ((size_t)(b * DSQ + j) * NH + h) * HD + d0);
            L += p; o0 = fmaf(p, v.x, o0); o1 = fmaf(p, v.y, o1); }
        const float inv = 1.0f / L;
        *(unsigned*)(WSP(bf16, WS_YY) + (size_t)(MPR + b * DSQ + t) * 2048 + 1024 + h * HD + d0) = cvtpk(o0 * inv, o1 * inv); }
}
__device__ __forceinline__ pattn::BlockRef<__hip_bfloat16, __hip_bfloat16> attn_ref(unsigned char* ws, int u) {
    constexpr int NQB = SEQ / pattn::QB;
    const int qb = NQB - 1 - (u >> 4), bh = u & 15; const size_t hb = (size_t)bh * SEQ * HD;
    pattn::BlockRef<__hip_bfloat16, __hip_bfloat16> r;
    r.Q = (const __hip_bfloat16*)(ws + WS_QB) + hb + (size_t)qb * pattn::QB * HD; r.K = (const __hip_bfloat16*)(ws + WS_KB) + hb; r.V = (const __hip_bfloat16*)(ws + WS_VB) + hb;
    r.CK = (const unsigned short*)(ws + WS_NCK) + (size_t)bh * SEQ * 16; r.P0 = qb * pattn::QB;
    r.O = (__hip_bfloat16*)(ws + WS_YY) + ((size_t)(bh >> 3) * SEQ + (size_t)qb * pattn::QB) * 2048 + 1024 + (bh & 7) * HD;
    return r;
}
__device__ __forceinline__ void attn_prompt_phase(Frame& F) {
    using BR = pattn::BlockRef<__hip_bfloat16, __hip_bfloat16>;
    constexpr int NU = NB * NH * (SEQ / pattn::QB);
    char* lds = (char*)F.lds;
    int u = blockIdx.x; if (u >= NU) return;
    BR cur = attn_ref(F.ws, u);
    pattn::Seam<__hip_bfloat16> S;
    pattn::causal_swa_prime<__hip_bfloat16, __hip_bfloat16>(cur, SEQ, lds, S, F.wave, F.lane);
    for (;;) { const int un = u + F.G; const bool last = un >= NU;
        const BR nxt = last ? cur : attn_ref(F.ws, un);
        pattn::causal_swa_block<__hip_bfloat16, __hip_bfloat16>(cur, nxt, SEQ, SEQ, lds, S, F.wave, F.lane);
        if (last) break;
        cur = nxt; u = un; }
}

constexpr int N_PHASES = 10;
__global__ void __launch_bounds__(NWAVES * 64, 2) fwd(Args args) {
    extern __shared__ __attribute__((aligned(16))) unsigned char lds[];
    Frame F;
    F.lds = lds; F.wave = __builtin_amdgcn_readfirstlane(threadIdx.x >> 6); F.lane = (int)__builtin_amdgcn_mbcnt_hi(~0u, __builtin_amdgcn_mbcnt_lo(~0u, 0u)); F.tid = F.wave * 64 + F.lane; F.G = gridDim.x;
    F.gw = blockIdx.x * NWAVES + F.wave; F.NGW = F.G * NWAVES;
    F.out = args.out; F.ws = args.ws;
    volatile LAS unsigned* MISC = (volatile LAS unsigned*)((LAS unsigned char*)lds + MISC_OFF);
    for (int u = F.tid; u < 128; u += NWAVES * 64) MISC[u] = 0u;
    __syncthreads();
    const int lo = args.ph_lo, hi = args.ph_hi;
    XcdBarrier bar; bar.bar = (unsigned*)(F.ws + WS_CTL) + CW_BAR; bar.x = 0; bar.st = nullptr;
    if (hi - lo > 1) bar = xcd_barrier_post((unsigned*)(F.ws + WS_CTL) + CW_BAR, MISC + 8);
#ifndef PH_MASK
#define PH_MASK 0x3ff
#endif
#define IN(k) (((PH_MASK >> (k)) & 1) && lo <= (k) && (k) < hi)
#define SEAM(k) do { if (IN(k) && IN((k) + 1)) xcd_barrier(bar); } while (0)
    LAS unsigned char* ring = (LAS unsigned char*)lds;

    if (IN(0)) { phase0(F); } SEAM(0);
    if (IN(1)) {
        pg8::Gemm g{(const pg8::bf16_t*)WSP(bf16, WS_XA), (const pg8::bf16_t*)WSP(bf16, WS_W1T), MPAD, 8192, 2048, 2048, 2048}; pg8::StaticOrder S; S.init(MPAD, 8192, F.G, (int)blockIdx.x);
        pg8::EpiIn E{WSP(float, WS_Z), (pg8::bf16_t*)WSP(bf16, WS_G), WSP(float, WS_R1)};
        pg8::gemm_phase<pg8::EpiIn, pg8::StaticOrder, true, true>(ring, g, S, E); } SEAM(1);
    #ifndef PH2_MASK
#define PH2_MASK 15
#endif
    if (IN(2)) { if (PH2_MASK & 1) rowpass(F); if (PH2_MASK & 2) s5::passA(F); if (PH2_MASK & 4) logf_cumsum(F); if (PH2_MASK & 8) rpast_fix(F); } SEAM(2);
    if (IN(3)) {
#ifndef PH3_MASK
#define PH3_MASK 7
#endif
        if (PH3_MASK & 1) attn_prompt_phase(F);
        __syncthreads();
        if (PH3_MASK & 2) s5::passB(F);
        __syncthreads();
        if (PH3_MASK & 4) { const int half = F.wave >> 2; const float* const ckp = INP(float, I_CK); const float* const cvp = INP(float, I_CV); const int* const ptp = INP(int, I_PT);
          for (int it = blockIdx.x; it < 256; it += F.G)
              sattn::split_unit(2 * it + half, (float*)F.lds + half * sattn::HALF_FLOATS, F.wave & 3, F.lane, WSP(float, WS_QS), ckp, cvp, ptp, WSP(float, WS_RP), WSP(float, WS_PML), WSP(float, WS_PO)); }
    } SEAM(3);
    if (IN(4)) {
        sample_combine(F);
        pg8::Gemm g{(const pg8::bf16_t*)WSP(bf16, WS_YP), (const pg8::bf16_t*)WSP(bf16, WS_WGLU), MPAD, 1024, 1024, 1024, 1024}; pg8::StaticOrder S; S.init(MPAD, 1024, F.G, (int)blockIdx.x);
        pg8::EpiGlu E{(const pg8::bf16_t*)WSP(bf16, WS_YP), (pg8::bf16_t*)WSP(bf16, WS_YY), INP(float, I_BGLU)};
        pg8::gemm_phase<pg8::EpiGlu, pg8::StaticOrder, true, true>(ring, g, S, E); } SEAM(4);
    if (IN(5)) {
        pg8::Gemm g{(const pg8::bf16_t*)WSP(bf16, WS_YY), (const pg8::bf16_t*)WSP(bf16, WS_WBR), MPAD, 2048, 1024, 2048, 2048}; pg8::StaticOrder S; S.init(MPAD, 2048, F.G, (int)blockIdx.x);
        pg8::EpiBrA E{(const pg8::bf16_t*)WSP(bf16, WS_G), WSP(float, WS_T1)};
        pg8::gemm_phase<pg8::EpiBrA, pg8::StaticOrder, true, true>(ring, g, S, E); } SEAM(5);
    if (IN(6)) {
        pg8::Gemm g{(const pg8::bf16_t*)WSP(bf16, WS_YY) + 1024, (const pg8::bf16_t*)WSP(bf16, WS_WBR) + 1024, MPAD, 2048, 1024, 2048, 2048}; pg8::StaticOrder S; S.init(MPAD, 2048, F.G, (int)blockIdx.x);
        pg8::EpiBrB E{(const pg8::bf16_t*)WSP(bf16, WS_G), WSP(float, WS_T1), (pg8::bf16_t*)WSP(bf16, WS_MG)};
        pg8::gemm_phase<pg8::EpiBrB, pg8::StaticOrder, true, true>(ring, g, S, E); } SEAM(6);
    if (IN(7)) {
        pg8::Gemm g{(const pg8::bf16_t*)WSP(bf16, WS_MG), (const pg8::bf16_t*)WSP(bf16, WS_WOUT), MPAD, 2048, 2048, 2048, 2048}; pg8::StaticOrder S; S.init(MPAD, 2048, F.G, (int)blockIdx.x);
        pg8::EpiOut E{INP(float, I_XP), INP(float, I_XS), WSP(float, WS_X1), (pg8::bf16_t*)WSP(bf16, WS_XB), WSP(float, WS_SS)};
        pg8::gemm_phase<pg8::EpiOut, pg8::StaticOrder, true, true>(ring, g, S, E); } SEAM(7);
    if (IN(8)) {
        pg8::Gemm g{(const pg8::bf16_t*)WSP(bf16, WS_XB), (const pg8::bf16_t*)WSP(bf16, WS_WFF1), MPAD, 2 * DFF, 2048, 2048, 2048}; pg8::StaticOrder S; S.init(MPAD, 2 * DFF, F.G, (int)blockIdx.x);
        pg8::EpiFF1 E{WSP(float, WS_SS), (pg8::bf16_t*)WSP(bf16, WS_H)};
        pg8::gemm_phase<pg8::EpiFF1, pg8::StaticOrder, true, true>(ring, g, S, E); } SEAM(8);
    if (IN(9)) {
        pg8::Gemm g{(const pg8::bf16_t*)WSP(bf16, WS_H), (const pg8::bf16_t*)WSP(bf16, WS_WFF2), MPAD, 2048, DFF, DFF, DFF}; pg8::StaticOrder S; S.init(MPAD, 2048, F.G, (int)blockIdx.x);
        pg8::EpiFF2 E{WSP(float, WS_X1), F.out + O_YP, F.out + O_YS};
        pg8::gemm_phase<pg8::EpiFF2, pg8::StaticOrder, true, true>(ring, g, S, E); }
#undef IN
#undef SEAM
}

extern "C" void kernel_launch(void* const* d_in, const int* in_sizes, int n_in, void* d_out, int out_size, void* d_ws, size_t ws_size, hipStream_t stream) {
    static int grid = 0;
    if (grid == 0) {
        if (n_in != 30 || out_size != (int)O_END || ws_size < WS_END) { fprintf(stderr, "kernel_launch: unexpected shapes (n_in %d out %d ws %zu)\n", n_in, out_size, ws_size); grid = -1; return; }
        int dev = 0, cus = 0, per_cu = 0;
        if (hipGetDevice(&dev) != hipSuccess || hipDeviceGetAttribute(&cus, hipDeviceAttributeMultiprocessorCount, dev) != hipSuccess) { grid = -1; return; }
        if (hipFuncSetAttribute((const void*)fwd, hipFuncAttributeMaxDynamicSharedMemorySize, LDS_BYTES) != hipSuccess) { fprintf(stderr, "kernel_launch: hipFuncSetAttribute failed\n"); grid = -1; return; }
        if (hipOccupancyMaxActiveBlocksPerMultiprocessor(&per_cu, (const void*)fwd, NWAVES * 64, LDS_BYTES) != hipSuccess || per_cu < 1) fprintf(stderr, "kernel_launch: occupancy query reports %d\n", per_cu);
        (void)hipGetLastError();
        grid = cus;
    }
    if (grid < 0) return;
    if (hipMemsetAsync((char*)d_ws + WS_CTL, 0, CTL_ZERO_BYTES, stream) != hipSuccess) return;
    Args a{};
    for (int i = 0; i < 30; ++i) a.in[i] = d_in[i];
    a.out = (float*)d_out; a.ws = (unsigned char*)d_ws;
#if MK_SPLIT
    for (int p = 0; p < N_PHASES; ++p) { a.ph_lo = p; a.ph_hi = p + 1; hipLaunchKernelGGL(fwd, dim3(grid), dim3(NWAVES * 64), LDS_BYTES, stream, a); }
#else
    a.ph_lo = 0; a.ph_hi = N_PHASES; hipLaunchKernelGGL(fwd, dim3(grid), dim3(NWAVES * 64), LDS_BYTES, stream, a);
#endif
}
```

```cpp
#include <hip/hip_runtime.h>
#include <hip/hip_bf16.h>
#include <cstdio>
#include <cstdint>

#ifndef MK_SPLIT
#define MK_SPLIT 0
#endif

constexpr int DM = 2048, NB = 2, SEQ = 4096, MPR = NB * SEQ, DBT = 8, DSQ = 4, MSM = DBT * DSQ, MR = MPR + MSM, MPAD = 8448;
constexpr int DSSM = 1024, NG = 64, NST = 64, GC = 16, NH = 8, HD = 128, DATT = 1024, DFF = 5632, NIN = 8200;
constexpr int PAST = 16384, PAGE = 128, NPAGES = 128;
constexpr float RMS_EPS = 1e-6f;
constexpr float LOG2E = 1.4426950408889634f;
constexpr int CT = 16, NCHK = MPR / CT, CPB = SEQ / CT;

namespace pg8 {
#define PG8_LAS __attribute__((address_space(3)))
typedef unsigned short bf16_t;
typedef short bf16x8 __attribute__((ext_vector_type(8)));
typedef float f32x4 __attribute__((ext_vector_type(4)));
typedef unsigned u32x4 __attribute__((ext_vector_type(4)));
constexpr int BM = 256, BK = 64, HALF = 128, HTB = HALF * BK * 2  , STAGE_BYTES = 8 * HTB, NXCD = 8, WGM = 8;

__host__ __device__ __forceinline__ int lds_byte(int r, int c) { const int st = (r >> 4) * 2 + (c >> 5), rr = r & 15, cc = c & 31, ob = rr * 64 + cc * 2; return st * 1024 + (ob ^ (((ob >> 9) & 1) << 5)); }
__host__ __device__ __forceinline__ void stage_rc(int b, int& R, int& C) { const int st = b / 1024, sb = b % 1024, swz = sb ^ (((sb >> 9) & 1) << 5); R = (st >> 1) * 16 + swz / 64; C = (st & 1) * 32 + (swz % 64) / 2; }
__host__ __device__ __forceinline__ int perm32(int rho) { const int n = rho >> 4, i = rho & 15; return 8 * (i >> 2) + 4 * n + (i & 3); }

struct Unit { int pm, pn; };
struct Gemm { const bf16_t* A; const bf16_t* Bt; int M, N, K, lda, ldb; };

struct StaticOrder {
    int nM, nN, nwg, G, c;
    __host__ __device__ void init(int M, int N, int G_, int c_) { nM = M / BM; nN = N / BM; nwg = nM * nN; G = G_; c = c_; }
    __host__ __device__ bool next(int i, Unit& u) const {
        const long L = (long)i * G + c; if (L >= nwg) return false;
        int wgid = (int)L; { const int q = nwg / NXCD, r = nwg % NXCD, xcd = wgid % NXCD, off = wgid / NXCD; wgid = (xcd < r ? xcd * (q + 1) : r * (q + 1) + (xcd - r) * q) + off; }
        const int nig = WGM * nN, gid = wgid / nig, fm = gid * WGM, gsz = (nM - fm) < WGM ? (nM - fm) : WGM;
        u.pm = fm + ((wgid % nig) % gsz); u.pn = (wgid % nig) / gsz; return true;
    }
    __device__ __forceinline__ void a_ready(const Unit&) const {}
    __device__ __forceinline__ void done(const Unit&) const {}
};

__device__ __forceinline__ unsigned cvt_pk_bf16(float lo, float hi) { unsigned r; asm volatile("v_cvt_pk_bf16_f32 %0, %1, %2" : "=v"(r) : "v"(lo), "v"(hi)); return r; }
typedef float f32x2 __attribute__((ext_vector_type(2)));
__device__ __forceinline__ f32x2 gelu_pk(f32x2 v) {
    const f32x2 av = __builtin_elementwise_abs(v), d = av * 0.2316418882f + 1.0f;
    f32x2 t; t.x = __builtin_amdgcn_rcpf(d.x); t.y = __builtin_amdgcn_rcpf(d.y);
    f32x2 q = t * 0.5307027145f + (-0.7265760135f); q = q * t + 0.7107068705f; q = q * t + (-0.142248368f); q = q * t + 0.127414796f; q = q * t;
    const f32x2 s = (v * v) * (-0.72134752044f);
    f32x2 e; e.x = __builtin_amdgcn_exp2f(s.x); e.y = __builtin_amdgcn_exp2f(s.y);
    const f32x2 m = v * (q * e), r = v - m;
    f32x2 o; o.x = v.x < 0.f ? m.x : r.x; o.y = v.y < 0.f ? m.y : r.y; return o;
}

__device__ __forceinline__ float sigm(float x) { return __builtin_amdgcn_rcpf(1.0f + __builtin_amdgcn_exp2f(-1.4426950408889634f * x)); }
__device__ __forceinline__ float bflo(unsigned w) { return __uint_as_float(w << 16); }
__device__ __forceinline__ float bfhi(unsigned w) { return __uint_as_float(w & 0xffff0000u); }
__device__ __forceinline__ u32x4 pack8(f32x4 a, f32x4 b) { u32x4 w; w.x = cvt_pk_bf16(a[0], a[1]); w.y = cvt_pk_bf16(a[2], a[3]); w.z = cvt_pk_bf16(b[0], b[1]); w.w = cvt_pk_bf16(b[2], b[3]); return w; }
__device__ __forceinline__ void unpack8(u32x4 w, f32x4& a, f32x4& b) { a = (f32x4){bflo(w.x), bfhi(w.x), bflo(w.y), bfhi(w.y)}; b = (f32x4){bflo(w.z), bfhi(w.z), bflo(w.w), bfhi(w.w)}; }
#define PG8_EPI_ROWS  for (int ai = 0; ai < 2; ++ai) _Pragma("unroll") for (int m = 0; m < 4; ++m)

struct EpiIn {
    static constexpr bool PERM = true, AFTER_DRAIN = false, MIDK = false;
    bf16_t* G; const float* R1; bf16_t* UB; bf16_t* QB; bf16_t* KB; bf16_t* VB; float* outK; float* outV; const float* gq; const float* gk; PG8_LAS float* P;
    __device__ __forceinline__ void operator()(const f32x4 (&acc)[2][2][4][2], const Unit& u, int wr, int wc, int fr, int fq) const {
        const int row0 = u.pm * BM + wr * 64 + fr, col0 = u.pn * BM + wc * 32 + 8 * fq, pn = u.pn;
        if (pn >= 4 && pn < 12) {
            const bool isk = pn >= 8; const int d = wc * 32 + 8 * fq;
#pragma unroll
            PG8_EPI_ROWS { const int rl = ai * HALF + wr * 64 + m * 16 + fr; const float r1 = R1[row0 + ai * HALF + m * 16];
#pragma unroll
                for (int bj = 0; bj < 2; ++bj) { const f32x4 v0 = acc[ai][bj][m][0] * r1, v1 = acc[ai][bj][m][1] * r1;
                    float ss = (v0[0] * v0[0] + v0[1] * v0[1]) + (v0[2] * v0[2] + v0[3] * v0[3]) + (v1[0] * v1[0] + v1[1] * v1[1]) + (v1[2] * v1[2] + v1[3] * v1[3]);
                    ss += __shfl_xor(ss, 16); ss += __shfl_xor(ss, 32);
                    if (fq == 0) P[(rl * 2 + bj) * 4 + wc] = ss; } }
            asm volatile("s_waitcnt lgkmcnt(0)" ::: "memory"); __builtin_amdgcn_s_barrier(); asm volatile("" ::: "memory");
            const float* gp = isk ? gk : gq; const f32x4 g0 = *(const f32x4*)(gp + d), g1 = *(const f32x4*)(gp + d + 4);
            bf16_t* ob = isk ? KB : QB;
#pragma unroll
            PG8_EPI_ROWS { const int row = row0 + ai * HALF + m * 16, rl = ai * HALF + wr * 64 + m * 16 + fr; const float r1 = R1[row];
#pragma unroll
                for (int bj = 0; bj < 2; ++bj) { const f32x4 t = *(const PG8_LAS f32x4*)(P + (rl * 2 + bj) * 4);
                    const float sc = r1 * __builtin_amdgcn_rsqf(((t[0] + t[1]) + (t[2] + t[3])) * (1.0f / 128.0f) + RMS_EPS); const int head = (pn & 3) * 2 + bj;
                    const f32x4 o0 = acc[ai][bj][m][0] * sc * g0, o1 = acc[ai][bj][m][1] * sc * g1;
                    *(u32x4*)(ob + ((size_t)((row >> 12) * NH + head) * SEQ + (row & (SEQ - 1))) * HD + d) = pack8(o0, o1);
                    if (isk) { float* p = outK + (size_t)row * DATT + head * HD + d; *(f32x4*)p = o0; *(f32x4*)(p + 4) = o1; } } }
            return; }
#pragma unroll
        PG8_EPI_ROWS { const int row = row0 + ai * HALF + m * 16; const float r1 = R1[row];
#pragma unroll
            for (int bj = 0; bj < 2; ++bj) { const int c = col0 + bj * HALF; f32x4 v0 = acc[ai][bj][m][0] * r1, v1 = acc[ai][bj][m][1] * r1;
                if (pn < 4) { *(u32x4*)(UB + ((size_t)((c >> 4) * 512 + (row >> 4)) * 16 + (row & 15)) * 16 + (c & 15)) = pack8(v0, v1); }
                else if (pn < 16) { const int head = (pn & 3) * 2 + bj, d = wc * 32 + 8 * fq;
                    *(u32x4*)(VB + ((size_t)((row >> 12) * NH + head) * SEQ + (row & (SEQ - 1))) * HD + d) = pack8(v0, v1);
                    float* p = outV + (size_t)row * DATT + head * HD + d; *(f32x4*)p = v0; *(f32x4*)(p + 4) = v1; }
                else { v0 = (f32x4){sigm(v0[0]), sigm(v0[1]), sigm(v0[2]), sigm(v0[3])}; v1 = (f32x4){sigm(v1[0]), sigm(v1[1]), sigm(v1[2]), sigm(v1[3])};
                       *(u32x4*)(G + (size_t)row * 4096 + (c - 4096)) = pack8(v0, v1); } } }
    }
};
struct EpiGlu {
    static constexpr bool PERM = true, AFTER_DRAIN = false, MIDK = false;
    const bf16_t* YP; bf16_t* YY; const float* bias;
    __device__ __forceinline__ void operator()(const f32x4 (&acc)[2][2][4][2], const Unit& u, int wr, int wc, int fr, int fq) const {
        const int row0 = u.pm * BM + wr * 64 + fr, col0 = u.pn * BM + wc * 32 + 8 * fq;
#pragma unroll
        PG8_EPI_ROWS { const int row = row0 + ai * HALF + m * 16;
#pragma unroll
            for (int bj = 0; bj < 2; ++bj) { const int c = col0 + bj * HALF; const f32x4 b0 = *(const f32x4*)(bias + c), b1 = *(const f32x4*)(bias + c + 4);
                f32x4 y0, y1; unpack8(*(const u32x4*)(YP + (size_t)row * 1024 + c), y0, y1);
                const f32x4 a0 = acc[ai][bj][m][0] + b0, a1 = acc[ai][bj][m][1] + b1;
                y0 = (f32x4){y0[0] * sigm(a0[0]), y0[1] * sigm(a0[1]), y0[2] * sigm(a0[2]), y0[3] * sigm(a0[3])};
                y1 = (f32x4){y1[0] * sigm(a1[0]), y1[1] * sigm(a1[1]), y1[2] * sigm(a1[2]), y1[3] * sigm(a1[3])};
                *(u32x4*)(YY + (size_t)row * 2048 + c) = pack8(y0, y1); } }
    }
};
struct EpiMerge {
    static constexpr bool PERM = true, AFTER_DRAIN = false, MIDK = true;
    const bf16_t* G; bf16_t* MG;
    __device__ __forceinline__ void mid(f32x4 (&acc)[2][2][4][2], const Unit& u, int wr, int wc, int fr, int fq) const {
        int off = (u.pm * BM + wr * 64 + fr) * 4096 + u.pn * BM + wc * 32 + 8 * fq;
        asm volatile("" : "+v"(off));
#pragma unroll
        PG8_EPI_ROWS {
#pragma unroll
            for (int bj = 0; bj < 2; ++bj) { const bf16_t* gp = G + (off + bj * HALF); f32x4 a0, a1, b0, b1; unpack8(*(const u32x4*)gp, a0, a1); unpack8(*(const u32x4*)(gp + 2048), b0, b1);
                acc[ai][bj][m][0] = acc[ai][bj][m][0] * (f32x4){a0[0] * __builtin_amdgcn_rcpf(b0[0]), a0[1] * __builtin_amdgcn_rcpf(b0[1]), a0[2] * __builtin_amdgcn_rcpf(b0[2]), a0[3] * __builtin_amdgcn_rcpf(b0[3])};
                acc[ai][bj][m][1] = acc[ai][bj][m][1] * (f32x4){a1[0] * __builtin_amdgcn_rcpf(b1[0]), a1[1] * __builtin_amdgcn_rcpf(b1[1]), a1[2] * __builtin_amdgcn_rcpf(b1[2]), a1[3] * __builtin_amdgcn_rcpf(b1[3])}; }
            off += (m == 3) ? (HALF - 48) * 4096 : 16 * 4096; asm volatile("" : "+v"(off)); }
    }
    __device__ __forceinline__ void operator()(const f32x4 (&acc)[2][2][4][2], const Unit& u, int wr, int wc, int fr, int fq) const {
        const int row0 = u.pm * BM + wr * 64 + fr, col0 = u.pn * BM + wc * 32 + 8 * fq;
#pragma unroll
        PG8_EPI_ROWS { const int row = row0 + ai * HALF + m * 16;
#pragma unroll
            for (int bj = 0; bj < 2; ++bj) { const int c = col0 + bj * HALF; f32x4 g0, g1; unpack8(*(const u32x4*)(G + (size_t)row * 4096 + 2048 + c), g0, g1);
                *(u32x4*)(MG + (size_t)row * 2048 + c) = pack8(acc[ai][bj][m][0] * g0, acc[ai][bj][m][1] * g1); } }
    }
};
struct EpiOut {
    static constexpr bool PERM = true, AFTER_DRAIN = false, MIDK = false;
    const float* xp; const float* xs; bf16_t* XB; float* SSR;
    __device__ __forceinline__ void operator()(const f32x4 (&acc)[2][2][4][2], const Unit& u, int wr, int wc, int fr, int fq) const {
        const int row0 = u.pm * BM + wr * 64 + fr, col0 = u.pn * BM + wc * 32 + 8 * fq;
#pragma unroll
        PG8_EPI_ROWS { const int row = row0 + ai * HALF + m * 16;
            const float* xr = row < MPR ? xp + (size_t)row * 2048 : xs + (size_t)(row < MR ? row - MPR : 0) * 2048; const bool live = row < MR; float s = 0.f;
#pragma unroll
            for (int bj = 0; bj < 2; ++bj) { const int c = col0 + bj * HALF; f32x4 x0 = (f32x4){0.f, 0.f, 0.f, 0.f}, x1 = x0;
                if (live) { x0 = *(const f32x4*)(xr + c); x1 = *(const f32x4*)(xr + c + 4); }
                x0 = x0 + acc[ai][bj][m][0]; x1 = x1 + acc[ai][bj][m][1];
                s += (x0[0] * x0[0] + x0[1] * x0[1]) + (x0[2] * x0[2] + x0[3] * x0[3]) + (x1[0] * x1[0] + x1[1] * x1[1]) + (x1[2] * x1[2] + x1[3] * x1[3]);
                *(u32x4*)(XB + (size_t)row * 2048 + c) = pack8(x0, x1); }
            s += __shfl_xor(s, 16); s += __shfl_xor(s, 32);
            if (fq == 0) __hip_atomic_fetch_add(SSR + row, s, __ATOMIC_RELAXED, __HIP_MEMORY_SCOPE_AGENT); }
    }
};
struct EpiFF1 {
    static constexpr bool PERM = true, AFTER_DRAIN = false, MIDK = false;
    const float* SSR; bf16_t* H; int probe;
    __device__ __forceinline__ void operator()(const f32x4 (&acc)[2][2][4][2], const Unit& u, int wr, int wc, int fr, int fq) const {
        if (probe & 8) { if (acc[0][0][0][0][0] == 123.456f) H[0] = 0; return; }
        const int row0 = u.pm * BM + wr * 64 + fr, col0 = u.pn * HALF + wc * 32 + 8 * fq;
#pragma unroll
        PG8_EPI_ROWS { const int row = row0 + ai * HALF + m * 16;
            const float r2 = __builtin_amdgcn_rsqf(SSR[row] * (1.0f / 2048.0f) + RMS_EPS);
            f32x4 o[2];
#pragma unroll
            for (int n = 0; n < 2; ++n) { const f32x4 g = acc[ai][0][m][n] * r2, up = acc[ai][1][m][n] * r2;
                o[n] = (f32x4){g[0] * sigm(g[0]) * up[0], g[1] * sigm(g[1]) * up[1], g[2] * sigm(g[2]) * up[2], g[3] * sigm(g[3]) * up[3]}; }
            *(u32x4*)(H + (size_t)row * DFF + col0) = pack8(o[0], o[1]); }
    }
};
struct EpiFF2 {
    static constexpr bool PERM = true, AFTER_DRAIN = false, MIDK = false;
    const bf16_t* XB; float* yp; float* ys;
    __device__ __forceinline__ void operator()(const f32x4 (&acc)[2][2][4][2], const Unit& u, int wr, int wc, int fr, int fq) const {
        const int row0 = u.pm * BM + wr * 64 + fr, col0 = u.pn * BM + wc * 32 + 8 * fq;
#pragma unroll
        PG8_EPI_ROWS { const int row = row0 + ai * HALF + m * 16; if (row >= MR) continue;
            float* orow = row < MPR ? yp + (size_t)row * 2048 : ys + (size_t)(row - MPR) * 2048;
#pragma unroll
            for (int bj = 0; bj < 2; ++bj) { const int c = col0 + bj * HALF; f32x4 x0, x1; unpack8(*(const u32x4*)(XB + (size_t)row * 2048 + c), x0, x1);
                *(f32x4*)(orow + c) = x0 + acc[ai][bj][m][0]; *(f32x4*)(orow + c + 4) = x1 + acc[ai][bj][m][1]; } }
    }
};
template <class Epi, class Sched, bool ALIGN_EPI = false, bool SP2 = false>
__device__ __forceinline__ void gemm_phase(PG8_LAS unsigned char* lds, const Gemm g, const Sched& S, const Epi& E, int wid_in, int lane_in) {
    const int wid = wid_in, lane = lane_in, tid = wid * 64 + lane, wr = wid >> 2, wc = wid & 3, fr = lane & 15, fq = lane >> 4;
    const int K = g.K, nt = K / BK;
    unsigned voffA[2], voffB[2];
#pragma unroll
    for (int i = 0; i < 2; ++i) { int R, C; stage_rc(tid * 16 + i * 8192, R, C); const int Rb = Epi::PERM ? ((R & ~31) + perm32(R & 31)) : R;
        voffA[i] = (unsigned)(R * g.lda + C) * 2u; voffB[i] = (unsigned)(Rb * g.ldb + C) * 2u; }
    const size_t kstep = (size_t)(BK * 2);
    const size_t hsA = (size_t)HALF * g.lda * 2, hsB = (size_t)HALF * g.ldb * 2;
    const size_t tsA = 2 * hsA, tsB = 2 * hsB;
    const unsigned ldsw = (unsigned)wid * 1024u;
    const int aoff = lds_byte(wr * 64 + fr, fq * 8), boff = lds_byte(wc * 32 + fr, fq * 8);
#define PG8_SA(b, h) (((b) * 2 + (h)) * HTB)
#define PG8_SB(b, h) ((4 + (b) * 2 + (h)) * HTB)
#define PG8_STAGE(bufoff, gbase, voff) do { _Pragma("unroll") for (int _i = 0; _i < 2; ++_i) \
        __builtin_amdgcn_global_load_lds((const unsigned*)((const char*)(gbase) + (voff)[_i]), (PG8_LAS unsigned*)(lds + (bufoff) + ldsw + _i * 8192), 16, 0, 0); } while (0)
#define PG8_LDA(dst, b, h) do { _Pragma("unroll") for (int m = 0; m < 4; ++m) _Pragma("unroll") for (int k = 0; k < 2; ++k) dst[m][k] = *(const PG8_LAS bf16x8*)(lds + PG8_SA(b, h) + aoff + m * 2048 + k * 1024); } while (0)
#define PG8_LDB(dst, b, h) do { _Pragma("unroll") for (int n = 0; n < 2; ++n) _Pragma("unroll") for (int k = 0; k < 2; ++k) dst[n][k] = *(const PG8_LAS bf16x8*)(lds + PG8_SB(b, h) + boff + n * 2048 + k * 1024); } while (0)
#define PG8_MMA(ai, bj, At, Bt) do { __builtin_amdgcn_s_setprio(1); _Pragma("unroll") for (int m = 0; m < 4; ++m) _Pragma("unroll") for (int n = 0; n < 2; ++n) _Pragma("unroll") for (int k = 0; k < 2; ++k) \
        acc[ai][bj][m][n] = __builtin_amdgcn_mfma_f32_16x16x32_bf16(Bt[n][k], At[m][k], acc[ai][bj][m][n], 0, 0, 0); __builtin_amdgcn_s_setprio(0); } while (0)
#define PG8_WAIT_V(n) asm volatile("s_waitcnt vmcnt(" #n ")" ::: "memory")
#define PG8_WAIT_L(n) asm volatile("s_waitcnt lgkmcnt(" #n ")" ::: "memory")
#define PG8_BAR __builtin_amdgcn_s_barrier()
#define PG8_SCHED __builtin_amdgcn_sched_barrier(0)
    Unit cur, nxt; int ui = 0;
    if (!S.next(0, cur)) return;
    f32x4 acc[2][2][4][2];
#pragma unroll
    for (int a = 0; a < 2; ++a)
#pragma unroll
        for (int b = 0; b < 2; ++b)
#pragma unroll
            for (int m = 0; m < 4; ++m)
#pragma unroll
                for (int n = 0; n < 2; ++n) acc[a][b][m][n] = (f32x4){0.f, 0.f, 0.f, 0.f};
    bf16x8 At[4][2], B0[2][2], B1[2][2];
    const char* cA = (const char*)g.A + (size_t)cur.pm * tsA; const char* cB = (const char*)g.Bt + (size_t)cur.pn * tsB;
    S.a_ready(cur);
    if constexpr (SP2) {
        PG8_STAGE(PG8_SB(0, 0), cB, voffB); PG8_STAGE(PG8_SB(0, 1), cB + hsB, voffB); PG8_STAGE(PG8_SA(0, 0), cA, voffA); PG8_STAGE(PG8_SA(0, 1), cA + hsA, voffA);
        if (wr == 1) PG8_BAR;
        PG8_WAIT_V(2); PG8_BAR;
        PG8_STAGE(PG8_SB(1, 0), cB + kstep, voffB); PG8_STAGE(PG8_SA(1, 0), cA + kstep, voffA); PG8_STAGE(PG8_SB(1, 1), cB + hsB + kstep, voffB);
        PG8_WAIT_V(6); PG8_BAR;
    } else {
        PG8_STAGE(PG8_SB(0, 0), cB, voffB); PG8_STAGE(PG8_SA(0, 0), cA, voffA); PG8_STAGE(PG8_SB(0, 1), cB + hsB, voffB); PG8_STAGE(PG8_SA(0, 1), cA + hsA, voffA);
        if (wr == 1) PG8_BAR;
        PG8_WAIT_V(4); PG8_BAR;
        PG8_STAGE(PG8_SB(1, 0), cB + kstep, voffB); PG8_STAGE(PG8_SA(1, 0), cA + kstep, voffA); PG8_STAGE(PG8_SB(1, 1), cB + hsB + kstep, voffB);
        PG8_WAIT_V(6); PG8_BAR;
    }
    for (;;) {
        const bool has_next = S.next(ui + 1, nxt);
        const char* nA = has_next ? (const char*)g.A + (size_t)nxt.pm * tsA : cA; const char* nB = has_next ? (const char*)g.Bt + (size_t)nxt.pn * tsB : cB;
        for (int t = 0; t < nt; t += 2) {
            if constexpr (Epi::MIDK) { if (t == (nt >> 1)) E.mid(acc, cur, wr, wc, fr, fq); }
            const bool last = (t == nt - 2);
            const char* a1 = cA + (size_t)(t + 1) * kstep;
            const char* a2 = last ? nA : cA + (size_t)(t + 2) * kstep; const char* b2 = last ? nB : cB + (size_t)(t + 2) * kstep;
            const char* a3 = a2 + kstep; const char* b3 = b2 + kstep;
            if (last && has_next) S.a_ready(nxt);
            if constexpr (SP2) {
            PG8_LDB(B0, 0, 0); PG8_LDB(B1, 0, 1); PG8_SCHED; PG8_LDA(At, 0, 0); PG8_STAGE(PG8_SA(1, 1), a1 + hsA, voffA);
            PG8_WAIT_V(8); PG8_WAIT_L(0); PG8_BAR; PG8_MMA(0, 0, At, B0); PG8_MMA(0, 1, At, B1); PG8_BAR; PG8_SCHED;
            PG8_LDA(At, 0, 1); PG8_STAGE(PG8_SB(0, 0), b2, voffB); PG8_STAGE(PG8_SB(0, 1), b2 + hsB, voffB); PG8_STAGE(PG8_SA(0, 0), a2, voffA);
            PG8_WAIT_V(8); PG8_WAIT_L(0); PG8_BAR; PG8_MMA(1, 0, At, B0); PG8_MMA(1, 1, At, B1); PG8_BAR; PG8_SCHED;
            PG8_LDB(B0, 1, 0); PG8_LDB(B1, 1, 1); PG8_SCHED; PG8_LDA(At, 1, 0); PG8_STAGE(PG8_SA(0, 1), a2 + hsA, voffA);
            PG8_WAIT_V(8); PG8_WAIT_L(0); PG8_BAR; PG8_MMA(0, 0, At, B0); PG8_MMA(0, 1, At, B1); PG8_BAR; PG8_SCHED;
            PG8_LDA(At, 1, 1); PG8_STAGE(PG8_SB(1, 0), b3, voffB); PG8_STAGE(PG8_SB(1, 1), b3 + hsB, voffB); PG8_STAGE(PG8_SA(1, 0), a3, voffA);
            PG8_WAIT_V(8); PG8_WAIT_L(0); PG8_BAR; PG8_MMA(1, 0, At, B0); PG8_MMA(1, 1, At, B1); PG8_BAR; PG8_SCHED;
            } else {
            PG8_LDB(B0, 0, 0); PG8_SCHED; PG8_LDA(At, 0, 0); PG8_STAGE(PG8_SA(1, 1), a1 + hsA, voffA);
            PG8_WAIT_L(8); PG8_BAR; PG8_WAIT_L(0); PG8_MMA(0, 0, At, B0); PG8_BAR; PG8_SCHED;
            PG8_LDB(B1, 0, 1); PG8_STAGE(PG8_SB(0, 0), b2, voffB);
            PG8_BAR; PG8_WAIT_L(0); PG8_MMA(0, 1, At, B1); PG8_BAR;
            PG8_LDA(At, 0, 1); PG8_STAGE(PG8_SA(0, 0), a2, voffA);
            PG8_BAR; PG8_WAIT_L(0); PG8_MMA(1, 0, At, B0); PG8_BAR; PG8_SCHED;
            PG8_STAGE(PG8_SB(0, 1), b2 + hsB, voffB);
            PG8_WAIT_V(6); PG8_BAR; PG8_MMA(1, 1, At, B1); PG8_BAR;
            PG8_LDB(B0, 1, 0); PG8_SCHED; PG8_LDA(At, 1, 0); PG8_STAGE(PG8_SA(0, 1), a2 + hsA, voffA);
            PG8_WAIT_L(8); PG8_BAR; PG8_WAIT_L(0); PG8_MMA(0, 0, At, B0); PG8_BAR; PG8_SCHED;
            PG8_LDB(B1, 1, 1); PG8_STAGE(PG8_SB(1, 0), b3, voffB);
            PG8_BAR; PG8_WAIT_L(0); PG8_MMA(0, 1, At, B1); PG8_BAR;
            PG8_LDA(At, 1, 1); PG8_STAGE(PG8_SA(1, 0), a3, voffA);
            PG8_BAR; PG8_WAIT_L(0); PG8_MMA(1, 0, At, B0); PG8_BAR; PG8_SCHED;
            PG8_STAGE(PG8_SB(1, 1), b3 + hsB, voffB);
            PG8_WAIT_V(6); PG8_BAR; PG8_MMA(1, 1, At, B1); PG8_BAR;
            }
        }
        if constexpr (ALIGN_EPI) { if (wr == 0) PG8_BAR; }
        if constexpr (!Epi::AFTER_DRAIN) { E(acc, cur, wr, wc, fr, fq); S.done(cur); }
        if (!has_next) break;
#pragma unroll
        for (int a = 0; a < 2; ++a)
#pragma unroll
            for (int b = 0; b < 2; ++b)
#pragma unroll
                for (int m = 0; m < 4; ++m)
#pragma unroll
                    for (int n = 0; n < 2; ++n) acc[a][b][m][n] = (f32x4){0.f, 0.f, 0.f, 0.f};
        cur = nxt; cA = nA; cB = nB; ++ui;
        if constexpr (ALIGN_EPI) { if (wr == 1) PG8_BAR; }
    }
    PG8_WAIT_V(0);
    if constexpr (!ALIGN_EPI) { if (wr == 0) PG8_BAR; }
    PG8_BAR;
    if constexpr (Epi::AFTER_DRAIN) { E.fused(acc, cur, wr, wc, fr, fq, lds, wid, lane); S.done(cur); }
#undef PG8_SA
#undef PG8_SB
#undef PG8_STAGE
#undef PG8_LDA
#undef PG8_LDB
#undef PG8_MMA
#undef PG8_WAIT_V
#undef PG8_WAIT_L
#undef PG8_BAR
#undef PG8_SCHED
}
}
namespace pattn {
constexpr int D = 128; constexpr float THR = 8.f; constexpr bool WSKIP = false;
constexpr float SCALE = 0.08838834764831845f;
constexpr int NW = 8, QBLK = 32, KVBLK = 64, QB = NW * QBLK;
constexpr int SHM_V = KVBLK * D * 2, SHM_K = KVBLK * D * 2;
constexpr int LDS_CK = 2 * SHM_V + 2 * SHM_K + NW * 64 * 4;
constexpr int LDS_BYTES = LDS_CK + 2 * 2048;
constexpr int OSTR = 2048;
using bf16 = __hip_bfloat16;
typedef short bf16x8 __attribute__((ext_vector_type(8)));
typedef short s16x4 __attribute__((ext_vector_type(4)));
typedef float f32x16 __attribute__((ext_vector_type(16)));
typedef float f32x4 __attribute__((ext_vector_type(4)));
typedef unsigned u32x4 __attribute__((ext_vector_type(4)));
template <class A, class Bt> struct same_t { static constexpr bool v = false; };
template <class A> struct same_t<A, A> { static constexpr bool v = true; };

#define KSWZ(row, colB) ((row) * 256 + ((colB) ^ (((row) & 7) << 4)))
#define SBAR() __builtin_amdgcn_sched_barrier(0)
__device__ __forceinline__ int v_st(int k, int c) { const int kk = (k & ~0xC) | ((k & 4) << 1) | ((k & 8) >> 1); return ((kk >> 3) * 4 + (c >> 5)) * 512 + ((kk & 7) * 32 + (c & 31)) * 2; }
__device__ __forceinline__ int v_rd_base(int lane) { return ((lane & 3) << 3) | (((lane >> 2) & 3) << 6) | (((lane >> 4) & 1) << 5) | (((lane >> 5) & 1) << 8); }
constexpr int v_rd_off(int d0, int ks, int half) { return d0 * 512 + ks * 4096 + half * 2048; }
__device__ __forceinline__ int crow(int r, int hi) { return (r & 3) + 8 * (r >> 2) + 4 * hi; }
__device__ __forceinline__ unsigned cvtpk(float lo, float hi) {
    unsigned r; asm volatile("v_cvt_pk_bf16_f32 %0, %1, %2" : "=v"(r) : "v"(lo), "v"(hi)); return r;
}
__device__ __forceinline__ bf16x8 pack8(f32x4 a, f32x4 b) {
    u32x4 w = {cvtpk(a[0], a[1]), cvtpk(a[2], a[3]), cvtpk(b[0], b[1]), cvtpk(b[2], b[3])};
    return *reinterpret_cast<bf16x8*>(&w);
}
template <class T> __device__ __forceinline__ bf16x8 load8(const T* p) {
    if constexpr (same_t<T, float>::v) { return pack8(*(const f32x4*)p, *(const f32x4*)(p + 4)); }
    else { return *reinterpret_cast<const bf16x8*>(p); }
}
__device__ __forceinline__ void mask_tile(f32x16& p0, f32x16& p1, int dq, unsigned W) {
    const float NEG = -__builtin_inff();
#pragma unroll
    for (int r = 0; r < 16; ++r) {
        const int c = (r & 3) + 8 * (r >> 2);
        if ((unsigned)(dq - c) >= W) p0[r] = NEG;
        if ((unsigned)(dq - c - 32) >= W) p1[r] = NEG;
    }
}
__device__ __forceinline__ void partialSM(f32x16& p0, f32x16& p1, float& m_reg, float& mn, float& alpha) {
    constexpr float C2 = 1.4426950408889634f * SCALE; mn = 0.f; alpha = 1.f;
    for (int r = 0; r < 16; ++r) p0[r] = fmaf(p0[r], C2, m_reg); for (int r = 0; r < 16; ++r) p1[r] = fmaf(p1[r], C2, m_reg);
    for (int r = 0; r < 16; ++r) p0[r] = __builtin_amdgcn_exp2f(p0[r]);
}
__device__ __forceinline__ void finishSM(f32x16& p0, f32x16& p1, float alpha, float& l_reg, bf16x8& pa0, bf16x8& pa1, bf16x8& pa2, bf16x8& pa3) {
    for (int r = 0; r < 16; ++r) p1[r] = __builtin_amdgcn_exp2f(p1[r]);
    float ps = 0; for (int r = 0; r < 16; ++r) ps += p0[r]; for (int r = 0; r < 16; ++r) ps += p1[r];
    { auto rr = __builtin_amdgcn_permlane32_swap(__float_as_uint(ps), __float_as_uint(ps), false, false);
      ps = __uint_as_float(rr[0]) + __uint_as_float(rr[1]); }
    l_reg = l_reg * alpha + ps;
#define PK4(P, B_, OUT) do { unsigned a0 = cvtpk(P[B_+0], P[B_+1]), a1 = cvtpk(P[B_+2], P[B_+3]);                          \
        unsigned b0 = cvtpk(P[B_+4], P[B_+5]), b1 = cvtpk(P[B_+6], P[B_+7]);                                             \
        auto r0 = __builtin_amdgcn_permlane32_swap(a0, b0, false, false); auto r1 = __builtin_amdgcn_permlane32_swap(a1, b1, false, false); \
        u32x4 w = {r0[0], r1[0], r0[1], r1[1]}; OUT = *reinterpret_cast<bf16x8*>(&w); } while (0)
    PK4(p0, 0, pa0); PK4(p0, 8, pa1); PK4(p1, 0, pa2); PK4(p1, 8, pa3);
#undef PK4
}
template <int KB, bool SK>
__device__ __forceinline__ void qkt(f32x16& p0, f32x16& p1, const char* K_lds, const char* CK_lds, int r32, int hi, const bf16x8* qr, bool act) {
    if (SK && !act) { const float NEG = -__builtin_inff();
#pragma unroll
        for (int r = 0; r < 16; ++r) { p0[r] = NEG; p1[r] = NEG; } return; }
    p0 = f32x16{}; p1 = f32x16{};
    const char* kb[4];
#pragma unroll
    for (int dd = 0; dd < 4; ++dd) kb[dd] = K_lds + KB * SHM_K + KSWZ(r32, (dd * 16 + hi * 8) * 2);
#pragma unroll
    for (int d0 = 0; d0 < 8; ++d0) { const char* a = kb[d0 & 3] + (d0 >> 2) * 128;
        bf16x8 b0 = *reinterpret_cast<const bf16x8*>(a);
        bf16x8 b1 = *reinterpret_cast<const bf16x8*>(a + 32 * 256);
        p0 = __builtin_amdgcn_mfma_f32_32x32x16_bf16(b0, qr[d0], p0, 0, 0, 0);
        p1 = __builtin_amdgcn_mfma_f32_32x32x16_bf16(b1, qr[d0], p1, 0, 0, 0); }
#ifndef NO_FOX
    {
        const char* a = CK_lds + KB * 2048 + r32 * 32 + hi * 16; const bf16x8 c0 = *reinterpret_cast<const bf16x8*>(a), c1 = *reinterpret_cast<const bf16x8*>(a + 1024);
        const short one = (short)0x3F80; const bf16x8 ones = {one, one, one, one, one, one, one, one};
        p0 = __builtin_amdgcn_mfma_f32_32x32x16_bf16(c0, ones, p0, 0, 0, 0); p1 = __builtin_amdgcn_mfma_f32_32x32x16_bf16(c1, ones, p1, 0, 0, 0); }
#endif
}
template <int VB, bool SK>
__device__ __forceinline__ void pv_tile(f32x16* o, int vb0, bf16x8 pa0, bf16x8 pa1, bf16x8 pa2, bf16x8 pa3, bool act) {
    if (SK && !act) return;
#define TRRD(dst, off) asm volatile("ds_read_b64_tr_b16 %0, %1 offset:%2" : "=&v"(dst) : "v"(vb0), "i"(off) : "memory")
#define PV_D0(d0) do { s16x4 l0, l1, l2, l3, h0, h1, h2, h3; constexpr int b_ = VB * SHM_V + v_rd_off(d0, 0, 0);     \
        TRRD(l0, b_); TRRD(h0, b_ + 2048); TRRD(l1, b_ + 4096); TRRD(h1, b_ + 6144); TRRD(l2, b_ + 8192); TRRD(h2, b_ + 10240); TRRD(l3, b_ + 12288); TRRD(h3, b_ + 14336); \
        asm volatile("s_waitcnt lgkmcnt(0)" ::: "memory"); SBAR();                 \
        o[d0] = __builtin_amdgcn_mfma_f32_32x32x16_bf16(pa0, (bf16x8){l0[0], l0[1], l0[2], l0[3], h0[0], h0[1], h0[2], h0[3]}, o[d0], 0, 0, 0);   \
        o[d0] = __builtin_amdgcn_mfma_f32_32x32x16_bf16(pa1, (bf16x8){l1[0], l1[1], l1[2], l1[3], h1[0], h1[1], h1[2], h1[3]}, o[d0], 0, 0, 0);   \
        o[d0] = __builtin_amdgcn_mfma_f32_32x32x16_bf16(pa2, (bf16x8){l2[0], l2[1], l2[2], l2[3], h2[0], h2[1], h2[2], h2[3]}, o[d0], 0, 0, 0);   \
        o[d0] = __builtin_amdgcn_mfma_f32_32x32x16_bf16(pa3, (bf16x8){l3[0], l3[1], l3[2], l3[3], h3[0], h3[1], h3[2], h3[3]}, o[d0], 0, 0, 0); } while (0)
    PV_D0(0); PV_D0(1); PV_D0(2); PV_D0(3);
#undef PV_D0
#undef TRRD
}

template <class TIn, class TOut> struct BlockRef { const TIn* Q; const TIn* K; const TIn* V; TOut* O; const unsigned short* CK; const float* XF; int P0, jlo; float negb2; };
template <class TIn> struct Seam {
    bf16x8 qr[8];
    bf16x8 st_v0, st_v1, st_k0, st_k1; f32x4 sf0, sf1, sf2, sf3;
    f32x4 tq[16];
};
__device__ __forceinline__ int swa_jlo(int P0, int W) { const int lowk = P0 - W + 1; return lowk > 0 ? lowk / KVBLK : 0; }
#define ROW(p, k0, rr) ((p) + (int)(((k0) + (rr)) * D + sc))
#define VMW() asm volatile("s_waitcnt vmcnt(0)" ::: "memory")
#define VMWN(n) asm volatile("s_waitcnt vmcnt(%0)" :: "i"(n) : "memory")
#define SLOAD_H(Kp, Vp, CKp, k0, bf) do { S.st_v0 = load8<TIn>(ROW(Vp, k0, sr)); S.st_v1 = load8<TIn>(ROW(Vp, k0, 32 + sr));              \
                         S.st_k0 = load8<TIn>(ROW(Kp, k0, sr)); S.st_k1 = load8<TIn>(ROW(Kp, k0, 32 + sr)); if (wid < 2) __builtin_amdgcn_global_load_lds((const unsigned*)((CKp) + (int)(((k0) + wid * 32) * 16 + lane * 8)), (__attribute__((address_space(3))) unsigned*)(CK_lds + (bf) * 2048 + wid * 1024), 16, 0, 0); } while (0)
#define SWRITE_HK(bf) do { *(bf16x8*)(K_lds + (bf) * SHM_K + kws) = S.st_k0; *(bf16x8*)(K_lds + (bf) * SHM_K + kws + 32 * 256) = S.st_k1; } while (0)
#define SWRITE_HV(bf) do { *(bf16x8*)(V_lds + (bf) * SHM_V + vst0) = S.st_v0; *(bf16x8*)(V_lds + (bf) * SHM_V + vst1) = S.st_v1; } while (0)
#define SWRITE_H(bf) do { SWRITE_HV(bf); SWRITE_HK(bf); } while (0)
#define SLOAD_F(p, k0) do { S.sf0 = *(const f32x4*)ROW(p, k0, sr); S.sf1 = *(const f32x4*)(ROW(p, k0, sr) + 4);                \
                            S.sf2 = *(const f32x4*)ROW(p, k0, 32 + sr); S.sf3 = *(const f32x4*)(ROW(p, k0, 32 + sr) + 4); } while (0)
#define SWRITE_KF(bf) do { *(bf16x8*)(K_lds + (bf) * SHM_K + kws) = pack8(S.sf0, S.sf1); *(bf16x8*)(K_lds + (bf) * SHM_K + kws + 32 * 256) = pack8(S.sf2, S.sf3); } while (0)
#define SWRITE_VF(bf) do { *(bf16x8*)(V_lds + (bf) * SHM_V + vst0) = pack8(S.sf0, S.sf1); *(bf16x8*)(V_lds + (bf) * SHM_V + vst1) = pack8(S.sf2, S.sf3); } while (0)
template <class TIn, class TOut>
__device__ __forceinline__ void causal_swa_prime(const BlockRef<TIn, TOut>& cur, int W, char* lds, Seam<TIn>& S, int wid_in, int lane_in) {
    constexpr bool F32 = same_t<TIn, float>::v;
    const int wid = wid_in, lane = lane_in, tid = wid * 64 + lane, r32 = lane & 31, hi = lane >> 5;
    const int sr = tid >> 4, sc = (tid & 15) * 8, kws = KSWZ(sr, sc * 2); char* K_lds = lds + 2 * SHM_V; char* CK_lds = lds + LDS_CK;
    const int kb0 = cur.jlo * KVBLK;
    for (int d0 = 0; d0 < 8; ++d0) S.qr[d0] = load8<TIn>(cur.Q + ((wid * QBLK + r32) * D + hi * 8) + d0 * 16);
    if constexpr (F32) { SLOAD_F((const float*)cur.K, kb0); VMW(); SWRITE_KF(0); SBAR(); SLOAD_F((const float*)cur.V, kb0); }
    else { SLOAD_H(cur.K, cur.V, cur.CK, kb0, 0); VMW(); SWRITE_HK(0); }
    __syncthreads();
}
template <class TIn, class TOut>
__device__ __forceinline__ void causal_swa_block(const BlockRef<TIn, TOut>& cur, const BlockRef<TIn, TOut>& nxt, int skv, int W, char* lds, Seam<TIn>& S, int wid_in, int lane_in) {
    constexpr bool F32 = same_t<TIn, float>::v;
    const int wid = wid_in, lane = lane_in, tid = wid * 64 + lane, r32 = lane & 31, hi = lane >> 5;
    const int j_lo = cur.jlo;
    int j_hi = (cur.P0 + QB - 1) / KVBLK + 1; if (j_hi > skv / KVBLK) j_hi = skv / KVBLK;
    const int NT = j_hi - j_lo;
    const int kbn = nxt.jlo * KVBLK;
    const int qlo = cur.P0 + wid * QBLK, qm = qlo + r32 - 4 * hi;
    char* V_lds = lds; char* K_lds = lds + 2 * SHM_V; char* CK_lds = lds + LDS_CK;
    float* ws = (float*)(lds + 2 * SHM_V + 2 * SHM_K) + wid * 64; float* li_l = ws, * al_l = ws + 32;
    float m_reg = cur.negb2 - (1.4426950408889634f * SCALE) * cur.XF[cur.P0 + wid * QBLK + r32], l_reg = 0; f32x16 o[4] = {};
    const int sr = tid >> 4, sc = (tid & 15) * 8, vst0 = v_st(sr, sc), vst1 = v_st(32 + sr, sc), kws = KSWZ(sr, sc * 2);
    const int vb0 = (int)(uintptr_t)V_lds + v_rd_base(lane);
    const TIn* Kh = cur.K; const TIn* Vh = cur.V; const unsigned short* CKh = cur.CK;
#define RESC(a) do { if (__any((a) < 1.f)) { if (hi == 0) al_l[r32] = (a); asm volatile("s_waitcnt lgkmcnt(0)" ::: "memory");              \
                     for (int d_ = 0; d_ < 4; ++d_) for (int r = 0; r < 16; ++r) o[d_][r] *= al_l[crow(r, hi)]; } } while (0)
#define KBASE(t) ((j_lo + (t)) * KVBLK)
#define ACT(t) (KBASE(t) <= qlo + QBLK - 1 && KBASE(t) + KVBLK - 1 >= qlo - W + 1)
#define MASKT(P0_, P1_, t) do { const int kb_ = KBASE(t); if ((!SK || ACT(t)) && (kb_ + KVBLK - 1 > qlo || kb_ <= qlo + QBLK - 1 - W)) mask_tile(P0_, P1_, qm - kb_, (unsigned)W); } while (0)
    constexpr int NQL = F32 ? 16 : 8;
    constexpr bool SK = WSKIP && !F32;
#define SEAM_K0() do { VMWN(NQL); if constexpr (F32) { SWRITE_KF(0); SBAR(); SLOAD_F((const float*)nxt.V, kbn); } else { SWRITE_HK(0); } SBAR(); } while (0)
    f32x16 pA0, pA1, pB0, pB1; float mnA, mnB, alA, alB; bf16x8 pa0, pa1, pa2, pa3;
    if constexpr (F32) { VMW(); SWRITE_VF(0); SBAR(); } else { SWRITE_HV(0); SBAR(); }
    if (NT > 1) { if constexpr (F32) SLOAD_F((const float*)Kh, KBASE(1)); else SLOAD_H(Kh, Vh, CKh, KBASE(1), 1); }
    SBAR(); qkt<0, SK>(pA0, pA1, K_lds, CK_lds, r32, hi, S.qr, ACT(0));
    if constexpr (F32) { if (NT > 1) { VMW(); SWRITE_KF(1); SBAR(); SLOAD_F((const float*)Vh, KBASE(1)); } }
    MASKT(pA0, pA1, 0); partialSM(pA0, pA1, m_reg, mnA, alA);
    if (NT > 1) { VMW(); if constexpr (F32) { SWRITE_VF(1); SBAR(); if (NT > 2) SLOAD_F((const float*)Kh, KBASE(2)); } else SWRITE_H(1); }
    __syncthreads();
#define HALF_STEP(PX0, PX1, mnX, alX, PY0, PY1, alY, t, KB, VB, SB) do {                                                      \
        SBAR(); qkt<KB, SK>(PX0, PX1, K_lds, CK_lds, r32, hi, S.qr, ACT(t));                                             \
        finishSM(PY0, PY1, alY, l_reg, pa0, pa1, pa2, pa3); SBAR();                                                           \
        if ((t) + 1 < NT) { if constexpr (F32) { VMW(); SWRITE_KF(SB); SBAR(); SLOAD_F((const float*)Vh, KBASE((t) + 1)); }  \
                            else { SLOAD_H(Kh, Vh, CKh, KBASE((t) + 1), SB); } SBAR(); }                                               \
        pv_tile<VB, SK>(o, vb0, pa0, pa1, pa2, pa3, ACT((t) - 1)); MASKT(PX0, PX1, (t)); partialSM(PX0, PX1, m_reg, mnX, alX);                                        \
        __syncthreads();                                                                                                      \
        if ((t) + 1 < NT) { VMW(); if constexpr (F32) { SWRITE_VF(SB); SBAR(); if ((t) + 2 < NT) SLOAD_F((const float*)Kh, KBASE((t) + 2)); } \
                            else { SWRITE_H(SB); } }                                                                          \
        RESC(alX); __syncthreads(); } while (0)
    for (int t = 1; t + 1 < NT; t += 2) {
        HALF_STEP(pB0, pB1, mnB, alB, pA0, pA1, alA, t, 1, 0, 0);
        HALF_STEP(pA0, pA1, mnA, alA, pB0, pB1, alB, t + 1, 0, 1, 1);
    }
    const bool even = (NT & 1) == 0;
    if (even) { SBAR(); qkt<1, SK>(pB0, pB1, K_lds, CK_lds, r32, hi, S.qr, ACT(NT - 1)); SBAR(); }
#define QROW(e) (nxt.Q + (size_t)(wid * QBLK + r32) * D + ((e) >> 1) * 16 + hi * 8 + ((e) & 1) * 4)
    if constexpr (F32) { SLOAD_F((const float*)nxt.K, kbn); SBAR();
#pragma unroll
        for (int e = 0; e < 8; ++e) S.tq[e] = *(const f32x4*)QROW(e); }
    else { SLOAD_H(nxt.K, nxt.V, nxt.CK, kbn, 0); SBAR();
#pragma unroll
        for (int d0 = 0; d0 < 8; ++d0) S.qr[d0] = load8<TIn>(nxt.Q + ((wid * QBLK + r32) * D + hi * 8) + d0 * 16); }
    SBAR();
    finishSM(pA0, pA1, alA, l_reg, pa0, pa1, pa2, pa3); SBAR();
    if constexpr (F32) {
#pragma unroll
        for (int e = 8; e < 16; ++e) S.tq[e] = *(const f32x4*)QROW(e); SBAR(); }
#undef QROW
    pv_tile<0, SK>(o, vb0, pa0, pa1, pa2, pa3, ACT(even ? NT - 2 : NT - 1));
    if (even) { MASKT(pB0, pB1, NT - 1); partialSM(pB0, pB1, m_reg, mnB, alB); __syncthreads(); RESC(alB);
        finishSM(pB0, pB1, alB, l_reg, pa0, pa1, pa2, pa3); SBAR(); pv_tile<1, SK>(o, vb0, pa0, pa1, pa2, pa3, ACT(NT - 1)); }
    SBAR(); SEAM_K0();
    if (hi == 0) li_l[r32] = l_reg; asm volatile("s_waitcnt lgkmcnt(0)" ::: "memory");
    float rli[16];
#pragma unroll
    for (int r = 0; r < 16; ++r) rli[r] = __builtin_amdgcn_rcpf(li_l[crow(r, hi)]);
    int oo = (wid * QBLK + 4 * hi) * OSTR + r32;
#pragma unroll
    for (int r = 0; r < 16; ++r) {
        asm volatile("" : "+v"(oo));
#pragma unroll
        for (int d0 = 0; d0 < 4; ++d0) { const float v = o[d0][r] * rli[r];
            if constexpr (same_t<TOut, float>::v) { cur.O[oo + d0 * 32] = v; }
            else { const float vn = __shfl_xor(v, 1);
                   if ((r32 & 1) == 0) *(unsigned*)(cur.O + (oo + d0 * 32)) = cvtpk(v, vn); } }
        oo += ((r & 3) == 3) ? 5 * OSTR : OSTR; }
    if constexpr (F32) {
#pragma unroll
        for (int d0 = 0; d0 < 8; ++d0) S.qr[d0] = pack8(S.tq[2 * d0], S.tq[2 * d0 + 1]); }
    __syncthreads();
#undef RESC
#undef KBASE
#undef ACT
#undef MASKT
#undef SEAM_K0
#undef HALF_STEP
}
#undef ROW
#undef VMW
#undef VMWN
#undef SLOAD_H
#undef SWRITE_HK
#undef SWRITE_HV
#undef SWRITE_H
#undef SLOAD_F
#undef SWRITE_KF
#undef SWRITE_VF
}
#define GAS __attribute__((address_space(1)))
#define LAS __attribute__((address_space(3)))
typedef unsigned short bf16;
typedef unsigned v4u __attribute__((ext_vector_type(4)));
typedef float f32x4 __attribute__((ext_vector_type(4)));
typedef short bf16x8 __attribute__((ext_vector_type(8)));
typedef GAS unsigned gu32;
typedef GAS unsigned long long gu64;
#define RLX_AGENT __ATOMIC_RELAXED, __HIP_MEMORY_SCOPE_AGENT
#define LDS_WAIT() asm volatile("s_waitcnt lgkmcnt(0)" ::: "memory")
#define VM_WAIT() asm volatile("s_waitcnt vmcnt(0)" ::: "memory")
__device__ __forceinline__ unsigned long long rt() { return __builtin_amdgcn_s_memrealtime(); }
__device__ __forceinline__ unsigned f2bf(float f) { unsigned u = __builtin_bit_cast(unsigned, f); return (u + 0x7fffu + ((u >> 16) & 1u)) >> 16; }
__device__ __forceinline__ unsigned pk2(float lo, float hi) { return f2bf(lo) | (f2bf(hi) << 16); }

#define XB_TMO      128
#define XB_XCNT(j)  (256  + 64 * (j))
#define XB_XSUB(j)  (1280 + 64 * (j))
#define XB_XGEN(j)  (2304 + 64 * (j))
#define XB_TOP      3328
#define XB_TOPGEN   3392
#define XCD_BAR_WORDS 3456
#define XB_SPIN_CAP (1u << 18)

__device__ __forceinline__ unsigned xb_ld(unsigned* p)              { return __hip_atomic_load(p, __ATOMIC_RELAXED, __HIP_MEMORY_SCOPE_AGENT); }
__device__ __forceinline__ unsigned xb_add(unsigned* p, unsigned v) { return __hip_atomic_fetch_add(p, v, __ATOMIC_RELAXED, __HIP_MEMORY_SCOPE_AGENT); }
__device__ __forceinline__ unsigned xb_xcc_id() { return (unsigned)__builtin_amdgcn_s_getreg((3 << 11) | 20) & 0xFu; }
#define XB_SPIN(cond, bar) do { unsigned _sp = 0; while (cond) { __builtin_amdgcn_s_sleep(1); \
    if ((++_sp & 255u) == 0u) { if (xb_ld(&(bar)[XB_TMO])) break; if (_sp > XB_SPIN_CAP) { atomicAdd(&(bar)[XB_TMO], 1u); break; } } } } while (0)

struct XcdBarrier {
    unsigned* bar; unsigned x;
    volatile LAS unsigned* st;
};

__device__ __forceinline__ XcdBarrier xcd_barrier_post(unsigned* bar, volatile LAS unsigned* st, bool t0) {
    XcdBarrier b; b.bar = bar; b.x = xb_xcc_id(); b.st = st;
    if (t0) (void)xb_add(&bar[XB_XCNT(b.x)], 1u);
    return b;
}
__device__ __forceinline__ void xcd_barrier_complete(unsigned* bar, unsigned x, unsigned& nloc, unsigned& nx) {
    const unsigned G = gridDim.x * gridDim.y * gridDim.z;
    unsigned sum, cnt, mine, sp = 0u;
    for (;;) {
        sum = 0u; cnt = 0u; mine = 0u;
#pragma unroll
        for (unsigned j = 0; j < 16; ++j) { const unsigned c = xb_ld(&bar[XB_XCNT(j)]); sum += c; cnt += (c > 0u) ? 1u : 0u; mine = (j == x) ? c : mine; }
        if (sum == G) break;
        __builtin_amdgcn_s_sleep(1);
        if ((++sp & 255u) == 0u) { if (xb_ld(&bar[XB_TMO])) break; if (sp > XB_SPIN_CAP) { atomicAdd(&bar[XB_TMO], 1u); break; } }
    }
    nloc = mine > 0u ? mine : 1u; nx = cnt > 0u ? cnt : 1u;
}

__device__ __forceinline__ void xcd_barrier(const XcdBarrier& b, bool t0) {
    asm volatile("s_waitcnt vmcnt(0)" ::: "memory");
    __syncthreads();
    if (t0) {
        unsigned* bar = b.bar;
        __builtin_amdgcn_s_waitcnt(0);
        unsigned nloc = b.st[0], nx = b.st[1];
        if (nloc == 0u) { xcd_barrier_complete(bar, b.x, nloc, nx); b.st[0] = nloc; b.st[1] = nx; }
        const unsigned old = xb_add(&bar[XB_XSUB(b.x)], 1u);
        const unsigned gen = old / nloc;
        if (old + 1u == (gen + 1u) * nloc) {
            __builtin_amdgcn_fence(__ATOMIC_RELEASE, "agent");
            asm volatile("s_waitcnt vmcnt(0)" ::: "memory");
            const unsigned og = xb_add(&bar[XB_TOP], 1u);
            const unsigned tg = og / nx;
            if (og + 1u == (tg + 1u) * nx) xb_add(&bar[XB_TOPGEN], 1u);
            else XB_SPIN(xb_ld(&bar[XB_TOPGEN]) == tg, bar);
            __builtin_amdgcn_fence(__ATOMIC_ACQUIRE, "agent");
            xb_add(&bar[XB_XGEN(b.x)], 1u);
            asm volatile("s_waitcnt vmcnt(0)" ::: "memory");
        } else {
            XB_SPIN(xb_ld(&bar[XB_XGEN(b.x)]) == gen, bar);
            __builtin_amdgcn_fence(__ATOMIC_ACQUIRE, "agent");
            asm volatile("s_waitcnt vmcnt(0)" ::: "memory");
        }
    }
    __syncthreads();
}
constexpr size_t O_YP = 0, O_YS = O_YP + (size_t)MPR * DM, O_KP = O_YS + (size_t)MSM * DM, O_VP = O_KP + (size_t)MPR * DATT, O_LFP = O_VP + (size_t)MPR * DATT,
                 O_HRP = O_LFP + (size_t)MPR * NH, O_HIP = O_HRP + (size_t)NB * NG * NST, O_KS = O_HIP + (size_t)NB * NG * NST, O_VS = O_KS + (size_t)MSM * DATT,
                 O_LFS = O_VS + (size_t)MSM * DATT, O_HRS = O_LFS + (size_t)MSM * NH, O_HIS = O_HRS + (size_t)DBT * NG * NST, O_END = O_HIS + (size_t)DBT * NG * NST;
static_assert(O_END == 33833216, "output size");

constexpr size_t al256(size_t x) { return (x + 255) & ~(size_t)255; }
constexpr size_t WS_CTL = 0, CTL_ZERO_BYTES = 64u << 10;
constexpr size_t WS_W1T  = 1u << 20;
constexpr size_t WS_WGLU = WS_W1T  + (size_t)8192 * 2048 * 2;
constexpr size_t WS_WBR  = WS_WGLU + (size_t)1024 * 1024 * 2;
constexpr size_t WS_WOUT = WS_WBR  + (size_t)2048 * 2048 * 2;
constexpr size_t WS_WFF1 = WS_WOUT + (size_t)2048 * 2048 * 2;
constexpr size_t WS_WFF2 = WS_WFF1 + (size_t)11264 * 2048 * 2;
constexpr size_t WS_XA   = WS_WFF2 + (size_t)2048 * 5632 * 2;
constexpr size_t WS_R1   = WS_XA   + (size_t)MPAD * 2048 * 2;
constexpr size_t WS_Z    = al256(WS_R1 + (size_t)MPAD * 4);
constexpr size_t WS_G    = WS_Z    + (size_t)MPAD * 4096 * 4;
constexpr size_t WS_YP   = WS_G    + (size_t)MPAD * 4096 * 2;
constexpr size_t WS_YY   = WS_YP   + (size_t)MPAD * 1024 * 2;
constexpr size_t WS_T1   = WS_YY   + (size_t)MPAD * 2048 * 2;
constexpr size_t WS_MG   = WS_T1   + (size_t)MPAD * 2048 * 4;
constexpr size_t WS_X1   = WS_MG   + (size_t)MPAD * 2048 * 2;
constexpr size_t WS_XB   = WS_X1   + (size_t)MPAD * 2048 * 4;
constexpr size_t WS_SS   = WS_XB   + (size_t)MPAD * 2048 * 2;
constexpr size_t WS_H    = WS_SS   + (size_t)MPAD * 32 * 4;
constexpr size_t WS_QB   = WS_H    + (size_t)MPAD * DFF * 2;
constexpr size_t WS_KB   = WS_QB   + (size_t)MPR * 1024 * 2;
constexpr size_t WS_VB   = WS_KB   + (size_t)MPR * 1024 * 2;
constexpr size_t WS_NCK  = WS_VB   + (size_t)MPR * 1024 * 2;
constexpr size_t WS_QS   = WS_NCK  + (size_t)NB * NH * SEQ * 16 * 2;
constexpr size_t WS_AB   = WS_QS   + (size_t)DBT * NH * DSQ * HD * 4;
constexpr size_t WS_AT   = WS_AB   + (size_t)NG * NST * 2 * 4;
constexpr size_t WS_BBR  = WS_AT   + (size_t)NG * NST * 2 * 4;
constexpr size_t WS_BBI  = WS_BBR  + (size_t)NG * NST * GC * 4;
constexpr size_t WS_E    = WS_BBI  + (size_t)NG * NST * GC * 4;
constexpr size_t WS_PW   = WS_E    + (size_t)NG * 512 * 128 * 4;
constexpr size_t WS_M3   = al256(WS_PW + (size_t)NG * 17 * NST * 2 * 4);
constexpr size_t WS_M2   = WS_M3   + (size_t)NG * 128 * 256 * 2;
constexpr size_t WS_KT   = WS_M2   + (size_t)NG * 256 * 128 * 2;
constexpr size_t WS_UB   = WS_KT   + (size_t)NG * 16 * 256 * 2;
constexpr size_t WS_AG   = WS_UB   + (size_t)NG * 512 * 256 * 2;
constexpr size_t WS_RP   = WS_AG   + (size_t)NG * 16 * 128 * 4;
constexpr size_t WS_TPG  = WS_RP   + (size_t)DBT * NH * PAST * 4;
constexpr size_t WS_PML  = WS_TPG  + (size_t)DBT * NH * NPAGES * 4;
constexpr size_t WS_PO   = WS_PML  + (size_t)256 * 64 * 2 * 4;
constexpr size_t WS_SS2  = WS_PO   + (size_t)256 * 64 * 128 * 4;
constexpr size_t WS_SSR  = WS_SS2  + (size_t)32 * 64 * 4;
constexpr size_t WS_LIST = al256(WS_SSR + (size_t)MPAD * 4);
constexpr size_t WS_XF   = al256(WS_LIST + (size_t)(256 + 2048 + 64) * 4);
constexpr size_t WS_JLO  = WS_XF   + (size_t)NB * NH * SEQ * 4;
constexpr size_t WS_END  = WS_JLO  + (size_t)256 * 4;
constexpr int CW_Q = 8192;
constexpr int CW_BAR = 4096;

constexpr int LDS_BYTES = 147456;
constexpr int MISC_OFF = LDS_BYTES - 512;
constexpr int NWAVES = 8;
struct Args { const void* in[30]; float* out; unsigned char* ws; int ph_lo, ph_hi, probe, pad; };
struct Frame {
    unsigned char* lds;
    int tid, lane, wave, G, gw, NGW;
    float* out; unsigned char* ws;
};
template <int OFF> __device__ __forceinline__ unsigned long long karg_load() {
    unsigned long long v; auto kp = __builtin_amdgcn_kernarg_segment_ptr();
    asm volatile("s_load_dwordx2 %0, %1, %2\n\ts_waitcnt lgkmcnt(0)" : "=s"(v) : "s"(kp), "n"(OFF) : "memory"); return v; }
#define INP(T, i) ((const T*)(const __attribute__((address_space(1))) T*)karg_load<8 * (i)>())
enum { I_XP = 0, I_XS, I_CK, I_CV, I_CLF, I_SRE, I_SIM, I_PT, I_G1, I_WIN, I_BF, I_GQ, I_GK, I_ARE, I_AIM, I_LDT, I_BRE, I_BIM, I_CRE, I_CIM, I_DSSM, I_WGLU, I_BGLU, I_WBRS, I_WBRA, I_WOUT, I_G2, I_WFG, I_WFU, I_WFD };
#define WSP(T, off) ((T*)(F.ws + (off)))

__device__ __forceinline__ float wave_sum(float v) {
#pragma unroll
    for (int o = 1; o < 64; o <<= 1) v += __shfl_xor(v, o);
    return v;
}
__device__ __forceinline__ unsigned cvtpk(float lo, float hi) { unsigned r; asm volatile("v_cvt_pk_bf16_f32 %0, %1, %2" : "=v"(r) : "v"(lo), "v"(hi)); return r; }

__device__ __forceinline__ void sincos_d(double x, double& s, double& c) {
    const double k = __builtin_rint(x * 0.63661977236758134308);
    double r = __builtin_fma(-k, 1.57079632679489655800e+00, x); r = __builtin_fma(-k, 6.12323399573676603587e-17, r);
    const long long q = (long long)k; const double r2 = r * r;
    double sp = -1.0 / 1307674368000.0; sp = sp * r2 + 1.0 / 6227020800.0; sp = sp * r2 - 1.0 / 39916800.0; sp = sp * r2 + 1.0 / 362880.0; sp = sp * r2 - 1.0 / 5040.0; sp = sp * r2 + 1.0 / 120.0; sp = sp * r2 - 1.0 / 6.0; sp = sp * r2 + 1.0; sp *= r;
    double cp = 1.0 / 20922789888000.0; cp = cp * r2 - 1.0 / 87178291200.0; cp = cp * r2 + 1.0 / 479001600.0; cp = cp * r2 - 1.0 / 3628800.0; cp = cp * r2 + 1.0 / 40320.0; cp = cp * r2 - 1.0 / 720.0; cp = cp * r2 + 1.0 / 24.0; cp = cp * r2 - 0.5; cp = cp * r2 + 1.0;
    const int qq = (int)(q & 3);
    s = (qq == 0) ? sp : (qq == 1) ? cp : (qq == 2) ? -sp : -cp;
    c = (qq == 0) ? cp : (qq == 1) ? -sp : (qq == 2) ? -cp : sp;
}
__device__ __forceinline__ double exp_d(double x) {
    const double k = __builtin_rint(x * 1.44269504088896338700e+00);
    double r = __builtin_fma(-k, 6.93147180369123816490e-01, x); r = __builtin_fma(-k, 1.90821492927058770002e-10, r);
    double p = 1.0 / 6227020800.0; p = p * r + 1.0 / 479001600.0; p = p * r + 1.0 / 39916800.0; p = p * r + 1.0 / 3628800.0; p = p * r + 1.0 / 362880.0; p = p * r + 1.0 / 40320.0; p = p * r + 1.0 / 5040.0;
    p = p * r + 1.0 / 720.0; p = p * r + 1.0 / 120.0; p = p * r + 1.0 / 24.0; p = p * r + 1.0 / 6.0; p = p * r + 0.5; p = p * r + 1.0; p = p * r + 1.0;
    int ki = (int)k; if (ki < -1000) return 0.0;
    return __builtin_ldexp(p, ki);
}

constexpr int WI_IN = 32 * 8, WI_GLU = 16 * 2, WI_BR = 16 * 4, WI_OUT = 32 * 4, WI_FF1 = 32 * 11, WI_FF2 = 88 * 4;
constexpr int WI_GLU0 = 2 * WI_IN, WI_BR0 = WI_GLU0 + WI_GLU, WI_OUT0 = WI_BR0 + 2 * WI_BR, WI_FF10 = WI_OUT0 + WI_OUT, WI_FF20 = WI_FF10 + 2 * WI_FF1, WI_END = WI_FF20 + WI_FF2;
struct WItem { const float* src; bf16* dst; const float* gs; int ldw, ldd, ilv; };
__device__ __forceinline__ void weight_copies(Frame& F, int it_lo, int it_hi, int bi, int nb, int prb = 0) {
    const float* const g1 = INP(float, I_G1); const float* const w_in = INP(float, I_WIN);
    const float* const w_glu = INP(float, I_WGLU); const float* const w_brs = INP(float, I_WBRS); const float* const w_bra = INP(float, I_WBRA); const float* const w_out = INP(float, I_WOUT);
    const float* const g2 = INP(float, I_G2); const float* const w_fg = INP(float, I_WFG); const float* const w_fu = INP(float, I_WFU); const float* const w_fd = INP(float, I_WFD);
    int drow0 = 0, n0g = 0;
    auto decode = [&](int it, WItem& t) { int r = it;
#define WC_SET(W_, ldw_, scol_, WT_, ldd_, drow_, k0_, dk0_, gs_, ilv_) do { t.src = (W_) + (size_t)(k0_) * (ldw_) + (scol_); t.dst = (WT_) + (dk0_) + (k0_); t.gs = (gs_) ? (gs_) + (k0_) : nullptr; t.ldw = (ldw_); t.ldd = (ldd_); t.ilv = (ilv_); drow0 = (drow_); n0g = (scol_); } while (0)
        if (r < 2 * WI_IN) { const int part = r / WI_IN; r -= part * WI_IN; const int kb = r / 8, nbk = r % 8; WC_SET(w_in, NIN, (part ? 4104 : 0) + 512 * nbk, WSP(bf16, WS_W1T), 2048, part * 4096 + 512 * nbk, 64 * kb, 0, g1, -1); return; } r -= 2 * WI_IN;
        if (r < WI_GLU) { const int kb = r / 2, nbk = r % 2; WC_SET(w_glu, 1024, 512 * nbk, WSP(bf16, WS_WGLU), 1024, 512 * nbk, 64 * kb, 0, (const float*)nullptr, -1); return; } r -= WI_GLU;
        if (r < 2 * WI_BR) { const int part = r / WI_BR; r -= part * WI_BR; const int kb = r / 4, nbk = r % 4; WC_SET(part ? w_bra : w_brs, 2048, 512 * nbk, WSP(bf16, WS_WBR), 2048, 512 * nbk, 64 * kb, part * 1024, (const float*)nullptr, -1); return; } r -= 2 * WI_BR;
        if (r < WI_OUT) { const int kb = r / 4, nbk = r % 4; WC_SET(w_out, 2048, 512 * nbk, WSP(bf16, WS_WOUT), 2048, 512 * nbk, 64 * kb, 0, (const float*)nullptr, -1); return; } r -= WI_OUT;
        if (r < 2 * WI_FF1) { const int part = r / WI_FF1; r -= part * WI_FF1; const int kb = r / 11, nbk = r % 11; WC_SET(part ? w_fu : w_fg, DFF, 512 * nbk, WSP(bf16, WS_WFF1), 2048, 0, 64 * kb, 0, g2, part); return; } r -= 2 * WI_FF1;
        { const int kb = r / 4, nbk = r % 4; WC_SET(w_fd, 2048, 512 * nbk, WSP(bf16, WS_WFF2), DFF, 512 * nbk, 64 * kb, 0, (const float*)nullptr, -1); }
#undef WC_SET
    };
    float* T = (float*)F.lds;
    f32x4 nx[16]; WItem tn; int it = it_lo + bi;
#define WC_LOAD() do { _Pragma("unroll") for (int i = 0; i < 16; ++i) nx[i] = *(const f32x4*)(tn.src + (size_t)(8 * F.wave + (i >> 1)) * tn.ldw + 256 * (i & 1) + 4 * F.lane); } while (0)
    if (it < it_hi) { decode(it, tn); WC_LOAD(); }
    for (; it < it_hi; it += nb) { const WItem t = tn; const int dr0 = drow0, n0 = n0g;
        __syncthreads();
#pragma unroll
        for (int i = 0; i < 16; ++i) { f32x4 v = nx[i]; if (t.gs) v = v * t.gs[8 * F.wave + (i >> 1)]; *(f32x4*)(T + (8 * F.wave + (i >> 1)) * 512 + 256 * (i & 1) + 4 * F.lane) = v; }
        if (it + nb < it_hi) { decode(it + nb, tn); WC_LOAD(); }
        __syncthreads();
        const int n = 64 * F.wave + F.lane, nsrc = n0 + n; const int row = t.ilv < 0 ? dr0 + n : 256 * (nsrc >> 7) + (nsrc & 127) + 128 * t.ilv;
        bf16* op = t.dst + (size_t)row * t.ldd; const float* tc = T + n;
#pragma unroll
        for (int c = 0; c < 8; ++c) { v4u o; o.x = cvtpk(tc[(8 * c) * 512], tc[(8 * c + 1) * 512]); o.y = cvtpk(tc[(8 * c + 2) * 512], tc[(8 * c + 3) * 512]); o.z = cvtpk(tc[(8 * c + 4) * 512], tc[(8 * c + 5) * 512]); o.w = cvtpk(tc[(8 * c + 6) * 512], tc[(8 * c + 7) * 512]);
            if (!(prb & 32) || o.x == 0x12345678u) *(v4u*)(op + 8 * c) = o; } }
#undef WC_LOAD
    __syncthreads();
}
__device__ __forceinline__ void phase0(Frame& F, int prb) {
    const float* const g1 = INP(float, I_G1); const float* const w_in = INP(float, I_WIN);
    float* WF = (float*)F.lds;
    for (int k = F.tid; k < DM; k += NWAVES * 64) { const float g = g1[k]; const float* wp = w_in + (size_t)k * NIN + 4096; const f32x4 a = *(const f32x4*)wp, b = *(const f32x4*)(wp + 4);
        WF[0 * DM + k] = g * a[0]; WF[1 * DM + k] = g * a[1]; WF[2 * DM + k] = g * a[2]; WF[3 * DM + k] = g * a[3];
        WF[4 * DM + k] = g * b[0]; WF[5 * DM + k] = g * b[1]; WF[6 * DM + k] = g * b[2]; WF[7 * DM + k] = g * b[3]; }
    __syncthreads();
    bf16* XA = WSP(bf16, WS_XA); float* R1 = WSP(float, WS_R1); const float* const xp = INP(float, I_XP); const float* const xs = INP(float, I_XS); const float* const b_f = INP(float, I_BF);
    if (!(prb & 64)) for (int m = MR + F.gw; m < MPAD; m += F.NGW) { unsigned long long* o8 = (unsigned long long*)(XA + (size_t)m * DM) + F.lane;
#pragma unroll
        for (int j = 0; j < 8; ++j) o8[64 * j] = 0ull;
        if (F.lane == 0) R1[m] = 0.f; }
    {
#define P0_ROWPTR(m_) ((const f32x4*)((m_) < MPR ? xp + (size_t)(m_) * DM : xs + (size_t)((m_) - MPR) * DM) + F.lane)
        f32x4 nx[8]; int m = (prb & 64) ? MR : F.gw;
        if (m < MR) { const f32x4* xr = P0_ROWPTR(m);
#pragma unroll
            for (int j = 0; j < 8; ++j) nx[j] = xr[64 * j]; }
        for (; m < MR; m += F.NGW) {
            f32x4 v[8];
#pragma unroll
            for (int j = 0; j < 8; ++j) v[j] = nx[j];
            const int mn = m + F.NGW;
            if (mn < MR) { const f32x4* xr = P0_ROWPTR(mn);
#pragma unroll
                for (int j = 0; j < 8; ++j) nx[j] = xr[64 * j]; }
            float ss = 0.f;
#pragma unroll
            for (int j = 0; j < 8; ++j) ss += (v[j][0] * v[j][0] + v[j][1] * v[j][1]) + (v[j][2] * v[j][2] + v[j][3] * v[j][3]);
            unsigned long long* o8 = (unsigned long long*)(XA + (size_t)m * DM) + F.lane;
#pragma unroll
            for (int j = 0; j < 8; ++j) o8[64 * j] = (unsigned long long)cvtpk(v[j][0], v[j][1]) | ((unsigned long long)cvtpk(v[j][2], v[j][3]) << 32);
            float a[8];
#pragma unroll
            for (int h = 0; h < 8; ++h) { float t = 0.f;
#pragma unroll
                for (int j = 0; j < 8; ++j) { const f32x4 w = *(const f32x4*)(WF + h * DM + 256 * j + 4 * F.lane); t += (v[j][0] * w[0] + v[j][1] * w[1]) + (v[j][2] * w[2] + v[j][3] * w[3]); }
                a[h] = t; }
            const bool b5 = (F.lane & 32) != 0, b4 = (F.lane & 16) != 0, b3 = (F.lane & 8) != 0; float w4[4], w2[2];
#pragma unroll
            for (int i = 0; i < 4; ++i) { const float snd = b5 ? a[i] : a[i + 4], kp = b5 ? a[i + 4] : a[i]; w4[i] = kp + __shfl_xor(snd, 32); }
#pragma unroll
            for (int i = 0; i < 2; ++i) { const float snd = b4 ? w4[i] : w4[i + 2], kp = b4 ? w4[i + 2] : w4[i]; w2[i] = kp + __shfl_xor(snd, 16); }
            float fl; { const float snd = b3 ? w2[0] : w2[1], kp = b3 ? w2[1] : w2[0]; fl = kp + __shfl_xor(snd, 8); }
            fl += __shfl_xor(fl, 1); fl += __shfl_xor(fl, 2); fl += __shfl_xor(fl, 4);
            ss = wave_sum(ss);
            const float r1 = 1.0f / sqrtf(ss * (1.0f / DM) + RMS_EPS);
            if (F.lane == 0) R1[m] = r1;
            if ((F.lane & 7) == 0) { const int h = ((F.lane >> 5) & 1) * 4 + ((F.lane >> 4) & 1) * 2 + ((F.lane >> 3) & 1); const float z = fl * r1 + b_f[h]; const float lf = fminf(z, 0.f) - log1pf(expf(-fabsf(z)));
                if (m < MPR) F.out[O_LFP + (size_t)m * NH + h] = lf; else F.out[O_LFS + (size_t)(m - MPR) * NH + h] = lf; }
        }
#undef P0_ROWPTR
    }
    for (int i = F.gw * 64 + F.lane; i < MPAD; i += F.NGW * 64) WSP(float, WS_SSR)[i] = 0.f;
    { const float* const ldt = INP(float, I_LDT); const float* const a_re = INP(float, I_ARE); const float* const a_im = INP(float, I_AIM); const float* const b_re = INP(float, I_BRE); const float* const b_im = INP(float, I_BIM);
    for (int g = F.gw; g < NG; g += F.NGW) { const int p = F.lane, gp = g * NST + p;
        const double dt = exp_d((double)ldt[g]), are = (double)a_re[gp], aim = (double)a_im[gp];
        double sn, cs; sincos_d(dt * aim, sn, cs); const double mag = exp_d(dt * are); const double abr = mag * cs, abi = mag * sn;
        float* AB = WSP(float, WS_AB); AB[2 * gp] = (float)abr; AB[2 * gp + 1] = (float)abi;
        { float* PW = WSP(float, WS_PW) + (size_t)g * 17 * NST * 2 + 2 * p; double pr = 1.0, pi = 0.0;
#pragma unroll 1
          for (int tau = 0; tau <= 16; ++tau) { PW[tau * NST * 2] = (float)pr; PW[tau * NST * 2 + 1] = (float)pi; const double nr = pr * abr - pi * abi, ni = pr * abi + pi * abr; pr = nr; pi = ni; } }
        const double er = abr - 1.0, ei = abi, inv = 1.0 / (are * are + aim * aim), fr = (er * are + ei * aim) * inv, fi = (ei * are - er * aim) * inv;
        float* BBR = WSP(float, WS_BBR) + (size_t)gp * GC; float* BBI = WSP(float, WS_BBI) + (size_t)gp * GC;
#pragma unroll
        for (int c = 0; c < GC; ++c) { const double br = (double)b_re[(size_t)gp * GC + c], bi = (double)b_im[(size_t)gp * GC + c]; BBR[c] = (float)(fr * br - fi * bi); BBI[c] = (float)(fr * bi + fi * br); }
    } }
    { const int* const pt = INP(int, I_PT); const float* const clf = INP(float, I_CLF);
    for (int it = F.gw; it < DBT * NPAGES; it += F.NGW) { const int b = it >> 7, j = it & 127, phys = pt[it]; const int seg = F.lane >> 3, h = F.lane & 7;
        const float* lp = clf + ((size_t)phys * PAGE + 16 * seg) * NH + h; float v[16];
#pragma unroll
        for (int i = 0; i < 16; ++i) v[i] = lp[i * NH];
        float s[16]; float run = 0.f;
#pragma unroll
        for (int i = 15; i >= 0; --i) { s[i] = run; run += v[i]; }
        float off = 0.f;
#pragma unroll
        for (int d = 1; d < 8; ++d) { const float t = __shfl(run, (F.lane + 8 * d) & 63); if (seg + d < 8) off += t; }
        float* rp = WSP(float, WS_RP) + ((size_t)(b * NH + h) * PAST) + j * PAGE + 16 * seg;
#pragma unroll
        for (int i = 0; i < 16; ++i) rp[i] = s[i] + off;
        if (seg == 0) WSP(float, WS_TPG)[(b * NH + h) * NPAGES + j] = off + run; } }
    __syncthreads();
    weight_copies(F, 0, WI_BR0, (int)blockIdx.x, F.G, prb);
}
__device__ __forceinline__ void rowpass(Frame& F) {
    const int h = F.lane >> 3, sub = F.lane & 7, off = h * HD + sub * 16;
    float gq[16], gk[16]; { const float* const gqp = INP(float, I_GQ); const float* const gkp = INP(float, I_GK);
#pragma unroll
    for (int i = 0; i < 16; ++i) { gq[i] = gqp[sub * 16 + i]; gk[i] = gkp[sub * 16 + i]; } }
    const float* Z = WSP(float, WS_Z);
    for (int m = MPR + F.gw; m < MR; m += F.NGW) {
        const float* z = Z + (size_t)m * 4096 + off; float q[16], k[16], v[16];
#pragma unroll
        for (int i = 0; i < 4; ++i) { const f32x4 a = *(const f32x4*)(z + 1024 + 4 * i), b = *(const f32x4*)(z + 2048 + 4 * i), c = *(const f32x4*)(z + 3072 + 4 * i);
#pragma unroll
            for (int e = 0; e < 4; ++e) { q[4 * i + e] = a[e]; k[4 * i + e] = b[e]; v[4 * i + e] = c[e]; } }
        float sq = 0.f, sk = 0.f;
#pragma unroll
        for (int i = 0; i < 16; ++i) { sq += q[i] * q[i]; sk += k[i] * k[i]; }
        sq += __shfl_xor(sq, 1); sq += __shfl_xor(sq, 2); sq += __shfl_xor(sq, 4); sk += __shfl_xor(sk, 1); sk += __shfl_xor(sk, 2); sk += __shfl_xor(sk, 4);
        const float rq = 1.0f / sqrtf(sq * (1.0f / HD) + RMS_EPS), rk = 1.0f / sqrtf(sk * (1.0f / HD) + RMS_EPS);
#pragma unroll
        for (int i = 0; i < 16; ++i) { q[i] = q[i] * rq * gq[i]; k[i] = k[i] * rk * gk[i]; }
        float* ko; float* vo;
        if (m < MPR) { const int b = m >> 12, s = m & (SEQ - 1); const size_t ao = ((size_t)(b * NH + h) * SEQ + s) * HD + sub * 16;
            v4u w;
            w.x = cvtpk(q[0], q[1]); w.y = cvtpk(q[2], q[3]); w.z = cvtpk(q[4], q[5]); w.w = cvtpk(q[6], q[7]); *(v4u*)(WSP(bf16, WS_QB) + ao) = w;
            w.x = cvtpk(q[8], q[9]); w.y = cvtpk(q[10], q[11]); w.z = cvtpk(q[12], q[13]); w.w = cvtpk(q[14], q[15]); *(v4u*)(WSP(bf16, WS_QB) + ao + 8) = w;
            w.x = cvtpk(k[0], k[1]); w.y = cvtpk(k[2], k[3]); w.z = cvtpk(k[4], k[5]); w.w = cvtpk(k[6], k[7]); *(v4u*)(WSP(bf16, WS_KB) + ao) = w;
            w.x = cvtpk(k[8], k[9]); w.y = cvtpk(k[10], k[11]); w.z = cvtpk(k[12], k[13]); w.w = cvtpk(k[14], k[15]); *(v4u*)(WSP(bf16, WS_KB) + ao + 8) = w;
            w.x = cvtpk(v[0], v[1]); w.y = cvtpk(v[2], v[3]); w.z = cvtpk(v[4], v[5]); w.w = cvtpk(v[6], v[7]); *(v4u*)(WSP(bf16, WS_VB) + ao) = w;
            w.x = cvtpk(v[8], v[9]); w.y = cvtpk(v[10], v[11]); w.z = cvtpk(v[12], v[13]); w.w = cvtpk(v[14], v[15]); *(v4u*)(WSP(bf16, WS_VB) + ao + 8) = w;
            ko = F.out + O_KP + (size_t)m * DATT + off; vo = F.out + O_VP + (size_t)m * DATT + off;
        } else { const int ms = m - MPR, b = ms >> 2, t = ms & 3; float* qs = WSP(float, WS_QS) + ((size_t)((b * NH + h) * DSQ + t)) * HD + sub * 16;
#pragma unroll
            for (int i = 0; i < 4; ++i) *(f32x4*)(qs + 4 * i) = (f32x4){q[4 * i], q[4 * i + 1], q[4 * i + 2], q[4 * i + 3]};
            ko = F.out + O_KS + (size_t)ms * DATT + off; vo = F.out + O_VS + (size_t)ms * DATT + off; }
#pragma unroll
        for (int i = 0; i < 4; ++i) { *(f32x4*)(ko + 4 * i) = (f32x4){k[4 * i], k[4 * i + 1], k[4 * i + 2], k[4 * i + 3]}; *(f32x4*)(vo + 4 * i) = (f32x4){v[4 * i], v[4 * i + 1], v[4 * i + 2], v[4 * i + 3]}; }
    }
}
__device__ __forceinline__ void logf_cumsum(Frame& F) {
    const float* const gqp = INP(float, I_GQ); const float* const gkp = INP(float, I_GK);
    for (int it = F.gw; it < NB * NH; it += F.NGW) { const int b = it >> 3, h = it & 7; const float* lf = F.out + O_LFP + ((size_t)b * SEQ + 64 * F.lane) * NH + h; bf16* o = WSP(bf16, WS_NCK) + ((size_t)it * SEQ + 64 * F.lane) * 16; float* xf = WSP(float, WS_XF) + (size_t)it * SEQ + 64 * F.lane;
        float v[64];
#pragma unroll
        for (int i = 0; i < 64; ++i) v[i] = lf[(size_t)i * NH];
        double tot = 0.0;
#pragma unroll
        for (int i = 0; i < 64; ++i) tot += (double)v[i];
        double ex = tot;
#pragma unroll
        for (int d = 1; d < 64; d <<= 1) { const double t = __shfl_up(ex, d); if (F.lane >= d) ex += t; }
        double run = ex - tot; float xs_[64];
#pragma unroll
        for (int i = 0; i < 64; ++i) { run += (double)v[i];
            const float x = (float)(-run * 11.313708498984761);
            xs_[i] = x; xf[i] = x;
            const unsigned h16 = cvtpk(x, 0.f) & 0xffffu; const float r1 = x - __uint_as_float(h16 << 16); const unsigned m16 = cvtpk(r1, 0.f) & 0xffffu; const float r2 = r1 - __uint_as_float(m16 << 16); const unsigned l16 = cvtpk(r2, 0.f) & 0xffffu;
            v4u w; w.x = h16 | (m16 << 16); w.y = l16; w.z = 0u; w.w = 0u; *(v4u*)(o + (size_t)i * 16) = w; *(v4u*)(o + (size_t)i * 16 + 8) = (v4u){0u, 0u, 0u, 0u}; }
        { float mq = fmaxf(fabsf(gqp[F.lane]), fabsf(gqp[F.lane + 64])), mk = fmaxf(fabsf(gkp[F.lane]), fabsf(gkp[F.lane + 64]));
#pragma unroll
          for (int od = 1; od < 64; od <<= 1) { mq = fmaxf(mq, __shfl_xor(mq, od)); mk = fmaxf(mk, __shfl_xor(mk, od)); }
          const float bq2 = 11.313708498984761f * 1.4426950408889634f * mq * mk, thr = (2.f * bq2 + 40.f) * (1.0f / (1.4426950408889634f * 0.08838834764831845f));
          for (int qb = 0; qb < 16; ++qb) { const float tgt = __shfl(xs_[0], 4 * qb) - thr; int cnt = 0;
#pragma unroll
              for (int i = 0; i < 64; ++i) cnt += (xs_[i] < tgt) ? 1 : 0;
#pragma unroll
              for (int od = 1; od < 64; od <<= 1) cnt += __shfl_xor(cnt, od);
              if (F.lane == 0) WSP(int, WS_JLO)[it * 16 + qb] = cnt >> 6; } } }
}
__device__ __forceinline__ void rpast_fix(Frame& F) {
    for (int it = F.gw; it < DBT * NH * NPAGES; it += F.NGW) { const int bh = it >> 7, j = it & 127; const float* tp = WSP(float, WS_TPG) + bh * NPAGES;
        float a = (F.lane > j ? tp[F.lane] : 0.f) + (F.lane + 64 > j ? tp[F.lane + 64] : 0.f); a = wave_sum(a);
        float* rp = WSP(float, WS_RP) + (size_t)bh * PAST + j * PAGE; rp[F.lane] = (rp[F.lane] + a) * LOG2E; rp[F.lane + 64] = (rp[F.lane + 64] + a) * LOG2E; }
}

namespace s5 {
constexpr int HS_STRIDE = 132, US_F = 256, HS_F = 16 * HS_STRIDE, CS_F = 64 * 32, WLDS_F = US_F + HS_F + CS_F;
__device__ __forceinline__ float gelu_erf(float y) { return 0.5f * y * (1.0f + erff(y * 0.70710678118654752440f)); }
template <int MODE>
__device__ __forceinline__ void unit(const float* U, int T, float& hre, float& him, const float* bbr, const float* bbi, float are, float aim, float* wl, int lane, bf16* YPr, const float* dv) {
    float br[16], bi[16];
#pragma unroll
    for (int i = 0; i < 4; ++i) { const f32x4 a = *(const f32x4*)(bbr + 4 * i), b = *(const f32x4*)(bbi + 4 * i);
#pragma unroll
        for (int e = 0; e < 4; ++e) { br[4 * i + e] = a[e]; bi[4 * i + e] = b[e]; } }
    float* Us = wl; float* Hs = wl + US_F; const float* Cs = wl + US_F + HS_F;
    for (int t0 = 0; t0 < T; t0 += 16) { const int nst = (T - t0) < 16 ? (T - t0) : 16;
        { const int row = lane >> 2, quad = lane & 3; f32x4 v = (f32x4){0.f, 0.f, 0.f, 0.f}; if (row < nst) v = *(const f32x4*)(U + (size_t)(t0 + row) * 4096 + quad * 4); *(f32x4*)(Us + row * 16 + quad * 4) = v; }
        LDS_WAIT(); asm volatile("" ::: "memory");
#pragma unroll 1
        for (int t = 0; t < nst; ++t) { float bur = 0.f, bui = 0.f;
#pragma unroll
            for (int i = 0; i < 4; ++i) { const f32x4 u = *(const f32x4*)(Us + t * 16 + 4 * i);
#pragma unroll
                for (int e = 0; e < 4; ++e) { bur = fmaf(br[4 * i + e], u[e], bur); bui = fmaf(bi[4 * i + e], u[e], bui); } }
            const float nre = fmaf(are, hre, fmaf(-aim, him, bur)), nim = fmaf(are, him, fmaf(aim, hre, bui)); hre = nre; him = nim;
            if (MODE == 1) { typedef float f32x2 __attribute__((ext_vector_type(2))); *(f32x2*)(Hs + t * HS_STRIDE + 2 * lane) = (f32x2){hre, him}; } }
        if (MODE == 1) { LDS_WAIT(); asm volatile("" ::: "memory");
            const int tl = lane >> 2, cq = lane & 3; float a0 = 0.f, a1 = 0.f, a2 = 0.f, a3 = 0.f;
#pragma unroll 4
            for (int pp = 0; pp < 32; ++pp) { const f32x4 h4 = *(const f32x4*)(Hs + tl * HS_STRIDE + 4 * pp);
                const f32x4 cA0 = *(const f32x4*)(Cs + (2 * pp) * 32 + cq * 8), cA1 = *(const f32x4*)(Cs + (2 * pp) * 32 + cq * 8 + 4);
                const f32x4 cB0 = *(const f32x4*)(Cs + (2 * pp + 1) * 32 + cq * 8), cB1 = *(const f32x4*)(Cs + (2 * pp + 1) * 32 + cq * 8 + 4);
                a0 += (cA0[0] * h4[0] - cA0[1] * h4[1]) + (cB0[0] * h4[2] - cB0[1] * h4[3]); a1 += (cA0[2] * h4[0] - cA0[3] * h4[1]) + (cB0[2] * h4[2] - cB0[3] * h4[3]);
                a2 += (cA1[0] * h4[0] - cA1[1] * h4[1]) + (cB1[0] * h4[2] - cB1[1] * h4[3]); a3 += (cA1[2] * h4[0] - cA1[3] * h4[1]) + (cB1[2] * h4[2] - cB1[3] * h4[3]); }
            if (tl < nst) { const f32x4 u = *(const f32x4*)(Us + tl * 16 + cq * 4), d = *(const f32x4*)(dv + cq * 4);
                const float y0 = gelu_erf(fmaf(d[0], u[0], a0)), y1 = gelu_erf(fmaf(d[1], u[1], a1)), y2 = gelu_erf(fmaf(d[2], u[2], a2)), y3 = gelu_erf(fmaf(d[3], u[3], a3));
                *(unsigned long long*)(YPr + (size_t)(t0 + tl) * 1024 + cq * 4) = (unsigned long long)cvtpk(y0, y1) | ((unsigned long long)cvtpk(y2, y3) << 32); }
            LDS_WAIT(); asm volatile("" ::: "memory"); }
    }
}
typedef float f32x16 __attribute__((ext_vector_type(16)));
__device__ __forceinline__ void gen_tables(Frame& F) {
    const float* PW = WSP(float, WS_PW); const float* BBR = WSP(float, WS_BBR); const float* BBI = WSP(float, WS_BBI);
    const float* const c_re = INP(float, I_CRE); const float* const c_im = INP(float, I_CIM); const float* const dssm = INP(float, I_DSSM);
    for (int it = F.gw; it < 3 * 1024; it += F.NGW) { const int kind = it >> 10, g = (it >> 4) & 63, x = it & 15, p = F.lane;
        if (kind == 0) {
            const float wr = PW[((size_t)(g * 17 + (15 - x)) * NST + p) * 2], wi = PW[((size_t)(g * 17 + (15 - x)) * NST + p) * 2 + 1]; float re[16], im[16];
#pragma unroll
            for (int i = 0; i < 4; ++i) { const f32x4 br = *(const f32x4*)(BBR + (size_t)(g * NST + p) * GC + 4 * i), bi = *(const f32x4*)(BBI + (size_t)(g * NST + p) * GC + 4 * i);
#pragma unroll
                for (int e = 0; e < 4; ++e) { re[4 * i + e] = wr * br[e] - wi * bi[e]; im[4 * i + e] = wr * bi[e] + wi * br[e]; } }
            bf16* o = WSP(bf16, WS_M3) + ((size_t)(g * 128 + p) * 256 + x * 16);
#pragma unroll
            for (int hf = 0; hf < 2; ++hf) { v4u w; w.x = cvtpk(re[8 * hf], re[8 * hf + 1]); w.y = cvtpk(re[8 * hf + 2], re[8 * hf + 3]); w.z = cvtpk(re[8 * hf + 4], re[8 * hf + 5]); w.w = cvtpk(re[8 * hf + 6], re[8 * hf + 7]); *(v4u*)(o + 8 * hf) = w;
                w.x = cvtpk(im[8 * hf], im[8 * hf + 1]); w.y = cvtpk(im[8 * hf + 2], im[8 * hf + 3]); w.z = cvtpk(im[8 * hf + 4], im[8 * hf + 5]); w.w = cvtpk(im[8 * hf + 6], im[8 * hf + 7]); *(v4u*)(o + (size_t)64 * 256 + 8 * hf) = w; }
        } else if (kind == 1) {
            const float wr = PW[((size_t)(g * 17 + x + 1) * NST + p) * 2], wi = PW[((size_t)(g * 17 + x + 1) * NST + p) * 2 + 1]; bf16* o = WSP(bf16, WS_M2) + (size_t)(g * 256 + x * 16) * 128 + p;
#pragma unroll 4
            for (int c = 0; c < GC; ++c) { const float cr = c_re[(size_t)(g * GC + c) * NST + p], ci = c_im[(size_t)(g * GC + c) * NST + p];
                o[(size_t)c * 128] = (bf16)(cvtpk(cr * wr - ci * wi, 0.f) & 0xffffu); o[(size_t)c * 128 + 64] = (bf16)(cvtpk(-(cr * wi + ci * wr), 0.f) & 0xffffu); }
        } else {
            const int c = F.lane >> 2, c4 = 4 * (F.lane & 3); float a0 = 0.f, a1 = 0.f, a2 = 0.f, a3 = 0.f;
#pragma unroll 4
            for (int pp = 0; pp < NST; ++pp) { const float wr = PW[((size_t)(g * 17 + x) * NST + pp) * 2], wi = PW[((size_t)(g * 17 + x) * NST + pp) * 2 + 1];
                const float cr = c_re[(size_t)(g * GC + c) * NST + pp], ci = c_im[(size_t)(g * GC + c) * NST + pp]; const float tr = cr * wr - ci * wi, ti = cr * wi + ci * wr;
                const f32x4 br = *(const f32x4*)(BBR + (size_t)(g * NST + pp) * GC + c4), bi = *(const f32x4*)(BBI + (size_t)(g * NST + pp) * GC + c4);
                a0 += tr * br[0] - ti * bi[0]; a1 += tr * br[1] - ti * bi[1]; a2 += tr * br[2] - ti * bi[2]; a3 += tr * br[3] - ti * bi[3]; }
            if (x == 0) { const float d = dssm[g * GC + c]; if (c4 == (c & 12)) { const int e = c & 3; if (e == 0) a0 += d; else if (e == 1) a1 += d; else if (e == 2) a2 += d; else a3 += d; } }
            *(unsigned long long*)(WSP(bf16, WS_KT) + ((size_t)(g * 16 + x) * 16 + c) * 16 + c4) = (unsigned long long)cvtpk(a0, a1) | ((unsigned long long)cvtpk(a2, a3) << 32);
        } }
}
__device__ __forceinline__ void passE(Frame& F) {
    const bf16* UB = WSP(bf16, WS_UB); const bf16* M3 = WSP(bf16, WS_M3); float* E = WSP(float, WS_E); const float* PW = WSP(float, WS_PW); const int r = F.lane & 31, kh = F.lane >> 5;
    for (int it = F.gw; it < NG * 16; it += F.NGW) { const int g = it >> 4, nt = it & 15;
        f32x16 acc[4];
#pragma unroll
        for (int m = 0; m < 4; ++m) acc[m] = (f32x16){0.f, 0.f, 0.f, 0.f, 0.f, 0.f, 0.f, 0.f, 0.f, 0.f, 0.f, 0.f, 0.f, 0.f, 0.f, 0.f};
        const bf16* bp = UB + (size_t)(g * 512 + 32 * nt + r) * 256 + 8 * kh; const bf16* ap = M3 + (size_t)(g * 128 + r) * 256 + 8 * kh;
#pragma unroll 4
        for (int s = 0; s < 16; ++s) { const bf16x8 bfr = *(const bf16x8*)(bp + 16 * s);
#pragma unroll
            for (int m = 0; m < 4; ++m) { const bf16x8 afr = *(const bf16x8*)(ap + (size_t)m * 32 * 256 + 16 * s); acc[m] = __builtin_amdgcn_mfma_f32_32x32x16_bf16(afr, bfr, acc[m], 0, 0, 0); } }
        float* ep = E + (size_t)(g * 512 + 32 * nt + r) * 128 + 4 * kh;
#pragma unroll
        for (int m = 0; m < 4; ++m)
#pragma unroll
            for (int qq = 0; qq < 4; ++qq) *(f32x4*)(ep + 32 * m + 8 * qq) = (f32x4){acc[m][4 * qq], acc[m][4 * qq + 1], acc[m][4 * qq + 2], acc[m][4 * qq + 3]};
        asm volatile("s_waitcnt vmcnt(0)" ::: "memory"); __builtin_amdgcn_fence(__ATOMIC_SEQ_CST, "workgroup");
        { const float tr = PW[((size_t)(g * 17 + 16) * NST + F.lane) * 2], ti = PW[((size_t)(g * 17 + 16) * NST + F.lane) * 2 + 1]; float hre = 0.f, him = 0.f;
          const unsigned* eq = (const unsigned*)(E + (size_t)(g * 512 + 32 * nt) * 128 + F.lane); float er[32], ei[32];
#pragma unroll
          for (int ch = 0; ch < 32; ++ch) { er[ch] = __uint_as_float(__hip_atomic_load(eq + (size_t)ch * 128, __ATOMIC_RELAXED, __HIP_MEMORY_SCOPE_AGENT)); ei[ch] = __uint_as_float(__hip_atomic_load(eq + (size_t)ch * 128 + 64, __ATOMIC_RELAXED, __HIP_MEMORY_SCOPE_AGENT)); }
#pragma unroll
          for (int ch = 0; ch < 32; ++ch) { const float nr = fmaf(tr, hre, fmaf(-ti, him, er[ch])), ni = fmaf(tr, him, fmaf(ti, hre, ei[ch])); hre = nr; him = ni; }
          float* ag = WSP(float, WS_AG) + (size_t)(g * 16 + nt) * 128; ag[F.lane] = hre; ag[64 + F.lane] = him; } }
}
constexpr int SL_STRIDE = 136;
__device__ __forceinline__ void passY(Frame& F, int it0, int itstep) {
    const bf16* UB = WSP(bf16, WS_UB); const bf16* M2 = WSP(bf16, WS_M2); const bf16* KT = WSP(bf16, WS_KT); const float* E = WSP(float, WS_E); const float* PW = WSP(float, WS_PW); const float* AG = WSP(float, WS_AG);
    bf16* Sl = (bf16*)F.lds + (size_t)F.wave * 32 * SL_STRIDE; const int r = F.lane & 31, kh = F.lane >> 5, tl = r >> 4, cc = r & 15;
    for (int it = it0; it < NG * 32; it += itstep) { const int g = it >> 5, b = (it >> 4) & 1, j = (it >> 1) & 7, mh = it & 1;
        { const float tr = PW[((size_t)(g * 17 + 16) * NST + F.lane) * 2], ti = PW[((size_t)(g * 17 + 16) * NST + F.lane) * 2 + 1];
          float t2r = tr, t2i = ti;
#pragma unroll
          for (int k = 0; k < 5; ++k) { const float nr = t2r * t2r - t2i * t2i, ni = 2.f * t2r * t2i; t2r = nr; t2i = ni; }
          float hre = 0.f, him = 0.f; const float* ag = AG + (size_t)(g * 16 + b * 8) * 128 + F.lane;
          for (int i = 0; i < j; ++i) { const float ar = ag[(size_t)i * 128], ai = ag[(size_t)i * 128 + 64]; const float nr = fmaf(t2r, hre, fmaf(-t2i, him, ar)), ni = fmaf(t2r, him, fmaf(t2i, hre, ai)); hre = nr; him = ni; }
          const float* ep = E + (size_t)(g * 512 + b * CPB + 32 * j) * 128 + F.lane; float er[32], ei[32];
#pragma unroll
          for (int ch = 0; ch < 32; ++ch) { er[ch] = ep[(size_t)ch * 128]; ei[ch] = ep[(size_t)ch * 128 + 64]; }
#pragma unroll
          for (int ch = 0; ch < 32; ++ch) { Sl[ch * SL_STRIDE + F.lane] = (bf16)(cvtpk(hre, 0.f) & 0xffffu); Sl[ch * SL_STRIDE + 64 + F.lane] = (bf16)(cvtpk(him, 0.f) & 0xffffu);
              const float nr = fmaf(tr, hre, fmaf(-ti, him, er[ch])), ni = fmaf(tr, him, fmaf(ti, hre, ei[ch])); hre = nr; him = ni; }
          if (j == 7 && mh == 0) { F.out[O_HRP + (size_t)(b * NG + g) * NST + F.lane] = hre; F.out[O_HIP + (size_t)(b * NG + g) * NST + F.lane] = him; } }
        LDS_WAIT(); asm volatile("" ::: "memory");
        f32x16 acc[4];
#pragma unroll
        for (int m = 0; m < 4; ++m) acc[m] = (f32x16){0.f, 0.f, 0.f, 0.f, 0.f, 0.f, 0.f, 0.f, 0.f, 0.f, 0.f, 0.f, 0.f, 0.f, 0.f, 0.f};
        const bf16* bp = UB + (size_t)(g * 512 + b * CPB + 32 * j + r) * 256 + 8 * kh; const bf16* kp = KT + (size_t)g * 4096 + cc * 16 + 8 * kh;
        const int t0 = 8 * mh;
#pragma unroll
        for (int s = 0; s < 16; ++s) { if (s > t0 + 7) break;
            const bf16x8 bfr = *(const bf16x8*)(bp + 16 * s);
#pragma unroll
            for (int mm = 0; mm < 4; ++mm) { const int tau = t0 + 2 * mm + tl - s; if (t0 + 2 * mm + 1 < s) continue;
                bf16x8 afr = (bf16x8){0, 0, 0, 0, 0, 0, 0, 0}; if (tau >= 0) afr = *(const bf16x8*)(kp + tau * 256);
                acc[mm] = __builtin_amdgcn_mfma_f32_32x32x16_bf16(afr, bfr, acc[mm], 0, 0, 0); } }
        const bf16* mp = M2 + (size_t)(g * 256 + 32 * (4 * mh) + r) * 128 + 8 * kh;
#pragma unroll 2
        for (int ks = 0; ks < 8; ++ks) { const bf16x8 bfr = *(const bf16x8*)(Sl + r * SL_STRIDE + 16 * ks + 8 * kh);
#pragma unroll
            for (int mm = 0; mm < 4; ++mm) { const bf16x8 afr = *(const bf16x8*)(mp + (size_t)mm * 32 * 128 + 16 * ks); acc[mm] = __builtin_amdgcn_mfma_f32_32x32x16_bf16(afr, bfr, acc[mm], 0, 0, 0); } }
        bf16* yp = WSP(bf16, WS_YP) + ((size_t)b * SEQ + (size_t)(32 * j + r) * CT + t0) * 1024 + g * GC + 4 * kh;
#pragma unroll
        for (int mm = 0; mm < 4; ++mm)
#pragma unroll
            for (int qq = 0; qq < 4; ++qq) { const float y0 = gelu_erf(acc[mm][4 * qq]), y1 = gelu_erf(acc[mm][4 * qq + 1]), y2 = gelu_erf(acc[mm][4 * qq + 2]), y3 = gelu_erf(acc[mm][4 * qq + 3]);
                *(unsigned long long*)(yp + (size_t)(2 * mm + (qq >> 1)) * 1024 + 8 * (qq & 1)) = (unsigned long long)cvtpk(y0, y1) | ((unsigned long long)cvtpk(y2, y3) << 32); }
        LDS_WAIT(); asm volatile("" ::: "memory"); }
}
__device__ __forceinline__ void passB(Frame& F, int it0, int itstep) {
    float* wl = (float*)F.lds + F.wave * WLDS_F; const float* Z = WSP(float, WS_Z); const float* AB = WSP(float, WS_AB); float* Cs = wl + US_F + HS_F;
    const float* const c_re = INP(float, I_CRE); const float* const c_im = INP(float, I_CIM); const float* const sre = INP(float, I_SRE); const float* const sim = INP(float, I_SIM); const float* const dssm = INP(float, I_DSSM);
    for (int it = it0; it < DBT * NG; it += itstep) { const int g = it & 63, bs = it >> 6, gp = g * NST + F.lane;
#pragma unroll 4
        for (int c = 0; c < GC; ++c) { typedef float f32x2 __attribute__((ext_vector_type(2))); *(f32x2*)(Cs + F.lane * 32 + c * 2) = (f32x2){c_re[(size_t)(g * GC + c) * NST + F.lane], c_im[(size_t)(g * GC + c) * NST + F.lane]}; }
        float hre = sre[(size_t)bs * NG * NST + gp], him = sim[(size_t)bs * NG * NST + gp]; const int row0 = MPR + bs * DSQ;
        unit<1>(Z + (size_t)row0 * 4096 + g * GC, DSQ, hre, him, WSP(float, WS_BBR) + (size_t)gp * GC, WSP(float, WS_BBI) + (size_t)gp * GC, AB[2 * gp], AB[2 * gp + 1], wl, F.lane, WSP(bf16, WS_YP) + (size_t)row0 * 1024 + g * GC, dssm + g * GC);
        F.out[O_HRS + (size_t)bs * NG * NST + gp] = hre; F.out[O_HIS + (size_t)bs * NG * NST + gp] = him; }
}
}
namespace sattn {
constexpr int D = 128, SPG = 16, WAVES = 4, GE = 4, NSPLIT = 32, NSUB = PAST / SPG, PPS = NSUB / NSPLIT, PPW = PPS / WAVES, TOK_STRIDE = NH * HD;
constexpr int LDS_P = 0, LDS_MRG = WAVES * 64, MRG_REC = 4 + D, HALF_FLOATS = 2560;
constexpr float SCALE = 0.088388347648318440f;
using bf16x2 = __attribute__((ext_vector_type(2))) __bf16;
using u32x4  = __attribute__((ext_vector_type(4))) unsigned;
using f32x4  = __attribute__((ext_vector_type(4))) float;
using f32x8  = __attribute__((ext_vector_type(8))) float;
__device__ __forceinline__ float dot2(unsigned k, unsigned q, float acc) { return __builtin_amdgcn_fdot2_f32_bf16(__builtin_bit_cast(bf16x2, k), __builtin_bit_cast(bf16x2, q), acc, false); }
template <int CTRL> __device__ __forceinline__ float dpp(float x) { return __builtin_bit_cast(float, __builtin_amdgcn_mov_dpp(__builtin_bit_cast(int, x), CTRL, 0xf, 0xf, true)); }
constexpr int XOR1 = 0xB1, XOR2 = 0x4E, XOR7 = 0x141, XOR8 = 0x128, ROR4 = 0x124;
__device__ __forceinline__ float xrow16_max(float x) {
  auto s = __builtin_amdgcn_permlane16_swap(__float_as_uint(x), __float_as_uint(x), false, false); x = fmaxf(__uint_as_float(s[0]), __uint_as_float(s[1]));
  auto t = __builtin_amdgcn_permlane32_swap(__float_as_uint(x), __float_as_uint(x), false, false); return fmaxf(__uint_as_float(t[0]), __uint_as_float(t[1])); }
__device__ __forceinline__ float xrow16_sum(float x) {
  auto s = __builtin_amdgcn_permlane16_swap(__float_as_uint(x), __float_as_uint(x), false, false); x = __uint_as_float(s[0]) + __uint_as_float(s[1]);
  auto t = __builtin_amdgcn_permlane32_swap(__float_as_uint(x), __float_as_uint(x), false, false); return __uint_as_float(t[0]) + __uint_as_float(t[1]); }
__device__ __forceinline__ u32x4 tobf(f32x8 x) { u32x4 w = {cvtpk(x[0], x[1]), cvtpk(x[2], x[3]), cvtpk(x[4], x[5]), cvtpk(x[6], x[7])}; return w; }

__device__ __forceinline__ void split_unit(int unit, float* lds, int wave, int lane, const float* QS, const float* ck, const float* cv, const int* pt, const float* RP, float* PML, float* PO, int prb = 0) {
  const bool pad = (unsigned)unit >> 31; const int bh = pad ? 0 : (unit >> 5), s = pad ? 0 : (unit & 31), kvh = bh & 7, b = bh >> 3, r = lane >> 4, c = lane & 15;
  constexpr float C2 = SCALE * 1.4426950408889634f;
  const int p0 = s * PPS;
  const int npg = (pad || (prb & 4096)) ? 0 : PPW;
  int btv = 0;
  if (lane < PPW) { const int pg = p0 + wave + 4 * lane; btv = pt[b * NPAGES + (pg >> 3)] * PAGE + (pg & 7) * SPG; }
  u32x4 qpk[GE];
#pragma unroll
  for (int g = 0; g < GE; ++g) qpk[g] = tobf(*reinterpret_cast<const f32x8*>(QS + ((size_t)((b * NH + kvh) * DSQ + g)) * D + 8 * c));
  const size_t loff = (size_t)r * TOK_STRIDE + (size_t)kvh * D + 8 * c;
  const float* rpb = RP + (size_t)(b * NH + kvh) * PAST + r + 4 * (c >> 2);
#define SA_ISSUE(i_) do { const int tb_ = __builtin_amdgcn_readlane(btv, (i_)); const float* kb_ = ck + (size_t)tb_ * TOK_STRIDE + loff; const float* vb_ = cv + (size_t)tb_ * TOK_STRIDE + loff; \
    _Pragma("unroll") for (int t_ = 0; t_ < 4; ++t_) { Kn[t_] = __builtin_nontemporal_load(reinterpret_cast<const f32x8*>(kb_ + (size_t)t_ * 4 * TOK_STRIDE)); Vn[t_] = __builtin_nontemporal_load(reinterpret_cast<const f32x8*>(vb_ + (size_t)t_ * 4 * TOK_STRIDE)); } \
    Bn = rpb[(p0 + wave + 4 * (i_)) * SPG]; } while (0)
  f32x8 Kn[4], Vn[4]; float Bn;
  float m = -INFINITY, l = 0.f, acc[GE * 8];
#pragma unroll
  for (int k = 0; k < GE * 8; ++k) acc[k] = 0.f;
  if (npg > 0) SA_ISSUE(0);
  for (int i = 0; i < npg; ++i) {
    u32x4 Kc[4], Vc[4];
#pragma unroll
    for (int t = 0; t < 4; ++t) { Kc[t] = tobf(Kn[t]); Vc[t] = tobf(Vn[t]); }
    const float Bc = Bn;
    if (i + 1 < npg) SA_ISSUE(i + 1);
    float x[4 * GE];
#pragma unroll
    for (int t = 0; t < 4; ++t)
#pragma unroll
      for (int g = 0; g < GE; ++g) { float d = 0.f;
#pragma unroll
        for (int k = 0; k < 4; ++k) d = dot2(Kc[t][k], qpk[g][k], d);
        x[t * GE + g] = d; }
#define SA_TR(HALF, CTRL, BIT) _Pragma("unroll") for (int h = 0; h < (HALF); ++h) { \
      const float lo_ = x[h], hi_ = x[h + (HALF)]; const float t1_ = lo_ + dpp<CTRL>(lo_), t2_ = hi_ + dpp<CTRL>(hi_); x[h] = (c & (BIT)) ? t2_ : t1_; }
    SA_TR(8, XOR8, 8) SA_TR(4, XOR7, 4) SA_TR(2, XOR2, 2) SA_TR(1, XOR1, 1)
#undef SA_TR
    const float sc = fmaf(x[0], C2, Bc);
    float pm = sc; pm = fmaxf(pm, dpp<ROR4>(pm)); pm = fmaxf(pm, dpp<XOR8>(pm)); pm = xrow16_max(pm);
    const float mn = fmaxf(m, pm), msub = (mn == -INFINITY) ? 0.f : mn;
    const float alpha = __builtin_amdgcn_exp2f(m - msub), p = __builtin_amdgcn_exp2f(sc - msub);
    l = fmaf(l, alpha, p); m = mn;
#pragma unroll
    for (int q4 = 0; q4 < 4; ++q4) { const float al = q4 == 0 ? dpp<0x00>(alpha) : q4 == 1 ? dpp<0x55>(alpha) : q4 == 2 ? dpp<0xAA>(alpha) : dpp<0xFF>(alpha);
#pragma unroll
      for (int k = 0; k < 8; ++k) acc[q4 * 8 + k] *= al; }
    float* prow = lds + LDS_P + (wave * 4 + r) * 16;
    prow[c] = p;
    asm volatile("s_waitcnt lgkmcnt(0)" ::: "memory");
    f32x4 pr[GE];
#pragma unroll
    for (int u = 0; u < GE; ++u) pr[u] = *reinterpret_cast<const f32x4*>(prow + 4 * u);
#pragma unroll
    for (int t = 0; t < 4; ++t) { float vf[8];
#pragma unroll
      for (int k = 0; k < 4; ++k) { vf[2 * k] = __builtin_bit_cast(float, Vc[t][k] << 16); vf[2 * k + 1] = __builtin_bit_cast(float, Vc[t][k] & 0xffff0000u); }
#pragma unroll
      for (int g = 0; g < GE; ++g) { const float pg_ = pr[t][g];
#pragma unroll
        for (int k = 0; k < 8; ++k) acc[g * 8 + k] = fmaf(pg_, vf[k], acc[g * 8 + k]); } }
  }
#undef SA_ISSUE
#pragma unroll
  for (int k = 0; k < GE * 8; ++k) acc[k] = xrow16_sum(acc[k]);
  { float t = l; t += dpp<ROR4>(t); t += dpp<XOR8>(t); l = xrow16_sum(t); }
  float* mrg = lds + LDS_MRG;
  if (r == 0) {
#pragma unroll
    for (int g = 0; g < GE; ++g) { float* rec = mrg + (wave * GE + g) * MRG_REC;
#pragma unroll
      for (int k = 0; k < 8; k += 4) *reinterpret_cast<f32x4*>(rec + 4 + 8 * c + k) = f32x4{acc[g * 8 + k], acc[g * 8 + k + 1], acc[g * 8 + k + 2], acc[g * 8 + k + 3]};
      if (c == g) { rec[0] = m; rec[1] = l; } } }
  __syncthreads();
  { const int g = wave, d0 = 2 * lane; const size_t row = (size_t)(b * NH + kvh) * DSQ + g;
    float M = -INFINITY;
#pragma unroll
    for (int w = 0; w < WAVES; ++w) M = fmaxf(M, mrg[(w * GE + g) * MRG_REC]);
    float L = 0.f, o0 = 0.f, o1 = 0.f;
#pragma unroll
    for (int w = 0; w < WAVES; ++w) { const float* rec = mrg + (w * GE + g) * MRG_REC; const float lw = rec[1]; const float wt = (lw > 0.f) ? __builtin_amdgcn_exp2f(rec[0] - M) : 0.f;
      L = fmaf(wt, lw, L); o0 = fmaf(wt, rec[4 + d0], o0); o1 = fmaf(wt, rec[4 + d0 + 1], o1); }
    const size_t slot = row * NSPLIT + s;
    if (!pad && !(prb & 4096)) { *reinterpret_cast<float2*>(PO + slot * D + d0) = make_float2(o0, o1);
    if (lane == 0) *reinterpret_cast<float2*>(PML + 2 * slot) = make_float2(M, L); } }
  __syncthreads();
}
}

__device__ __forceinline__ void sample_combine(Frame& F) {
    const float* PML = WSP(float, WS_PML); const float* PO = WSP(float, WS_PO); const float* QS = WSP(float, WS_QS);
    constexpr float C2 = 0.088388347648318440f * 1.4426950408889634f;
    for (int row = F.gw; row < DBT * NH * DSQ; row += F.NGW) { const int t = row & 3, h = (row >> 2) & 7, b = row >> 5, d0 = 2 * F.lane; const unsigned live = WSP(unsigned, WS_LIST)[64 + (row >> 2)];
        const float2 q = *(const float2*)(QS + (size_t)row * HD + d0);
        float sn[DSQ]; float run = 0.f;
#pragma unroll
        for (int j = 0; j < DSQ; ++j) { const float2 k = *(const float2*)(F.out + O_KS + ((size_t)(b * DSQ + j) * NH + h) * HD + d0); const float d = wave_sum(q.x * k.x + q.y * k.y);
            run += F.out[O_LFS + (size_t)(b * DSQ + j) * NH + h]; sn[j] = (j <= t) ? fmaf(d, C2, -run * LOG2E) : -INFINITY; }
        float M = -INFINITY;
#pragma unroll 8
        for (int s = 0; s < sattn::NSPLIT; ++s) if ((live >> s) & 1u) M = fmaxf(M, PML[2 * ((size_t)row * sattn::NSPLIT + s)]);
#pragma unroll
        for (int j = 0; j < DSQ; ++j) M = fmaxf(M, sn[j]);
        float L = 0.f, o0 = 0.f, o1 = 0.f;
#pragma unroll 8
        for (int s = 0; s < sattn::NSPLIT; ++s) { if (!((live >> s) & 1u)) continue; const size_t slot = (size_t)row * sattn::NSPLIT + s; const float ls = PML[2 * slot + 1], w = (ls > 0.f) ? __builtin_amdgcn_exp2f(PML[2 * slot] - M) : 0.f;
            const float2 a = *(const float2*)(PO + slot * HD + d0); L = fmaf(w, ls, L); o0 = fmaf(w, a.x, o0); o1 = fmaf(w, a.y, o1); }
#pragma unroll
        for (int j = 0; j < DSQ; ++j) { const float p = __builtin_amdgcn_exp2f(sn[j] - M); const float2 v = *(const float2*)(F.out + O_VS + ((size_t)(b * DSQ + j) * NH + h) * HD + d0);
            L += p; o0 = fmaf(p, v.x, o0); o1 = fmaf(p, v.y, o1); }
        const float inv = 1.0f / L;
        *(unsigned*)(WSP(bf16, WS_YY) + (size_t)(MPR + b * DSQ + t) * 2048 + 1024 + h * HD + d0) = cvtpk(o0 * inv, o1 * inv); }
}
namespace sk {
typedef float f32x16 __attribute__((ext_vector_type(16)));
__device__ __forceinline__ void st_bf16(bf16* p, float x) { *p = (bf16)(cvtpk(x, 0.f) & 0xffffu); }
__device__ __forceinline__ float ld_bf16(const bf16* p) { return __uint_as_float((unsigned)(*p) << 16); }
__device__ __forceinline__ float sigm(float x) { return 1.0f / (1.0f + __expf(-x)); }
template <int NBLK, class Epi>
__device__ __forceinline__ void run(Frame& F, const bf16* A, int lda, const bf16* Bt, int ldb, int K, int nunits, const Epi& E, int ustart = -1, int ustride = 0) {
    float* P = (float*)F.lds;
    const int r = F.lane & 31, kh = F.lane >> 5, kw = K >> 3, nb4 = kw >> 6;
    if (ustart < 0) { ustart = F.G - 1 - (int)blockIdx.x; ustride = F.G; }
    for (int u = ustart; u < nunits; u += ustride) {
        f32x16 acc[NBLK];
#pragma unroll
        for (int b = 0; b < NBLK; ++b) acc[b] = (f32x16){0.f, 0.f, 0.f, 0.f, 0.f, 0.f, 0.f, 0.f, 0.f, 0.f, 0.f, 0.f, 0.f, 0.f, 0.f, 0.f};
        const bf16* ap[NBLK]; const bf16* bp[NBLK];
#pragma unroll
        for (int b = 0; b < NBLK; ++b) { ap[b] = A + (size_t)r * lda + E.koff(b) + F.wave * kw + 8 * kh; bp[b] = Bt + (size_t)(E.brow(u, b) + r) * ldb + E.koff(b) + F.wave * kw + 8 * kh; }
#define SK_LOAD(AF, BF, s_) do { _Pragma("unroll") for (int i = 0; i < 4; ++i) { _Pragma("unroll") for (int b = 0; b < NBLK; ++b) { \
            AF[b][i] = (b == 0 || Epi::SPLIT_A) ? *(const bf16x8*)(ap[b] + 64 * (s_) + 16 * i) : AF[0][i]; BF[b][i] = *(const bf16x8*)(bp[b] + 64 * (s_) + 16 * i); } } } while (0)
        bf16x8 af[NBLK][4], bf[NBLK][4], an[NBLK][4], bn[NBLK][4];
        SK_LOAD(af, bf, 0);
#pragma unroll 1
        for (int s = 0; s < nb4; ++s) {
            if (s + 1 < nb4) SK_LOAD(an, bn, s + 1);
#pragma unroll
            for (int i = 0; i < 4; ++i)
#pragma unroll
                for (int b = 0; b < NBLK; ++b) acc[b] = __builtin_amdgcn_mfma_f32_32x32x16_bf16(af[b][i], bf[b][i], acc[b], 0, 0, 0);
#pragma unroll
            for (int i = 0; i < 4; ++i)
#pragma unroll
                for (int b = 0; b < NBLK; ++b) { af[b][i] = an[b][i]; bf[b][i] = bn[b][i]; } }
#undef SK_LOAD
#pragma unroll
        for (int b = 0; b < NBLK; ++b)
#pragma unroll
            for (int q = 0; q < 16; ++q) P[((F.wave * NBLK + b) * 32 + ((q & 3) + 8 * (q >> 2) + 4 * kh)) * 32 + r] = acc[b][q];
        __syncthreads();
#pragma unroll
        for (int e2 = 0; e2 < 2; ++e2) { const int e = F.tid + 512 * e2, row = e >> 5, col = e & 31; float v[NBLK];
#pragma unroll
            for (int b = 0; b < NBLK; ++b) { float t = 0.f;
#pragma unroll
                for (int w = 0; w < 8; ++w) t += P[((w * NBLK + b) * 32 + row) * 32 + col];
                v[b] = t; }
            E.apply(u, row, col, v); }
        __syncthreads();
    }
}
struct In { float* Z; bf16* G; const float* R1;
    static constexpr bool SPLIT_A = false; __device__ __forceinline__ int koff(int) const { return 0; }
    __device__ __forceinline__ int brow(int u, int) const { return 32 * u; }
    __device__ __forceinline__ void apply(int u, int row, int col, const float* v) const { const int c = 32 * u + col; const size_t gr = MPR + row; const float z = v[0] * R1[gr];
        if (c < 4096) Z[gr * 4096 + c] = z; else st_bf16(G + gr * 4096 + (c - 4096), sigm(z)); } };
struct Glu { const bf16* YP; bf16* YY; const float* bias;
    static constexpr bool SPLIT_A = false; __device__ __forceinline__ int koff(int) const { return 0; }
    __device__ __forceinline__ int brow(int u, int) const { return 32 * u; }
    __device__ __forceinline__ void apply(int u, int row, int col, const float* v) const { const int c = 32 * u + col; const size_t gr = MPR + row; st_bf16(YY + gr * 2048 + c, ld_bf16(YP + gr * 1024 + c) * sigm(v[0] + bias[c])); } };
struct Merge { const bf16* G; bf16* MG;
    static constexpr bool SPLIT_A = true; __device__ __forceinline__ int koff(int b) const { return 1024 * b; }
    __device__ __forceinline__ int brow(int u, int) const { return 32 * u; }
    __device__ __forceinline__ void apply(int u, int row, int col, const float* v) const { const int c = 32 * u + col; const size_t gr = MPR + row;
        st_bf16(MG + gr * 2048 + c, ld_bf16(G + gr * 4096 + c) * v[0] + ld_bf16(G + gr * 4096 + 2048 + c) * v[1]); } };
struct Out { const float* xs; bf16* XB; float* SSR;
    static constexpr bool SPLIT_A = false; __device__ __forceinline__ int koff(int) const { return 0; }
    __device__ __forceinline__ int brow(int u, int) const { return 32 * u; }
    __device__ __forceinline__ void apply(int u, int row, int col, const float* v) const { const int c = 32 * u + col; const size_t gr = MPR + row; const float x1 = xs[(size_t)row * 2048 + c] + v[0];
        st_bf16(XB + gr * 2048 + c, x1); float s = x1 * x1;
        s += __shfl_xor(s, 1); s += __shfl_xor(s, 2); s += __shfl_xor(s, 4); s += __shfl_xor(s, 8); s += __shfl_xor(s, 16);
        if (col == 0) __hip_atomic_fetch_add(SSR + MPR + row, s, __ATOMIC_RELAXED, __HIP_MEMORY_SCOPE_AGENT); } };
struct FF1 { const float* SSR; bf16* H;
    static constexpr bool SPLIT_A = false; __device__ __forceinline__ int koff(int) const { return 0; }
    __device__ __forceinline__ int brow(int u, int b) const { const int h0 = 32 * u; return 256 * (h0 >> 7) + (h0 & 127) + 128 * b; }
    __device__ __forceinline__ void apply(int u, int row, int col, const float* v) const {
        const float r2 = 1.0f / sqrtf(SSR[MPR + row] * (1.0f / 2048.0f) + RMS_EPS), g = v[0] * r2, up = v[1] * r2;
        st_bf16(H + (size_t)(MPR + row) * DFF + 32 * u + col, g * sigm(g) * up); } };
struct FF2 { const bf16* XB; float* ys;
    static constexpr bool SPLIT_A = false; __device__ __forceinline__ int koff(int) const { return 0; }
    __device__ __forceinline__ int brow(int u, int) const { return 32 * u; }
    __device__ __forceinline__ void apply(int u, int row, int col, const float* v) const { const int c = 32 * u + col; ys[(size_t)row * 2048 + c] = ld_bf16(XB + (size_t)(MPR + row) * 2048 + c) + v[0]; } };
}
__device__ __forceinline__ pattn::BlockRef<__hip_bfloat16, __hip_bfloat16> attn_ref(unsigned char* ws, int u) {
    constexpr int NQB = SEQ / pattn::QB;
    const int qb = NQB - 1 - (u >> 4), bh = u & 15; const size_t hb = (size_t)bh * SEQ * HD;
    pattn::BlockRef<__hip_bfloat16, __hip_bfloat16> r;
    r.Q = (const __hip_bfloat16*)(ws + WS_QB) + hb + (size_t)qb * pattn::QB * HD; r.K = (const __hip_bfloat16*)(ws + WS_KB) + hb; r.V = (const __hip_bfloat16*)(ws + WS_VB) + hb;
    r.CK = (const unsigned short*)(ws + WS_NCK) + (size_t)bh * SEQ * 16; r.P0 = qb * pattn::QB; r.XF = (const float*)(ws + WS_XF) + (size_t)bh * SEQ;
    r.jlo = __builtin_amdgcn_readfirstlane(((const int*)(ws + WS_JLO))[bh * 16 + qb]); r.negb2 = -__uint_as_float(__builtin_amdgcn_readfirstlane(__float_as_uint(((const float*)(ws + WS_SS2))[0])));
    r.O = (__hip_bfloat16*)(ws + WS_YY) + ((size_t)(bh >> 3) * SEQ + (size_t)qb * pattn::QB) * 2048 + 1024 + (bh & 7) * HD;
    return r;
}
__device__ __forceinline__ void refresh_lane(Frame& F) {
    int l; asm volatile("v_mbcnt_lo_u32_b32 %0, -1, 0\n\tv_mbcnt_hi_u32_b32 %0, -1, %0" : "=v"(l)); F.lane = l; F.tid = F.wave * 64 + l;
    unsigned long long w_ = (unsigned long long)F.ws, o_ = (unsigned long long)F.out; asm volatile("" : "+s"(w_), "+s"(o_));
    F.ws = (unsigned char*)(__attribute__((address_space(1))) unsigned char*)w_; F.out = (float*)(__attribute__((address_space(1))) float*)o_;
}

__device__ __forceinline__ int pull(Frame& F, int qword) {
    volatile LAS unsigned* w = (volatile LAS unsigned*)(F.lds + MISC_OFF + 64);
    if (F.tid == 0) *w = __hip_atomic_fetch_add((unsigned*)(F.ws + WS_CTL) + CW_Q + qword, 1u, __ATOMIC_RELAXED, __HIP_MEMORY_SCOPE_AGENT);
    __syncthreads(); const unsigned v = *w; __syncthreads(); return __builtin_amdgcn_readfirstlane((int)v);
}
__device__ __forceinline__ int pull8(Frame& F, int qword0, int nunits) {
    volatile LAS unsigned* w = (volatile LAS unsigned*)(F.lds + MISC_OFF + 64);
    if (F.tid == 0) { unsigned* heads = (unsigned*)(F.ws + WS_CTL) + CW_Q + qword0; const unsigned per = (unsigned)nunits >> 3; unsigned r = (unsigned)nunits;
        for (unsigned t = 0; t < 8u; ++t) { const unsigned q = (blockIdx.x + t) & 7u;
            if (__hip_atomic_load(heads + 64 * q, __ATOMIC_RELAXED, __HIP_MEMORY_SCOPE_AGENT) >= per) continue;
            const unsigned i = __hip_atomic_fetch_add(heads + 64 * q, 1u, __ATOMIC_RELAXED, __HIP_MEMORY_SCOPE_AGENT);
            if (i < per) { r = i * 8u + q; break; } }
        *w = r; }
    __syncthreads(); const unsigned v = *w; __syncthreads(); return __builtin_amdgcn_readfirstlane((int)v);
}
__device__ __forceinline__ void attn_prompt_phase(Frame& F) {
    using BR = pattn::BlockRef<__hip_bfloat16, __hip_bfloat16>;
    constexpr int NU = NB * NH * (SEQ / pattn::QB);
    char* lds = (char*)F.lds;
    int u = pull(F, 64); if (u >= NU) return;
    BR cur = attn_ref(F.ws, u);
    pattn::Seam<__hip_bfloat16> S;
    pattn::causal_swa_prime<__hip_bfloat16, __hip_bfloat16>(cur, SEQ, lds, S, F.wave, F.lane);
    for (;;) { const int un = pull(F, 64); const bool last = un >= NU;
        const BR nxt = last ? cur : attn_ref(F.ws, un);
        pattn::causal_swa_block<__hip_bfloat16, __hip_bfloat16>(cur, nxt, SEQ, SEQ, lds, S, F.wave, F.lane);
        if (last) break;
        cur = nxt; }
}

constexpr int N_PHASES = 9;
__global__ void __launch_bounds__(NWAVES * 64, 2) fwd(Args args) {
    extern __shared__ __attribute__((aligned(16))) unsigned char lds[];
    Frame F;
    F.lds = lds; F.wave = __builtin_amdgcn_readfirstlane(threadIdx.x >> 6); refresh_lane(F); F.G = gridDim.x;
    F.gw = blockIdx.x * NWAVES + F.wave; F.NGW = F.G * NWAVES;
    F.out = args.out; F.ws = args.ws;
    volatile LAS unsigned* MISC = (volatile LAS unsigned*)((LAS unsigned char*)lds + MISC_OFF);
    for (int u = F.tid; u < 128; u += NWAVES * 64) MISC[u] = 0u;
    __syncthreads();
    const int lo = args.ph_lo, hi = args.ph_hi;
    XcdBarrier bar; bar.bar = (unsigned*)(F.ws + WS_CTL) + CW_BAR; bar.x = 0; bar.st = nullptr;
    if (hi - lo > 1) bar = xcd_barrier_post((unsigned*)(F.ws + WS_CTL) + CW_BAR, MISC + 8, F.tid == 0);
#ifndef PH_MASK
#define PH_MASK 0x1ff
#endif
#define IN(k) (((PH_MASK >> (k)) & 1) && lo <= (k) && (k) < hi)
#define SEAM(k) do { if (IN(k) && IN((k) + 1)) { xcd_barrier(bar, F.tid == 0); refresh_lane(F); } } while (0)
#ifndef PH_DUP
#define PH_DUP 0
#endif
#ifndef SUB_DUP
#define SUB_DUP 0
#endif
#define SUBREP(k) _Pragma("unroll") for (int srep = 0; srep < 1 + ((SUB_DUP >> (k)) & 1); ++srep)
#define REP(k) _Pragma("unroll") for (int rep = 0; rep < 1 + ((PH_DUP >> (k)) & 1); ++rep)
#define REPBAR() do { if (rep) xcd_barrier(bar, F.tid == 0); } while (0)
    LAS unsigned char* ring = (LAS unsigned char*)lds;

    if (IN(0)) REP(0) { REPBAR(); phase0(F, args.probe); } SEAM(0);
    if (IN(1)) REP(1) { REPBAR();
        s5::gen_tables(F); __syncthreads();
        pg8::Gemm g{(const pg8::bf16_t*)WSP(bf16, WS_XA), (const pg8::bf16_t*)WSP(bf16, WS_W1T), MPR, 8192, 2048, 2048, 2048}; pg8::StaticOrder S; S.init(MPR, 8192, F.G, (int)blockIdx.x);
        pg8::EpiIn E{(pg8::bf16_t*)WSP(bf16, WS_G), WSP(float, WS_R1), (pg8::bf16_t*)WSP(bf16, WS_UB), (pg8::bf16_t*)WSP(bf16, WS_QB), (pg8::bf16_t*)WSP(bf16, WS_KB), (pg8::bf16_t*)WSP(bf16, WS_VB),
                      F.out + O_KP, F.out + O_VP, INP(float, I_GQ), INP(float, I_GK), (LAS float*)(ring + 131072)};
        pg8::gemm_phase<pg8::EpiIn, pg8::StaticOrder, true, true>(ring, g, S, E, F.wave, F.lane);
        __syncthreads();
        sk::run<1>(F, WSP(bf16, WS_XA) + (size_t)MPR * 2048, 2048, WSP(bf16, WS_W1T), 2048, 2048, 256, sk::In{WSP(float, WS_Z), WSP(bf16, WS_G), WSP(float, WS_R1)}); } SEAM(1);
    #ifndef PH2_MASK
#define PH2_MASK 15
#endif
    if (IN(2)) REP(2) { REPBAR(); if (PH2_MASK & 1) SUBREP(0) rowpass(F); if (PH2_MASK & 2) SUBREP(1) s5::passE(F); if (PH2_MASK & 4) SUBREP(2) logf_cumsum(F); if ((PH2_MASK & 8) && rep == 0) rpast_fix(F);
        if (F.gw == 0) { const float* const gqp = INP(float, I_GQ); const float* const gkp = INP(float, I_GK);
            float mq = fmaxf(fabsf(gqp[F.lane]), fabsf(gqp[F.lane + 64])), mk = fmaxf(fabsf(gkp[F.lane]), fabsf(gkp[F.lane + 64]));
#pragma unroll
            for (int o = 1; o < 64; o <<= 1) { mq = fmaxf(mq, __shfl_xor(mq, o)); mk = fmaxf(mk, __shfl_xor(mk, o)); }
            const float bq2 = 11.313708498984761f * 1.4426950408889634f * mq * mk;
            const float thr = -(3.f * bq2 + 40.f); const float* tp = WSP(float, WS_TPG) + F.lane * NPAGES; float suf = 0.f; unsigned flags = 0u;
            for (int pgi = NPAGES - 1; pgi >= 0; --pgi) { if ((pgi & 3) == 3 && !(suf * LOG2E < thr)) flags |= 1u << (pgi >> 2); suf += tp[pgi]; }
            unsigned* L = WSP(unsigned, WS_LIST); L[64 + F.lane] = flags; unsigned base = 0u;
            for (int s = 0; s < 32; ++s) { const bool lv = (flags >> s) & 1u; const unsigned long long mk2 = __ballot(lv);
                if (lv) L[256 + base + __builtin_popcountll(mk2 & ((1ull << F.lane) - 1ull))] = ((unsigned)F.lane << 5) | (unsigned)s;
                base += (unsigned)__builtin_popcountll(mk2); }
            if (F.lane == 0) { L[0] = base; if (base & 1u) L[256 + base] = 0x80000000u; } }
  __syncthreads(); if ((int)blockIdx.x >= 128 && F.G == 256) weight_copies(F, WI_FF10, WI_FF10 + WI_FF1, (int)blockIdx.x - 128, 128); else if (F.G != 256) weight_copies(F, WI_FF10, WI_FF10 + WI_FF1, (int)blockIdx.x, F.G); } SEAM(2);
    if (IN(3)) REP(3) { REPBAR(); refresh_lane(F);
        constexpr int NSTREAM = 128; const bool stream = (int)blockIdx.x < NSTREAM;
        const int prb = args.probe;
#define P3_STREAM_LOOP() do { const int half = F.wave >> 2; const unsigned* const L = WSP(unsigned, WS_LIST); const int nbu_ = (int)((__builtin_amdgcn_readfirstlane((int)L[0]) + 1) >> 1); const int nbu = (prb & 512) ? (nbu_ < 256 ? nbu_ : 256) : ((prb & 1024) ? (nbu_ < 128 ? nbu_ : 128) : ((prb & 2048) ? 16 : nbu_)); \
            volatile LAS unsigned* qw = (volatile LAS unsigned*)(F.lds + MISC_OFF + 64); unsigned* qh = (unsigned*)(F.ws + WS_CTL) + CW_Q; \
            int bu = pull(F, 0); \
            while (bu < nbu) { unsigned pend = 0u; if (F.tid == 0) pend = __hip_atomic_fetch_add(qh, 1u, __ATOMIC_RELAXED, __HIP_MEMORY_SCOPE_AGENT); \
                const float* const ckp = INP(float, I_CK); const float* const cvp = INP(float, I_CV); const int* const ptp = INP(int, I_PT); \
                sattn::split_unit(__builtin_amdgcn_readfirstlane((int)L[256 + 2 * bu + half]), (float*)F.lds + half * sattn::HALF_FLOATS, F.wave & 3, F.lane, WSP(float, WS_QS), ckp, cvp, ptp, WSP(float, WS_RP), WSP(float, WS_PML), WSP(float, WS_PO), prb); \
                if (F.tid == 0) *qw = pend; __syncthreads(); bu = __builtin_amdgcn_readfirstlane((int)*qw); __syncthreads(); } \
            __syncthreads(); refresh_lane(F); } while (0)
        if (stream && !(prb & 1)) P3_STREAM_LOOP();
        if (!(prb & 2)) attn_prompt_phase(F);
        __syncthreads(); refresh_lane(F);
        if (!(prb & 4)) { for (int bu = pull(F, 128); bu < 256; bu = pull(F, 128)) s5::passY(F, bu * 8 + F.wave, 1 << 30);
        for (int bu = pull(F, 192); bu < 64; bu = pull(F, 192)) s5::passB(F, bu * 8 + F.wave, 1 << 30); }
        __syncthreads(); refresh_lane(F);
        if (!stream && !(prb & 17)) P3_STREAM_LOOP();
#undef P3_STREAM_LOOP
    } SEAM(3);
    if (IN(4)) REP(4) { REPBAR();
        sample_combine(F);
        if ((int)blockIdx.x >= 128 && F.G == 256) { weight_copies(F, WI_BR0, WI_FF10, (int)blockIdx.x - 128, 128); weight_copies(F, WI_FF10 + WI_FF1, WI_FF10 + WI_FF1 + 256, (int)blockIdx.x - 128, 128); }
        else if (F.G != 256) { weight_copies(F, WI_BR0, WI_FF10, (int)blockIdx.x, F.G); weight_copies(F, WI_FF10 + WI_FF1, WI_FF20, (int)blockIdx.x, F.G); }
        __syncthreads(); refresh_lane(F);
        { pg8::Gemm g{(const pg8::bf16_t*)WSP(bf16, WS_YP), (const pg8::bf16_t*)WSP(bf16, WS_WGLU), MPR, 1024, 1024, 1024, 1024}; pg8::StaticOrder S; S.init(MPR, 1024, F.G, (int)blockIdx.x);
          pg8::EpiGlu E{(const pg8::bf16_t*)WSP(bf16, WS_YP), (pg8::bf16_t*)WSP(bf16, WS_YY), INP(float, I_BGLU)};
          pg8::gemm_phase<pg8::EpiGlu, pg8::StaticOrder, true, true>(ring, g, S, E, F.wave, F.lane); }
        __syncthreads(); refresh_lane(F);
        if ((int)blockIdx.x < 96 && F.G == 256) weight_copies(F, WI_FF10 + WI_FF1 + 256, WI_FF20, (int)blockIdx.x, 96);
        __syncthreads();
        sk::run<1>(F, WSP(bf16, WS_YP) + (size_t)MPR * 1024, 1024, WSP(bf16, WS_WGLU), 1024, 1024, 32, sk::Glu{WSP(bf16, WS_YP), WSP(bf16, WS_YY), INP(float, I_BGLU)}); } SEAM(4);
    if (IN(5)) REP(5) { REPBAR();
        pg8::Gemm g{(const pg8::bf16_t*)WSP(bf16, WS_YY), (const pg8::bf16_t*)WSP(bf16, WS_WBR), MPR, 2048, 2048, 2048, 2048}; pg8::StaticOrder S; S.init(MPR, 2048, F.G, (int)blockIdx.x);
        pg8::EpiMerge E{(const pg8::bf16_t*)WSP(bf16, WS_G), (pg8::bf16_t*)WSP(bf16, WS_MG)};
        pg8::gemm_phase<pg8::EpiMerge, pg8::StaticOrder, true, true>(ring, g, S, E, F.wave, F.lane);
        __syncthreads();
        sk::run<2>(F, WSP(bf16, WS_YY) + (size_t)MPR * 2048, 2048, WSP(bf16, WS_WBR), 2048, 1024, 64, sk::Merge{WSP(bf16, WS_G), WSP(bf16, WS_MG)}); } SEAM(5);
    if (IN(6)) REP(6) { REPBAR();
        pg8::Gemm g{(const pg8::bf16_t*)WSP(bf16, WS_MG), (const pg8::bf16_t*)WSP(bf16, WS_WOUT), MPR, 2048, 2048, 2048, 2048}; pg8::StaticOrder S; S.init(MPR, 2048, F.G, (int)blockIdx.x);
        pg8::EpiOut E{INP(float, I_XP), INP(float, I_XS), (pg8::bf16_t*)WSP(bf16, WS_XB), WSP(float, WS_SSR)};
        pg8::gemm_phase<pg8::EpiOut, pg8::StaticOrder, true, true>(ring, g, S, E, F.wave, F.lane);
        __syncthreads();
        sk::run<1>(F, WSP(bf16, WS_MG) + (size_t)MPR * 2048, 2048, WSP(bf16, WS_WOUT), 2048, 2048, 64, sk::Out{INP(float, I_XS), WSP(bf16, WS_XB), WSP(float, WS_SSR)}); } SEAM(6);
    if (IN(7)) REP(7) { REPBAR();
        pg8::Gemm g{(const pg8::bf16_t*)WSP(bf16, WS_XB), (const pg8::bf16_t*)WSP(bf16, WS_WFF1), MPR, 2 * DFF, 2048, 2048, 2048}; pg8::StaticOrder S; S.init(MPR, 2 * DFF, F.G, (int)blockIdx.x);
        pg8::EpiFF1 E{WSP(float, WS_SSR), (pg8::bf16_t*)WSP(bf16, WS_H), args.probe};
        pg8::gemm_phase<pg8::EpiFF1, pg8::StaticOrder, true, true>(ring, g, S, E, F.wave, F.lane);
        __syncthreads();
        if (F.G == 256) sk::run<2>(F, WSP(bf16, WS_XB) + (size_t)MPR * 2048, 2048, WSP(bf16, WS_WFF1), 2048, 2048, DFF / 32, sk::FF1{WSP(float, WS_SSR), WSP(bf16, WS_H)}, (int)blockIdx.x >= 128 ? 255 - (int)blockIdx.x : DFF / 32, 128);
        else sk::run<2>(F, WSP(bf16, WS_XB) + (size_t)MPR * 2048, 2048, WSP(bf16, WS_WFF1), 2048, 2048, DFF / 32, sk::FF1{WSP(float, WS_SSR), WSP(bf16, WS_H)});
        __syncthreads(); refresh_lane(F);
        if ((int)blockIdx.x >= 128 && F.G == 256) weight_copies(F, WI_FF20, WI_END, (int)blockIdx.x - 128, 128);
        else if (F.G != 256) weight_copies(F, WI_FF20, WI_END, (int)blockIdx.x, F.G); } SEAM(7);
    if (IN(8)) REP(8) { REPBAR();
        pg8::Gemm g{(const pg8::bf16_t*)WSP(bf16, WS_H), (const pg8::bf16_t*)WSP(bf16, WS_WFF2), MPR, 2048, DFF, DFF, DFF}; pg8::StaticOrder S; S.init(MPR, 2048, F.G, (int)blockIdx.x);
        pg8::EpiFF2 E{(const pg8::bf16_t*)WSP(bf16, WS_XB), F.out + O_YP, F.out + O_YS};
        pg8::gemm_phase<pg8::EpiFF2, pg8::StaticOrder, true, true>(ring, g, S, E, F.wave, F.lane);
        __syncthreads();
        sk::run<1>(F, WSP(bf16, WS_H) + (size_t)MPR * DFF, DFF, WSP(bf16, WS_WFF2), DFF, DFF, 64, sk::FF2{WSP(bf16, WS_XB), F.out + O_YS}); }
#undef IN
#undef SEAM
}

extern "C" void kernel_launch(void* const* d_in, const int* in_sizes, int n_in, void* d_out, int out_size, void* d_ws, size_t ws_size, hipStream_t stream) {
    static int grid = 0;
    if (grid == 0) {
        if (n_in != 30 || out_size != (int)O_END || ws_size < WS_END) { fprintf(stderr, "kernel_launch: unexpected shapes (n_in %d out %d ws %zu)\n", n_in, out_size, ws_size); grid = -1; return; }
        int dev = 0, cus = 0, per_cu = 0;
        if (hipGetDevice(&dev) != hipSuccess || hipDeviceGetAttribute(&cus, hipDeviceAttributeMultiprocessorCount, dev) != hipSuccess) { grid = -1; return; }
        if (hipFuncSetAttribute((const void*)fwd, hipFuncAttributeMaxDynamicSharedMemorySize, LDS_BYTES) != hipSuccess) { fprintf(stderr, "kernel_launch: hipFuncSetAttribute failed\n"); grid = -1; return; }
        if (hipOccupancyMaxActiveBlocksPerMultiprocessor(&per_cu, (const void*)fwd, NWAVES * 64, LDS_BYTES) != hipSuccess || per_cu < 1) fprintf(stderr, "kernel_launch: occupancy query reports %d\n", per_cu);
        (void)hipGetLastError();
        grid = cus;
    }
    if (grid < 0) return;
    if (hipMemsetAsync((char*)d_ws + WS_CTL, 0, CTL_ZERO_BYTES, stream) != hipSuccess) return;
    Args a{};
    for (int i = 0; i < 30; ++i) a.in[i] = d_in[i];
    a.out = (float*)d_out; a.ws = (unsigned char*)d_ws;
#if MK_SPLIT
    for (int p = 0; p < N_PHASES; ++p) { a.ph_lo = p; a.ph_hi = p + 1; hipLaunchKernelGGL(fwd, dim3(grid), dim3(NWAVES * 64), LDS_BYTES, stream, a); }
#else
    a.ph_lo = 0; a.ph_hi = N_PHASES; hipLaunchKernelGGL(fwd, dim3(grid), dim3(NWAVES * 64), LDS_BYTES, stream, a);
#endif
#ifdef PROBE_EXTRA_PHASE
    a.ph_lo = PROBE_EXTRA_PHASE; a.ph_hi = PROBE_EXTRA_PHASE + 1;
#ifdef PROBE_SKIP
    a.probe = PROBE_SKIP;
#endif
    hipLaunchKernelGGL(fwd, dim3(grid), dim3(NWAVES * 64), LDS_BYTES, stream, a);
#endif
#ifdef PROBE_EXTRA_LO
    (void)hipMemsetAsync((char*)d_ws + WS_CTL, 0, CTL_ZERO_BYTES, stream);
    a.ph_lo = PROBE_EXTRA_LO; a.ph_hi = PROBE_EXTRA_HI;
#ifdef PROBE_SKIP
    a.probe = PROBE_SKIP;
#endif
    hipLaunchKernelGGL(fwd, dim3(grid), dim3(NWAVES * 64), LDS_BYTES, stream, a);
#endif
}
```

```cpp
#include <hip/hip_runtime.h>
#include <hip/hip_bf16.h>
#include <cstdio>
#include <cstdint>

#ifndef MK_SPLIT
#define MK_SPLIT 0
#endif

constexpr int DM = 2048, NB = 2, SEQ = 4096, MPR = NB * SEQ, DBT = 8, DSQ = 4, MSM = DBT * DSQ, MR = MPR + MSM, MPAD = 8448;
constexpr int DSSM = 1024, NG = 64, NST = 64, GC = 16, NH = 8, HD = 128, DATT = 1024, DFF = 5632, NIN = 8200;
constexpr int PAST = 16384, PAGE = 128, NPAGES = 128;
constexpr float RMS_EPS = 1e-6f;
constexpr float LOG2E = 1.4426950408889634f;
constexpr int CT = 16, NCHK = MPR / CT, CPB = SEQ / CT;

namespace pg8 {
#define PG8_LAS __attribute__((address_space(3)))
typedef unsigned short bf16_t;
typedef short bf16x8 __attribute__((ext_vector_type(8)));
typedef float f32x4 __attribute__((ext_vector_type(4)));
typedef unsigned u32x4 __attribute__((ext_vector_type(4)));
constexpr int BM = 256, BK = 64, HALF = 128, HTB = HALF * BK * 2  , STAGE_BYTES = 8 * HTB, NXCD = 8, WGM = 8;

__host__ __device__ __forceinline__ int lds_byte(int r, int c) { const int st = (r >> 4) * 2 + (c >> 5), rr = r & 15, cc = c & 31, ob = rr * 64 + cc * 2; return st * 1024 + (ob ^ (((ob >> 9) & 1) << 5)); }
__host__ __device__ __forceinline__ void stage_rc(int b, int& R, int& C) { const int st = b / 1024, sb = b % 1024, swz = sb ^ (((sb >> 9) & 1) << 5); R = (st >> 1) * 16 + swz / 64; C = (st & 1) * 32 + (swz % 64) / 2; }
__host__ __device__ __forceinline__ int perm32(int rho) { const int n = rho >> 4, i = rho & 15; return 8 * (i >> 2) + 4 * n + (i & 3); }

struct Unit { int pm, pn; };
struct Gemm { const bf16_t* A; const bf16_t* Bt; int M, N, K, lda, ldb; };

struct StaticOrder {
    int nM, nN, nwg, G, c;
    __host__ __device__ void init(int M, int N, int G_, int c_) { nM = M / BM; nN = N / BM; nwg = nM * nN; G = G_; c = c_; }
    __host__ __device__ bool next(int i, Unit& u) const {
        const long L = (long)i * G + c; if (L >= nwg) return false;
        int wgid = (int)L; { const int q = nwg / NXCD, r = nwg % NXCD, xcd = wgid % NXCD, off = wgid / NXCD; wgid = (xcd < r ? xcd * (q + 1) : r * (q + 1) + (xcd - r) * q) + off; }
        const int nig = WGM * nN, gid = wgid / nig, fm = gid * WGM, gsz = (nM - fm) < WGM ? (nM - fm) : WGM;
        u.pm = fm + ((wgid % nig) % gsz); u.pn = (wgid % nig) / gsz; return true;
    }
    __device__ __forceinline__ void a_ready(const Unit&) const {}
    __device__ __forceinline__ void done(const Unit&) const {}
};

__device__ __forceinline__ unsigned cvt_pk_bf16(float lo, float hi) { unsigned r; asm volatile("v_cvt_pk_bf16_f32 %0, %1, %2" : "=v"(r) : "v"(lo), "v"(hi)); return r; }
typedef float f32x2 __attribute__((ext_vector_type(2)));
__device__ __forceinline__ f32x2 gelu_pk(f32x2 v) {
    const f32x2 av = __builtin_elementwise_abs(v), d = av * 0.2316418882f + 1.0f;
    f32x2 t; t.x = __builtin_amdgcn_rcpf(d.x); t.y = __builtin_amdgcn_rcpf(d.y);
    f32x2 q = t * 0.5307027145f + (-0.7265760135f); q = q * t + 0.7107068705f; q = q * t + (-0.142248368f); q = q * t + 0.127414796f; q = q * t;
    const f32x2 s = (v * v) * (-0.72134752044f);
    f32x2 e; e.x = __builtin_amdgcn_exp2f(s.x); e.y = __builtin_amdgcn_exp2f(s.y);
    const f32x2 m = v * (q * e), r = v - m;
    f32x2 o; o.x = v.x < 0.f ? m.x : r.x; o.y = v.y < 0.f ? m.y : r.y; return o;
}

__device__ __forceinline__ float sigm(float x) { return __builtin_amdgcn_rcpf(1.0f + __builtin_amdgcn_exp2f(-1.4426950408889634f * x)); }
__device__ __forceinline__ float bflo(unsigned w) { return __uint_as_float(w << 16); }
__device__ __forceinline__ float bfhi(unsigned w) { return __uint_as_float(w & 0xffff0000u); }
__device__ __forceinline__ u32x4 pack8(f32x4 a, f32x4 b) { u32x4 w; w.x = cvt_pk_bf16(a[0], a[1]); w.y = cvt_pk_bf16(a[2], a[3]); w.z = cvt_pk_bf16(b[0], b[1]); w.w = cvt_pk_bf16(b[2], b[3]); return w; }
__device__ __forceinline__ void unpack8(u32x4 w, f32x4& a, f32x4& b) { a = (f32x4){bflo(w.x), bfhi(w.x), bflo(w.y), bfhi(w.y)}; b = (f32x4){bflo(w.z), bfhi(w.z), bflo(w.w), bfhi(w.w)}; }
#define PG8_EPI_ROWS  for (int ai = 0; ai < 2; ++ai) _Pragma("unroll") for (int m = 0; m < 4; ++m)

struct EpiIn {
    static constexpr bool PERM = true, AFTER_DRAIN = false, MIDK = false;
    bf16_t* G; const float* R1; bf16_t* UB; bf16_t* QB; bf16_t* KB; bf16_t* VB; float* outK; float* outV; const float* gq; const float* gk; PG8_LAS float* P;
    __device__ __forceinline__ void operator()(const f32x4 (&acc)[2][2][4][2], const Unit& u, int wr, int wc, int fr, int fq) const {
        const int row0 = u.pm * BM + wr * 64 + fr, col0 = u.pn * BM + wc * 32 + 8 * fq, pn = u.pn;
        if (pn >= 4 && pn < 12) {
            const bool isk = pn >= 8; const int d = wc * 32 + 8 * fq;
#pragma unroll
            PG8_EPI_ROWS { const int rl = ai * HALF + wr * 64 + m * 16 + fr; const float r1 = R1[row0 + ai * HALF + m * 16];
#pragma unroll
                for (int bj = 0; bj < 2; ++bj) { const f32x4 v0 = acc[ai][bj][m][0] * r1, v1 = acc[ai][bj][m][1] * r1;
                    float ss = (v0[0] * v0[0] + v0[1] * v0[1]) + (v0[2] * v0[2] + v0[3] * v0[3]) + (v1[0] * v1[0] + v1[1] * v1[1]) + (v1[2] * v1[2] + v1[3] * v1[3]);
                    ss += __shfl_xor(ss, 16); ss += __shfl_xor(ss, 32);
                    if (fq == 0) P[(rl * 2 + bj) * 4 + wc] = ss; } }
            asm volatile("s_waitcnt lgkmcnt(0)" ::: "memory"); __builtin_amdgcn_s_barrier(); asm volatile("" ::: "memory");
            const float* gp = isk ? gk : gq; const f32x4 g0 = *(const f32x4*)(gp + d), g1 = *(const f32x4*)(gp + d + 4);
            bf16_t* ob = isk ? KB : QB;
#pragma unroll
            PG8_EPI_ROWS { const int row = row0 + ai * HALF + m * 16, rl = ai * HALF + wr * 64 + m * 16 + fr; const float r1 = R1[row];
#pragma unroll
                for (int bj = 0; bj < 2; ++bj) { const f32x4 t = *(const PG8_LAS f32x4*)(P + (rl * 2 + bj) * 4);
                    const float sc = r1 * __builtin_amdgcn_rsqf(((t[0] + t[1]) + (t[2] + t[3])) * (1.0f / 128.0f) + RMS_EPS); const int head = (pn & 3) * 2 + bj;
                    const f32x4 o0 = acc[ai][bj][m][0] * sc * g0, o1 = acc[ai][bj][m][1] * sc * g1;
                    *(u32x4*)(ob + ((size_t)((row >> 12) * NH + head) * SEQ + (row & (SEQ - 1))) * HD + d) = pack8(o0, o1);
                    if (isk) { float* p = outK + (size_t)row * DATT + head * HD + d; *(f32x4*)p = o0; *(f32x4*)(p + 4) = o1; } } }
            return; }
#pragma unroll
        PG8_EPI_ROWS { const int row = row0 + ai * HALF + m * 16; const float r1 = R1[row];
#pragma unroll
            for (int bj = 0; bj < 2; ++bj) { const int c = col0 + bj * HALF; f32x4 v0 = acc[ai][bj][m][0] * r1, v1 = acc[ai][bj][m][1] * r1;
                if (pn < 4) { *(u32x4*)(UB + ((size_t)((c >> 4) * 512 + (row >> 4)) * 16 + (row & 15)) * 16 + (c & 15)) = pack8(v0, v1); }
                else if (pn < 16) { const int head = (pn & 3) * 2 + bj, d = wc * 32 + 8 * fq;
                    *(u32x4*)(VB + ((size_t)((row >> 12) * NH + head) * SEQ + (row & (SEQ - 1))) * HD + d) = pack8(v0, v1);
                    float* p = outV + (size_t)row * DATT + head * HD + d; *(f32x4*)p = v0; *(f32x4*)(p + 4) = v1; }
                else { v0 = (f32x4){sigm(v0[0]), sigm(v0[1]), sigm(v0[2]), sigm(v0[3])}; v1 = (f32x4){sigm(v1[0]), sigm(v1[1]), sigm(v1[2]), sigm(v1[3])};
                       *(u32x4*)(G + (size_t)row * 4096 + (c - 4096)) = pack8(v0, v1); } } }
    }
};
struct EpiGlu {
    static constexpr bool PERM = true, AFTER_DRAIN = false, MIDK = false;
    const bf16_t* YP; bf16_t* YY; const float* bias;
    __device__ __forceinline__ void operator()(const f32x4 (&acc)[2][2][4][2], const Unit& u, int wr, int wc, int fr, int fq) const {
        const int row0 = u.pm * BM + wr * 64 + fr, col0 = u.pn * BM + wc * 32 + 8 * fq;
#pragma unroll
        PG8_EPI_ROWS { const int row = row0 + ai * HALF + m * 16;
#pragma unroll
            for (int bj = 0; bj < 2; ++bj) { const int c = col0 + bj * HALF; const f32x4 b0 = *(const f32x4*)(bias + c), b1 = *(const f32x4*)(bias + c + 4);
                f32x4 y0, y1; unpack8(*(const u32x4*)(YP + (size_t)row * 1024 + c), y0, y1);
                const f32x4 a0 = acc[ai][bj][m][0] + b0, a1 = acc[ai][bj][m][1] + b1;
                y0 = (f32x4){y0[0] * sigm(a0[0]), y0[1] * sigm(a0[1]), y0[2] * sigm(a0[2]), y0[3] * sigm(a0[3])};
                y1 = (f32x4){y1[0] * sigm(a1[0]), y1[1] * sigm(a1[1]), y1[2] * sigm(a1[2]), y1[3] * sigm(a1[3])};
                *(u32x4*)(YY + (size_t)row * 2048 + c) = pack8(y0, y1); } }
    }
};
struct EpiMerge {
    static constexpr bool PERM = true, AFTER_DRAIN = false, MIDK = true;
    const bf16_t* G; bf16_t* MG;
    __device__ __forceinline__ void mid(f32x4 (&acc)[2][2][4][2], const Unit& u, int wr, int wc, int fr, int fq) const {
        int off = (u.pm * BM + wr * 64 + fr) * 4096 + u.pn * BM + wc * 32 + 8 * fq;
        asm volatile("" : "+v"(off));
#pragma unroll
        PG8_EPI_ROWS {
#pragma unroll
            for (int bj = 0; bj < 2; ++bj) { const bf16_t* gp = G + (off + bj * HALF); f32x4 a0, a1, b0, b1; unpack8(*(const u32x4*)gp, a0, a1); unpack8(*(const u32x4*)(gp + 2048), b0, b1);
                acc[ai][bj][m][0] = acc[ai][bj][m][0] * (f32x4){a0[0] * __builtin_amdgcn_rcpf(b0[0]), a0[1] * __builtin_amdgcn_rcpf(b0[1]), a0[2] * __builtin_amdgcn_rcpf(b0[2]), a0[3] * __builtin_amdgcn_rcpf(b0[3])};
                acc[ai][bj][m][1] = acc[ai][bj][m][1] * (f32x4){a1[0] * __builtin_amdgcn_rcpf(b1[0]), a1[1] * __builtin_amdgcn_rcpf(b1[1]), a1[2] * __builtin_amdgcn_rcpf(b1[2]), a1[3] * __builtin_amdgcn_rcpf(b1[3])}; }
            off += (m == 3) ? (HALF - 48) * 4096 : 16 * 4096; asm volatile("" : "+v"(off)); }
    }
    __device__ __forceinline__ void operator()(const f32x4 (&acc)[2][2][4][2], const Unit& u, int wr, int wc, int fr, int fq) const {
        const int row0 = u.pm * BM + wr * 64 + fr, col0 = u.pn * BM + wc * 32 + 8 * fq;
#pragma unroll
        PG8_EPI_ROWS { const int row = row0 + ai * HALF + m * 16;
#pragma unroll
            for (int bj = 0; bj < 2; ++bj) { const int c = col0 + bj * HALF; f32x4 g0, g1; unpack8(*(const u32x4*)(G + (size_t)row * 4096 + 2048 + c), g0, g1);
                *(u32x4*)(MG + (size_t)row * 2048 + c) = pack8(acc[ai][bj][m][0] * g0, acc[ai][bj][m][1] * g1); } }
    }
};
struct EpiOut {
    static constexpr bool PERM = true, AFTER_DRAIN = false, MIDK = false;
    const float* xp; const float* xs; bf16_t* XB; float* SSR;
    __device__ __forceinline__ void operator()(const f32x4 (&acc)[2][2][4][2], const Unit& u, int wr, int wc, int fr, int fq) const {
        const int row0 = u.pm * BM + wr * 64 + fr, col0 = u.pn * BM + wc * 32 + 8 * fq;
#pragma unroll
        PG8_EPI_ROWS { const int row = row0 + ai * HALF + m * 16;
            const float* xr = row < MPR ? xp + (size_t)row * 2048 : xs + (size_t)(row < MR ? row - MPR : 0) * 2048; const bool live = row < MR; float s = 0.f;
#pragma unroll
            for (int bj = 0; bj < 2; ++bj) { const int c = col0 + bj * HALF; f32x4 x0 = (f32x4){0.f, 0.f, 0.f, 0.f}, x1 = x0;
                if (live) { x0 = *(const f32x4*)(xr + c); x1 = *(const f32x4*)(xr + c + 4); }
                x0 = x0 + acc[ai][bj][m][0]; x1 = x1 + acc[ai][bj][m][1];
                s += (x0[0] * x0[0] + x0[1] * x0[1]) + (x0[2] * x0[2] + x0[3] * x0[3]) + (x1[0] * x1[0] + x1[1] * x1[1]) + (x1[2] * x1[2] + x1[3] * x1[3]);
                *(u32x4*)(XB + (size_t)row * 2048 + c) = pack8(x0, x1); }
            s += __shfl_xor(s, 16); s += __shfl_xor(s, 32);
            if (fq == 0) __hip_atomic_fetch_add(SSR + row, s, __ATOMIC_RELAXED, __HIP_MEMORY_SCOPE_AGENT); }
    }
};
struct EpiFF1 {
    static constexpr bool PERM = true, AFTER_DRAIN = false, MIDK = false;
    const float* SSR; bf16_t* H; int probe;
    __device__ __forceinline__ void operator()(const f32x4 (&acc)[2][2][4][2], const Unit& u, int wr, int wc, int fr, int fq) const {
        if (probe & 8) { if (acc[0][0][0][0][0] == 123.456f) H[0] = 0; return; }
        const int row0 = u.pm * BM + wr * 64 + fr, col0 = u.pn * HALF + wc * 32 + 8 * fq;
#pragma unroll
        PG8_EPI_ROWS { const int row = row0 + ai * HALF + m * 16;
            const float r2 = __builtin_amdgcn_rsqf(SSR[row] * (1.0f / 2048.0f) + RMS_EPS);
            f32x4 o[2];
#pragma unroll
            for (int n = 0; n < 2; ++n) { const f32x4 g = acc[ai][0][m][n] * r2, up = acc[ai][1][m][n] * r2;
                o[n] = (f32x4){g[0] * sigm(g[0]) * up[0], g[1] * sigm(g[1]) * up[1], g[2] * sigm(g[2]) * up[2], g[3] * sigm(g[3]) * up[3]}; }
            *(u32x4*)(H + (size_t)row * DFF + col0) = pack8(o[0], o[1]); }
    }
};
struct EpiFF2 {
    static constexpr bool PERM = true, AFTER_DRAIN = false, MIDK = false;
    const bf16_t* XB; float* yp; float* ys;
    __device__ __forceinline__ void operator()(const f32x4 (&acc)[2][2][4][2], const Unit& u, int wr, int wc, int fr, int fq) const {
        const int row0 = u.pm * BM + wr * 64 + fr, col0 = u.pn * BM + wc * 32 + 8 * fq;
#pragma unroll
        PG8_EPI_ROWS { const int row = row0 + ai * HALF + m * 16; if (row >= MR) continue;
            float* orow = row < MPR ? yp + (size_t)row * 2048 : ys + (size_t)(row - MPR) * 2048;
#pragma unroll
            for (int bj = 0; bj < 2; ++bj) { const int c = col0 + bj * HALF; f32x4 x0, x1; unpack8(*(const u32x4*)(XB + (size_t)row * 2048 + c), x0, x1);
                *(f32x4*)(orow + c) = x0 + acc[ai][bj][m][0]; *(f32x4*)(orow + c + 4) = x1 + acc[ai][bj][m][1]; } }
    }
};
template <class Epi, class Sched, bool ALIGN_EPI = false, bool SP2 = false>
__device__ __forceinline__ void gemm_phase(PG8_LAS unsigned char* lds, const Gemm g, const Sched& S, const Epi& E, int wid_in, int lane_in) {
    const int wid = wid_in, lane = lane_in, tid = wid * 64 + lane, wr = wid >> 2, wc = wid & 3, fr = lane & 15, fq = lane >> 4;
    const int K = g.K, nt = K / BK;
    unsigned voffA[2], voffB[2];
#pragma unroll
    for (int i = 0; i < 2; ++i) { int R, C; stage_rc(tid * 16 + i * 8192, R, C); const int Rb = Epi::PERM ? ((R & ~31) + perm32(R & 31)) : R;
        voffA[i] = (unsigned)(R * g.lda + C) * 2u; voffB[i] = (unsigned)(Rb * g.ldb + C) * 2u; }
    const size_t kstep = (size_t)(BK * 2);
    const size_t hsA = (size_t)HALF * g.lda * 2, hsB = (size_t)HALF * g.ldb * 2;
    const size_t tsA = 2 * hsA, tsB = 2 * hsB;
    const unsigned ldsw = (unsigned)wid * 1024u;
    const int aoff = lds_byte(wr * 64 + fr, fq * 8), boff = lds_byte(wc * 32 + fr, fq * 8);
#define PG8_SA(b, h) (((b) * 2 + (h)) * HTB)
#define PG8_SB(b, h) ((4 + (b) * 2 + (h)) * HTB)
#define PG8_STAGE(bufoff, gbase, voff) do { _Pragma("unroll") for (int _i = 0; _i < 2; ++_i) \
        __builtin_amdgcn_global_load_lds((const unsigned*)((const char*)(gbase) + (voff)[_i]), (PG8_LAS unsigned*)(lds + (bufoff) + ldsw + _i * 8192), 16, 0, 0); } while (0)
#define PG8_LDA(dst, b, h) do { _Pragma("unroll") for (int m = 0; m < 4; ++m) _Pragma("unroll") for (int k = 0; k < 2; ++k) dst[m][k] = *(const PG8_LAS bf16x8*)(lds + PG8_SA(b, h) + aoff + m * 2048 + k * 1024); } while (0)
#define PG8_LDB(dst, b, h) do { _Pragma("unroll") for (int n = 0; n < 2; ++n) _Pragma("unroll") for (int k = 0; k < 2; ++k) dst[n][k] = *(const PG8_LAS bf16x8*)(lds + PG8_SB(b, h) + boff + n * 2048 + k * 1024); } while (0)
#define PG8_MMA(ai, bj, At, Bt) do { __builtin_amdgcn_s_setprio(1); _Pragma("unroll") for (int m = 0; m < 4; ++m) _Pragma("unroll") for (int n = 0; n < 2; ++n) _Pragma("unroll") for (int k = 0; k < 2; ++k) \
        acc[ai][bj][m][n] = __builtin_amdgcn_mfma_f32_16x16x32_bf16(Bt[n][k], At[m][k], acc[ai][bj][m][n], 0, 0, 0); __builtin_amdgcn_s_setprio(0); } while (0)
#define PG8_WAIT_V(n) asm volatile("s_waitcnt vmcnt(" #n ")" ::: "memory")
#define PG8_WAIT_L(n) asm volatile("s_waitcnt lgkmcnt(" #n ")" ::: "memory")
#define PG8_BAR __builtin_amdgcn_s_barrier()
#define PG8_SCHED __builtin_amdgcn_sched_barrier(0)
    Unit cur, nxt; int ui = 0;
    if (!S.next(0, cur)) return;
    f32x4 acc[2][2][4][2];
#pragma unroll
    for (int a = 0; a < 2; ++a)
#pragma unroll
        for (int b = 0; b < 2; ++b)
#pragma unroll
            for (int m = 0; m < 4; ++m)
#pragma unroll
                for (int n = 0; n < 2; ++n) acc[a][b][m][n] = (f32x4){0.f, 0.f, 0.f, 0.f};
    bf16x8 At[4][2], B0[2][2], B1[2][2];
    const char* cA = (const char*)g.A + (size_t)cur.pm * tsA; const char* cB = (const char*)g.Bt + (size_t)cur.pn * tsB;
    S.a_ready(cur);
    if constexpr (SP2) {
        PG8_STAGE(PG8_SB(0, 0), cB, voffB); PG8_STAGE(PG8_SB(0, 1), cB + hsB, voffB); PG8_STAGE(PG8_SA(0, 0), cA, voffA); PG8_STAGE(PG8_SA(0, 1), cA + hsA, voffA);
        if (wr == 1) PG8_BAR;
        PG8_WAIT_V(2); PG8_BAR;
        PG8_STAGE(PG8_SB(1, 0), cB + kstep, voffB); PG8_STAGE(PG8_SA(1, 0), cA + kstep, voffA); PG8_STAGE(PG8_SB(1, 1), cB + hsB + kstep, voffB);
        PG8_WAIT_V(6); PG8_BAR;
    } else {
        PG8_STAGE(PG8_SB(0, 0), cB, voffB); PG8_STAGE(PG8_SA(0, 0), cA, voffA); PG8_STAGE(PG8_SB(0, 1), cB + hsB, voffB); PG8_STAGE(PG8_SA(0, 1), cA + hsA, voffA);
        if (wr == 1) PG8_BAR;
        PG8_WAIT_V(4); PG8_BAR;
        PG8_STAGE(PG8_SB(1, 0), cB + kstep, voffB); PG8_STAGE(PG8_SA(1, 0), cA + kstep, voffA); PG8_STAGE(PG8_SB(1, 1), cB + hsB + kstep, voffB);
        PG8_WAIT_V(6); PG8_BAR;
    }
    for (;;) {
        const bool has_next = S.next(ui + 1, nxt);
        const char* nA = has_next ? (const char*)g.A + (size_t)nxt.pm * tsA : cA; const char* nB = has_next ? (const char*)g.Bt + (size_t)nxt.pn * tsB : cB;
        for (int t = 0; t < nt; t += 2) {
            if constexpr (Epi::MIDK) { if (t == (nt >> 1)) E.mid(acc, cur, wr, wc, fr, fq); }
            const bool last = (t == nt - 2);
            const char* a1 = cA + (size_t)(t + 1) * kstep;
            const char* a2 = last ? nA : cA + (size_t)(t + 2) * kstep; const char* b2 = last ? nB : cB + (size_t)(t + 2) * kstep;
            const char* a3 = a2 + kstep; const char* b3 = b2 + kstep;
            if (last && has_next) S.a_ready(nxt);
            if constexpr (SP2) {
            PG8_LDB(B0, 0, 0); PG8_LDB(B1, 0, 1); PG8_SCHED; PG8_LDA(At, 0, 0); PG8_STAGE(PG8_SA(1, 1), a1 + hsA, voffA);
            PG8_WAIT_V(8); PG8_WAIT_L(0); PG8_BAR; PG8_MMA(0, 0, At, B0); PG8_MMA(0, 1, At, B1); PG8_BAR; PG8_SCHED;
            PG8_LDA(At, 0, 1); PG8_STAGE(PG8_SB(0, 0), b2, voffB); PG8_STAGE(PG8_SB(0, 1), b2 + hsB, voffB); PG8_STAGE(PG8_SA(0, 0), a2, voffA);
            PG8_WAIT_V(8); PG8_WAIT_L(0); PG8_BAR; PG8_MMA(1, 0, At, B0); PG8_MMA(1, 1, At, B1); PG8_BAR; PG8_SCHED;
            PG8_LDB(B0, 1, 0); PG8_LDB(B1, 1, 1); PG8_SCHED; PG8_LDA(At, 1, 0); PG8_STAGE(PG8_SA(0, 1), a2 + hsA, voffA);
            PG8_WAIT_V(8); PG8_WAIT_L(0); PG8_BAR; PG8_MMA(0, 0, At, B0); PG8_MMA(0, 1, At, B1); PG8_BAR; PG8_SCHED;
            PG8_LDA(At, 1, 1); PG8_STAGE(PG8_SB(1, 0), b3, voffB); PG8_STAGE(PG8_SB(1, 1), b3 + hsB, voffB); PG8_STAGE(PG8_SA(1, 0), a3, voffA);
            PG8_WAIT_V(8); PG8_WAIT_L(0); PG8_BAR; PG8_MMA(1, 0, At, B0); PG8_MMA(1, 1, At, B1); PG8_BAR; PG8_SCHED;
            } else {
            PG8_LDB(B0, 0, 0); PG8_SCHED; PG8_LDA(At, 0, 0); PG8_STAGE(PG8_SA(1, 1), a1 + hsA, voffA);
            PG8_WAIT_L(8); PG8_BAR; PG8_WAIT_L(0); PG8_MMA(0, 0, At, B0); PG8_BAR; PG8_SCHED;
            PG8_LDB(B1, 0, 1); PG8_STAGE(PG8_SB(0, 0), b2, voffB);
            PG8_BAR; PG8_WAIT_L(0); PG8_MMA(0, 1, At, B1); PG8_BAR;
            PG8_LDA(At, 0, 1); PG8_STAGE(PG8_SA(0, 0), a2, voffA);
            PG8_BAR; PG8_WAIT_L(0); PG8_MMA(1, 0, At, B0); PG8_BAR; PG8_SCHED;
            PG8_STAGE(PG8_SB(0, 1), b2 + hsB, voffB);
            PG8_WAIT_V(6); PG8_BAR; PG8_MMA(1, 1, At, B1); PG8_BAR;
            PG8_LDB(B0, 1, 0); PG8_SCHED; PG8_LDA(At, 1, 0); PG8_STAGE(PG8_SA(0, 1), a2 + hsA, voffA);
            PG8_WAIT_L(8); PG8_BAR; PG8_WAIT_L(0); PG8_MMA(0, 0, At, B0); PG8_BAR; PG8_SCHED;
            PG8_LDB(B1, 1, 1); PG8_STAGE(PG8_SB(1, 0), b3, voffB);
            PG8_BAR; PG8_WAIT_L(0); PG8_MMA(0, 1, At, B1); PG8_BAR;
            PG8_LDA(At, 1, 1); PG8_STAGE(PG8_SA(1, 0), a3, voffA);
            PG8_BAR; PG8_WAIT_L(0); PG8_MMA(1, 0, At, B0); PG8_BAR; PG8_SCHED;
            PG8_STAGE(PG8_SB(1, 1), b3 + hsB, voffB);
            PG8_WAIT_V(6); PG8_BAR; PG8_MMA(1, 1, At, B1); PG8_BAR;
            }
        }
        if constexpr (ALIGN_EPI) { if (wr == 0) PG8_BAR; }
        if constexpr (!Epi::AFTER_DRAIN) { E(acc, cur, wr, wc, fr, fq); S.done(cur); }
        if (!has_next) break;
#pragma unroll
        for (int a = 0; a < 2; ++a)
#pragma unroll
            for (int b = 0; b < 2; ++b)
#pragma unroll
                for (int m = 0; m < 4; ++m)
#pragma unroll
                    for (int n = 0; n < 2; ++n) acc[a][b][m][n] = (f32x4){0.f, 0.f, 0.f, 0.f};
        cur = nxt; cA = nA; cB = nB; ++ui;
        if constexpr (ALIGN_EPI) { if (wr == 1) PG8_BAR; }
    }
    PG8_WAIT_V(0);
    if constexpr (!ALIGN_EPI) { if (wr == 0) PG8_BAR; }
    PG8_BAR;
    if constexpr (Epi::AFTER_DRAIN) { E.fused(acc, cur, wr, wc, fr, fq, lds, wid, lane); S.done(cur); }
#undef PG8_SA
#undef PG8_SB
#undef PG8_STAGE
#undef PG8_LDA
#undef PG8_LDB
#undef PG8_MMA
#undef PG8_WAIT_V
#undef PG8_WAIT_L
#undef PG8_BAR
#undef PG8_SCHED
}
}
namespace pattn {
constexpr int D = 128; constexpr float THR = 8.f; constexpr bool WSKIP = false;
constexpr float SCALE = 0.08838834764831845f;
constexpr int NW = 8, QBLK = 32, KVBLK = 64, QB = NW * QBLK;
constexpr int SHM_V = KVBLK * D * 2, SHM_K = KVBLK * D * 2;
constexpr int LDS_CK = 2 * SHM_V + 2 * SHM_K + NW * 64 * 4;
constexpr int LDS_BYTES = LDS_CK + 2 * 2048;
constexpr int OSTR = 2048;
using bf16 = __hip_bfloat16;
typedef short bf16x8 __attribute__((ext_vector_type(8)));
typedef short s16x4 __attribute__((ext_vector_type(4)));
typedef float f32x16 __attribute__((ext_vector_type(16)));
typedef float f32x4 __attribute__((ext_vector_type(4)));
typedef unsigned u32x4 __attribute__((ext_vector_type(4)));
template <class A, class Bt> struct same_t { static constexpr bool v = false; };
template <class A> struct same_t<A, A> { static constexpr bool v = true; };

#define KSWZ(row, colB) ((row) * 256 + ((colB) ^ (((row) & 7) << 4)))
#define SBAR() __builtin_amdgcn_sched_barrier(0)
__device__ __forceinline__ int v_st(int k, int c) { const int kk = (k & ~0xC) | ((k & 4) << 1) | ((k & 8) >> 1); return ((kk >> 3) * 4 + (c >> 5)) * 512 + ((kk & 7) * 32 + (c & 31)) * 2; }
__device__ __forceinline__ int v_rd_base(int lane) { return ((lane & 3) << 3) | (((lane >> 2) & 3) << 6) | (((lane >> 4) & 1) << 5) | (((lane >> 5) & 1) << 8); }
constexpr int v_rd_off(int d0, int ks, int half) { return d0 * 512 + ks * 4096 + half * 2048; }
__device__ __forceinline__ int crow(int r, int hi) { return (r & 3) + 8 * (r >> 2) + 4 * hi; }
__device__ __forceinline__ unsigned cvtpk(float lo, float hi) {
    unsigned r; asm volatile("v_cvt_pk_bf16_f32 %0, %1, %2" : "=v"(r) : "v"(lo), "v"(hi)); return r;
}
__device__ __forceinline__ bf16x8 pack8(f32x4 a, f32x4 b) {
    u32x4 w = {cvtpk(a[0], a[1]), cvtpk(a[2], a[3]), cvtpk(b[0], b[1]), cvtpk(b[2], b[3])};
    return *reinterpret_cast<bf16x8*>(&w);
}
template <class T> __device__ __forceinline__ bf16x8 load8(const T* p) {
    if constexpr (same_t<T, float>::v) { return pack8(*(const f32x4*)p, *(const f32x4*)(p + 4)); }
    else { return *reinterpret_cast<const bf16x8*>(p); }
}
__device__ __forceinline__ void mask_tile(f32x16& p0, f32x16& p1, int dq, unsigned W) {
    const float NEG = -__builtin_inff();
#pragma unroll
    for (int r = 0; r < 16; ++r) {
        const int c = (r & 3) + 8 * (r >> 2);
        if ((unsigned)(dq - c) >= W) p0[r] = NEG;
        if ((unsigned)(dq - c - 32) >= W) p1[r] = NEG;
    }
}
__device__ __forceinline__ void partialSM(f32x16& p0, f32x16& p1, float& m_reg, float& mn, float& alpha) {
    constexpr float C2 = 1.4426950408889634f * SCALE; mn = 0.f; alpha = 1.f;
    for (int r = 0; r < 16; ++r) p0[r] = fmaf(p0[r], C2, m_reg); for (int r = 0; r < 16; ++r) p1[r] = fmaf(p1[r], C2, m_reg);
    for (int r = 0; r < 16; ++r) p0[r] = __builtin_amdgcn_exp2f(p0[r]);
}
__device__ __forceinline__ void finishSM(f32x16& p0, f32x16& p1, float alpha, float& l_reg, bf16x8& pa0, bf16x8& pa1, bf16x8& pa2, bf16x8& pa3) {
    for (int r = 0; r < 16; ++r) p1[r] = __builtin_amdgcn_exp2f(p1[r]);
    float ps = 0; for (int r = 0; r < 16; ++r) ps += p0[r]; for (int r = 0; r < 16; ++r) ps += p1[r];
    { auto rr = __builtin_amdgcn_permlane32_swap(__float_as_uint(ps), __float_as_uint(ps), false, false);
      ps = __uint_as_float(rr[0]) + __uint_as_float(rr[1]); }
    l_reg = l_reg * alpha + ps;
#define PK4(P, B_, OUT) do { unsigned a0 = cvtpk(P[B_+0], P[B_+1]), a1 = cvtpk(P[B_+2], P[B_+3]);                          \
        unsigned b0 = cvtpk(P[B_+4], P[B_+5]), b1 = cvtpk(P[B_+6], P[B_+7]);                                             \
        auto r0 = __builtin_amdgcn_permlane32_swap(a0, b0, false, false); auto r1 = __builtin_amdgcn_permlane32_swap(a1, b1, false, false); \
        u32x4 w = {r0[0], r1[0], r0[1], r1[1]}; OUT = *reinterpret_cast<bf16x8*>(&w); } while (0)
    PK4(p0, 0, pa0); PK4(p0, 8, pa1); PK4(p1, 0, pa2); PK4(p1, 8, pa3);
#undef PK4
}
template <int KB, bool SK>
__device__ __forceinline__ void qkt(f32x16& p0, f32x16& p1, const char* K_lds, const char* CK_lds, int r32, int hi, const bf16x8* qr, bool act) {
    if (SK && !act) { const float NEG = -__builtin_inff();
#pragma unroll
        for (int r = 0; r < 16; ++r) { p0[r] = NEG; p1[r] = NEG; } return; }
    p0 = f32x16{}; p1 = f32x16{};
    const char* kb[4];
#pragma unroll
    for (int dd = 0; dd < 4; ++dd) kb[dd] = K_lds + KB * SHM_K + KSWZ(r32, (dd * 16 + hi * 8) * 2);
#pragma unroll
    for (int d0 = 0; d0 < 8; ++d0) { const char* a = kb[d0 & 3] + (d0 >> 2) * 128;
        bf16x8 b0 = *reinterpret_cast<const bf16x8*>(a);
        bf16x8 b1 = *reinterpret_cast<const bf16x8*>(a + 32 * 256);
        p0 = __builtin_amdgcn_mfma_f32_32x32x16_bf16(b0, qr[d0], p0, 0, 0, 0);
        p1 = __builtin_amdgcn_mfma_f32_32x32x16_bf16(b1, qr[d0], p1, 0, 0, 0); }
#ifndef NO_FOX
    {
        const char* a = CK_lds + KB * 2048 + r32 * 32 + hi * 16; const bf16x8 c0 = *reinterpret_cast<const bf16x8*>(a), c1 = *reinterpret_cast<const bf16x8*>(a + 1024);
        const short one = (short)0x3F80; const bf16x8 ones = {one, one, one, one, one, one, one, one};
        p0 = __builtin_amdgcn_mfma_f32_32x32x16_bf16(c0, ones, p0, 0, 0, 0); p1 = __builtin_amdgcn_mfma_f32_32x32x16_bf16(c1, ones, p1, 0, 0, 0); }
#endif
}
template <int VB, bool SK>
__device__ __forceinline__ void pv_tile(f32x16* o, int vb0, bf16x8 pa0, bf16x8 pa1, bf16x8 pa2, bf16x8 pa3, bool act) {
    if (SK && !act) return;
#define TRRD(dst, off) asm volatile("ds_read_b64_tr_b16 %0, %1 offset:%2" : "=&v"(dst) : "v"(vb0), "i"(off) : "memory")
#define PV_D0(d0) do { s16x4 l0, l1, l2, l3, h0, h1, h2, h3; constexpr int b_ = VB * SHM_V + v_rd_off(d0, 0, 0);     \
        TRRD(l0, b_); TRRD(h0, b_ + 2048); TRRD(l1, b_ + 4096); TRRD(h1, b_ + 6144); TRRD(l2, b_ + 8192); TRRD(h2, b_ + 10240); TRRD(l3, b_ + 12288); TRRD(h3, b_ + 14336); \
        asm volatile("s_waitcnt lgkmcnt(0)" ::: "memory"); SBAR();                 \
        o[d0] = __builtin_amdgcn_mfma_f32_32x32x16_bf16(pa0, (bf16x8){l0[0], l0[1], l0[2], l0[3], h0[0], h0[1], h0[2], h0[3]}, o[d0], 0, 0, 0);   \
        o[d0] = __builtin_amdgcn_mfma_f32_32x32x16_bf16(pa1, (bf16x8){l1[0], l1[1], l1[2], l1[3], h1[0], h1[1], h1[2], h1[3]}, o[d0], 0, 0, 0);   \
        o[d0] = __builtin_amdgcn_mfma_f32_32x32x16_bf16(pa2, (bf16x8){l2[0], l2[1], l2[2], l2[3], h2[0], h2[1], h2[2], h2[3]}, o[d0], 0, 0, 0);   \
        o[d0] = __builtin_amdgcn_mfma_f32_32x32x16_bf16(pa3, (bf16x8){l3[0], l3[1], l3[2], l3[3], h3[0], h3[1], h3[2], h3[3]}, o[d0], 0, 0, 0); } while (0)
    PV_D0(0); PV_D0(1); PV_D0(2); PV_D0(3);
#undef PV_D0
#undef TRRD
}

template <class TIn, class TOut> struct BlockRef { const TIn* Q; const TIn* K; const TIn* V; TOut* O; const unsigned short* CK; const float* XF; int P0, jlo; float negb2; };
template <class TIn> struct Seam {
    bf16x8 qr[8];
    bf16x8 st_v0, st_v1, st_k0, st_k1; f32x4 sf0, sf1, sf2, sf3;
    f32x4 tq[16];
};
__device__ __forceinline__ int swa_jlo(int P0, int W) { const int lowk = P0 - W + 1; return lowk > 0 ? lowk / KVBLK : 0; }
#define ROW(p, k0, rr) ((p) + (int)(((k0) + (rr)) * D + sc))
#define VMW() asm volatile("s_waitcnt vmcnt(0)" ::: "memory")
#define VMWN(n) asm volatile("s_waitcnt vmcnt(%0)" :: "i"(n) : "memory")
#define SLOAD_H(Kp, Vp, CKp, k0, bf) do { S.st_v0 = load8<TIn>(ROW(Vp, k0, sr)); S.st_v1 = load8<TIn>(ROW(Vp, k0, 32 + sr));              \
                         S.st_k0 = load8<TIn>(ROW(Kp, k0, sr)); S.st_k1 = load8<TIn>(ROW(Kp, k0, 32 + sr)); if (wid < 2) __builtin_amdgcn_global_load_lds((const unsigned*)((CKp) + (int)(((k0) + wid * 32) * 16 + lane * 8)), (__attribute__((address_space(3))) unsigned*)(CK_lds + (bf) * 2048 + wid * 1024), 16, 0, 0); } while (0)
#define SWRITE_HK(bf) do { *(bf16x8*)(K_lds + (bf) * SHM_K + kws) = S.st_k0; *(bf16x8*)(K_lds + (bf) * SHM_K + kws + 32 * 256) = S.st_k1; } while (0)
#define SWRITE_HV(bf) do { *(bf16x8*)(V_lds + (bf) * SHM_V + vst0) = S.st_v0; *(bf16x8*)(V_lds + (bf) * SHM_V + vst1) = S.st_v1; } while (0)
#define SWRITE_H(bf) do { SWRITE_HV(bf); SWRITE_HK(bf); } while (0)
#define SLOAD_F(p, k0) do { S.sf0 = *(const f32x4*)ROW(p, k0, sr); S.sf1 = *(const f32x4*)(ROW(p, k0, sr) + 4);                \
                            S.sf2 = *(const f32x4*)ROW(p, k0, 32 + sr); S.sf3 = *(const f32x4*)(ROW(p, k0, 32 + sr) + 4); } while (0)
#define SWRITE_KF(bf) do { *(bf16x8*)(K_lds + (bf) * SHM_K + kws) = pack8(S.sf0, S.sf1); *(bf16x8*)(K_lds + (bf) * SHM_K + kws + 32 * 256) = pack8(S.sf2, S.sf3); } while (0)
#define SWRITE_VF(bf) do { *(bf16x8*)(V_lds + (bf) * SHM_V + vst0) = pack8(S.sf0, S.sf1); *(bf16x8*)(V_lds + (bf) * SHM_V + vst1) = pack8(S.sf2, S.sf3); } while (0)
template <class TIn, class TOut>
__device__ __forceinline__ void causal_swa_prime(const BlockRef<TIn, TOut>& cur, int W, char* lds, Seam<TIn>& S, int wid_in, int lane_in) {
    constexpr bool F32 = same_t<TIn, float>::v;
    const int wid = wid_in, lane = lane_in, tid = wid * 64 + lane, r32 = lane & 31, hi = lane >> 5;
    const int sr = tid >> 4, sc = (tid & 15) * 8, kws = KSWZ(sr, sc * 2); char* K_lds = lds + 2 * SHM_V; char* CK_lds = lds + LDS_CK;
    const int kb0 = cur.jlo * KVBLK;
    for (int d0 = 0; d0 < 8; ++d0) S.qr[d0] = load8<TIn>(cur.Q + ((wid * QBLK + r32) * D + hi * 8) + d0 * 16);
    if constexpr (F32) { SLOAD_F((const float*)cur.K, kb0); VMW(); SWRITE_KF(0); SBAR(); SLOAD_F((const float*)cur.V, kb0); }
    else { SLOAD_H(cur.K, cur.V, cur.CK, kb0, 0); VMW(); SWRITE_HK(0); }
    __syncthreads();
}
template <class TIn, class TOut>
__device__ __forceinline__ void causal_swa_block(const BlockRef<TIn, TOut>& cur, const BlockRef<TIn, TOut>& nxt, int skv, int W, char* lds, Seam<TIn>& S, int wid_in, int lane_in) {
    constexpr bool F32 = same_t<TIn, float>::v;
    const int wid = wid_in, lane = lane_in, tid = wid * 64 + lane, r32 = lane & 31, hi = lane >> 5;
    const int j_lo = cur.jlo;
    int j_hi = (cur.P0 + QB - 1) / KVBLK + 1; if (j_hi > skv / KVBLK) j_hi = skv / KVBLK;
    const int NT = j_hi - j_lo;
    const int kbn = nxt.jlo * KVBLK;
    const int qlo = cur.P0 + wid * QBLK, qm = qlo + r32 - 4 * hi;
    char* V_lds = lds; char* K_lds = lds + 2 * SHM_V; char* CK_lds = lds + LDS_CK;
    float* ws = (float*)(lds + 2 * SHM_V + 2 * SHM_K) + wid * 64; float* li_l = ws, * al_l = ws + 32;
    float m_reg = cur.negb2 - (1.4426950408889634f * SCALE) * cur.XF[cur.P0 + wid * QBLK + r32], l_reg = 0; f32x16 o[4] = {};
    const int sr = tid >> 4, sc = (tid & 15) * 8, vst0 = v_st(sr, sc), vst1 = v_st(32 + sr, sc), kws = KSWZ(sr, sc * 2);
    const int vb0 = (int)(uintptr_t)V_lds + v_rd_base(lane);
    const TIn* Kh = cur.K; const TIn* Vh = cur.V; const unsigned short* CKh = cur.CK;
#define RESC(a) do { if (__any((a) < 1.f)) { if (hi == 0) al_l[r32] = (a); asm volatile("s_waitcnt lgkmcnt(0)" ::: "memory");              \
                     for (int d_ = 0; d_ < 4; ++d_) for (int r = 0; r < 16; ++r) o[d_][r] *= al_l[crow(r, hi)]; } } while (0)
#define KBASE(t) ((j_lo + (t)) * KVBLK)
#define ACT(t) (KBASE(t) <= qlo + QBLK - 1 && KBASE(t) + KVBLK - 1 >= qlo - W + 1)
#define MASKT(P0_, P1_, t) do { const int kb_ = KBASE(t); if ((!SK || ACT(t)) && (kb_ + KVBLK - 1 > qlo || kb_ <= qlo + QBLK - 1 - W)) mask_tile(P0_, P1_, qm - kb_, (unsigned)W); } while (0)
    constexpr int NQL = F32 ? 16 : 8;
    constexpr bool SK = WSKIP && !F32;
#define SEAM_K0() do { VMWN(NQL); if constexpr (F32) { SWRITE_KF(0); SBAR(); SLOAD_F((const float*)nxt.V, kbn); } else { SWRITE_HK(0); } SBAR(); } while (0)
    f32x16 pA0, pA1, pB0, pB1; float mnA, mnB, alA, alB; bf16x8 pa0, pa1, pa2, pa3;
    if constexpr (F32) { VMW(); SWRITE_VF(0); SBAR(); } else { SWRITE_HV(0); SBAR(); }
    if (NT > 1) { if constexpr (F32) SLOAD_F((const float*)Kh, KBASE(1)); else SLOAD_H(Kh, Vh, CKh, KBASE(1), 1); }
    SBAR(); qkt<0, SK>(pA0, pA1, K_lds, CK_lds, r32, hi, S.qr, ACT(0));
    if constexpr (F32) { if (NT > 1) { VMW(); SWRITE_KF(1); SBAR(); SLOAD_F((const float*)Vh, KBASE(1)); } }
    MASKT(pA0, pA1, 0); partialSM(pA0, pA1, m_reg, mnA, alA);
    if (NT > 1) { VMW(); if constexpr (F32) { SWRITE_VF(1); SBAR(); if (NT > 2) SLOAD_F((const float*)Kh, KBASE(2)); } else SWRITE_H(1); }
    __syncthreads();
#define HALF_STEP(PX0, PX1, mnX, alX, PY0, PY1, alY, t, KB, VB, SB) do {                                                      \
        SBAR(); qkt<KB, SK>(PX0, PX1, K_lds, CK_lds, r32, hi, S.qr, ACT(t));                                             \
        finishSM(PY0, PY1, alY, l_reg, pa0, pa1, pa2, pa3); SBAR();                                                           \
        if ((t) + 1 < NT) { if constexpr (F32) { VMW(); SWRITE_KF(SB); SBAR(); SLOAD_F((const float*)Vh, KBASE((t) + 1)); }  \
                            else { SLOAD_H(Kh, Vh, CKh, KBASE((t) + 1), SB); } SBAR(); }                                               \
        pv_tile<VB, SK>(o, vb0, pa0, pa1, pa2, pa3, ACT((t) - 1)); MASKT(PX0, PX1, (t)); partialSM(PX0, PX1, m_reg, mnX, alX);                                        \
        __syncthreads();                                                                                                      \
        if ((t) + 1 < NT) { VMW(); if constexpr (F32) { SWRITE_VF(SB); SBAR(); if ((t) + 2 < NT) SLOAD_F((const float*)Kh, KBASE((t) + 2)); } \
                            else { SWRITE_H(SB); } }                                                                          \
        RESC(alX); __syncthreads(); } while (0)
    for (int t = 1; t + 1 < NT; t += 2) {
        HALF_STEP(pB0, pB1, mnB, alB, pA0, pA1, alA, t, 1, 0, 0);
        HALF_STEP(pA0, pA1, mnA, alA, pB0, pB1, alB, t + 1, 0, 1, 1);
    }
    const bool even = (NT & 1) == 0;
    if (even) { SBAR(); qkt<1, SK>(pB0, pB1, K_lds, CK_lds, r32, hi, S.qr, ACT(NT - 1)); SBAR(); }
#define QROW(e) (nxt.Q + (size_t)(wid * QBLK + r32) * D + ((e) >> 1) * 16 + hi * 8 + ((e) & 1) * 4)
    if constexpr (F32) { SLOAD_F((const float*)nxt.K, kbn); SBAR();
#pragma unroll
        for (int e = 0; e < 8; ++e) S.tq[e] = *(const f32x4*)QROW(e); }
    else { SLOAD_H(nxt.K, nxt.V, nxt.CK, kbn, 0); SBAR();
#pragma unroll
        for (int d0 = 0; d0 < 8; ++d0) S.qr[d0] = load8<TIn>(nxt.Q + ((wid * QBLK + r32) * D + hi * 8) + d0 * 16); }
    SBAR();
    finishSM(pA0, pA1, alA, l_reg, pa0, pa1, pa2, pa3); SBAR();
    if constexpr (F32) {
#pragma unroll
        for (int e = 8; e < 16; ++e) S.tq[e] = *(const f32x4*)QROW(e); SBAR(); }
#undef QROW
    pv_tile<0, SK>(o, vb0, pa0, pa1, pa2, pa3, ACT(even ? NT - 2 : NT - 1));
    if (even) { MASKT(pB0, pB1, NT - 1); partialSM(pB0, pB1, m_reg, mnB, alB); __syncthreads(); RESC(alB);
        finishSM(pB0, pB1, alB, l_reg, pa0, pa1, pa2, pa3); SBAR(); pv_tile<1, SK>(o, vb0, pa0, pa1, pa2, pa3, ACT(NT - 1)); }
    SBAR(); SEAM_K0();
    if (hi == 0) li_l[r32] = l_reg; asm volatile("s_waitcnt lgkmcnt(0)" ::: "memory");
    float rli[16];
#pragma unroll
    for (int r = 0; r < 16; ++r) rli[r] = __builtin_amdgcn_rcpf(li_l[crow(r, hi)]);
    int oo = (wid * QBLK + 4 * hi) * OSTR + r32;
#pragma unroll
    for (int r = 0; r < 16; ++r) {
        asm volatile("" : "+v"(oo));
#pragma unroll
        for (int d0 = 0; d0 < 4; ++d0) { const float v = o[d0][r] * rli[r];
            if constexpr (same_t<TOut, float>::v) { cur.O[oo + d0 * 32] = v; }
            else { const float vn = __shfl_xor(v, 1);
                   if ((r32 & 1) == 0) *(unsigned*)(cur.O + (oo + d0 * 32)) = cvtpk(v, vn); } }
        oo += ((r & 3) == 3) ? 5 * OSTR : OSTR; }
    if constexpr (F32) {
#pragma unroll
        for (int d0 = 0; d0 < 8; ++d0) S.qr[d0] = pack8(S.tq[2 * d0], S.tq[2 * d0 + 1]); }
    __syncthreads();
#undef RESC
#undef KBASE
#undef ACT
#undef MASKT
#undef SEAM_K0
#undef HALF_STEP
}
#undef ROW
#undef VMW
#undef VMWN
#undef SLOAD_H
#undef SWRITE_HK
#undef SWRITE_HV
#undef SWRITE_H
#undef SLOAD_F
#undef SWRITE_KF
#undef SWRITE_VF
}
#define GAS __attribute__((address_space(1)))
#define LAS __attribute__((address_space(3)))
typedef unsigned short bf16;
typedef unsigned v4u __attribute__((ext_vector_type(4)));
typedef float f32x4 __attribute__((ext_vector_type(4)));
typedef short bf16x8 __attribute__((ext_vector_type(8)));
typedef GAS unsigned gu32;
typedef GAS unsigned long long gu64;
#define RLX_AGENT __ATOMIC_RELAXED, __HIP_MEMORY_SCOPE_AGENT
#define LDS_WAIT() asm volatile("s_waitcnt lgkmcnt(0)" ::: "memory")
#define VM_WAIT() asm volatile("s_waitcnt vmcnt(0)" ::: "memory")
__device__ __forceinline__ unsigned long long rt() { return __builtin_amdgcn_s_memrealtime(); }
__device__ __forceinline__ unsigned f2bf(float f) { unsigned u = __builtin_bit_cast(unsigned, f); return (u + 0x7fffu + ((u >> 16) & 1u)) >> 16; }
__device__ __forceinline__ unsigned pk2(float lo, float hi) { return f2bf(lo) | (f2bf(hi) << 16); }

#define XB_TMO      128
#define XB_XCNT(j)  (256  + 64 * (j))
#define XB_XSUB(j)  (1280 + 64 * (j))
#define XB_XGEN(j)  (2304 + 64 * (j))
#define XB_TOP      3328
#define XB_TOPGEN   3392
#define XCD_BAR_WORDS 3456
#define XB_SPIN_CAP (1u << 18)

__device__ __forceinline__ unsigned xb_ld(unsigned* p)              { return __hip_atomic_load(p, __ATOMIC_RELAXED, __HIP_MEMORY_SCOPE_AGENT); }
__device__ __forceinline__ unsigned xb_add(unsigned* p, unsigned v) { return __hip_atomic_fetch_add(p, v, __ATOMIC_RELAXED, __HIP_MEMORY_SCOPE_AGENT); }
__device__ __forceinline__ unsigned xb_xcc_id() { return (unsigned)__builtin_amdgcn_s_getreg((3 << 11) | 20) & 0xFu; }
#define XB_SPIN(cond, bar) do { unsigned _sp = 0; while (cond) { __builtin_amdgcn_s_sleep(1); \
    if ((++_sp & 255u) == 0u) { if (xb_ld(&(bar)[XB_TMO])) break; if (_sp > XB_SPIN_CAP) { atomicAdd(&(bar)[XB_TMO], 1u); break; } } } } while (0)

struct XcdBarrier {
    unsigned* bar; unsigned x;
    volatile LAS unsigned* st;
};

__device__ __forceinline__ XcdBarrier xcd_barrier_post(unsigned* bar, volatile LAS unsigned* st, bool t0) {
    XcdBarrier b; b.bar = bar; b.x = xb_xcc_id(); b.st = st;
    if (t0) (void)xb_add(&bar[XB_XCNT(b.x)], 1u);
    return b;
}
__device__ __forceinline__ void xcd_barrier_complete(unsigned* bar, unsigned x, unsigned& nloc, unsigned& nx) {
    const unsigned G = gridDim.x * gridDim.y * gridDim.z;
    unsigned sum, cnt, mine, sp = 0u;
    for (;;) {
        sum = 0u; cnt = 0u; mine = 0u;
#pragma unroll
        for (unsigned j = 0; j < 16; ++j) { const unsigned c = xb_ld(&bar[XB_XCNT(j)]); sum += c; cnt += (c > 0u) ? 1u : 0u; mine = (j == x) ? c : mine; }
        if (sum == G) break;
        __builtin_amdgcn_s_sleep(1);
        if ((++sp & 255u) == 0u) { if (xb_ld(&bar[XB_TMO])) break; if (sp > XB_SPIN_CAP) { atomicAdd(&bar[XB_TMO], 1u); break; } }
    }
    nloc = mine > 0u ? mine : 1u; nx = cnt > 0u ? cnt : 1u;
}

__device__ __forceinline__ void xcd_barrier(const XcdBarrier& b, bool t0) {
    asm volatile("s_waitcnt vmcnt(0)" ::: "memory");
    __syncthreads();
    if (t0) {
        unsigned* bar = b.bar;
        __builtin_amdgcn_s_waitcnt(0);
        unsigned nloc = b.st[0], nx = b.st[1];
        if (nloc == 0u) { xcd_barrier_complete(bar, b.x, nloc, nx); b.st[0] = nloc; b.st[1] = nx; }
        const unsigned old = xb_add(&bar[XB_XSUB(b.x)], 1u);
        const unsigned gen = old / nloc;
        if (old + 1u == (gen + 1u) * nloc) {
            __builtin_amdgcn_fence(__ATOMIC_RELEASE, "agent");
            asm volatile("s_waitcnt vmcnt(0)" ::: "memory");
            const unsigned og = xb_add(&bar[XB_TOP], 1u);
            const unsigned tg = og / nx;
            if (og + 1u == (tg + 1u) * nx) xb_add(&bar[XB_TOPGEN], 1u);
            else XB_SPIN(xb_ld(&bar[XB_TOPGEN]) == tg, bar);
            __builtin_amdgcn_fence(__ATOMIC_ACQUIRE, "agent");
            xb_add(&bar[XB_XGEN(b.x)], 1u);
            asm volatile("s_waitcnt vmcnt(0)" ::: "memory");
        } else {
            XB_SPIN(xb_ld(&bar[XB_XGEN(b.x)]) == gen, bar);
            __builtin_amdgcn_fence(__ATOMIC_ACQUIRE, "agent");
            asm volatile("s_waitcnt vmcnt(0)" ::: "memory");
        }
    }
    __syncthreads();
}
constexpr size_t O_YP = 0, O_YS = O_YP + (size_t)MPR * DM, O_KP = O_YS + (size_t)MSM * DM, O_VP = O_KP + (size_t)MPR * DATT, O_LFP = O_VP + (size_t)MPR * DATT,
                 O_HRP = O_LFP + (size_t)MPR * NH, O_HIP = O_HRP + (size_t)NB * NG * NST, O_KS = O_HIP + (size_t)NB * NG * NST, O_VS = O_KS + (size_t)MSM * DATT,
                 O_LFS = O_VS + (size_t)MSM * DATT, O_HRS = O_LFS + (size_t)MSM * NH, O_HIS = O_HRS + (size_t)DBT * NG * NST, O_END = O_HIS + (size_t)DBT * NG * NST;
static_assert(O_END == 33833216, "output size");

constexpr size_t al256(size_t x) { return (x + 255) & ~(size_t)255; }
constexpr size_t WS_CTL = 0, CTL_ZERO_BYTES = 64u << 10;
constexpr size_t WS_W1T  = 1u << 20;
constexpr size_t WS_WGLU = WS_W1T  + (size_t)8192 * 2048 * 2;
constexpr size_t WS_WBR  = WS_WGLU + (size_t)1024 * 1024 * 2;
constexpr size_t WS_WOUT = WS_WBR  + (size_t)2048 * 2048 * 2;
constexpr size_t WS_WFF1 = WS_WOUT + (size_t)2048 * 2048 * 2;
constexpr size_t WS_WFF2 = WS_WFF1 + (size_t)11264 * 2048 * 2;
constexpr size_t WS_XA   = WS_WFF2 + (size_t)2048 * 5632 * 2;
constexpr size_t WS_R1   = WS_XA   + (size_t)MPAD * 2048 * 2;
constexpr size_t WS_Z    = al256(WS_R1 + (size_t)MPAD * 4);
constexpr size_t WS_G    = WS_Z    + (size_t)MPAD * 4096 * 4;
constexpr size_t WS_YP   = WS_G    + (size_t)MPAD * 4096 * 2;
constexpr size_t WS_YY   = WS_YP   + (size_t)MPAD * 1024 * 2;
constexpr size_t WS_T1   = WS_YY   + (size_t)MPAD * 2048 * 2;
constexpr size_t WS_MG   = WS_T1   + (size_t)MPAD * 2048 * 4;
constexpr size_t WS_X1   = WS_MG   + (size_t)MPAD * 2048 * 2;
constexpr size_t WS_XB   = WS_X1   + (size_t)MPAD * 2048 * 4;
constexpr size_t WS_SS   = WS_XB   + (size_t)MPAD * 2048 * 2;
constexpr size_t WS_H    = WS_SS   + (size_t)MPAD * 32 * 4;
constexpr size_t WS_QB   = WS_H    + (size_t)MPAD * DFF * 2;
constexpr size_t WS_KB   = WS_QB   + (size_t)MPR * 1024 * 2;
constexpr size_t WS_VB   = WS_KB   + (size_t)MPR * 1024 * 2;
constexpr size_t WS_NCK  = WS_VB   + (size_t)MPR * 1024 * 2;
constexpr size_t WS_QS   = WS_NCK  + (size_t)NB * NH * SEQ * 16 * 2;
constexpr size_t WS_AB   = WS_QS   + (size_t)DBT * NH * DSQ * HD * 4;
constexpr size_t WS_AT   = WS_AB   + (size_t)NG * NST * 2 * 4;
constexpr size_t WS_BBR  = WS_AT   + (size_t)NG * NST * 2 * 4;
constexpr size_t WS_BBI  = WS_BBR  + (size_t)NG * NST * GC * 4;
constexpr size_t WS_E    = WS_BBI  + (size_t)NG * NST * GC * 4;
constexpr size_t WS_PW   = WS_E    + (size_t)NG * 512 * 128 * 4;
constexpr size_t WS_M3   = al256(WS_PW + (size_t)NG * 17 * NST * 2 * 4);
constexpr size_t WS_M2   = WS_M3   + (size_t)NG * 128 * 256 * 2;
constexpr size_t WS_KT   = WS_M2   + (size_t)NG * 256 * 128 * 2;
constexpr size_t WS_UB   = WS_KT   + (size_t)NG * 16 * 256 * 2;
constexpr size_t WS_AG   = WS_UB   + (size_t)NG * 512 * 256 * 2;
constexpr size_t WS_RP   = WS_AG   + (size_t)NG * 16 * 128 * 4;
constexpr size_t WS_TPG  = WS_RP   + (size_t)DBT * NH * PAST * 4;
constexpr size_t WS_PML  = WS_TPG  + (size_t)DBT * NH * NPAGES * 4;
constexpr size_t WS_PO   = WS_PML  + (size_t)256 * 64 * 2 * 4;
constexpr size_t WS_SS2  = WS_PO   + (size_t)256 * 64 * 128 * 4;
constexpr size_t WS_SSR  = WS_SS2  + (size_t)32 * 64 * 4;
constexpr size_t WS_LIST = al256(WS_SSR + (size_t)MPAD * 4);
constexpr size_t WS_XF   = al256(WS_LIST + (size_t)(256 + 2048 + 64) * 4);
constexpr size_t WS_JLO  = WS_XF   + (size_t)NB * NH * SEQ * 4;
constexpr size_t WS_END  = WS_JLO  + (size_t)256 * 4;
constexpr int CW_Q = 8192;
constexpr int CW_BAR = 4096;

constexpr int LDS_BYTES = 147456;
constexpr int MISC_OFF = LDS_BYTES - 512;
constexpr int NWAVES = 8;
struct Args { const void* in[30]; float* out; unsigned char* ws; int ph_lo, ph_hi, probe, pad; };
struct Frame {
    unsigned char* lds;
    int tid, lane, wave, G, gw, NGW;
    float* out; unsigned char* ws;
};
template <int OFF> __device__ __forceinline__ unsigned long long karg_load() {
    unsigned long long v; auto kp = __builtin_amdgcn_kernarg_segment_ptr();
    asm volatile("s_load_dwordx2 %0, %1, %2\n\ts_waitcnt lgkmcnt(0)" : "=s"(v) : "s"(kp), "n"(OFF) : "memory"); return v; }
#define INP(T, i) ((const T*)(const __attribute__((address_space(1))) T*)karg_load<8 * (i)>())
enum { I_XP = 0, I_XS, I_CK, I_CV, I_CLF, I_SRE, I_SIM, I_PT, I_G1, I_WIN, I_BF, I_GQ, I_GK, I_ARE, I_AIM, I_LDT, I_BRE, I_BIM, I_CRE, I_CIM, I_DSSM, I_WGLU, I_BGLU, I_WBRS, I_WBRA, I_WOUT, I_G2, I_WFG, I_WFU, I_WFD };
#define WSP(T, off) ((T*)(F.ws + (off)))

__device__ __forceinline__ float wave_sum(float v) {
#pragma unroll
    for (int o = 1; o < 64; o <<= 1) v += __shfl_xor(v, o);
    return v;
}
__device__ __forceinline__ unsigned cvtpk(float lo, float hi) { unsigned r; asm volatile("v_cvt_pk_bf16_f32 %0, %1, %2" : "=v"(r) : "v"(lo), "v"(hi)); return r; }

__device__ __forceinline__ void sincos_d(double x, double& s, double& c) {
    const double k = __builtin_rint(x * 0.63661977236758134308);
    double r = __builtin_fma(-k, 1.57079632679489655800e+00, x); r = __builtin_fma(-k, 6.12323399573676603587e-17, r);
    const long long q = (long long)k; const double r2 = r * r;
    double sp = -1.0 / 1307674368000.0; sp = sp * r2 + 1.0 / 6227020800.0; sp = sp * r2 - 1.0 / 39916800.0; sp = sp * r2 + 1.0 / 362880.0; sp = sp * r2 - 1.0 / 5040.0; sp = sp * r2 + 1.0 / 120.0; sp = sp * r2 - 1.0 / 6.0; sp = sp * r2 + 1.0; sp *= r;
    double cp = 1.0 / 20922789888000.0; cp = cp * r2 - 1.0 / 87178291200.0; cp = cp * r2 + 1.0 / 479001600.0; cp = cp * r2 - 1.0 / 3628800.0; cp = cp * r2 + 1.0 / 40320.0; cp = cp * r2 - 1.0 / 720.0; cp = cp * r2 + 1.0 / 24.0; cp = cp * r2 - 0.5; cp = cp * r2 + 1.0;
    const int qq = (int)(q & 3);
    s = (qq == 0) ? sp : (qq == 1) ? cp : (qq == 2) ? -sp : -cp;
    c = (qq == 0) ? cp : (qq == 1) ? -sp : (qq == 2) ? -cp : sp;
}
__device__ __forceinline__ double exp_d(double x) {
    const double k = __builtin_rint(x * 1.44269504088896338700e+00);
    double r = __builtin_fma(-k, 6.93147180369123816490e-01, x); r = __builtin_fma(-k, 1.90821492927058770002e-10, r);
    double p = 1.0 / 6227020800.0; p = p * r + 1.0 / 479001600.0; p = p * r + 1.0 / 39916800.0; p = p * r + 1.0 / 3628800.0; p = p * r + 1.0 / 362880.0; p = p * r + 1.0 / 40320.0; p = p * r + 1.0 / 5040.0;
    p = p * r + 1.0 / 720.0; p = p * r + 1.0 / 120.0; p = p * r + 1.0 / 24.0; p = p * r + 1.0 / 6.0; p = p * r + 0.5; p = p * r + 1.0; p = p * r + 1.0;
    int ki = (int)k; if (ki < -1000) return 0.0;
    return __builtin_ldexp(p, ki);
}

constexpr int WI_IN = 32 * 8, WI_GLU = 16 * 2, WI_BR = 16 * 4, WI_OUT = 32 * 4, WI_FF1 = 32 * 11, WI_FF2 = 88 * 4;
constexpr int WI_GLU0 = 2 * WI_IN, WI_BR0 = WI_GLU0 + WI_GLU, WI_OUT0 = WI_BR0 + 2 * WI_BR, WI_FF10 = WI_OUT0 + WI_OUT, WI_FF20 = WI_FF10 + 2 * WI_FF1, WI_END = WI_FF20 + WI_FF2;
struct WItem { const float* src; bf16* dst; const float* gs; int ldw, ldd, ilv; };
__device__ __forceinline__ void weight_copies(Frame& F, int it_lo, int it_hi, int bi, int nb, int prb = 0) {
    const float* const g1 = INP(float, I_G1); const float* const w_in = INP(float, I_WIN);
    const float* const w_glu = INP(float, I_WGLU); const float* const w_brs = INP(float, I_WBRS); const float* const w_bra = INP(float, I_WBRA); const float* const w_out = INP(float, I_WOUT);
    const float* const g2 = INP(float, I_G2); const float* const w_fg = INP(float, I_WFG); const float* const w_fu = INP(float, I_WFU); const float* const w_fd = INP(float, I_WFD);
    int drow0 = 0, n0g = 0;
    auto decode = [&](int it, WItem& t) { int r = it;
#define WC_SET(W_, ldw_, scol_, WT_, ldd_, drow_, k0_, dk0_, gs_, ilv_) do { t.src = (W_) + (size_t)(k0_) * (ldw_) + (scol_); t.dst = (WT_) + (dk0_) + (k0_); t.gs = (gs_) ? (gs_) + (k0_) : nullptr; t.ldw = (ldw_); t.ldd = (ldd_); t.ilv = (ilv_); drow0 = (drow_); n0g = (scol_); } while (0)
        if (r < 2 * WI_IN) { const int part = r / WI_IN; r -= part * WI_IN; const int kb = r / 8, nbk = r % 8; WC_SET(w_in, NIN, (part ? 4104 : 0) + 512 * nbk, WSP(bf16, WS_W1T), 2048, part * 4096 + 512 * nbk, 64 * kb, 0, g1, -1); return; } r -= 2 * WI_IN;
        if (r < WI_GLU) { const int kb = r / 2, nbk = r % 2; WC_SET(w_glu, 1024, 512 * nbk, WSP(bf16, WS_WGLU), 1024, 512 * nbk, 64 * kb, 0, (const float*)nullptr, -1); return; } r -= WI_GLU;
        if (r < 2 * WI_BR) { const int part = r / WI_BR; r -= part * WI_BR; const int kb = r / 4, nbk = r % 4; WC_SET(part ? w_bra : w_brs, 2048, 512 * nbk, WSP(bf16, WS_WBR), 2048, 512 * nbk, 64 * kb, part * 1024, (const float*)nullptr, -1); return; } r -= 2 * WI_BR;
        if (r < WI_OUT) { const int kb = r / 4, nbk = r % 4; WC_SET(w_out, 2048, 512 * nbk, WSP(bf16, WS_WOUT), 2048, 512 * nbk, 64 * kb, 0, (const float*)nullptr, -1); return; } r -= WI_OUT;
        if (r < 2 * WI_FF1) { const int part = r / WI_FF1; r -= part * WI_FF1; const int kb = r / 11, nbk = r % 11; WC_SET(part ? w_fu : w_fg, DFF, 512 * nbk, WSP(bf16, WS_WFF1), 2048, 0, 64 * kb, 0, g2, part); return; } r -= 2 * WI_FF1;
        { const int kb = r / 4, nbk = r % 4; WC_SET(w_fd, 2048, 512 * nbk, WSP(bf16, WS_WFF2), DFF, 512 * nbk, 64 * kb, 0, (const float*)nullptr, -1); }
#undef WC_SET
    };
    float* T = (float*)F.lds;
    f32x4 nx[16]; WItem tn; int it = it_lo + bi;
#define WC_LOAD() do { _Pragma("unroll") for (int i = 0; i < 16; ++i) nx[i] = *(const f32x4*)(tn.src + (size_t)(8 * F.wave + (i >> 1)) * tn.ldw + 256 * (i & 1) + 4 * F.lane); } while (0)
    if (it < it_hi) { decode(it, tn); WC_LOAD(); }
    for (; it < it_hi; it += nb) { const WItem t = tn; const int dr0 = drow0, n0 = n0g;
        __syncthreads();
#pragma unroll
        for (int i = 0; i < 16; ++i) { f32x4 v = nx[i]; if (t.gs) v = v * t.gs[8 * F.wave + (i >> 1)]; *(f32x4*)(T + (8 * F.wave + (i >> 1)) * 512 + 256 * (i & 1) + 4 * F.lane) = v; }
        if (it + nb < it_hi) { decode(it + nb, tn); WC_LOAD(); }
        __syncthreads();
        const int n = 64 * F.wave + F.lane, nsrc = n0 + n; const int row = t.ilv < 0 ? dr0 + n : 256 * (nsrc >> 7) + (nsrc & 127) + 128 * t.ilv;
        bf16* op = t.dst + (size_t)row * t.ldd; const float* tc = T + n;
#pragma unroll
        for (int c = 0; c < 8; ++c) { v4u o; o.x = cvtpk(tc[(8 * c) * 512], tc[(8 * c + 1) * 512]); o.y = cvtpk(tc[(8 * c + 2) * 512], tc[(8 * c + 3) * 512]); o.z = cvtpk(tc[(8 * c + 4) * 512], tc[(8 * c + 5) * 512]); o.w = cvtpk(tc[(8 * c + 6) * 512], tc[(8 * c + 7) * 512]);
            if (!(prb & 32) || o.x == 0x12345678u) *(v4u*)(op + 8 * c) = o; } }
#undef WC_LOAD
    __syncthreads();
}
__device__ __forceinline__ void phase0(Frame& F, int prb) {
    const float* const g1 = INP(float, I_G1); const float* const w_in = INP(float, I_WIN);
    float* WF = (float*)F.lds;
    for (int k = F.tid; k < DM; k += NWAVES * 64) { const float g = g1[k]; const float* wp = w_in + (size_t)k * NIN + 4096; const f32x4 a = *(const f32x4*)wp, b = *(const f32x4*)(wp + 4);
        WF[0 * DM + k] = g * a[0]; WF[1 * DM + k] = g * a[1]; WF[2 * DM + k] = g * a[2]; WF[3 * DM + k] = g * a[3];
        WF[4 * DM + k] = g * b[0]; WF[5 * DM + k] = g * b[1]; WF[6 * DM + k] = g * b[2]; WF[7 * DM + k] = g * b[3]; }
    __syncthreads();
    bf16* XA = WSP(bf16, WS_XA); float* R1 = WSP(float, WS_R1); const float* const xp = INP(float, I_XP); const float* const xs = INP(float, I_XS); const float* const b_f = INP(float, I_BF);
    if (!(prb & 64)) for (int m = MR + F.gw; m < MPAD; m += F.NGW) { unsigned long long* o8 = (unsigned long long*)(XA + (size_t)m * DM) + F.lane;
#pragma unroll
        for (int j = 0; j < 8; ++j) o8[64 * j] = 0ull;
        if (F.lane == 0) R1[m] = 0.f; }
    {
#define P0_ROWPTR(m_) ((const f32x4*)((m_) < MPR ? xp + (size_t)(m_) * DM : xs + (size_t)((m_) - MPR) * DM) + F.lane)
        f32x4 nx[8]; int m = (prb & 64) ? MR : F.gw;
        if (m < MR) { const f32x4* xr = P0_ROWPTR(m);
#pragma unroll
            for (int j = 0; j < 8; ++j) nx[j] = xr[64 * j]; }
        for (; m < MR; m += F.NGW) {
            f32x4 v[8];
#pragma unroll
            for (int j = 0; j < 8; ++j) v[j] = nx[j];
            const int mn = m + F.NGW;
            if (mn < MR) { const f32x4* xr = P0_ROWPTR(mn);
#pragma unroll
                for (int j = 0; j < 8; ++j) nx[j] = xr[64 * j]; }
            float ss = 0.f;
#pragma unroll
            for (int j = 0; j < 8; ++j) ss += (v[j][0] * v[j][0] + v[j][1] * v[j][1]) + (v[j][2] * v[j][2] + v[j][3] * v[j][3]);
            unsigned long long* o8 = (unsigned long long*)(XA + (size_t)m * DM) + F.lane;
#pragma unroll
            for (int j = 0; j < 8; ++j) o8[64 * j] = (unsigned long long)cvtpk(v[j][0], v[j][1]) | ((unsigned long long)cvtpk(v[j][2], v[j][3]) << 32);
            float a[8];
#pragma unroll
            for (int h = 0; h < 8; ++h) { float t = 0.f;
#pragma unroll
                for (int j = 0; j < 8; ++j) { const f32x4 w = *(const f32x4*)(WF + h * DM + 256 * j + 4 * F.lane); t += (v[j][0] * w[0] + v[j][1] * w[1]) + (v[j][2] * w[2] + v[j][3] * w[3]); }
                a[h] = t; }
            const bool b5 = (F.lane & 32) != 0, b4 = (F.lane & 16) != 0, b3 = (F.lane & 8) != 0; float w4[4], w2[2];
#pragma unroll
            for (int i = 0; i < 4; ++i) { const float snd = b5 ? a[i] : a[i + 4], kp = b5 ? a[i + 4] : a[i]; w4[i] = kp + __shfl_xor(snd, 32); }
#pragma unroll
            for (int i = 0; i < 2; ++i) { const float snd = b4 ? w4[i] : w4[i + 2], kp = b4 ? w4[i + 2] : w4[i]; w2[i] = kp + __shfl_xor(snd, 16); }
            float fl; { const float snd = b3 ? w2[0] : w2[1], kp = b3 ? w2[1] : w2[0]; fl = kp + __shfl_xor(snd, 8); }
            fl += __shfl_xor(fl, 1); fl += __shfl_xor(fl, 2); fl += __shfl_xor(fl, 4);
            ss = wave_sum(ss);
            const float r1 = 1.0f / sqrtf(ss * (1.0f / DM) + RMS_EPS);
            if (F.lane == 0) R1[m] = r1;
            if ((F.lane & 7) == 0) { const int h = ((F.lane >> 5) & 1) * 4 + ((F.lane >> 4) & 1) * 2 + ((F.lane >> 3) & 1); const float z = fl * r1 + b_f[h]; const float lf = fminf(z, 0.f) - log1pf(expf(-fabsf(z)));
                if (m < MPR) F.out[O_LFP + (size_t)m * NH + h] = lf; else F.out[O_LFS + (size_t)(m - MPR) * NH + h] = lf; }
        }
#undef P0_ROWPTR
    }
    for (int i = F.gw * 64 + F.lane; i < MPAD; i += F.NGW * 64) WSP(float, WS_SSR)[i] = 0.f;
    { const float* const ldt = INP(float, I_LDT); const float* const a_re = INP(float, I_ARE); const float* const a_im = INP(float, I_AIM); const float* const b_re = INP(float, I_BRE); const float* const b_im = INP(float, I_BIM);
    for (int g = F.gw; g < NG; g += F.NGW) { const int p = F.lane, gp = g * NST + p;
        const double dt = exp_d((double)ldt[g]), are = (double)a_re[gp], aim = (double)a_im[gp];
        double sn, cs; sincos_d(dt * aim, sn, cs); const double mag = exp_d(dt * are); const double abr = mag * cs, abi = mag * sn;
        float* AB = WSP(float, WS_AB); AB[2 * gp] = (float)abr; AB[2 * gp + 1] = (float)abi;
        { float* PW = WSP(float, WS_PW) + (size_t)g * 17 * NST * 2 + 2 * p; double pr = 1.0, pi = 0.0;
#pragma unroll 1
          for (int tau = 0; tau <= 16; ++tau) { PW[tau * NST * 2] = (float)pr; PW[tau * NST * 2 + 1] = (float)pi; const double nr = pr * abr - pi * abi, ni = pr * abi + pi * abr; pr = nr; pi = ni; } }
        const double er = abr - 1.0, ei = abi, inv = 1.0 / (are * are + aim * aim), fr = (er * are + ei * aim) * inv, fi = (ei * are - er * aim) * inv;
        float* BBR = WSP(float, WS_BBR) + (size_t)gp * GC; float* BBI = WSP(float, WS_BBI) + (size_t)gp * GC;
#pragma unroll
        for (int c = 0; c < GC; ++c) { const double br = (double)b_re[(size_t)gp * GC + c], bi = (double)b_im[(size_t)gp * GC + c]; BBR[c] = (float)(fr * br - fi * bi); BBI[c] = (float)(fr * bi + fi * br); }
    } }
    { const int* const pt = INP(int, I_PT); const float* const clf = INP(float, I_CLF);
    for (int it = F.gw; it < DBT * NPAGES; it += F.NGW) { const int b = it >> 7, j = it & 127, phys = pt[it]; const int seg = F.lane >> 3, h = F.lane & 7;
        const float* lp = clf + ((size_t)phys * PAGE + 16 * seg) * NH + h; float v[16];
#pragma unroll
        for (int i = 0; i < 16; ++i) v[i] = lp[i * NH];
        float s[16]; float run = 0.f;
#pragma unroll
        for (int i = 15; i >= 0; --i) { s[i] = run; run += v[i]; }
        float off = 0.f;
#pragma unroll
        for (int d = 1; d < 8; ++d) { const float t = __shfl(run, (F.lane + 8 * d) & 63); if (seg + d < 8) off += t; }
        float* rp = WSP(float, WS_RP) + ((size_t)(b * NH + h) * PAST) + j * PAGE + 16 * seg;
#pragma unroll
        for (int i = 0; i < 16; ++i) rp[i] = s[i] + off;
        if (seg == 0) WSP(float, WS_TPG)[(b * NH + h) * NPAGES + j] = off + run; } }
    __syncthreads();
    weight_copies(F, 0, WI_BR0, (int)blockIdx.x, F.G, prb);
}
__device__ __forceinline__ void rowpass(Frame& F) {
    const int h = F.lane >> 3, sub = F.lane & 7, off = h * HD + sub * 16;
    float gq[16], gk[16]; { const float* const gqp = INP(float, I_GQ); const float* const gkp = INP(float, I_GK);
#pragma unroll
    for (int i = 0; i < 16; ++i) { gq[i] = gqp[sub * 16 + i]; gk[i] = gkp[sub * 16 + i]; } }
    const float* Z = WSP(float, WS_Z);
    for (int m = MPR + F.gw; m < MR; m += F.NGW) {
        const float* z = Z + (size_t)m * 4096 + off; float q[16], k[16], v[16];
#pragma unroll
        for (int i = 0; i < 4; ++i) { const f32x4 a = *(const f32x4*)(z + 1024 + 4 * i), b = *(const f32x4*)(z + 2048 + 4 * i), c = *(const f32x4*)(z + 3072 + 4 * i);
#pragma unroll
            for (int e = 0; e < 4; ++e) { q[4 * i + e] = a[e]; k[4 * i + e] = b[e]; v[4 * i + e] = c[e]; } }
        float sq = 0.f, sk = 0.f;
#pragma unroll
        for (int i = 0; i < 16; ++i) { sq += q[i] * q[i]; sk += k[i] * k[i]; }
        sq += __shfl_xor(sq, 1); sq += __shfl_xor(sq, 2); sq += __shfl_xor(sq, 4); sk += __shfl_xor(sk, 1); sk += __shfl_xor(sk, 2); sk += __shfl_xor(sk, 4);
        const float rq = 1.0f / sqrtf(sq * (1.0f / HD) + RMS_EPS), rk = 1.0f / sqrtf(sk * (1.0f / HD) + RMS_EPS);
#pragma unroll
        for (int i = 0; i < 16; ++i) { q[i] = q[i] * rq * gq[i]; k[i] = k[i] * rk * gk[i]; }
        float* ko; float* vo;
        if (m < MPR) { const int b = m >> 12, s = m & (SEQ - 1); const size_t ao = ((size_t)(b * NH + h) * SEQ + s) * HD + sub * 16;
            v4u w;
            w.x = cvtpk(q[0], q[1]); w.y = cvtpk(q[2], q[3]); w.z = cvtpk(q[4], q[5]); w.w = cvtpk(q[6], q[7]); *(v4u*)(WSP(bf16, WS_QB) + ao) = w;
            w.x = cvtpk(q[8], q[9]); w.y = cvtpk(q[10], q[11]); w.z = cvtpk(q[12], q[13]); w.w = cvtpk(q[14], q[15]); *(v4u*)(WSP(bf16, WS_QB) + ao + 8) = w;
            w.x = cvtpk(k[0], k[1]); w.y = cvtpk(k[2], k[3]); w.z = cvtpk(k[4], k[5]); w.w = cvtpk(k[6], k[7]); *(v4u*)(WSP(bf16, WS_KB) + ao) = w;
            w.x = cvtpk(k[8], k[9]); w.y = cvtpk(k[10], k[11]); w.z = cvtpk(k[12], k[13]); w.w = cvtpk(k[14], k[15]); *(v4u*)(WSP(bf16, WS_KB) + ao + 8) = w;
            w.x = cvtpk(v[0], v[1]); w.y = cvtpk(v[2], v[3]); w.z = cvtpk(v[4], v[5]); w.w = cvtpk(v[6], v[7]); *(v4u*)(WSP(bf16, WS_VB) + ao) = w;
            w.x = cvtpk(v[8], v[9]); w.y = cvtpk(v[10], v[11]); w.z = cvtpk(v[12], v[13]); w.w = cvtpk(v[14], v[15]); *(v4u*)(WSP(bf16, WS_VB) + ao + 8) = w;
            ko = F.out + O_KP + (size_t)m * DATT + off; vo = F.out + O_VP + (size_t)m * DATT + off;
        } else { const int ms = m - MPR, b = ms >> 2, t = ms & 3; float* qs = WSP(float, WS_QS) + ((size_t)((b * NH + h) * DSQ + t)) * HD + sub * 16;
#pragma unroll
            for (int i = 0; i < 4; ++i) *(f32x4*)(qs + 4 * i) = (f32x4){q[4 * i], q[4 * i + 1], q[4 * i + 2], q[4 * i + 3]};
            ko = F.out + O_KS + (size_t)ms * DATT + off; vo = F.out + O_VS + (size_t)ms * DATT + off; }
#pragma unroll
        for (int i = 0; i < 4; ++i) { *(f32x4*)(ko + 4 * i) = (f32x4){k[4 * i], k[4 * i + 1], k[4 * i + 2], k[4 * i + 3]}; *(f32x4*)(vo + 4 * i) = (f32x4){v[4 * i], v[4 * i + 1], v[4 * i + 2], v[4 * i + 3]}; }
    }
}
__device__ __forceinline__ void logf_cumsum(Frame& F, int it) {
    const float* const gqp = INP(float, I_GQ); const float* const gkp = INP(float, I_GK);
    const int b = it >> 3, h = it & 7, pos0 = 512 * F.wave + 8 * F.lane;
    const float* lf = F.out + O_LFP + ((size_t)b * SEQ + pos0) * NH + h; bf16* o = WSP(bf16, WS_NCK) + ((size_t)it * SEQ + pos0) * 16; float* xf = WSP(float, WS_XF) + (size_t)it * SEQ + pos0;
    double* WT = (double*)F.lds; float* TG = (float*)(F.lds + 128); int* CN = (int*)(F.lds + 256);
    float v[8];
#pragma unroll
    for (int i = 0; i < 8; ++i) v[i] = lf[(size_t)i * NH];
    double tot = 0.0;
#pragma unroll
    for (int i = 0; i < 8; ++i) tot += (double)v[i];
    double ex = tot;
#pragma unroll
    for (int d = 1; d < 64; d <<= 1) { const double t = __shfl_up(ex, d); if (F.lane >= d) ex += t; }
    if (F.lane == 63) WT[F.wave] = ex;
    if (F.tid < 16) CN[F.tid] = 0;
    __syncthreads();
    double run = ex - tot;
    for (int w = 0; w < F.wave; ++w) run += WT[w];
    float xs_[8];
#pragma unroll
    for (int i = 0; i < 8; ++i) { run += (double)v[i];
        const float x = (float)(-run * 11.313708498984761);
        xs_[i] = x; xf[i] = x;
        const unsigned h16 = cvtpk(x, 0.f) & 0xffffu; const float r1 = x - __uint_as_float(h16 << 16); const unsigned m16 = cvtpk(r1, 0.f) & 0xffffu; const float r2 = r1 - __uint_as_float(m16 << 16); const unsigned l16 = cvtpk(r2, 0.f) & 0xffffu;
        v4u w; w.x = h16 | (m16 << 16); w.y = l16; w.z = 0u; w.w = 0u; *(v4u*)(o + (size_t)i * 16) = w; *(v4u*)(o + (size_t)i * 16 + 8) = (v4u){0u, 0u, 0u, 0u}; }
    if ((F.lane & 31) == 0) TG[2 * F.wave + (F.lane >> 5)] = xs_[0];
    __syncthreads();
    { float mq = fmaxf(fabsf(gqp[F.lane]), fabsf(gqp[F.lane + 64])), mk = fmaxf(fabsf(gkp[F.lane]), fabsf(gkp[F.lane + 64]));
#pragma unroll
      for (int od = 1; od < 64; od <<= 1) { mq = fmaxf(mq, __shfl_xor(mq, od)); mk = fmaxf(mk, __shfl_xor(mk, od)); }
      const float bq2 = 11.313708498984761f * 1.4426950408889634f * mq * mk, thr = (2.f * bq2 + 40.f) * (1.0f / (1.4426950408889634f * 0.08838834764831845f));
#pragma unroll 4
      for (int qb = 0; qb < 16; ++qb) { const float tgt = TG[qb] - thr; int cnt = 0;
#pragma unroll
          for (int i = 0; i < 8; ++i) cnt += (xs_[i] < tgt) ? 1 : 0;
#pragma unroll
          for (int od = 1; od < 64; od <<= 1) cnt += __shfl_xor(cnt, od);
          if (F.lane == 0 && cnt) atomicAdd(CN + qb, cnt); } }
    __syncthreads();
    if (F.tid < 16) WSP(int, WS_JLO)[it * 16 + F.tid] = CN[F.tid] >> 6;
    __syncthreads();
}
__device__ __forceinline__ void rpast_fix(Frame& F) {
    for (int it = F.gw; it < DBT * NH * NPAGES; it += F.NGW) { const int bh = it >> 7, j = it & 127; const float* tp = WSP(float, WS_TPG) + bh * NPAGES;
        float a = (F.lane > j ? tp[F.lane] : 0.f) + (F.lane + 64 > j ? tp[F.lane + 64] : 0.f); a = wave_sum(a);
        float* rp = WSP(float, WS_RP) + (size_t)bh * PAST + j * PAGE; rp[F.lane] = (rp[F.lane] + a) * LOG2E; rp[F.lane + 64] = (rp[F.lane + 64] + a) * LOG2E; }
}

namespace s5 {
constexpr int HS_STRIDE = 132, US_F = 256, HS_F = 16 * HS_STRIDE, CS_F = 64 * 32, WLDS_F = US_F + HS_F + CS_F;
__device__ __forceinline__ float gelu_erf(float y) { return 0.5f * y * (1.0f + erff(y * 0.70710678118654752440f)); }
template <int MODE>
__device__ __forceinline__ void unit(const float* U, int T, float& hre, float& him, const float* bbr, const float* bbi, float are, float aim, float* wl, int lane, bf16* YPr, const float* dv) {
    float br[16], bi[16];
#pragma unroll
    for (int i = 0; i < 4; ++i) { const f32x4 a = *(const f32x4*)(bbr + 4 * i), b = *(const f32x4*)(bbi + 4 * i);
#pragma unroll
        for (int e = 0; e < 4; ++e) { br[4 * i + e] = a[e]; bi[4 * i + e] = b[e]; } }
    float* Us = wl; float* Hs = wl + US_F; const float* Cs = wl + US_F + HS_F;
    for (int t0 = 0; t0 < T; t0 += 16) { const int nst = (T - t0) < 16 ? (T - t0) : 16;
        { const int row = lane >> 2, quad = lane & 3; f32x4 v = (f32x4){0.f, 0.f, 0.f, 0.f}; if (row < nst) v = *(const f32x4*)(U + (size_t)(t0 + row) * 4096 + quad * 4); *(f32x4*)(Us + row * 16 + quad * 4) = v; }
        LDS_WAIT(); asm volatile("" ::: "memory");
#pragma unroll 1
        for (int t = 0; t < nst; ++t) { float bur = 0.f, bui = 0.f;
#pragma unroll
            for (int i = 0; i < 4; ++i) { const f32x4 u = *(const f32x4*)(Us + t * 16 + 4 * i);
#pragma unroll
                for (int e = 0; e < 4; ++e) { bur = fmaf(br[4 * i + e], u[e], bur); bui = fmaf(bi[4 * i + e], u[e], bui); } }
            const float nre = fmaf(are, hre, fmaf(-aim, him, bur)), nim = fmaf(are, him, fmaf(aim, hre, bui)); hre = nre; him = nim;
            if (MODE == 1) { typedef float f32x2 __attribute__((ext_vector_type(2))); *(f32x2*)(Hs + t * HS_STRIDE + 2 * lane) = (f32x2){hre, him}; } }
        if (MODE == 1) { LDS_WAIT(); asm volatile("" ::: "memory");
            const int tl = lane >> 2, cq = lane & 3; float a0 = 0.f, a1 = 0.f, a2 = 0.f, a3 = 0.f;
#pragma unroll 4
            for (int pp = 0; pp < 32; ++pp) { const f32x4 h4 = *(const f32x4*)(Hs + tl * HS_STRIDE + 4 * pp);
                const f32x4 cA0 = *(const f32x4*)(Cs + (2 * pp) * 32 + cq * 8), cA1 = *(const f32x4*)(Cs + (2 * pp) * 32 + cq * 8 + 4);
                const f32x4 cB0 = *(const f32x4*)(Cs + (2 * pp + 1) * 32 + cq * 8), cB1 = *(const f32x4*)(Cs + (2 * pp + 1) * 32 + cq * 8 + 4);
                a0 += (cA0[0] * h4[0] - cA0[1] * h4[1]) + (cB0[0] * h4[2] - cB0[1] * h4[3]); a1 += (cA0[2] * h4[0] - cA0[3] * h4[1]) + (cB0[2] * h4[2] - cB0[3] * h4[3]);
                a2 += (cA1[0] * h4[0] - cA1[1] * h4[1]) + (cB1[0] * h4[2] - cB1[1] * h4[3]); a3 += (cA1[2] * h4[0] - cA1[3] * h4[1]) + (cB1[2] * h4[2] - cB1[3] * h4[3]); }
            if (tl < nst) { const f32x4 u = *(const f32x4*)(Us + tl * 16 + cq * 4), d = *(const f32x4*)(dv + cq * 4);
                const float y0 = gelu_erf(fmaf(d[0], u[0], a0)), y1 = gelu_erf(fmaf(d[1], u[1], a1)), y2 = gelu_erf(fmaf(d[2], u[2], a2)), y3 = gelu_erf(fmaf(d[3], u[3], a3));
                *(unsigned long long*)(YPr + (size_t)(t0 + tl) * 1024 + cq * 4) = (unsigned long long)cvtpk(y0, y1) | ((unsigned long long)cvtpk(y2, y3) << 32); }
            LDS_WAIT(); asm volatile("" ::: "memory"); }
    }
}
typedef float f32x16 __attribute__((ext_vector_type(16)));
__device__ __forceinline__ void gen_tables(Frame& F) {
    const float* PW = WSP(float, WS_PW); const float* BBR = WSP(float, WS_BBR); const float* BBI = WSP(float, WS_BBI);
    const float* const c_re = INP(float, I_CRE); const float* const c_im = INP(float, I_CIM); const float* const dssm = INP(float, I_DSSM);
    for (int it = F.gw; it < 3 * 1024; it += F.NGW) { const int kind = it >> 10, g = (it >> 4) & 63, x = it & 15, p = F.lane;
        if (kind == 0) {
            const float wr = PW[((size_t)(g * 17 + (15 - x)) * NST + p) * 2], wi = PW[((size_t)(g * 17 + (15 - x)) * NST + p) * 2 + 1]; float re[16], im[16];
#pragma unroll
            for (int i = 0; i < 4; ++i) { const f32x4 br = *(const f32x4*)(BBR + (size_t)(g * NST + p) * GC + 4 * i), bi = *(const f32x4*)(BBI + (size_t)(g * NST + p) * GC + 4 * i);
#pragma unroll
                for (int e = 0; e < 4; ++e) { re[4 * i + e] = wr * br[e] - wi * bi[e]; im[4 * i + e] = wr * bi[e] + wi * br[e]; } }
            bf16* o = WSP(bf16, WS_M3) + ((size_t)(g * 128 + p) * 256 + x * 16);
#pragma unroll
            for (int hf = 0; hf < 2; ++hf) { v4u w; w.x = cvtpk(re[8 * hf], re[8 * hf + 1]); w.y = cvtpk(re[8 * hf + 2], re[8 * hf + 3]); w.z = cvtpk(re[8 * hf + 4], re[8 * hf + 5]); w.w = cvtpk(re[8 * hf + 6], re[8 * hf + 7]); *(v4u*)(o + 8 * hf) = w;
                w.x = cvtpk(im[8 * hf], im[8 * hf + 1]); w.y = cvtpk(im[8 * hf + 2], im[8 * hf + 3]); w.z = cvtpk(im[8 * hf + 4], im[8 * hf + 5]); w.w = cvtpk(im[8 * hf + 6], im[8 * hf + 7]); *(v4u*)(o + (size_t)64 * 256 + 8 * hf) = w; }
        } else if (kind == 1) {
            const float wr = PW[((size_t)(g * 17 + x + 1) * NST + p) * 2], wi = PW[((size_t)(g * 17 + x + 1) * NST + p) * 2 + 1]; bf16* o = WSP(bf16, WS_M2) + (size_t)(g * 256 + x * 16) * 128 + p;
#pragma unroll 4
            for (int c = 0; c < GC; ++c) { const float cr = c_re[(size_t)(g * GC + c) * NST + p], ci = c_im[(size_t)(g * GC + c) * NST + p];
                o[(size_t)c * 128] = (bf16)(cvtpk(cr * wr - ci * wi, 0.f) & 0xffffu); o[(size_t)c * 128 + 64] = (bf16)(cvtpk(-(cr * wi + ci * wr), 0.f) & 0xffffu); }
        } else {
            const int c = F.lane >> 2, c4 = 4 * (F.lane & 3); float a0 = 0.f, a1 = 0.f, a2 = 0.f, a3 = 0.f;
#pragma unroll 4
            for (int pp = 0; pp < NST; ++pp) { const float wr = PW[((size_t)(g * 17 + x) * NST + pp) * 2], wi = PW[((size_t)(g * 17 + x) * NST + pp) * 2 + 1];
                const float cr = c_re[(size_t)(g * GC + c) * NST + pp], ci = c_im[(size_t)(g * GC + c) * NST + pp]; const float tr = cr * wr - ci * wi, ti = cr * wi + ci * wr;
                const f32x4 br = *(const f32x4*)(BBR + (size_t)(g * NST + pp) * GC + c4), bi = *(const f32x4*)(BBI + (size_t)(g * NST + pp) * GC + c4);
                a0 += tr * br[0] - ti * bi[0]; a1 += tr * br[1] - ti * bi[1]; a2 += tr * br[2] - ti * bi[2]; a3 += tr * br[3] - ti * bi[3]; }
            if (x == 0) { const float d = dssm[g * GC + c]; if (c4 == (c & 12)) { const int e = c & 3; if (e == 0) a0 += d; else if (e == 1) a1 += d; else if (e == 2) a2 += d; else a3 += d; } }
            *(unsigned long long*)(WSP(bf16, WS_KT) + ((size_t)(g * 16 + x) * 16 + c) * 16 + c4) = (unsigned long long)cvtpk(a0, a1) | ((unsigned long long)cvtpk(a2, a3) << 32);
        } }
}
__device__ __forceinline__ void passE(Frame& F) {
    const bf16* UB = WSP(bf16, WS_UB); const bf16* M3 = WSP(bf16, WS_M3); float* E = WSP(float, WS_E); const float* PW = WSP(float, WS_PW); const int r = F.lane & 31, kh = F.lane >> 5;
    for (int it = F.gw; it < NG * 16; it += F.NGW) { const int g = it >> 4, nt = it & 15;
        f32x16 acc[4];
#pragma unroll
        for (int m = 0; m < 4; ++m) acc[m] = (f32x16){0.f, 0.f, 0.f, 0.f, 0.f, 0.f, 0.f, 0.f, 0.f, 0.f, 0.f, 0.f, 0.f, 0.f, 0.f, 0.f};
        const bf16* bp = UB + (size_t)(g * 512 + 32 * nt + r) * 256 + 8 * kh; const bf16* ap = M3 + (size_t)(g * 128 + r) * 256 + 8 * kh;
#pragma unroll 4
        for (int s = 0; s < 16; ++s) { const bf16x8 bfr = *(const bf16x8*)(bp + 16 * s);
#pragma unroll
            for (int m = 0; m < 4; ++m) { const bf16x8 afr = *(const bf16x8*)(ap + (size_t)m * 32 * 256 + 16 * s); acc[m] = __builtin_amdgcn_mfma_f32_32x32x16_bf16(afr, bfr, acc[m], 0, 0, 0); } }
        float* ep = E + (size_t)(g * 512 + 32 * nt + r) * 128 + 4 * kh;
#pragma unroll
        for (int m = 0; m < 4; ++m)
#pragma unroll
            for (int qq = 0; qq < 4; ++qq) *(f32x4*)(ep + 32 * m + 8 * qq) = (f32x4){acc[m][4 * qq], acc[m][4 * qq + 1], acc[m][4 * qq + 2], acc[m][4 * qq + 3]};
        asm volatile("s_waitcnt vmcnt(0)" ::: "memory"); __builtin_amdgcn_fence(__ATOMIC_SEQ_CST, "workgroup");
        { const float tr = PW[((size_t)(g * 17 + 16) * NST + F.lane) * 2], ti = PW[((size_t)(g * 17 + 16) * NST + F.lane) * 2 + 1]; float hre = 0.f, him = 0.f;
          const unsigned* eq = (const unsigned*)(E + (size_t)(g * 512 + 32 * nt) * 128 + F.lane); float er[32], ei[32];
#pragma unroll
          for (int ch = 0; ch < 32; ++ch) { er[ch] = __uint_as_float(__hip_atomic_load(eq + (size_t)ch * 128, __ATOMIC_RELAXED, __HIP_MEMORY_SCOPE_AGENT)); ei[ch] = __uint_as_float(__hip_atomic_load(eq + (size_t)ch * 128 + 64, __ATOMIC_RELAXED, __HIP_MEMORY_SCOPE_AGENT)); }
#pragma unroll
          for (int ch = 0; ch < 32; ++ch) { const float nr = fmaf(tr, hre, fmaf(-ti, him, er[ch])), ni = fmaf(tr, him, fmaf(ti, hre, ei[ch])); hre = nr; him = ni; }
          float* ag = WSP(float, WS_AG) + (size_t)(g * 16 + nt) * 128; ag[F.lane] = hre; ag[64 + F.lane] = him; } }
}
constexpr int SL_STRIDE = 136;
__device__ __forceinline__ void passY(Frame& F, int it0, int itstep) {
    const bf16* UB = WSP(bf16, WS_UB); const bf16* M2 = WSP(bf16, WS_M2); const bf16* KT = WSP(bf16, WS_KT); const float* E = WSP(float, WS_E); const float* PW = WSP(float, WS_PW); const float* AG = WSP(float, WS_AG);
    bf16* Sl = (bf16*)F.lds + (size_t)F.wave * 32 * SL_STRIDE; const int r = F.lane & 31, kh = F.lane >> 5, tl = r >> 4, cc = r & 15;
    for (int it = it0; it < NG * 32; it += itstep) { const int g = it >> 5, b = (it >> 4) & 1, j = (it >> 1) & 7, mh = it & 1;
        { const float tr = PW[((size_t)(g * 17 + 16) * NST + F.lane) * 2], ti = PW[((size_t)(g * 17 + 16) * NST + F.lane) * 2 + 1];
          float t2r = tr, t2i = ti;
#pragma unroll
          for (int k = 0; k < 5; ++k) { const float nr = t2r * t2r - t2i * t2i, ni = 2.f * t2r * t2i; t2r = nr; t2i = ni; }
          float hre = 0.f, him = 0.f; const float* ag = AG + (size_t)(g * 16 + b * 8) * 128 + F.lane;
          for (int i = 0; i < j; ++i) { const float ar = ag[(size_t)i * 128], ai = ag[(size_t)i * 128 + 64]; const float nr = fmaf(t2r, hre, fmaf(-t2i, him, ar)), ni = fmaf(t2r, him, fmaf(t2i, hre, ai)); hre = nr; him = ni; }
          const float* ep = E + (size_t)(g * 512 + b * CPB + 32 * j) * 128 + F.lane; float er[32], ei[32];
#pragma unroll
          for (int ch = 0; ch < 32; ++ch) { er[ch] = ep[(size_t)ch * 128]; ei[ch] = ep[(size_t)ch * 128 + 64]; }
#pragma unroll
          for (int ch = 0; ch < 32; ++ch) { Sl[ch * SL_STRIDE + F.lane] = (bf16)(cvtpk(hre, 0.f) & 0xffffu); Sl[ch * SL_STRIDE + 64 + F.lane] = (bf16)(cvtpk(him, 0.f) & 0xffffu);
              const float nr = fmaf(tr, hre, fmaf(-ti, him, er[ch])), ni = fmaf(tr, him, fmaf(ti, hre, ei[ch])); hre = nr; him = ni; }
          if (j == 7 && mh == 0) { F.out[O_HRP + (size_t)(b * NG + g) * NST + F.lane] = hre; F.out[O_HIP + (size_t)(b * NG + g) * NST + F.lane] = him; } }
        LDS_WAIT(); asm volatile("" ::: "memory");
        f32x16 acc[4];
#pragma unroll
        for (int m = 0; m < 4; ++m) acc[m] = (f32x16){0.f, 0.f, 0.f, 0.f, 0.f, 0.f, 0.f, 0.f, 0.f, 0.f, 0.f, 0.f, 0.f, 0.f, 0.f, 0.f};
        const bf16* bp = UB + (size_t)(g * 512 + b * CPB + 32 * j + r) * 256 + 8 * kh; const bf16* kp = KT + (size_t)g * 4096 + cc * 16 + 8 * kh;
        const int t0 = 8 * mh;
#pragma unroll
        for (int s = 0; s < 16; ++s) { if (s > t0 + 7) break;
            const bf16x8 bfr = *(const bf16x8*)(bp + 16 * s);
#pragma unroll
            for (int mm = 0; mm < 4; ++mm) { const int tau = t0 + 2 * mm + tl - s; if (t0 + 2 * mm + 1 < s) continue;
                bf16x8 afr = (bf16x8){0, 0, 0, 0, 0, 0, 0, 0}; if (tau >= 0) afr = *(const bf16x8*)(kp + tau * 256);
                acc[mm] = __builtin_amdgcn_mfma_f32_32x32x16_bf16(afr, bfr, acc[mm], 0, 0, 0); } }
        const bf16* mp = M2 + (size_t)(g * 256 + 32 * (4 * mh) + r) * 128 + 8 * kh;
#pragma unroll 2
        for (int ks = 0; ks < 8; ++ks) { const bf16x8 bfr = *(const bf16x8*)(Sl + r * SL_STRIDE + 16 * ks + 8 * kh);
#pragma unroll
            for (int mm = 0; mm < 4; ++mm) { const bf16x8 afr = *(const bf16x8*)(mp + (size_t)mm * 32 * 128 + 16 * ks); acc[mm] = __builtin_amdgcn_mfma_f32_32x32x16_bf16(afr, bfr, acc[mm], 0, 0, 0); } }
        bf16* yp = WSP(bf16, WS_YP) + ((size_t)b * SEQ + (size_t)(32 * j + r) * CT + t0) * 1024 + g * GC + 4 * kh;
#pragma unroll
        for (int mm = 0; mm < 4; ++mm)
#pragma unroll
            for (int qq = 0; qq < 4; ++qq) { const float y0 = gelu_erf(acc[mm][4 * qq]), y1 = gelu_erf(acc[mm][4 * qq + 1]), y2 = gelu_erf(acc[mm][4 * qq + 2]), y3 = gelu_erf(acc[mm][4 * qq + 3]);
                *(unsigned long long*)(yp + (size_t)(2 * mm + (qq >> 1)) * 1024 + 8 * (qq & 1)) = (unsigned long long)cvtpk(y0, y1) | ((unsigned long long)cvtpk(y2, y3) << 32); }
        LDS_WAIT(); asm volatile("" ::: "memory"); }
}
__device__ __forceinline__ void passB(Frame& F, int it0, int itstep) {
    float* wl = (float*)F.lds + F.wave * WLDS_F; const float* Z = WSP(float, WS_Z); const float* AB = WSP(float, WS_AB); float* Cs = wl + US_F + HS_F;
    const float* const c_re = INP(float, I_CRE); const float* const c_im = INP(float, I_CIM); const float* const sre = INP(float, I_SRE); const float* const sim = INP(float, I_SIM); const float* const dssm = INP(float, I_DSSM);
    for (int it = it0; it < DBT * NG; it += itstep) { const int g = it & 63, bs = it >> 6, gp = g * NST + F.lane;
#pragma unroll 4
        for (int c = 0; c < GC; ++c) { typedef float f32x2 __attribute__((ext_vector_type(2))); *(f32x2*)(Cs + F.lane * 32 + c * 2) = (f32x2){c_re[(size_t)(g * GC + c) * NST + F.lane], c_im[(size_t)(g * GC + c) * NST + F.lane]}; }
        float hre = sre[(size_t)bs * NG * NST + gp], him = sim[(size_t)bs * NG * NST + gp]; const int row0 = MPR + bs * DSQ;
        unit<1>(Z + (size_t)row0 * 4096 + g * GC, DSQ, hre, him, WSP(float, WS_BBR) + (size_t)gp * GC, WSP(float, WS_BBI) + (size_t)gp * GC, AB[2 * gp], AB[2 * gp + 1], wl, F.lane, WSP(bf16, WS_YP) + (size_t)row0 * 1024 + g * GC, dssm + g * GC);
        F.out[O_HRS + (size_t)bs * NG * NST + gp] = hre; F.out[O_HIS + (size_t)bs * NG * NST + gp] = him; }
}
}
namespace sattn {
constexpr int D = 128, SPG = 16, WAVES = 4, GE = 4, NSPLIT = 32, NSUB = PAST / SPG, PPS = NSUB / NSPLIT, PPW = PPS / WAVES, TOK_STRIDE = NH * HD;
constexpr int LDS_P = 0, LDS_MRG = WAVES * 64, MRG_REC = 4 + D, HALF_FLOATS = 2560;
constexpr float SCALE = 0.088388347648318440f;
using bf16x2 = __attribute__((ext_vector_type(2))) __bf16;
using u32x4  = __attribute__((ext_vector_type(4))) unsigned;
using f32x4  = __attribute__((ext_vector_type(4))) float;
using f32x8  = __attribute__((ext_vector_type(8))) float;
__device__ __forceinline__ float dot2(unsigned k, unsigned q, float acc) { return __builtin_amdgcn_fdot2_f32_bf16(__builtin_bit_cast(bf16x2, k), __builtin_bit_cast(bf16x2, q), acc, false); }
template <int CTRL> __device__ __forceinline__ float dpp(float x) { return __builtin_bit_cast(float, __builtin_amdgcn_mov_dpp(__builtin_bit_cast(int, x), CTRL, 0xf, 0xf, true)); }
constexpr int XOR1 = 0xB1, XOR2 = 0x4E, XOR7 = 0x141, XOR8 = 0x128, ROR4 = 0x124;
__device__ __forceinline__ float xrow16_max(float x) {
  auto s = __builtin_amdgcn_permlane16_swap(__float_as_uint(x), __float_as_uint(x), false, false); x = fmaxf(__uint_as_float(s[0]), __uint_as_float(s[1]));
  auto t = __builtin_amdgcn_permlane32_swap(__float_as_uint(x), __float_as_uint(x), false, false); return fmaxf(__uint_as_float(t[0]), __uint_as_float(t[1])); }
__device__ __forceinline__ float xrow16_sum(float x) {
  auto s = __builtin_amdgcn_permlane16_swap(__float_as_uint(x), __float_as_uint(x), false, false); x = __uint_as_float(s[0]) + __uint_as_float(s[1]);
  auto t = __builtin_amdgcn_permlane32_swap(__float_as_uint(x), __float_as_uint(x), false, false); return __uint_as_float(t[0]) + __uint_as_float(t[1]); }
__device__ __forceinline__ u32x4 tobf(f32x8 x) { u32x4 w = {cvtpk(x[0], x[1]), cvtpk(x[2], x[3]), cvtpk(x[4], x[5]), cvtpk(x[6], x[7])}; return w; }

__device__ __forceinline__ void split_unit(int unit, float* lds, int wave, int lane, const float* QS, const float* ck, const float* cv, const int* pt, const float* RP, float* PML, float* PO, int prb = 0) {
  const bool pad = (unsigned)unit >> 31; const int bh = pad ? 0 : (unit >> 5), s = pad ? 0 : (unit & 31), kvh = bh & 7, b = bh >> 3, r = lane >> 4, c = lane & 15;
  constexpr float C2 = SCALE * 1.4426950408889634f;
  const int p0 = s * PPS;
  const int npg = (pad || (prb & 4096)) ? 0 : PPW;
  int btv = 0;
  if (lane < PPW) { const int pg = p0 + wave + 4 * lane; btv = pt[b * NPAGES + (pg >> 3)] * PAGE + (pg & 7) * SPG; }
  u32x4 qpk[GE];
#pragma unroll
  for (int g = 0; g < GE; ++g) qpk[g] = tobf(*reinterpret_cast<const f32x8*>(QS + ((size_t)((b * NH + kvh) * DSQ + g)) * D + 8 * c));
  const size_t loff = (size_t)r * TOK_STRIDE + (size_t)kvh * D + 8 * c;
  const float* rpb = RP + (size_t)(b * NH + kvh) * PAST + r + 4 * (c >> 2);
#define SA_ISSUE(i_) do { const int tb_ = __builtin_amdgcn_readlane(btv, (i_)); const float* kb_ = ck + (size_t)tb_ * TOK_STRIDE + loff; const float* vb_ = cv + (size_t)tb_ * TOK_STRIDE + loff; \
    _Pragma("unroll") for (int t_ = 0; t_ < 4; ++t_) { Kn[t_] = __builtin_nontemporal_load(reinterpret_cast<const f32x8*>(kb_ + (size_t)t_ * 4 * TOK_STRIDE)); Vn[t_] = __builtin_nontemporal_load(reinterpret_cast<const f32x8*>(vb_ + (size_t)t_ * 4 * TOK_STRIDE)); } \
    Bn = rpb[(p0 + wave + 4 * (i_)) * SPG]; } while (0)
  f32x8 Kn[4], Vn[4]; float Bn;
  float m = -INFINITY, l = 0.f, acc[GE * 8];
#pragma unroll
  for (int k = 0; k < GE * 8; ++k) acc[k] = 0.f;
  if (npg > 0) SA_ISSUE(0);
  for (int i = 0; i < npg; ++i) {
    u32x4 Kc[4], Vc[4];
#pragma unroll
    for (int t = 0; t < 4; ++t) { Kc[t] = tobf(Kn[t]); Vc[t] = tobf(Vn[t]); }
    const float Bc = Bn;
    if (i + 1 < npg) SA_ISSUE(i + 1);
    float x[4 * GE];
#pragma unroll
    for (int t = 0; t < 4; ++t)
#pragma unroll
      for (int g = 0; g < GE; ++g) { float d = 0.f;
#pragma unroll
        for (int k = 0; k < 4; ++k) d = dot2(Kc[t][k], qpk[g][k], d);
        x[t * GE + g] = d; }
#define SA_TR(HALF, CTRL, BIT) _Pragma("unroll") for (int h = 0; h < (HALF); ++h) { \
      const float lo_ = x[h], hi_ = x[h + (HALF)]; const float t1_ = lo_ + dpp<CTRL>(lo_), t2_ = hi_ + dpp<CTRL>(hi_); x[h] = (c & (BIT)) ? t2_ : t1_; }
    SA_TR(8, XOR8, 8) SA_TR(4, XOR7, 4) SA_TR(2, XOR2, 2) SA_TR(1, XOR1, 1)
#undef SA_TR
    const float sc = fmaf(x[0], C2, Bc);
    float pm = sc; pm = fmaxf(pm, dpp<ROR4>(pm)); pm = fmaxf(pm, dpp<XOR8>(pm)); pm = xrow16_max(pm);
    const float mn = fmaxf(m, pm), msub = (mn == -INFINITY) ? 0.f : mn;
    const float alpha = __builtin_amdgcn_exp2f(m - msub), p = __builtin_amdgcn_exp2f(sc - msub);
    l = fmaf(l, alpha, p); m = mn;
#pragma unroll
    for (int q4 = 0; q4 < 4; ++q4) { const float al = q4 == 0 ? dpp<0x00>(alpha) : q4 == 1 ? dpp<0x55>(alpha) : q4 == 2 ? dpp<0xAA>(alpha) : dpp<0xFF>(alpha);
#pragma unroll
      for (int k = 0; k < 8; ++k) acc[q4 * 8 + k] *= al; }
    float* prow = lds + LDS_P + (wave * 4 + r) * 16;
    prow[c] = p;
    asm volatile("s_waitcnt lgkmcnt(0)" ::: "memory");
    f32x4 pr[GE];
#pragma unroll
    for (int u = 0; u < GE; ++u) pr[u] = *reinterpret_cast<const f32x4*>(prow + 4 * u);
#pragma unroll
    for (int t = 0; t < 4; ++t) { float vf[8];
#pragma unroll
      for (int k = 0; k < 4; ++k) { vf[2 * k] = __builtin_bit_cast(float, Vc[t][k] << 16); vf[2 * k + 1] = __builtin_bit_cast(float, Vc[t][k] & 0xffff0000u); }
#pragma unroll
      for (int g = 0; g < GE; ++g) { const float pg_ = pr[t][g];
#pragma unroll
        for (int k = 0; k < 8; ++k) acc[g * 8 + k] = fmaf(pg_, vf[k], acc[g * 8 + k]); } }
  }
#undef SA_ISSUE
#pragma unroll
  for (int k = 0; k < GE * 8; ++k) acc[k] = xrow16_sum(acc[k]);
  { float t = l; t += dpp<ROR4>(t); t += dpp<XOR8>(t); l = xrow16_sum(t); }
  float* mrg = lds + LDS_MRG;
  if (r == 0) {
#pragma unroll
    for (int g = 0; g < GE; ++g) { float* rec = mrg + (wave * GE + g) * MRG_REC;
#pragma unroll
      for (int k = 0; k < 8; k += 4) *reinterpret_cast<f32x4*>(rec + 4 + 8 * c + k) = f32x4{acc[g * 8 + k], acc[g * 8 + k + 1], acc[g * 8 + k + 2], acc[g * 8 + k + 3]};
      if (c == g) { rec[0] = m; rec[1] = l; } } }
  __syncthreads();
  { const int g = wave, d0 = 2 * lane; const size_t row = (size_t)(b * NH + kvh) * DSQ + g;
    float M = -INFINITY;
#pragma unroll
    for (int w = 0; w < WAVES; ++w) M = fmaxf(M, mrg[(w * GE + g) * MRG_REC]);
    float L = 0.f, o0 = 0.f, o1 = 0.f;
#pragma unroll
    for (int w = 0; w < WAVES; ++w) { const float* rec = mrg + (w * GE + g) * MRG_REC; const float lw = rec[1]; const float wt = (lw > 0.f) ? __builtin_amdgcn_exp2f(rec[0] - M) : 0.f;
      L = fmaf(wt, lw, L); o0 = fmaf(wt, rec[4 + d0], o0); o1 = fmaf(wt, rec[4 + d0 + 1], o1); }
    const size_t slot = row * NSPLIT + s;
    if (!pad && !(prb & 4096)) { *reinterpret_cast<float2*>(PO + slot * D + d0) = make_float2(o0, o1);
    if (lane == 0) *reinterpret_cast<float2*>(PML + 2 * slot) = make_float2(M, L); } }
  __syncthreads();
}
}

__device__ __forceinline__ void sample_combine(Frame& F) {
    const float* PML = WSP(float, WS_PML); const float* PO = WSP(float, WS_PO); const float* QS = WSP(float, WS_QS);
    constexpr float C2 = 0.088388347648318440f * 1.4426950408889634f;
    for (int row = F.gw; row < DBT * NH * DSQ; row += F.NGW) { const int t = row & 3, h = (row >> 2) & 7, b = row >> 5, d0 = 2 * F.lane; const unsigned live = WSP(unsigned, WS_LIST)[64 + (row >> 2)];
        const float2 q = *(const float2*)(QS + (size_t)row * HD + d0);
        float sn[DSQ]; float run = 0.f;
#pragma unroll
        for (int j = 0; j < DSQ; ++j) { const float2 k = *(const float2*)(F.out + O_KS + ((size_t)(b * DSQ + j) * NH + h) * HD + d0); const float d = wave_sum(q.x * k.x + q.y * k.y);
            run += F.out[O_LFS + (size_t)(b * DSQ + j) * NH + h]; sn[j] = (j <= t) ? fmaf(d, C2, -run * LOG2E) : -INFINITY; }
        float M = -INFINITY;
#pragma unroll 8
        for (int s = 0; s < sattn::NSPLIT; ++s) if ((live >> s) & 1u) M = fmaxf(M, PML[2 * ((size_t)row * sattn::NSPLIT + s)]);
#pragma unroll
        for (int j = 0; j < DSQ; ++j) M = fmaxf(M, sn[j]);
        float L = 0.f, o0 = 0.f, o1 = 0.f;
#pragma unroll 8
        for (int s = 0; s < sattn::NSPLIT; ++s) { if (!((live >> s) & 1u)) continue; const size_t slot = (size_t)row * sattn::NSPLIT + s; const float ls = PML[2 * slot + 1], w = (ls > 0.f) ? __builtin_amdgcn_exp2f(PML[2 * slot] - M) : 0.f;
            const float2 a = *(const float2*)(PO + slot * HD + d0); L = fmaf(w, ls, L); o0 = fmaf(w, a.x, o0); o1 = fmaf(w, a.y, o1); }
#pragma unroll
        for (int j = 0; j < DSQ; ++j) { const float p = __builtin_amdgcn_exp2f(sn[j] - M); const float2 v = *(const float2*)(F.out + O_VS + ((size_t)(b * DSQ + j) * NH + h) * HD + d0);
            L += p; o0 = fmaf(p, v.x, o0); o1 = fmaf(p, v.y, o1); }
        const float inv = 1.0f / L;
        *(unsigned*)(WSP(bf16, WS_YY) + (size_t)(MPR + b * DSQ + t) * 2048 + 1024 + h * HD + d0) = cvtpk(o0 * inv, o1 * inv); }
}
namespace sk {
typedef float f32x16 __attribute__((ext_vector_type(16)));
__device__ __forceinline__ void st_bf16(bf16* p, float x) { *p = (bf16)(cvtpk(x, 0.f) & 0xffffu); }
__device__ __forceinline__ float ld_bf16(const bf16* p) { return __uint_as_float((unsigned)(*p) << 16); }
__device__ __forceinline__ float sigm(float x) { return 1.0f / (1.0f + __expf(-x)); }
template <int NBLK, class Epi>
__device__ __forceinline__ void run(Frame& F, const bf16* A, int lda, const bf16* Bt, int ldb, int K, int nunits, const Epi& E, int ustart = -1, int ustride = 0) {
    float* P = (float*)F.lds;
    const int r = F.lane & 31, kh = F.lane >> 5, kw = K >> 3, nb4 = kw >> 6;
    if (ustart < 0) { ustart = F.G - 1 - (int)blockIdx.x; ustride = F.G; }
    for (int u = ustart; u < nunits; u += ustride) {
        f32x16 acc[NBLK];
#pragma unroll
        for (int b = 0; b < NBLK; ++b) acc[b] = (f32x16){0.f, 0.f, 0.f, 0.f, 0.f, 0.f, 0.f, 0.f, 0.f, 0.f, 0.f, 0.f, 0.f, 0.f, 0.f, 0.f};
        const bf16* ap[NBLK]; const bf16* bp[NBLK];
#pragma unroll
        for (int b = 0; b < NBLK; ++b) { ap[b] = A + (size_t)r * lda + E.koff(b) + F.wave * kw + 8 * kh; bp[b] = Bt + (size_t)(E.brow(u, b) + r) * ldb + E.koff(b) + F.wave * kw + 8 * kh; }
#define SK_LOAD(AF, BF, s_) do { _Pragma("unroll") for (int i = 0; i < 4; ++i) { _Pragma("unroll") for (int b = 0; b < NBLK; ++b) { \
            AF[b][i] = (b == 0 || Epi::SPLIT_A) ? *(const bf16x8*)(ap[b] + 64 * (s_) + 16 * i) : AF[0][i]; BF[b][i] = *(const bf16x8*)(bp[b] + 64 * (s_) + 16 * i); } } } while (0)
        bf16x8 af[NBLK][4], bf[NBLK][4], an[NBLK][4], bn[NBLK][4];
        SK_LOAD(af, bf, 0);
#pragma unroll 1
        for (int s = 0; s < nb4; ++s) {
            if (s + 1 < nb4) SK_LOAD(an, bn, s + 1);
#pragma unroll
            for (int i = 0; i < 4; ++i)
#pragma unroll
                for (int b = 0; b < NBLK; ++b) acc[b] = __builtin_amdgcn_mfma_f32_32x32x16_bf16(af[b][i], bf[b][i], acc[b], 0, 0, 0);
#pragma unroll
            for (int i = 0; i < 4; ++i)
#pragma unroll
                for (int b = 0; b < NBLK; ++b) { af[b][i] = an[b][i]; bf[b][i] = bn[b][i]; } }
#undef SK_LOAD
#pragma unroll
        for (int b = 0; b < NBLK; ++b)
#pragma unroll
            for (int q = 0; q < 16; ++q) P[((F.wave * NBLK + b) * 32 + ((q & 3) + 8 * (q >> 2) + 4 * kh)) * 32 + r] = acc[b][q];
        __syncthreads();
#pragma unroll
        for (int e2 = 0; e2 < 2; ++e2) { const int e = F.tid + 512 * e2, row = e >> 5, col = e & 31; float v[NBLK];
#pragma unroll
            for (int b = 0; b < NBLK; ++b) { float t = 0.f;
#pragma unroll
                for (int w = 0; w < 8; ++w) t += P[((w * NBLK + b) * 32 + row) * 32 + col];
                v[b] = t; }
            E.apply(u, row, col, v); }
        __syncthreads();
    }
}
struct In { float* Z; bf16* G; const float* R1;
    static constexpr bool SPLIT_A = false; __device__ __forceinline__ int koff(int) const { return 0; }
    __device__ __forceinline__ int brow(int u, int) const { return 32 * u; }
    __device__ __forceinline__ void apply(int u, int row, int col, const float* v) const { const int c = 32 * u + col; const size_t gr = MPR + row; const float z = v[0] * R1[gr];
        if (c < 4096) Z[gr * 4096 + c] = z; else st_bf16(G + gr * 4096 + (c - 4096), sigm(z)); } };
struct Glu { const bf16* YP; bf16* YY; const float* bias;
    static constexpr bool SPLIT_A = false; __device__ __forceinline__ int koff(int) const { return 0; }
    __device__ __forceinline__ int brow(int u, int) const { return 32 * u; }
    __device__ __forceinline__ void apply(int u, int row, int col, const float* v) const { const int c = 32 * u + col; const size_t gr = MPR + row; st_bf16(YY + gr * 2048 + c, ld_bf16(YP + gr * 1024 + c) * sigm(v[0] + bias[c])); } };
struct Merge { const bf16* G; bf16* MG;
    static constexpr bool SPLIT_A = true; __device__ __forceinline__ int koff(int b) const { return 1024 * b; }
    __device__ __forceinline__ int brow(int u, int) const { return 32 * u; }
    __device__ __forceinline__ void apply(int u, int row, int col, const float* v) const { const int c = 32 * u + col; const size_t gr = MPR + row;
        st_bf16(MG + gr * 2048 + c, ld_bf16(G + gr * 4096 + c) * v[0] + ld_bf16(G + gr * 4096 + 2048 + c) * v[1]); } };
struct Out { const float* xs; bf16* XB; float* SSR;
    static constexpr bool SPLIT_A = false; __device__ __forceinline__ int koff(int) const { return 0; }
    __device__ __forceinline__ int brow(int u, int) const { return 32 * u; }
    __device__ __forceinline__ void apply(int u, int row, int col, const float* v) const { const int c = 32 * u + col; const size_t gr = MPR + row; const float x1 = xs[(size_t)row * 2048 + c] + v[0];
        st_bf16(XB + gr * 2048 + c, x1); float s = x1 * x1;
        s += __shfl_xor(s, 1); s += __shfl_xor(s, 2); s += __shfl_xor(s, 4); s += __shfl_xor(s, 8); s += __shfl_xor(s, 16);
        if (col == 0) __hip_atomic_fetch_add(SSR + MPR + row, s, __ATOMIC_RELAXED, __HIP_MEMORY_SCOPE_AGENT); } };
struct FF1 { const float* SSR; bf16* H;
    static constexpr bool SPLIT_A = false; __device__ __forceinline__ int koff(int) const { return 0; }
    __device__ __forceinline__ int brow(int u, int b) const { const int h0 = 32 * u; return 256 * (h0 >> 7) + (h0 & 127) + 128 * b; }
    __device__ __forceinline__ void apply(int u, int row, int col, const float* v) const {
        const float r2 = 1.0f / sqrtf(SSR[MPR + row] * (1.0f / 2048.0f) + RMS_EPS), g = v[0] * r2, up = v[1] * r2;
        st_bf16(H + (size_t)(MPR + row) * DFF + 32 * u + col, g * sigm(g) * up); } };
struct FF2 { const bf16* XB; float* ys;
    static constexpr bool SPLIT_A = false; __device__ __forceinline__ int koff(int) const { return 0; }
    __device__ __forceinline__ int brow(int u, int) const { return 32 * u; }
    __device__ __forceinline__ void apply(int u, int row, int col, const float* v) const { const int c = 32 * u + col; ys[(size_t)row * 2048 + c] = ld_bf16(XB + (size_t)(MPR + row) * 2048 + c) + v[0]; } };
}
__device__ __forceinline__ pattn::BlockRef<__hip_bfloat16, __hip_bfloat16> attn_ref(unsigned char* ws, int u) {
    constexpr int NQB = SEQ / pattn::QB;
    const int qb = NQB - 1 - (u >> 4), bh = u & 15; const size_t hb = (size_t)bh * SEQ * HD;
    pattn::BlockRef<__hip_bfloat16, __hip_bfloat16> r;
    r.Q = (const __hip_bfloat16*)(ws + WS_QB) + hb + (size_t)qb * pattn::QB * HD; r.K = (const __hip_bfloat16*)(ws + WS_KB) + hb; r.V = (const __hip_bfloat16*)(ws + WS_VB) + hb;
    r.CK = (const unsigned short*)(ws + WS_NCK) + (size_t)bh * SEQ * 16; r.P0 = qb * pattn::QB; r.XF = (const float*)(ws + WS_XF) + (size_t)bh * SEQ;
    r.jlo = __builtin_amdgcn_readfirstlane(((const int*)(ws + WS_JLO))[bh * 16 + qb]); r.negb2 = -__uint_as_float(__builtin_amdgcn_readfirstlane(__float_as_uint(((const float*)(ws + WS_SS2))[0])));
    r.O = (__hip_bfloat16*)(ws + WS_YY) + ((size_t)(bh >> 3) * SEQ + (size_t)qb * pattn::QB) * 2048 + 1024 + (bh & 7) * HD;
    return r;
}
__device__ __forceinline__ void refresh_lane(Frame& F) {
    int l; asm volatile("v_mbcnt_lo_u32_b32 %0, -1, 0\n\tv_mbcnt_hi_u32_b32 %0, -1, %0" : "=v"(l)); F.lane = l; F.tid = F.wave * 64 + l;
    unsigned long long w_ = (unsigned long long)F.ws, o_ = (unsigned long long)F.out; asm volatile("" : "+s"(w_), "+s"(o_));
    F.ws = (unsigned char*)(__attribute__((address_space(1))) unsigned char*)w_; F.out = (float*)(__attribute__((address_space(1))) float*)o_;
}

__device__ __forceinline__ int pull(Frame& F, int qword) {
    volatile LAS unsigned* w = (volatile LAS unsigned*)(F.lds + MISC_OFF + 64);
    if (F.tid == 0) *w = __hip_atomic_fetch_add((unsigned*)(F.ws + WS_CTL) + CW_Q + qword, 1u, __ATOMIC_RELAXED, __HIP_MEMORY_SCOPE_AGENT);
    __syncthreads(); const unsigned v = *w; __syncthreads(); return __builtin_amdgcn_readfirstlane((int)v);
}
__device__ __forceinline__ int pull8(Frame& F, int qword0, int nunits) {
    volatile LAS unsigned* w = (volatile LAS unsigned*)(F.lds + MISC_OFF + 64);
    if (F.tid == 0) { unsigned* heads = (unsigned*)(F.ws + WS_CTL) + CW_Q + qword0; const unsigned per = (unsigned)nunits >> 3; unsigned r = (unsigned)nunits;
        for (unsigned t = 0; t < 8u; ++t) { const unsigned q = (blockIdx.x + t) & 7u;
            if (__hip_atomic_load(heads + 64 * q, __ATOMIC_RELAXED, __HIP_MEMORY_SCOPE_AGENT) >= per) continue;
            const unsigned i = __hip_atomic_fetch_add(heads + 64 * q, 1u, __ATOMIC_RELAXED, __HIP_MEMORY_SCOPE_AGENT);
            if (i < per) { r = i * 8u + q; break; } }
        *w = r; }
    __syncthreads(); const unsigned v = *w; __syncthreads(); return __builtin_amdgcn_readfirstlane((int)v);
}
__device__ __forceinline__ void attn_prompt_phase(Frame& F) {
    using BR = pattn::BlockRef<__hip_bfloat16, __hip_bfloat16>;
    constexpr int NU = NB * NH * (SEQ / pattn::QB);
    char* lds = (char*)F.lds;
    int u = pull(F, 64); if (u >= NU) return;
    BR cur = attn_ref(F.ws, u);
    pattn::Seam<__hip_bfloat16> S;
    pattn::causal_swa_prime<__hip_bfloat16, __hip_bfloat16>(cur, SEQ, lds, S, F.wave, F.lane);
    for (;;) { const int un = pull(F, 64); const bool last = un >= NU;
        const BR nxt = last ? cur : attn_ref(F.ws, un);
        pattn::causal_swa_block<__hip_bfloat16, __hip_bfloat16>(cur, nxt, SEQ, SEQ, lds, S, F.wave, F.lane);
        if (last) break;
        cur = nxt; }
}

constexpr int N_PHASES = 9;
__global__ void __launch_bounds__(NWAVES * 64, 2) fwd(Args args) {
    extern __shared__ __attribute__((aligned(16))) unsigned char lds[];
    Frame F;
    F.lds = lds; F.wave = __builtin_amdgcn_readfirstlane(threadIdx.x >> 6); refresh_lane(F); F.G = gridDim.x;
    F.gw = blockIdx.x * NWAVES + F.wave; F.NGW = F.G * NWAVES;
    F.out = args.out; F.ws = args.ws;
    volatile LAS unsigned* MISC = (volatile LAS unsigned*)((LAS unsigned char*)lds + MISC_OFF);
    for (int u = F.tid; u < 128; u += NWAVES * 64) MISC[u] = 0u;
    __syncthreads();
    const int lo = args.ph_lo, hi = args.ph_hi;
    XcdBarrier bar; bar.bar = (unsigned*)(F.ws + WS_CTL) + CW_BAR; bar.x = 0; bar.st = nullptr;
    if (hi - lo > 1) bar = xcd_barrier_post((unsigned*)(F.ws + WS_CTL) + CW_BAR, MISC + 8, F.tid == 0);
#ifndef PH_MASK
#define PH_MASK 0x1ff
#endif
#define IN(k) (((PH_MASK >> (k)) & 1) && lo <= (k) && (k) < hi)
#define SEAM(k) do { if (IN(k) && IN((k) + 1)) { xcd_barrier(bar, F.tid == 0); refresh_lane(F); } } while (0)
#ifndef PH_DUP
#define PH_DUP 0
#endif
#ifndef SUB_DUP
#define SUB_DUP 0
#endif
#define SUBREP(k) _Pragma("unroll") for (int srep = 0; srep < 1 + ((SUB_DUP >> (k)) & 1); ++srep)
#define REP(k) _Pragma("unroll") for (int rep = 0; rep < 1 + ((PH_DUP >> (k)) & 1); ++rep)
#define REPBAR() do { if (rep) xcd_barrier(bar, F.tid == 0); } while (0)
    LAS unsigned char* ring = (LAS unsigned char*)lds;

    if (IN(0)) REP(0) { REPBAR(); phase0(F, args.probe); } SEAM(0);
    if (IN(1)) REP(1) { REPBAR();
        s5::gen_tables(F); __syncthreads();
        pg8::Gemm g{(const pg8::bf16_t*)WSP(bf16, WS_XA), (const pg8::bf16_t*)WSP(bf16, WS_W1T), MPR, 8192, 2048, 2048, 2048}; pg8::StaticOrder S; S.init(MPR, 8192, F.G, (int)blockIdx.x);
        pg8::EpiIn E{(pg8::bf16_t*)WSP(bf16, WS_G), WSP(float, WS_R1), (pg8::bf16_t*)WSP(bf16, WS_UB), (pg8::bf16_t*)WSP(bf16, WS_QB), (pg8::bf16_t*)WSP(bf16, WS_KB), (pg8::bf16_t*)WSP(bf16, WS_VB),
                      F.out + O_KP, F.out + O_VP, INP(float, I_GQ), INP(float, I_GK), (LAS float*)(ring + 131072)};
        pg8::gemm_phase<pg8::EpiIn, pg8::StaticOrder, true, true>(ring, g, S, E, F.wave, F.lane);
        __syncthreads();
        sk::run<1>(F, WSP(bf16, WS_XA) + (size_t)MPR * 2048, 2048, WSP(bf16, WS_W1T), 2048, 2048, 256, sk::In{WSP(float, WS_Z), WSP(bf16, WS_G), WSP(float, WS_R1)}); } SEAM(1);
    #ifndef PH2_MASK
#define PH2_MASK 15
#endif
    if (IN(2)) REP(2) { REPBAR(); if (PH2_MASK & 1) SUBREP(0) rowpass(F); if (PH2_MASK & 2) SUBREP(1) s5::passE(F); if (PH2_MASK & 4) SUBREP(2) { __syncthreads(); if (F.G == 256) { if ((int)blockIdx.x >= 240) logf_cumsum(F, (int)blockIdx.x - 240); } else for (int it = (int)blockIdx.x; it < NB * NH; it += F.G) logf_cumsum(F, it); }     if ((PH2_MASK & 8) && rep == 0) rpast_fix(F);
        if (F.gw == (F.G == 256 ? 200 * NWAVES : 0)) { const float* const gqp = INP(float, I_GQ); const float* const gkp = INP(float, I_GK);
            float mq = fmaxf(fabsf(gqp[F.lane]), fabsf(gqp[F.lane + 64])), mk = fmaxf(fabsf(gkp[F.lane]), fabsf(gkp[F.lane + 64]));
#pragma unroll
            for (int o = 1; o < 64; o <<= 1) { mq = fmaxf(mq, __shfl_xor(mq, o)); mk = fmaxf(mk, __shfl_xor(mk, o)); }
            const float bq2 = 11.313708498984761f * 1.4426950408889634f * mq * mk;
            const float thr = -(3.f * bq2 + 40.f); const float* tp = WSP(float, WS_TPG) + F.lane * NPAGES; float suf = 0.f; unsigned flags = 0u;
            for (int pgi = NPAGES - 1; pgi >= 0; --pgi) { if ((pgi & 3) == 3 && !(suf * LOG2E < thr)) flags |= 1u << (pgi >> 2); suf += tp[pgi]; }
            unsigned* L = WSP(unsigned, WS_LIST); L[64 + F.lane] = flags; unsigned base = 0u;
            for (int s = 0; s < 32; ++s) { const bool lv = (flags >> s) & 1u; const unsigned long long mk2 = __ballot(lv);
                if (lv) L[256 + base + __builtin_popcountll(mk2 & ((1ull << F.lane) - 1ull))] = ((unsigned)F.lane << 5) | (unsigned)s;
                base += (unsigned)__builtin_popcountll(mk2); }
            if (F.lane == 0) { L[0] = base; if (base & 1u) L[256 + base] = 0x80000000u; } }
  __syncthreads(); if ((int)blockIdx.x >= 128 && F.G == 256) weight_copies(F, WI_FF10, WI_FF10 + WI_FF1, (int)blockIdx.x - 128, 128); else if (F.G != 256) weight_copies(F, WI_FF10, WI_FF10 + WI_FF1, (int)blockIdx.x, F.G); } SEAM(2);
    if (IN(3)) REP(3) { REPBAR(); refresh_lane(F);
        constexpr int NSTREAM = 128; const bool stream = (int)blockIdx.x < NSTREAM;
        const int prb = args.probe;
#define P3_STREAM_LOOP() do { const int half = F.wave >> 2; const unsigned* const L = WSP(unsigned, WS_LIST); const int nbu_ = (int)((__builtin_amdgcn_readfirstlane((int)L[0]) + 1) >> 1); const int nbu = (prb & 512) ? (nbu_ < 256 ? nbu_ : 256) : ((prb & 1024) ? (nbu_ < 128 ? nbu_ : 128) : ((prb & 2048) ? 16 : nbu_)); \
            volatile LAS unsigned* qw = (volatile LAS unsigned*)(F.lds + MISC_OFF + 64); unsigned* qh = (unsigned*)(F.ws + WS_CTL) + CW_Q; \
            int bu = pull(F, 0); \
            while (bu < nbu) { unsigned pend = 0u; if (F.tid == 0) pend = __hip_atomic_fetch_add(qh, 1u, __ATOMIC_RELAXED, __HIP_MEMORY_SCOPE_AGENT); \
                const float* const ckp = INP(float, I_CK); const float* const cvp = INP(float, I_CV); const int* const ptp = INP(int, I_PT); \
                sattn::split_unit(__builtin_amdgcn_readfirstlane((int)L[256 + 2 * bu + half]), (float*)F.lds + half * sattn::HALF_FLOATS, F.wave & 3, F.lane, WSP(float, WS_QS), ckp, cvp, ptp, WSP(float, WS_RP), WSP(float, WS_PML), WSP(float, WS_PO), prb); \
                if (F.tid == 0) *qw = pend; __syncthreads(); bu = __builtin_amdgcn_readfirstlane((int)*qw); __syncthreads(); } \
            __syncthreads(); refresh_lane(F); } while (0)
        if (stream && !(prb & 1)) P3_STREAM_LOOP();
        if (!(prb & 2)) attn_prompt_phase(F);
        __syncthreads(); refresh_lane(F);
        if (!(prb & 4)) { for (int bu = pull(F, 128); bu < 256; bu = pull(F, 128)) s5::passY(F, bu * 8 + F.wave, 1 << 30);
        for (int bu = pull(F, 192); bu < 64; bu = pull(F, 192)) s5::passB(F, bu * 8 + F.wave, 1 << 30); }
        __syncthreads(); refresh_lane(F);
        if (!stream && !(prb & 17)) P3_STREAM_LOOP();
#undef P3_STREAM_LOOP
    } SEAM(3);
    if (IN(4)) REP(4) { REPBAR();
        sample_combine(F);
        if ((int)blockIdx.x >= 128 && F.G == 256) { weight_copies(F, WI_BR0, WI_FF10, (int)blockIdx.x - 128, 128); weight_copies(F, WI_FF10 + WI_FF1, WI_FF10 + WI_FF1 + 256, (int)blockIdx.x - 128, 128); }
        else if (F.G != 256) { weight_copies(F, WI_BR0, WI_FF10, (int)blockIdx.x, F.G); weight_copies(F, WI_FF10 + WI_FF1, WI_FF20, (int)blockIdx.x, F.G); }
        __syncthreads(); refresh_lane(F);
        { pg8::Gemm g{(const pg8::bf16_t*)WSP(bf16, WS_YP), (const pg8::bf16_t*)WSP(bf16, WS_WGLU), MPR, 1024, 1024, 1024, 1024}; pg8::StaticOrder S; S.init(MPR, 1024, F.G, (int)blockIdx.x);
          pg8::EpiGlu E{(const pg8::bf16_t*)WSP(bf16, WS_YP), (pg8::bf16_t*)WSP(bf16, WS_YY), INP(float, I_BGLU)};
          pg8::gemm_phase<pg8::EpiGlu, pg8::StaticOrder, true, true>(ring, g, S, E, F.wave, F.lane); }
        __syncthreads(); refresh_lane(F);
        if ((int)blockIdx.x < 96 && F.G == 256) weight_copies(F, WI_FF10 + WI_FF1 + 256, WI_FF20, (int)blockIdx.x, 96);
        __syncthreads();
        sk::run<1>(F, WSP(bf16, WS_YP) + (size_t)MPR * 1024, 1024, WSP(bf16, WS_WGLU), 1024, 1024, 32, sk::Glu{WSP(bf16, WS_YP), WSP(bf16, WS_YY), INP(float, I_BGLU)}); } SEAM(4);
    if (IN(5)) REP(5) { REPBAR();
        pg8::Gemm g{(const pg8::bf16_t*)WSP(bf16, WS_YY), (const pg8::bf16_t*)WSP(bf16, WS_WBR), MPR, 2048, 2048, 2048, 2048}; pg8::StaticOrder S; S.init(MPR, 2048, F.G, (int)blockIdx.x);
        pg8::EpiMerge E{(const pg8::bf16_t*)WSP(bf16, WS_G), (pg8::bf16_t*)WSP(bf16, WS_MG)};
        pg8::gemm_phase<pg8::EpiMerge, pg8::StaticOrder, true, true>(ring, g, S, E, F.wave, F.lane);
        __syncthreads();
        sk::run<2>(F, WSP(bf16, WS_YY) + (size_t)MPR * 2048, 2048, WSP(bf16, WS_WBR), 2048, 1024, 64, sk::Merge{WSP(bf16, WS_G), WSP(bf16, WS_MG)}); } SEAM(5);
    if (IN(6)) REP(6) { REPBAR();
        pg8::Gemm g{(const pg8::bf16_t*)WSP(bf16, WS_MG), (const pg8::bf16_t*)WSP(bf16, WS_WOUT), MPR, 2048, 2048, 2048, 2048}; pg8::StaticOrder S; S.init(MPR, 2048, F.G, (int)blockIdx.x);
        pg8::EpiOut E{INP(float, I_XP), INP(float, I_XS), (pg8::bf16_t*)WSP(bf16, WS_XB), WSP(float, WS_SSR)};
        pg8::gemm_phase<pg8::EpiOut, pg8::StaticOrder, true, true>(ring, g, S, E, F.wave, F.lane);
        __syncthreads();
        sk::run<1>(F, WSP(bf16, WS_MG) + (size_t)MPR * 2048, 2048, WSP(bf16, WS_WOUT), 2048, 2048, 64, sk::Out{INP(float, I_XS), WSP(bf16, WS_XB), WSP(float, WS_SSR)}); } SEAM(6);
    if (IN(7)) REP(7) { REPBAR();
        pg8::Gemm g{(const pg8::bf16_t*)WSP(bf16, WS_XB), (const pg8::bf16_t*)WSP(bf16, WS_WFF1), MPR, 2 * DFF, 2048, 2048, 2048}; pg8::StaticOrder S; S.init(MPR, 2 * DFF, F.G, (int)blockIdx.x);
        pg8::EpiFF1 E{WSP(float, WS_SSR), (pg8::bf16_t*)WSP(bf16, WS_H), args.probe};
        pg8::gemm_phase<pg8::EpiFF1, pg8::StaticOrder, true, true>(ring, g, S, E, F.wave, F.lane);
        __syncthreads();
        if (F.G == 256) sk::run<2>(F, WSP(bf16, WS_XB) + (size_t)MPR * 2048, 2048, WSP(bf16, WS_WFF1), 2048, 2048, DFF / 32, sk::FF1{WSP(float, WS_SSR), WSP(bf16, WS_H)}, (int)blockIdx.x >= 128 ? 255 - (int)blockIdx.x : DFF / 32, 128);
        else sk::run<2>(F, WSP(bf16, WS_XB) + (size_t)MPR * 2048, 2048, WSP(bf16, WS_WFF1), 2048, 2048, DFF / 32, sk::FF1{WSP(float, WS_SSR), WSP(bf16, WS_H)});
        __syncthreads(); refresh_lane(F);
        if ((int)blockIdx.x >= 128 && F.G == 256) weight_copies(F, WI_FF20, WI_END, (int)blockIdx.x - 128, 128);
        else if (F.G != 256) weight_copies(F, WI_FF20, WI_END, (int)blockIdx.x, F.G); } SEAM(7);
    if (IN(8)) REP(8) { REPBAR();
        pg8::Gemm g{(const pg8::bf16_t*)WSP(bf16, WS_H), (const pg8::bf16_t*)WSP(bf16, WS_WFF2), MPR, 2048, DFF, DFF, DFF}; pg8::StaticOrder S; S.init(MPR, 2048, F.G, (int)blockIdx.x);
        pg8::EpiFF2 E{(const pg8::bf16_t*)WSP(bf16, WS_XB), F.out + O_YP, F.out + O_YS};
        pg8::gemm_phase<pg8::EpiFF2, pg8::StaticOrder, true, true>(ring, g, S, E, F.wave, F.lane);
        __syncthreads();
        sk::run<1>(F, WSP(bf16, WS_H) + (size_t)MPR * DFF, DFF, WSP(bf16, WS_WFF2), DFF, DFF, 64, sk::FF2{WSP(bf16, WS_XB), F.out + O_YS}); }
#undef IN
#undef SEAM
}

extern "C" void kernel_launch(void* const* d_in, const int* in_sizes, int n_in, void* d_out, int out_size, void* d_ws, size_t ws_size, hipStream_t stream) {
    static int grid = 0;
    if (grid == 0) {
        if (n_in != 30 || out_size != (int)O_END || ws_size < WS_END) { fprintf(stderr, "kernel_launch: unexpected shapes (n_in %d out %d ws %zu)\n", n_in, out_size, ws_size); grid = -1; return; }
        int dev = 0, cus = 0, per_cu = 0;
        if (hipGetDevice(&dev) != hipSuccess || hipDeviceGetAttribute(&cus, hipDeviceAttributeMultiprocessorCount, dev) != hipSuccess) { grid = -1; return; }
        if (hipFuncSetAttribute((const void*)fwd, hipFuncAttributeMaxDynamicSharedMemorySize, LDS_BYTES) != hipSuccess) { fprintf(stderr, "kernel_launch: hipFuncSetAttribute failed\n"); grid = -1; return; }
        if (hipOccupancyMaxActiveBlocksPerMultiprocessor(&per_cu, (const void*)fwd, NWAVES * 64, LDS_BYTES) != hipSuccess || per_cu < 1) fprintf(stderr, "kernel_launch: occupancy query reports %d\n", per_cu);
        (void)hipGetLastError();
        grid = cus;
    }
    if (grid < 0) return;
    if (hipMemsetAsync((char*)d_ws + WS_CTL, 0, CTL_ZERO_BYTES, stream) != hipSuccess) return;
    Args a{};
    for (int i = 0; i < 30; ++i) a.in[i] = d_in[i];
    a.out = (float*)d_out; a.ws = (unsigned char*)d_ws;
#if MK_SPLIT
    for (int p = 0; p < N_PHASES; ++p) { a.ph_lo = p; a.ph_hi = p + 1; hipLaunchKernelGGL(fwd, dim3(grid), dim3(NWAVES * 64), LDS_BYTES, stream, a); }
#else
    a.ph_lo = 0; a.ph_hi = N_PHASES; hipLaunchKernelGGL(fwd, dim3(grid), dim3(NWAVES * 64), LDS_BYTES, stream, a);
#endif
#ifdef PROBE_EXTRA_PHASE
    a.ph_lo = PROBE_EXTRA_PHASE; a.ph_hi = PROBE_EXTRA_PHASE + 1;
#ifdef PROBE_SKIP
    a.probe = PROBE_SKIP;
#endif
    hipLaunchKernelGGL(fwd, dim3(grid), dim3(NWAVES * 64), LDS_BYTES, stream, a);
#endif
#ifdef PROBE_EXTRA_LO
    (void)hipMemsetAsync((char*)d_ws + WS_CTL, 0, CTL_ZERO_BYTES, stream);
    a.ph_lo = PROBE_EXTRA_LO; a.ph_hi = PROBE_EXTRA_HI;
#ifdef PROBE_SKIP
    a.probe = PROBE_SKIP;
#endif
    hipLaunchKernelGGL(fwd, dim3(grid), dim3(NWAVES * 64), LDS_BYTES, stream, a);
#endif
}
```

```cpp
#include <hip/hip_runtime.h>
#include <hip/hip_bf16.h>
#include <cstdio>
#include <cstdint>

#ifndef MK_SPLIT
#define MK_SPLIT 0
#endif

constexpr int DM = 2048, NB = 2, SEQ = 4096, MPR = NB * SEQ, DBT = 8, DSQ = 4, MSM = DBT * DSQ, MR = MPR + MSM, MPAD = 8448;
constexpr int DSSM = 1024, NG = 64, NST = 64, GC = 16, NH = 8, HD = 128, DATT = 1024, DFF = 5632, NIN = 8200;
constexpr int PAST = 16384, PAGE = 128, NPAGES = 128;
constexpr float RMS_EPS = 1e-6f;
constexpr float LOG2E = 1.4426950408889634f;
constexpr int CT = 16, NCHK = MPR / CT, CPB = SEQ / CT;

namespace pg8 {
#define PG8_LAS __attribute__((address_space(3)))
typedef unsigned short bf16_t;
typedef short bf16x8 __attribute__((ext_vector_type(8)));
typedef float f32x4 __attribute__((ext_vector_type(4)));
typedef unsigned u32x4 __attribute__((ext_vector_type(4)));
constexpr int BM = 256, BK = 64, HALF = 128, HTB = HALF * BK * 2  , STAGE_BYTES = 8 * HTB, NXCD = 8, WGM = 8;

__host__ __device__ __forceinline__ int lds_byte(int r, int c) { const int st = (r >> 4) * 2 + (c >> 5), rr = r & 15, cc = c & 31, ob = rr * 64 + cc * 2; return st * 1024 + (ob ^ (((ob >> 9) & 1) << 5)); }
__host__ __device__ __forceinline__ void stage_rc(int b, int& R, int& C) { const int st = b / 1024, sb = b % 1024, swz = sb ^ (((sb >> 9) & 1) << 5); R = (st >> 1) * 16 + swz / 64; C = (st & 1) * 32 + (swz % 64) / 2; }
__host__ __device__ __forceinline__ int perm32(int rho) { const int n = rho >> 4, i = rho & 15; return 8 * (i >> 2) + 4 * n + (i & 3); }

struct Unit { int pm, pn; };
struct Gemm { const bf16_t* A; const bf16_t* Bt; int M, N, K, lda, ldb; };

struct StaticOrder {
    int nM, nN, nwg, G, c;
    __host__ __device__ void init(int M, int N, int G_, int c_) { nM = M / BM; nN = N / BM; nwg = nM * nN; G = G_; c = c_; }
    __host__ __device__ bool next(int i, Unit& u) const {
        const long L = (long)i * G + c; if (L >= nwg) return false;
        int wgid = (int)L; { const int q = nwg / NXCD, r = nwg % NXCD, xcd = wgid % NXCD, off = wgid / NXCD; wgid = (xcd < r ? xcd * (q + 1) : r * (q + 1) + (xcd - r) * q) + off; }
        const int nig = WGM * nN, gid = wgid / nig, fm = gid * WGM, gsz = (nM - fm) < WGM ? (nM - fm) : WGM;
        u.pm = fm + ((wgid % nig) % gsz); u.pn = (wgid % nig) / gsz; return true;
    }
    __device__ __forceinline__ void a_ready(const Unit&) const {}
    __device__ __forceinline__ void done(const Unit&) const {}
};

__device__ __forceinline__ unsigned cvt_pk_bf16(float lo, float hi) { unsigned r; asm volatile("v_cvt_pk_bf16_f32 %0, %1, %2" : "=v"(r) : "v"(lo), "v"(hi)); return r; }
typedef float f32x2 __attribute__((ext_vector_type(2)));
__device__ __forceinline__ f32x2 gelu_pk(f32x2 v) {
    const f32x2 av = __builtin_elementwise_abs(v), d = av * 0.2316418882f + 1.0f;
    f32x2 t; t.x = __builtin_amdgcn_rcpf(d.x); t.y = __builtin_amdgcn_rcpf(d.y);
    f32x2 q = t * 0.5307027145f + (-0.7265760135f); q = q * t + 0.7107068705f; q = q * t + (-0.142248368f); q = q * t + 0.127414796f; q = q * t;
    const f32x2 s = (v * v) * (-0.72134752044f);
    f32x2 e; e.x = __builtin_amdgcn_exp2f(s.x); e.y = __builtin_amdgcn_exp2f(s.y);
    const f32x2 m = v * (q * e), r = v - m;
    f32x2 o; o.x = v.x < 0.f ? m.x : r.x; o.y = v.y < 0.f ? m.y : r.y; return o;
}

__device__ __forceinline__ float sigm(float x) { return __builtin_amdgcn_rcpf(1.0f + __builtin_amdgcn_exp2f(-1.4426950408889634f * x)); }
__device__ __forceinline__ float bflo(unsigned w) { return __uint_as_float(w << 16); }
__device__ __forceinline__ float bfhi(unsigned w) { return __uint_as_float(w & 0xffff0000u); }
__device__ __forceinline__ u32x4 pack8(f32x4 a, f32x4 b) { u32x4 w; w.x = cvt_pk_bf16(a[0], a[1]); w.y = cvt_pk_bf16(a[2], a[3]); w.z = cvt_pk_bf16(b[0], b[1]); w.w = cvt_pk_bf16(b[2], b[3]); return w; }
__device__ __forceinline__ void unpack8(u32x4 w, f32x4& a, f32x4& b) { a = (f32x4){bflo(w.x), bfhi(w.x), bflo(w.y), bfhi(w.y)}; b = (f32x4){bflo(w.z), bfhi(w.z), bflo(w.w), bfhi(w.w)}; }
#define PG8_EPI_ROWS  for (int ai = 0; ai < 2; ++ai) _Pragma("unroll") for (int m = 0; m < 4; ++m)

struct EpiIn {
    static constexpr bool PERM = true, AFTER_DRAIN = false, MIDK = false;
    bf16_t* G; const float* R1; bf16_t* UB; bf16_t* QB; bf16_t* KB; bf16_t* VB; float* outK; float* outV; const float* gq; const float* gk; PG8_LAS float* P;
    __device__ __forceinline__ void operator()(const f32x4 (&acc)[2][2][4][2], const Unit& u, int wr, int wc, int fr, int fq) const {
        const int row0 = u.pm * BM + wr * 64 + fr, col0 = u.pn * BM + wc * 32 + 8 * fq, pn = u.pn;
        if (pn >= 4 && pn < 12) {
            const bool isk = pn >= 8; const int d = wc * 32 + 8 * fq;
#pragma unroll
            PG8_EPI_ROWS { const int rl = ai * HALF + wr * 64 + m * 16 + fr; const float r1 = R1[row0 + ai * HALF + m * 16];
#pragma unroll
                for (int bj = 0; bj < 2; ++bj) { const f32x4 v0 = acc[ai][bj][m][0] * r1, v1 = acc[ai][bj][m][1] * r1;
                    float ss = (v0[0] * v0[0] + v0[1] * v0[1]) + (v0[2] * v0[2] + v0[3] * v0[3]) + (v1[0] * v1[0] + v1[1] * v1[1]) + (v1[2] * v1[2] + v1[3] * v1[3]);
                    ss += __shfl_xor(ss, 16); ss += __shfl_xor(ss, 32);
                    if (fq == 0) P[(rl * 2 + bj) * 4 + wc] = ss; } }
            asm volatile("s_waitcnt lgkmcnt(0)" ::: "memory"); __builtin_amdgcn_s_barrier(); asm volatile("" ::: "memory");
            const float* gp = isk ? gk : gq; const f32x4 g0 = *(const f32x4*)(gp + d), g1 = *(const f32x4*)(gp + d + 4);
            bf16_t* ob = isk ? KB : QB;
#pragma unroll
            PG8_EPI_ROWS { const int row = row0 + ai * HALF + m * 16, rl = ai * HALF + wr * 64 + m * 16 + fr; const float r1 = R1[row];
#pragma unroll
                for (int bj = 0; bj < 2; ++bj) { const f32x4 t = *(const PG8_LAS f32x4*)(P + (rl * 2 + bj) * 4);
                    const float sc = r1 * __builtin_amdgcn_rsqf(((t[0] + t[1]) + (t[2] + t[3])) * (1.0f / 128.0f) + RMS_EPS); const int head = (pn & 3) * 2 + bj;
                    const f32x4 o0 = acc[ai][bj][m][0] * sc * g0, o1 = acc[ai][bj][m][1] * sc * g1;
                    *(u32x4*)(ob + ((size_t)((row >> 12) * NH + head) * SEQ + (row & (SEQ - 1))) * HD + d) = pack8(o0, o1);
                    if (isk) { float* p = outK + (size_t)row * DATT + head * HD + d; *(f32x4*)p = o0; *(f32x4*)(p + 4) = o1; } } }
            return; }
#pragma unroll
        PG8_EPI_ROWS { const int row = row0 + ai * HALF + m * 16; const float r1 = R1[row];
#pragma unroll
            for (int bj = 0; bj < 2; ++bj) { const int c = col0 + bj * HALF; f32x4 v0 = acc[ai][bj][m][0] * r1, v1 = acc[ai][bj][m][1] * r1;
                if (pn < 4) { *(u32x4*)(UB + ((size_t)((c >> 4) * 512 + (row >> 4)) * 16 + (row & 15)) * 16 + (c & 15)) = pack8(v0, v1); }
                else if (pn < 16) { const int head = (pn & 3) * 2 + bj, d = wc * 32 + 8 * fq;
                    *(u32x4*)(VB + ((size_t)((row >> 12) * NH + head) * SEQ + (row & (SEQ - 1))) * HD + d) = pack8(v0, v1);
                    float* p = outV + (size_t)row * DATT + head * HD + d; *(f32x4*)p = v0; *(f32x4*)(p + 4) = v1; }
                else { v0 = (f32x4){sigm(v0[0]), sigm(v0[1]), sigm(v0[2]), sigm(v0[3])}; v1 = (f32x4){sigm(v1[0]), sigm(v1[1]), sigm(v1[2]), sigm(v1[3])};
                       *(u32x4*)(G + (size_t)row * 4096 + (c - 4096)) = pack8(v0, v1); } } }
    }
};
struct EpiGlu {
    static constexpr bool PERM = true, AFTER_DRAIN = false, MIDK = false;
    const bf16_t* YP; bf16_t* YY; const float* bias;
    __device__ __forceinline__ void operator()(const f32x4 (&acc)[2][2][4][2], const Unit& u, int wr, int wc, int fr, int fq) const {
        const int row0 = u.pm * BM + wr * 64 + fr, col0 = u.pn * BM + wc * 32 + 8 * fq;
#pragma unroll
        PG8_EPI_ROWS { const int row = row0 + ai * HALF + m * 16;
#pragma unroll
            for (int bj = 0; bj < 2; ++bj) { const int c = col0 + bj * HALF; const f32x4 b0 = *(const f32x4*)(bias + c), b1 = *(const f32x4*)(bias + c + 4);
                f32x4 y0, y1; unpack8(*(const u32x4*)(YP + (size_t)row * 1024 + c), y0, y1);
                const f32x4 a0 = acc[ai][bj][m][0] + b0, a1 = acc[ai][bj][m][1] + b1;
                y0 = (f32x4){y0[0] * sigm(a0[0]), y0[1] * sigm(a0[1]), y0[2] * sigm(a0[2]), y0[3] * sigm(a0[3])};
                y1 = (f32x4){y1[0] * sigm(a1[0]), y1[1] * sigm(a1[1]), y1[2] * sigm(a1[2]), y1[3] * sigm(a1[3])};
                *(u32x4*)(YY + (size_t)row * 2048 + c) = pack8(y0, y1); } }
    }
};
struct EpiMerge {
    static constexpr bool PERM = true, AFTER_DRAIN = false, MIDK = true;
    const bf16_t* G; bf16_t* MG;
    __device__ __forceinline__ void mid(f32x4 (&acc)[2][2][4][2], const Unit& u, int wr, int wc, int fr, int fq) const {
        int off = (u.pm * BM + wr * 64 + fr) * 4096 + u.pn * BM + wc * 32 + 8 * fq;
        asm volatile("" : "+v"(off));
#pragma unroll
        PG8_EPI_ROWS {
#pragma unroll
            for (int bj = 0; bj < 2; ++bj) { const bf16_t* gp = G + (off + bj * HALF); f32x4 a0, a1, b0, b1; unpack8(*(const u32x4*)gp, a0, a1); unpack8(*(const u32x4*)(gp + 2048), b0, b1);
                acc[ai][bj][m][0] = acc[ai][bj][m][0] * (f32x4){a0[0] * __builtin_amdgcn_rcpf(b0[0]), a0[1] * __builtin_amdgcn_rcpf(b0[1]), a0[2] * __builtin_amdgcn_rcpf(b0[2]), a0[3] * __builtin_amdgcn_rcpf(b0[3])};
                acc[ai][bj][m][1] = acc[ai][bj][m][1] * (f32x4){a1[0] * __builtin_amdgcn_rcpf(b1[0]), a1[1] * __builtin_amdgcn_rcpf(b1[1]), a1[2] * __builtin_amdgcn_rcpf(b1[2]), a1[3] * __builtin_amdgcn_rcpf(b1[3])}; }
            off += (m == 3) ? (HALF - 48) * 4096 : 16 * 4096; asm volatile("" : "+v"(off)); }
    }
    __device__ __forceinline__ void operator()(const f32x4 (&acc)[2][2][4][2], const Unit& u, int wr, int wc, int fr, int fq) const {
        const int row0 = u.pm * BM + wr * 64 + fr, col0 = u.pn * BM + wc * 32 + 8 * fq;
#pragma unroll
        PG8_EPI_ROWS { const int row = row0 + ai * HALF + m * 16;
#pragma unroll
            for (int bj = 0; bj < 2; ++bj) { const int c = col0 + bj * HALF; f32x4 g0, g1; unpack8(*(const u32x4*)(G + (size_t)row * 4096 + 2048 + c), g0, g1);
                *(u32x4*)(MG + (size_t)row * 2048 + c) = pack8(acc[ai][bj][m][0] * g0, acc[ai][bj][m][1] * g1); } }
    }
};
struct EpiOut {
    static constexpr bool PERM = true, AFTER_DRAIN = false, MIDK = false;
    const float* xp; const float* xs; bf16_t* XB; float* SSR;
    __device__ __forceinline__ void operator()(const f32x4 (&acc)[2][2][4][2], const Unit& u, int wr, int wc, int fr, int fq) const {
        const int row0 = u.pm * BM + wr * 64 + fr, col0 = u.pn * BM + wc * 32 + 8 * fq;
#pragma unroll
        PG8_EPI_ROWS { const int row = row0 + ai * HALF + m * 16;
            const float* xr = row < MPR ? xp + (size_t)row * 2048 : xs + (size_t)(row < MR ? row - MPR : 0) * 2048; const bool live = row < MR; float s = 0.f;
#pragma unroll
            for (int bj = 0; bj < 2; ++bj) { const int c = col0 + bj * HALF; f32x4 x0 = (f32x4){0.f, 0.f, 0.f, 0.f}, x1 = x0;
                if (live) { x0 = *(const f32x4*)(xr + c); x1 = *(const f32x4*)(xr + c + 4); }
                x0 = x0 + acc[ai][bj][m][0]; x1 = x1 + acc[ai][bj][m][1];
                s += (x0[0] * x0[0] + x0[1] * x0[1]) + (x0[2] * x0[2] + x0[3] * x0[3]) + (x1[0] * x1[0] + x1[1] * x1[1]) + (x1[2] * x1[2] + x1[3] * x1[3]);
                *(u32x4*)(XB + (size_t)row * 2048 + c) = pack8(x0, x1); }
            s += __shfl_xor(s, 16); s += __shfl_xor(s, 32);
            if (fq == 0) __hip_atomic_fetch_add(SSR + row, s, __ATOMIC_RELAXED, __HIP_MEMORY_SCOPE_AGENT); }
    }
};
struct EpiFF1 {
    static constexpr bool PERM = true, AFTER_DRAIN = false, MIDK = false;
    const float* SSR; bf16_t* H; int probe;
    __device__ __forceinline__ void operator()(const f32x4 (&acc)[2][2][4][2], const Unit& u, int wr, int wc, int fr, int fq) const {
        if (probe & 8) { if (acc[0][0][0][0][0] == 123.456f) H[0] = 0; return; }
        const int row0 = u.pm * BM + wr * 64 + fr, col0 = u.pn * HALF + wc * 32 + 8 * fq;
#pragma unroll
        PG8_EPI_ROWS { const int row = row0 + ai * HALF + m * 16;
            const float r2 = __builtin_amdgcn_rsqf(SSR[row] * (1.0f / 2048.0f) + RMS_EPS);
            f32x4 o[2];
#pragma unroll
            for (int n = 0; n < 2; ++n) { const f32x4 g = acc[ai][0][m][n] * r2, up = acc[ai][1][m][n] * r2;
                o[n] = (f32x4){g[0] * sigm(g[0]) * up[0], g[1] * sigm(g[1]) * up[1], g[2] * sigm(g[2]) * up[2], g[3] * sigm(g[3]) * up[3]}; }
            *(u32x4*)(H + (size_t)row * DFF + col0) = pack8(o[0], o[1]); }
    }
};
struct EpiFF2 {
    static constexpr bool PERM = true, AFTER_DRAIN = false, MIDK = false;
    const bf16_t* XB; float* yp; float* ys;
    __device__ __forceinline__ void operator()(const f32x4 (&acc)[2][2][4][2], const Unit& u, int wr, int wc, int fr, int fq) const {
        const int row0 = u.pm * BM + wr * 64 + fr, col0 = u.pn * BM + wc * 32 + 8 * fq;
#pragma unroll
        PG8_EPI_ROWS { const int row = row0 + ai * HALF + m * 16; if (row >= MR) continue;
            float* orow = row < MPR ? yp + (size_t)row * 2048 : ys + (size_t)(row - MPR) * 2048;
#pragma unroll
            for (int bj = 0; bj < 2; ++bj) { const int c = col0 + bj * HALF; f32x4 x0, x1; unpack8(*(const u32x4*)(XB + (size_t)row * 2048 + c), x0, x1);
                *(f32x4*)(orow + c) = x0 + acc[ai][bj][m][0]; *(f32x4*)(orow + c + 4) = x1 + acc[ai][bj][m][1]; } }
    }
};
template <class Epi, class Sched, bool ALIGN_EPI = false, bool SP2 = false>
__device__ __forceinline__ void gemm_phase(PG8_LAS unsigned char* lds, const Gemm g, const Sched& S, const Epi& E, int wid_in, int lane_in) {
    const int wid = wid_in, lane = lane_in, tid = wid * 64 + lane, wr = wid >> 2, wc = wid & 3, fr = lane & 15, fq = lane >> 4;
    const int K = g.K, nt = K / BK;
    unsigned voffA[2], voffB[2];
#pragma unroll
    for (int i = 0; i < 2; ++i) { int R, C; stage_rc(tid * 16 + i * 8192, R, C); const int Rb = Epi::PERM ? ((R & ~31) + perm32(R & 31)) : R;
        voffA[i] = (unsigned)(R * g.lda + C) * 2u; voffB[i] = (unsigned)(Rb * g.ldb + C) * 2u; }
    const size_t kstep = (size_t)(BK * 2);
    const size_t hsA = (size_t)HALF * g.lda * 2, hsB = (size_t)HALF * g.ldb * 2;
    const size_t tsA = 2 * hsA, tsB = 2 * hsB;
    const unsigned ldsw = (unsigned)wid * 1024u;
    const int aoff = lds_byte(wr * 64 + fr, fq * 8), boff = lds_byte(wc * 32 + fr, fq * 8);
#define PG8_SA(b, h) (((b) * 2 + (h)) * HTB)
#define PG8_SB(b, h) ((4 + (b) * 2 + (h)) * HTB)
#define PG8_STAGE(bufoff, gbase, voff) do { _Pragma("unroll") for (int _i = 0; _i < 2; ++_i) \
        __builtin_amdgcn_global_load_lds((const unsigned*)((const char*)(gbase) + (voff)[_i]), (PG8_LAS unsigned*)(lds + (bufoff) + ldsw + _i * 8192), 16, 0, 0); } while (0)
#define PG8_LDA(dst, b, h) do { _Pragma("unroll") for (int m = 0; m < 4; ++m) _Pragma("unroll") for (int k = 0; k < 2; ++k) dst[m][k] = *(const PG8_LAS bf16x8*)(lds + PG8_SA(b, h) + aoff + m * 2048 + k * 1024); } while (0)
#define PG8_LDB(dst, b, h) do { _Pragma("unroll") for (int n = 0; n < 2; ++n) _Pragma("unroll") for (int k = 0; k < 2; ++k) dst[n][k] = *(const PG8_LAS bf16x8*)(lds + PG8_SB(b, h) + boff + n * 2048 + k * 1024); } while (0)
#define PG8_MMA(ai, bj, At, Bt) do { __builtin_amdgcn_s_setprio(1); _Pragma("unroll") for (int m = 0; m < 4; ++m) _Pragma("unroll") for (int n = 0; n < 2; ++n) _Pragma("unroll") for (int k = 0; k < 2; ++k) \
        acc[ai][bj][m][n] = __builtin_amdgcn_mfma_f32_16x16x32_bf16(Bt[n][k], At[m][k], acc[ai][bj][m][n], 0, 0, 0); __builtin_amdgcn_s_setprio(0); } while (0)
#define PG8_WAIT_V(n) asm volatile("s_waitcnt vmcnt(" #n ")" ::: "memory")
#define PG8_WAIT_L(n) asm volatile("s_waitcnt lgkmcnt(" #n ")" ::: "memory")
#define PG8_BAR __builtin_amdgcn_s_barrier()
#define PG8_SCHED __builtin_amdgcn_sched_barrier(0)
    Unit cur, nxt; int ui = 0;
    if (!S.next(0, cur)) return;
    f32x4 acc[2][2][4][2];
#pragma unroll
    for (int a = 0; a < 2; ++a)
#pragma unroll
        for (int b = 0; b < 2; ++b)
#pragma unroll
            for (int m = 0; m < 4; ++m)
#pragma unroll
                for (int n = 0; n < 2; ++n) acc[a][b][m][n] = (f32x4){0.f, 0.f, 0.f, 0.f};
    bf16x8 At[4][2], B0[2][2], B1[2][2];
    const char* cA = (const char*)g.A + (size_t)cur.pm * tsA; const char* cB = (const char*)g.Bt + (size_t)cur.pn * tsB;
    S.a_ready(cur);
    if constexpr (SP2) {
        PG8_STAGE(PG8_SB(0, 0), cB, voffB); PG8_STAGE(PG8_SB(0, 1), cB + hsB, voffB); PG8_STAGE(PG8_SA(0, 0), cA, voffA); PG8_STAGE(PG8_SA(0, 1), cA + hsA, voffA);
        if (wr == 1) PG8_BAR;
        PG8_WAIT_V(2); PG8_BAR;
        PG8_STAGE(PG8_SB(1, 0), cB + kstep, voffB); PG8_STAGE(PG8_SA(1, 0), cA + kstep, voffA); PG8_STAGE(PG8_SB(1, 1), cB + hsB + kstep, voffB);
        PG8_WAIT_V(6); PG8_BAR;
    } else {
        PG8_STAGE(PG8_SB(0, 0), cB, voffB); PG8_STAGE(PG8_SA(0, 0), cA, voffA); PG8_STAGE(PG8_SB(0, 1), cB + hsB, voffB); PG8_STAGE(PG8_SA(0, 1), cA + hsA, voffA);
        if (wr == 1) PG8_BAR;
        PG8_WAIT_V(4); PG8_BAR;
        PG8_STAGE(PG8_SB(1, 0), cB + kstep, voffB); PG8_STAGE(PG8_SA(1, 0), cA + kstep, voffA); PG8_STAGE(PG8_SB(1, 1), cB + hsB + kstep, voffB);
        PG8_WAIT_V(6); PG8_BAR;
    }
    for (;;) {
        const bool has_next = S.next(ui + 1, nxt);
        const char* nA = has_next ? (const char*)g.A + (size_t)nxt.pm * tsA : cA; const char* nB = has_next ? (const char*)g.Bt + (size_t)nxt.pn * tsB : cB;
        for (int t = 0; t < nt; t += 2) {
            if constexpr (Epi::MIDK) { if (t == (nt >> 1)) E.mid(acc, cur, wr, wc, fr, fq); }
            const bool last = (t == nt - 2);
            const char* a1 = cA + (size_t)(t + 1) * kstep;
            const char* a2 = last ? nA : cA + (size_t)(t + 2) * kstep; const char* b2 = last ? nB : cB + (size_t)(t + 2) * kstep;
            const char* a3 = a2 + kstep; const char* b3 = b2 + kstep;
            if (last && has_next) S.a_ready(nxt);
            if constexpr (SP2) {
            PG8_LDB(B0, 0, 0); PG8_LDB(B1, 0, 1); PG8_SCHED; PG8_LDA(At, 0, 0); PG8_STAGE(PG8_SA(1, 1), a1 + hsA, voffA);
            PG8_WAIT_V(8); PG8_WAIT_L(0); PG8_BAR; PG8_MMA(0, 0, At, B0); PG8_MMA(0, 1, At, B1); PG8_BAR; PG8_SCHED;
            PG8_LDA(At, 0, 1); PG8_STAGE(PG8_SB(0, 0), b2, voffB); PG8_STAGE(PG8_SB(0, 1), b2 + hsB, voffB); PG8_STAGE(PG8_SA(0, 0), a2, voffA);
            PG8_WAIT_V(8); PG8_WAIT_L(0); PG8_BAR; PG8_MMA(1, 0, At, B0); PG8_MMA(1, 1, At, B1); PG8_BAR; PG8_SCHED;
            PG8_LDB(B0, 1, 0); PG8_LDB(B1, 1, 1); PG8_SCHED; PG8_LDA(At, 1, 0); PG8_STAGE(PG8_SA(0, 1), a2 + hsA, voffA);
            PG8_WAIT_V(8); PG8_WAIT_L(0); PG8_BAR; PG8_MMA(0, 0, At, B0); PG8_MMA(0, 1, At, B1); PG8_BAR; PG8_SCHED;
            PG8_LDA(At, 1, 1); PG8_STAGE(PG8_SB(1, 0), b3, voffB); PG8_STAGE(PG8_SB(1, 1), b3 + hsB, voffB); PG8_STAGE(PG8_SA(1, 0), a3, voffA);
            PG8_WAIT_V(8); PG8_WAIT_L(0); PG8_BAR; PG8_MMA(1, 0, At, B0); PG8_MMA(1, 1, At, B1); PG8_BAR; PG8_SCHED;
            } else {
            PG8_LDB(B0, 0, 0); PG8_SCHED; PG8_LDA(At, 0, 0); PG8_STAGE(PG8_SA(1, 1), a1 + hsA, voffA);
            PG8_WAIT_L(8); PG8_BAR; PG8_WAIT_L(0); PG8_MMA(0, 0, At, B0); PG8_BAR; PG8_SCHED;
            PG8_LDB(B1, 0, 1); PG8_STAGE(PG8_SB(0, 0), b2, voffB);
            PG8_BAR; PG8_WAIT_L(0); PG8_MMA(0, 1, At, B1); PG8_BAR;
            PG8_LDA(At, 0, 1); PG8_STAGE(PG8_SA(0, 0), a2, voffA);
            PG8_BAR; PG8_WAIT_L(0); PG8_MMA(1, 0, At, B0); PG8_BAR; PG8_SCHED;
            PG8_STAGE(PG8_SB(0, 1), b2 + hsB, voffB);
            PG8_WAIT_V(6); PG8_BAR; PG8_MMA(1, 1, At, B1); PG8_BAR;
            PG8_LDB(B0, 1, 0); PG8_SCHED; PG8_LDA(At, 1, 0); PG8_STAGE(PG8_SA(0, 1), a2 + hsA, voffA);
            PG8_WAIT_L(8); PG8_BAR; PG8_WAIT_L(0); PG8_MMA(0, 0, At, B0); PG8_BAR; PG8_SCHED;
            PG8_LDB(B1, 1, 1); PG8_STAGE(PG8_SB(1, 0), b3, voffB);
            PG8_BAR; PG8_WAIT_L(0); PG8_MMA(0, 1, At, B1); PG8_BAR;
            PG8_LDA(At, 1, 1); PG8_STAGE(PG8_SA(1, 0), a3, voffA);
            PG8_BAR; PG8_WAIT_L(0); PG8_MMA(1, 0, At, B0); PG8_BAR; PG8_SCHED;
            PG8_STAGE(PG8_SB(1, 1), b3 + hsB, voffB);
            PG8_WAIT_V(6); PG8_BAR; PG8_MMA(1, 1, At, B1); PG8_BAR;
            }
        }
        if constexpr (ALIGN_EPI) { if (wr == 0) PG8_BAR; }
        if constexpr (!Epi::AFTER_DRAIN) { E(acc, cur, wr, wc, fr, fq); S.done(cur); }
        if (!has_next) break;
#pragma unroll
        for (int a = 0; a < 2; ++a)
#pragma unroll
            for (int b = 0; b < 2; ++b)
#pragma unroll
                for (int m = 0; m < 4; ++m)
#pragma unroll
                    for (int n = 0; n < 2; ++n) acc[a][b][m][n] = (f32x4){0.f, 0.f, 0.f, 0.f};
        cur = nxt; cA = nA; cB = nB; ++ui;
        if constexpr (ALIGN_EPI) { if (wr == 1) PG8_BAR; }
    }
    PG8_WAIT_V(0);
    if constexpr (!ALIGN_EPI) { if (wr == 0) PG8_BAR; }
    PG8_BAR;
    if constexpr (Epi::AFTER_DRAIN) { E.fused(acc, cur, wr, wc, fr, fq, lds, wid, lane); S.done(cur); }
#undef PG8_SA
#undef PG8_SB
#undef PG8_STAGE
#undef PG8_LDA
#undef PG8_LDB
#undef PG8_MMA
#undef PG8_WAIT_V
#undef PG8_WAIT_L
#undef PG8_BAR
#undef PG8_SCHED
}
}
namespace pattn {
constexpr int D = 128; constexpr float THR = 8.f; constexpr bool WSKIP = false;
constexpr float SCALE = 0.08838834764831845f;
constexpr int NW = 8, QBLK = 32, KVBLK = 64, QB = NW * QBLK;
constexpr int SHM_V = KVBLK * D * 2, SHM_K = KVBLK * D * 2;
constexpr int LDS_CK = 2 * SHM_V + 2 * SHM_K + NW * 64 * 4;
constexpr int LDS_BYTES = LDS_CK + 2 * 2048;
constexpr int OSTR = 2048;
using bf16 = __hip_bfloat16;
typedef short bf16x8 __attribute__((ext_vector_type(8)));
typedef short s16x4 __attribute__((ext_vector_type(4)));
typedef float f32x16 __attribute__((ext_vector_type(16)));
typedef float f32x4 __attribute__((ext_vector_type(4)));
typedef unsigned u32x4 __attribute__((ext_vector_type(4)));
template <class A, class Bt> struct same_t { static constexpr bool v = false; };
template <class A> struct same_t<A, A> { static constexpr bool v = true; };

#define KSWZ(row, colB) ((row) * 256 + ((colB) ^ (((row) & 7) << 4)))
#define SBAR() __builtin_amdgcn_sched_barrier(0)
__device__ __forceinline__ int v_st(int k, int c) { const int kk = (k & ~0xC) | ((k & 4) << 1) | ((k & 8) >> 1); return ((kk >> 3) * 4 + (c >> 5)) * 512 + ((kk & 7) * 32 + (c & 31)) * 2; }
__device__ __forceinline__ int v_rd_base(int lane) { return ((lane & 3) << 3) | (((lane >> 2) & 3) << 6) | (((lane >> 4) & 1) << 5) | (((lane >> 5) & 1) << 8); }
constexpr int v_rd_off(int d0, int ks, int half) { return d0 * 512 + ks * 4096 + half * 2048; }
__device__ __forceinline__ int crow(int r, int hi) { return (r & 3) + 8 * (r >> 2) + 4 * hi; }
__device__ __forceinline__ unsigned cvtpk(float lo, float hi) {
    unsigned r; asm volatile("v_cvt_pk_bf16_f32 %0, %1, %2" : "=v"(r) : "v"(lo), "v"(hi)); return r;
}
__device__ __forceinline__ bf16x8 pack8(f32x4 a, f32x4 b) {
    u32x4 w = {cvtpk(a[0], a[1]), cvtpk(a[2], a[3]), cvtpk(b[0], b[1]), cvtpk(b[2], b[3])};
    return *reinterpret_cast<bf16x8*>(&w);
}
template <class T> __device__ __forceinline__ bf16x8 load8(const T* p) {
    if constexpr (same_t<T, float>::v) { return pack8(*(const f32x4*)p, *(const f32x4*)(p + 4)); }
    else { return *reinterpret_cast<const bf16x8*>(p); }
}
__device__ __forceinline__ void mask_tile(f32x16& p0, f32x16& p1, int dq, unsigned W) {
    const float NEG = -__builtin_inff();
#pragma unroll
    for (int r = 0; r < 16; ++r) {
        const int c = (r & 3) + 8 * (r >> 2);
        if ((unsigned)(dq - c) >= W) p0[r] = NEG;
        if ((unsigned)(dq - c - 32) >= W) p1[r] = NEG;
    }
}
__device__ __forceinline__ void partialSM(f32x16& p0, f32x16& p1, float& m_reg, float& mn, float& alpha) {
    constexpr float C2 = 1.4426950408889634f * SCALE; mn = 0.f; alpha = 1.f;
    for (int r = 0; r < 16; ++r) p0[r] = fmaf(p0[r], C2, m_reg); for (int r = 0; r < 16; ++r) p1[r] = fmaf(p1[r], C2, m_reg);
    for (int r = 0; r < 16; ++r) p0[r] = __builtin_amdgcn_exp2f(p0[r]);
}
__device__ __forceinline__ void finishSM(f32x16& p0, f32x16& p1, float alpha, float& l_reg, bf16x8& pa0, bf16x8& pa1, bf16x8& pa2, bf16x8& pa3) {
    for (int r = 0; r < 16; ++r) p1[r] = __builtin_amdgcn_exp2f(p1[r]);
    float ps = 0; for (int r = 0; r < 16; ++r) ps += p0[r]; for (int r = 0; r < 16; ++r) ps += p1[r];
    { auto rr = __builtin_amdgcn_permlane32_swap(__float_as_uint(ps), __float_as_uint(ps), false, false);
      ps = __uint_as_float(rr[0]) + __uint_as_float(rr[1]); }
    l_reg = l_reg * alpha + ps;
#define PK4(P, B_, OUT) do { unsigned a0 = cvtpk(P[B_+0], P[B_+1]), a1 = cvtpk(P[B_+2], P[B_+3]);                          \
        unsigned b0 = cvtpk(P[B_+4], P[B_+5]), b1 = cvtpk(P[B_+6], P[B_+7]);                                             \
        auto r0 = __builtin_amdgcn_permlane32_swap(a0, b0, false, false); auto r1 = __builtin_amdgcn_permlane32_swap(a1, b1, false, false); \
        u32x4 w = {r0[0], r1[0], r0[1], r1[1]}; OUT = *reinterpret_cast<bf16x8*>(&w); } while (0)
    PK4(p0, 0, pa0); PK4(p0, 8, pa1); PK4(p1, 0, pa2); PK4(p1, 8, pa3);
#undef PK4
}
template <int KB, bool SK>
__device__ __forceinline__ void qkt(f32x16& p0, f32x16& p1, const char* K_lds, const char* CK_lds, int r32, int hi, const bf16x8* qr, bool act) {
    if (SK && !act) { const float NEG = -__builtin_inff();
#pragma unroll
        for (int r = 0; r < 16; ++r) { p0[r] = NEG; p1[r] = NEG; } return; }
    p0 = f32x16{}; p1 = f32x16{};
    const char* kb[4];
#pragma unroll
    for (int dd = 0; dd < 4; ++dd) kb[dd] = K_lds + KB * SHM_K + KSWZ(r32, (dd * 16 + hi * 8) * 2);
#pragma unroll
    for (int d0 = 0; d0 < 8; ++d0) { const char* a = kb[d0 & 3] + (d0 >> 2) * 128;
        bf16x8 b0 = *reinterpret_cast<const bf16x8*>(a);
        bf16x8 b1 = *reinterpret_cast<const bf16x8*>(a + 32 * 256);
        p0 = __builtin_amdgcn_mfma_f32_32x32x16_bf16(b0, qr[d0], p0, 0, 0, 0);
        p1 = __builtin_amdgcn_mfma_f32_32x32x16_bf16(b1, qr[d0], p1, 0, 0, 0); }
#ifndef NO_FOX
    {
        const char* a = CK_lds + KB * 2048 + r32 * 32 + hi * 16; const bf16x8 c0 = *reinterpret_cast<const bf16x8*>(a), c1 = *reinterpret_cast<const bf16x8*>(a + 1024);
        const short one = (short)0x3F80; const bf16x8 ones = {one, one, one, one, one, one, one, one};
        p0 = __builtin_amdgcn_mfma_f32_32x32x16_bf16(c0, ones, p0, 0, 0, 0); p1 = __builtin_amdgcn_mfma_f32_32x32x16_bf16(c1, ones, p1, 0, 0, 0); }
#endif
}
template <int VB, bool SK>
__device__ __forceinline__ void pv_tile(f32x16* o, int vb0, bf16x8 pa0, bf16x8 pa1, bf16x8 pa2, bf16x8 pa3, bool act) {
    if (SK && !act) return;
#define TRRD(dst, off) asm volatile("ds_read_b64_tr_b16 %0, %1 offset:%2" : "=&v"(dst) : "v"(vb0), "i"(off) : "memory")
#define PV_D0(d0) do { s16x4 l0, l1, l2, l3, h0, h1, h2, h3; constexpr int b_ = VB * SHM_V + v_rd_off(d0, 0, 0);     \
        TRRD(l0, b_); TRRD(h0, b_ + 2048); TRRD(l1, b_ + 4096); TRRD(h1, b_ + 6144); TRRD(l2, b_ + 8192); TRRD(h2, b_ + 10240); TRRD(l3, b_ + 12288); TRRD(h3, b_ + 14336); \
        asm volatile("s_waitcnt lgkmcnt(0)" ::: "memory"); SBAR();                 \
        o[d0] = __builtin_amdgcn_mfma_f32_32x32x16_bf16(pa0, (bf16x8){l0[0], l0[1], l0[2], l0[3], h0[0], h0[1], h0[2], h0[3]}, o[d0], 0, 0, 0);   \
        o[d0] = __builtin_amdgcn_mfma_f32_32x32x16_bf16(pa1, (bf16x8){l1[0], l1[1], l1[2], l1[3], h1[0], h1[1], h1[2], h1[3]}, o[d0], 0, 0, 0);   \
        o[d0] = __builtin_amdgcn_mfma_f32_32x32x16_bf16(pa2, (bf16x8){l2[0], l2[1], l2[2], l2[3], h2[0], h2[1], h2[2], h2[3]}, o[d0], 0, 0, 0);   \
        o[d0] = __builtin_amdgcn_mfma_f32_32x32x16_bf16(pa3, (bf16x8){l3[0], l3[1], l3[2], l3[3], h3[0], h3[1], h3[2], h3[3]}, o[d0], 0, 0, 0); } while (0)
    PV_D0(0); PV_D0(1); PV_D0(2); PV_D0(3);
#undef PV_D0
#undef TRRD
}

template <class TIn, class TOut> struct BlockRef { const TIn* Q; const TIn* K; const TIn* V; TOut* O; const unsigned short* CK; const float* XF; int P0, jlo; float negb2; };
template <class TIn> struct Seam {
    bf16x8 qr[8];
    bf16x8 st_v0, st_v1, st_k0, st_k1; f32x4 sf0, sf1, sf2, sf3;
    f32x4 tq[16];
};
__device__ __forceinline__ int swa_jlo(int P0, int W) { const int lowk = P0 - W + 1; return lowk > 0 ? lowk / KVBLK : 0; }
#define ROW(p, k0, rr) ((p) + (int)(((k0) + (rr)) * D + sc))
#define VMW() asm volatile("s_waitcnt vmcnt(0)" ::: "memory")
#define VMWN(n) asm volatile("s_waitcnt vmcnt(%0)" :: "i"(n) : "memory")
#define SLOAD_H(Kp, Vp, CKp, k0, bf) do { S.st_v0 = load8<TIn>(ROW(Vp, k0, sr)); S.st_v1 = load8<TIn>(ROW(Vp, k0, 32 + sr));              \
                         S.st_k0 = load8<TIn>(ROW(Kp, k0, sr)); S.st_k1 = load8<TIn>(ROW(Kp, k0, 32 + sr)); if (wid < 2) __builtin_amdgcn_global_load_lds((const unsigned*)((CKp) + (int)(((k0) + wid * 32) * 16 + lane * 8)), (__attribute__((address_space(3))) unsigned*)(CK_lds + (bf) * 2048 + wid * 1024), 16, 0, 0); } while (0)
#define SWRITE_HK(bf) do { *(bf16x8*)(K_lds + (bf) * SHM_K + kws) = S.st_k0; *(bf16x8*)(K_lds + (bf) * SHM_K + kws + 32 * 256) = S.st_k1; } while (0)
#define SWRITE_HV(bf) do { *(bf16x8*)(V_lds + (bf) * SHM_V + vst0) = S.st_v0; *(bf16x8*)(V_lds + (bf) * SHM_V + vst1) = S.st_v1; } while (0)
#define SWRITE_H(bf) do { SWRITE_HV(bf); SWRITE_HK(bf); } while (0)
#define SLOAD_F(p, k0) do { S.sf0 = *(const f32x4*)ROW(p, k0, sr); S.sf1 = *(const f32x4*)(ROW(p, k0, sr) + 4);                \
                            S.sf2 = *(const f32x4*)ROW(p, k0, 32 + sr); S.sf3 = *(const f32x4*)(ROW(p, k0, 32 + sr) + 4); } while (0)
#define SWRITE_KF(bf) do { *(bf16x8*)(K_lds + (bf) * SHM_K + kws) = pack8(S.sf0, S.sf1); *(bf16x8*)(K_lds + (bf) * SHM_K + kws + 32 * 256) = pack8(S.sf2, S.sf3); } while (0)
#define SWRITE_VF(bf) do { *(bf16x8*)(V_lds + (bf) * SHM_V + vst0) = pack8(S.sf0, S.sf1); *(bf16x8*)(V_lds + (bf) * SHM_V + vst1) = pack8(S.sf2, S.sf3); } while (0)
template <class TIn, class TOut>
__device__ __forceinline__ void causal_swa_prime(const BlockRef<TIn, TOut>& cur, int W, char* lds, Seam<TIn>& S, int wid_in, int lane_in) {
    constexpr bool F32 = same_t<TIn, float>::v;
    const int wid = wid_in, lane = lane_in, tid = wid * 64 + lane, r32 = lane & 31, hi = lane >> 5;
    const int sr = tid >> 4, sc = (tid & 15) * 8, kws = KSWZ(sr, sc * 2); char* K_lds = lds + 2 * SHM_V; char* CK_lds = lds + LDS_CK;
    const int kb0 = cur.jlo * KVBLK;
    for (int d0 = 0; d0 < 8; ++d0) S.qr[d0] = load8<TIn>(cur.Q + ((wid * QBLK + r32) * D + hi * 8) + d0 * 16);
    if constexpr (F32) { SLOAD_F((const float*)cur.K, kb0); VMW(); SWRITE_KF(0); SBAR(); SLOAD_F((const float*)cur.V, kb0); }
    else { SLOAD_H(cur.K, cur.V, cur.CK, kb0, 0); VMW(); SWRITE_HK(0); }
    __syncthreads();
}
template <class TIn, class TOut>
__device__ __forceinline__ void causal_swa_block(const BlockRef<TIn, TOut>& cur, const BlockRef<TIn, TOut>& nxt, int skv, int W, char* lds, Seam<TIn>& S, int wid_in, int lane_in) {
    constexpr bool F32 = same_t<TIn, float>::v;
    const int wid = wid_in, lane = lane_in, tid = wid * 64 + lane, r32 = lane & 31, hi = lane >> 5;
    const int j_lo = cur.jlo;
    int j_hi = (cur.P0 + QB - 1) / KVBLK + 1; if (j_hi > skv / KVBLK) j_hi = skv / KVBLK;
    const int NT = j_hi - j_lo;
    const int kbn = nxt.jlo * KVBLK;
    const int qlo = cur.P0 + wid * QBLK, qm = qlo + r32 - 4 * hi;
    char* V_lds = lds; char* K_lds = lds + 2 * SHM_V; char* CK_lds = lds + LDS_CK;
    float* ws = (float*)(lds + 2 * SHM_V + 2 * SHM_K) + wid * 64; float* li_l = ws, * al_l = ws + 32;
    float m_reg = cur.negb2 - (1.4426950408889634f * SCALE) * cur.XF[cur.P0 + wid * QBLK + r32], l_reg = 0; f32x16 o[4] = {};
    const int sr = tid >> 4, sc = (tid & 15) * 8, vst0 = v_st(sr, sc), vst1 = v_st(32 + sr, sc), kws = KSWZ(sr, sc * 2);
    const int vb0 = (int)(uintptr_t)V_lds + v_rd_base(lane);
    const TIn* Kh = cur.K; const TIn* Vh = cur.V; const unsigned short* CKh = cur.CK;
#define RESC(a) do { if (__any((a) < 1.f)) { if (hi == 0) al_l[r32] = (a); asm volatile("s_waitcnt lgkmcnt(0)" ::: "memory");              \
                     for (int d_ = 0; d_ < 4; ++d_) for (int r = 0; r < 16; ++r) o[d_][r] *= al_l[crow(r, hi)]; } } while (0)
#define KBASE(t) ((j_lo + (t)) * KVBLK)
#define ACT(t) (KBASE(t) <= qlo + QBLK - 1 && KBASE(t) + KVBLK - 1 >= qlo - W + 1)
#define MASKT(P0_, P1_, t) do { const int kb_ = KBASE(t); if ((!SK || ACT(t)) && (kb_ + KVBLK - 1 > qlo || kb_ <= qlo + QBLK - 1 - W)) mask_tile(P0_, P1_, qm - kb_, (unsigned)W); } while (0)
    constexpr int NQL = F32 ? 16 : 8;
    constexpr bool SK = WSKIP && !F32;
#define SEAM_K0() do { VMWN(NQL); if constexpr (F32) { SWRITE_KF(0); SBAR(); SLOAD_F((const float*)nxt.V, kbn); } else { SWRITE_HK(0); } SBAR(); } while (0)
    f32x16 pA0, pA1, pB0, pB1; float mnA, mnB, alA, alB; bf16x8 pa0, pa1, pa2, pa3;
    if constexpr (F32) { VMW(); SWRITE_VF(0); SBAR(); } else { SWRITE_HV(0); SBAR(); }
    if (NT > 1) { if constexpr (F32) SLOAD_F((const float*)Kh, KBASE(1)); else SLOAD_H(Kh, Vh, CKh, KBASE(1), 1); }
    SBAR(); qkt<0, SK>(pA0, pA1, K_lds, CK_lds, r32, hi, S.qr, ACT(0));
    if constexpr (F32) { if (NT > 1) { VMW(); SWRITE_KF(1); SBAR(); SLOAD_F((const float*)Vh, KBASE(1)); } }
    MASKT(pA0, pA1, 0); partialSM(pA0, pA1, m_reg, mnA, alA);
    if (NT > 1) { VMW(); if constexpr (F32) { SWRITE_VF(1); SBAR(); if (NT > 2) SLOAD_F((const float*)Kh, KBASE(2)); } else SWRITE_H(1); }
    __syncthreads();
#define HALF_STEP(PX0, PX1, mnX, alX, PY0, PY1, alY, t, KB, VB, SB) do {                                                      \
        SBAR(); qkt<KB, SK>(PX0, PX1, K_lds, CK_lds, r32, hi, S.qr, ACT(t));                                             \
        finishSM(PY0, PY1, alY, l_reg, pa0, pa1, pa2, pa3); SBAR();                                                           \
        if ((t) + 1 < NT) { if constexpr (F32) { VMW(); SWRITE_KF(SB); SBAR(); SLOAD_F((const float*)Vh, KBASE((t) + 1)); }  \
                            else { SLOAD_H(Kh, Vh, CKh, KBASE((t) + 1), SB); } SBAR(); }                                               \
        pv_tile<VB, SK>(o, vb0, pa0, pa1, pa2, pa3, ACT((t) - 1)); MASKT(PX0, PX1, (t)); partialSM(PX0, PX1, m_reg, mnX, alX);                                        \
        __syncthreads();                                                                                                      \
        if ((t) + 1 < NT) { VMW(); if constexpr (F32) { SWRITE_VF(SB); SBAR(); if ((t) + 2 < NT) SLOAD_F((const float*)Kh, KBASE((t) + 2)); } \
                            else { SWRITE_H(SB); } }                                                                          \
        RESC(alX); __syncthreads(); } while (0)
    for (int t = 1; t + 1 < NT; t += 2) {
        HALF_STEP(pB0, pB1, mnB, alB, pA0, pA1, alA, t, 1, 0, 0);
        HALF_STEP(pA0, pA1, mnA, alA, pB0, pB1, alB, t + 1, 0, 1, 1);
    }
    const bool even = (NT & 1) == 0;
    if (even) { SBAR(); qkt<1, SK>(pB0, pB1, K_lds, CK_lds, r32, hi, S.qr, ACT(NT - 1)); SBAR(); }
#define QROW(e) (nxt.Q + (size_t)(wid * QBLK + r32) * D + ((e) >> 1) * 16 + hi * 8 + ((e) & 1) * 4)
    if constexpr (F32) { SLOAD_F((const float*)nxt.K, kbn); SBAR();
#pragma unroll
        for (int e = 0; e < 8; ++e) S.tq[e] = *(const f32x4*)QROW(e); }
    else { SLOAD_H(nxt.K, nxt.V, nxt.CK, kbn, 0); SBAR();
#pragma unroll
        for (int d0 = 0; d0 < 8; ++d0) S.qr[d0] = load8<TIn>(nxt.Q + ((wid * QBLK + r32) * D + hi * 8) + d0 * 16); }
    SBAR();
    finishSM(pA0, pA1, alA, l_reg, pa0, pa1, pa2, pa3); SBAR();
    if constexpr (F32) {
#pragma unroll
        for (int e = 8; e < 16; ++e) S.tq[e] = *(const f32x4*)QROW(e); SBAR(); }
#undef QROW
    pv_tile<0, SK>(o, vb0, pa0, pa1, pa2, pa3, ACT(even ? NT - 2 : NT - 1));
    if (even) { MASKT(pB0, pB1, NT - 1); partialSM(pB0, pB1, m_reg, mnB, alB); __syncthreads(); RESC(alB);
        finishSM(pB0, pB1, alB, l_reg, pa0, pa1, pa2, pa3); SBAR(); pv_tile<1, SK>(o, vb0, pa0, pa1, pa2, pa3, ACT(NT - 1)); }
    SBAR(); SEAM_K0();
    if (hi == 0) li_l[r32] = l_reg; asm volatile("s_waitcnt lgkmcnt(0)" ::: "memory");
    float rli[16];
#pragma unroll
    for (int r = 0; r < 16; ++r) rli[r] = __builtin_amdgcn_rcpf(li_l[crow(r, hi)]);
    int oo = (wid * QBLK + 4 * hi) * OSTR + r32;
#pragma unroll
    for (int r = 0; r < 16; ++r) {
        asm volatile("" : "+v"(oo));
#pragma unroll
        for (int d0 = 0; d0 < 4; ++d0) { const float v = o[d0][r] * rli[r];
            if constexpr (same_t<TOut, float>::v) { cur.O[oo + d0 * 32] = v; }
            else { const float vn = __shfl_xor(v, 1);
                   if ((r32 & 1) == 0) *(unsigned*)(cur.O + (oo + d0 * 32)) = cvtpk(v, vn); } }
        oo += ((r & 3) == 3) ? 5 * OSTR : OSTR; }
    if constexpr (F32) {
#pragma unroll
        for (int d0 = 0; d0 < 8; ++d0) S.qr[d0] = pack8(S.tq[2 * d0], S.tq[2 * d0 + 1]); }
    __syncthreads();
#undef RESC
#undef KBASE
#undef ACT
#undef MASKT
#undef SEAM_K0
#undef HALF_STEP
}
#undef ROW
#undef VMW
#undef VMWN
#undef SLOAD_H
#undef SWRITE_HK
#undef SWRITE_HV
#undef SWRITE_H
#undef SLOAD_F
#undef SWRITE_KF
#undef SWRITE_VF
}
#define GAS __attribute__((address_space(1)))
#define LAS __attribute__((address_space(3)))
typedef unsigned short bf16;
typedef unsigned v4u __attribute__((ext_vector_type(4)));
typedef float f32x4 __attribute__((ext_vector_type(4)));
typedef short bf16x8 __attribute__((ext_vector_type(8)));
typedef GAS unsigned gu32;
typedef GAS unsigned long long gu64;
#define RLX_AGENT __ATOMIC_RELAXED, __HIP_MEMORY_SCOPE_AGENT
#define LDS_WAIT() asm volatile("s_waitcnt lgkmcnt(0)" ::: "memory")
#define VM_WAIT() asm volatile("s_waitcnt vmcnt(0)" ::: "memory")
__device__ __forceinline__ unsigned long long rt() { return __builtin_amdgcn_s_memrealtime(); }
__device__ __forceinline__ unsigned f2bf(float f) { unsigned u = __builtin_bit_cast(unsigned, f); return (u + 0x7fffu + ((u >> 16) & 1u)) >> 16; }
__device__ __forceinline__ unsigned pk2(float lo, float hi) { return f2bf(lo) | (f2bf(hi) << 16); }

#define XB_TMO      128
#define XB_XCNT(j)  (256  + 64 * (j))
#define XB_XSUB(j)  (1280 + 64 * (j))
#define XB_XGEN(j)  (2304 + 64 * (j))
#define XB_TOP      3328
#define XB_TOPGEN   3392
#define XCD_BAR_WORDS 3456
#define XB_SPIN_CAP (1u << 18)

__device__ __forceinline__ unsigned xb_ld(unsigned* p)              { return __hip_atomic_load(p, __ATOMIC_RELAXED, __HIP_MEMORY_SCOPE_AGENT); }
__device__ __forceinline__ unsigned xb_add(unsigned* p, unsigned v) { return __hip_atomic_fetch_add(p, v, __ATOMIC_RELAXED, __HIP_MEMORY_SCOPE_AGENT); }
__device__ __forceinline__ unsigned xb_xcc_id() { return (unsigned)__builtin_amdgcn_s_getreg((3 << 11) | 20) & 0xFu; }
#define XB_SPIN(cond, bar) do { unsigned _sp = 0; while (cond) { __builtin_amdgcn_s_sleep(1); \
    if ((++_sp & 255u) == 0u) { if (xb_ld(&(bar)[XB_TMO])) break; if (_sp > XB_SPIN_CAP) { atomicAdd(&(bar)[XB_TMO], 1u); break; } } } } while (0)

struct XcdBarrier {
    unsigned* bar; unsigned x;
    volatile LAS unsigned* st;
};

__device__ __forceinline__ XcdBarrier xcd_barrier_post(unsigned* bar, volatile LAS unsigned* st, bool t0) {
    XcdBarrier b; b.bar = bar; b.x = xb_xcc_id(); b.st = st;
    if (t0) (void)xb_add(&bar[XB_XCNT(b.x)], 1u);
    return b;
}
__device__ __forceinline__ void xcd_barrier_complete(unsigned* bar, unsigned x, unsigned& nloc, unsigned& nx) {
    const unsigned G = gridDim.x * gridDim.y * gridDim.z;
    unsigned sum, cnt, mine, sp = 0u;
    for (;;) {
        sum = 0u; cnt = 0u; mine = 0u;
#pragma unroll
        for (unsigned j = 0; j < 16; ++j) { const unsigned c = xb_ld(&bar[XB_XCNT(j)]); sum += c; cnt += (c > 0u) ? 1u : 0u; mine = (j == x) ? c : mine; }
        if (sum == G) break;
        __builtin_amdgcn_s_sleep(1);
        if ((++sp & 255u) == 0u) { if (xb_ld(&bar[XB_TMO])) break; if (sp > XB_SPIN_CAP) { atomicAdd(&bar[XB_TMO], 1u); break; } }
    }
    nloc = mine > 0u ? mine : 1u; nx = cnt > 0u ? cnt : 1u;
}

__device__ __forceinline__ void xcd_barrier(const XcdBarrier& b, bool t0) {
    asm volatile("s_waitcnt vmcnt(0)" ::: "memory");
    __syncthreads();
    if (t0) {
        unsigned* bar = b.bar;
        __builtin_amdgcn_s_waitcnt(0);
        unsigned nloc = b.st[0], nx = b.st[1];
        if (nloc == 0u) { xcd_barrier_complete(bar, b.x, nloc, nx); b.st[0] = nloc; b.st[1] = nx; }
        const unsigned old = xb_add(&bar[XB_XSUB(b.x)], 1u);
        const unsigned gen = old / nloc;
        if (old + 1u == (gen + 1u) * nloc) {
            __builtin_amdgcn_fence(__ATOMIC_RELEASE, "agent");
            asm volatile("s_waitcnt vmcnt(0)" ::: "memory");
            const unsigned og = xb_add(&bar[XB_TOP], 1u);
            const unsigned tg = og / nx;
            if (og + 1u == (tg + 1u) * nx) xb_add(&bar[XB_TOPGEN], 1u);
            else XB_SPIN(xb_ld(&bar[XB_TOPGEN]) == tg, bar);
            __builtin_amdgcn_fence(__ATOMIC_ACQUIRE, "agent");
            xb_add(&bar[XB_XGEN(b.x)], 1u);
            asm volatile("s_waitcnt vmcnt(0)" ::: "memory");
        } else {
            XB_SPIN(xb_ld(&bar[XB_XGEN(b.x)]) == gen, bar);
            __builtin_amdgcn_fence(__ATOMIC_ACQUIRE, "agent");
            asm volatile("s_waitcnt vmcnt(0)" ::: "memory");
        }
    }
    __syncthreads();
}
constexpr size_t O_YP = 0, O_YS = O_YP + (size_t)MPR * DM, O_KP = O_YS + (size_t)MSM * DM, O_VP = O_KP + (size_t)MPR * DATT, O_LFP = O_VP + (size_t)MPR * DATT,
                 O_HRP = O_LFP + (size_t)MPR * NH, O_HIP = O_HRP + (size_t)NB * NG * NST, O_KS = O_HIP + (size_t)NB * NG * NST, O_VS = O_KS + (size_t)MSM * DATT,
                 O_LFS = O_VS + (size_t)MSM * DATT, O_HRS = O_LFS + (size_t)MSM * NH, O_HIS = O_HRS + (size_t)DBT * NG * NST, O_END = O_HIS + (size_t)DBT * NG * NST;
static_assert(O_END == 33833216, "output size");

constexpr size_t al256(size_t x) { return (x + 255) & ~(size_t)255; }
constexpr size_t WS_CTL = 0, CTL_ZERO_BYTES = 64u << 10;
constexpr size_t WS_W1T  = 1u << 20;
constexpr size_t WS_WGLU = WS_W1T  + (size_t)8192 * 2048 * 2;
constexpr size_t WS_WBR  = WS_WGLU + (size_t)1024 * 1024 * 2;
constexpr size_t WS_WOUT = WS_WBR  + (size_t)2048 * 2048 * 2;
constexpr size_t WS_WFF1 = WS_WOUT + (size_t)2048 * 2048 * 2;
constexpr size_t WS_WFF2 = WS_WFF1 + (size_t)11264 * 2048 * 2;
constexpr size_t WS_XA   = WS_WFF2 + (size_t)2048 * 5632 * 2;
constexpr size_t WS_R1   = WS_XA   + (size_t)MPAD * 2048 * 2;
constexpr size_t WS_Z    = al256(WS_R1 + (size_t)MPAD * 4);
constexpr size_t WS_G    = WS_Z    + (size_t)MPAD * 4096 * 4;
constexpr size_t WS_YP   = WS_G    + (size_t)MPAD * 4096 * 2;
constexpr size_t WS_YY   = WS_YP   + (size_t)MPAD * 1024 * 2;
constexpr size_t WS_T1   = WS_YY   + (size_t)MPAD * 2048 * 2;
constexpr size_t WS_MG   = WS_T1   + (size_t)MPAD * 2048 * 4;
constexpr size_t WS_X1   = WS_MG   + (size_t)MPAD * 2048 * 2;
constexpr size_t WS_XB   = WS_X1   + (size_t)MPAD * 2048 * 4;
constexpr size_t WS_SS   = WS_XB   + (size_t)MPAD * 2048 * 2;
constexpr size_t WS_H    = WS_SS   + (size_t)MPAD * 32 * 4;
constexpr size_t WS_QB   = WS_H    + (size_t)MPAD * DFF * 2;
constexpr size_t WS_KB   = WS_QB   + (size_t)MPR * 1024 * 2;
constexpr size_t WS_VB   = WS_KB   + (size_t)MPR * 1024 * 2;
constexpr size_t WS_NCK  = WS_VB   + (size_t)MPR * 1024 * 2;
constexpr size_t WS_QS   = WS_NCK  + (size_t)NB * NH * SEQ * 16 * 2;
constexpr size_t WS_AB   = WS_QS   + (size_t)DBT * NH * DSQ * HD * 4;
constexpr size_t WS_AT   = WS_AB   + (size_t)NG * NST * 2 * 4;
constexpr size_t WS_BBR  = WS_AT   + (size_t)NG * NST * 2 * 4;
constexpr size_t WS_BBI  = WS_BBR  + (size_t)NG * NST * GC * 4;
constexpr size_t WS_E    = WS_BBI  + (size_t)NG * NST * GC * 4;
constexpr size_t WS_PW   = WS_E    + (size_t)NG * 512 * 128 * 4;
constexpr size_t WS_M3   = al256(WS_PW + (size_t)NG * 17 * NST * 2 * 4);
constexpr size_t WS_M2   = WS_M3   + (size_t)NG * 128 * 256 * 2;
constexpr size_t WS_KT   = WS_M2   + (size_t)NG * 256 * 128 * 2;
constexpr size_t WS_UB   = WS_KT   + (size_t)NG * 16 * 256 * 2;
constexpr size_t WS_AG   = WS_UB   + (size_t)NG * 512 * 256 * 2;
constexpr size_t WS_RP   = WS_AG   + (size_t)NG * 16 * 128 * 4;
constexpr size_t WS_TPG  = WS_RP   + (size_t)DBT * NH * PAST * 4;
constexpr size_t WS_PML  = WS_TPG  + (size_t)DBT * NH * NPAGES * 4;
constexpr size_t WS_PO   = WS_PML  + (size_t)256 * 64 * 2 * 4;
constexpr size_t WS_SS2  = WS_PO   + (size_t)256 * 64 * 128 * 4;
constexpr size_t WS_SSR  = WS_SS2  + (size_t)32 * 64 * 4;
constexpr size_t WS_LIST = al256(WS_SSR + (size_t)MPAD * 4);
constexpr size_t WS_XF   = al256(WS_LIST + (size_t)(256 + 2048 + 64) * 4);
constexpr size_t WS_JLO  = WS_XF   + (size_t)NB * NH * SEQ * 4;
constexpr size_t WS_END  = WS_JLO  + (size_t)256 * 4;
constexpr int CW_Q = 8192;
constexpr int CW_BAR = 4096;

constexpr int LDS_BYTES = 147456;
constexpr int MISC_OFF = LDS_BYTES - 512;
constexpr int NWAVES = 8;
struct Args { const void* in[30]; float* out; unsigned char* ws; int ph_lo, ph_hi, probe, pad; };
struct Frame {
    unsigned char* lds;
    int tid, lane, wave, G, gw, NGW;
    float* out; unsigned char* ws;
};
template <int OFF> __device__ __forceinline__ unsigned long long karg_load() {
    unsigned long long v; auto kp = __builtin_amdgcn_kernarg_segment_ptr();
    asm volatile("s_load_dwordx2 %0, %1, %2\n\ts_waitcnt lgkmcnt(0)" : "=s"(v) : "s"(kp), "n"(OFF) : "memory"); return v; }
#define INP(T, i) ((const T*)(const __attribute__((address_space(1))) T*)karg_load<8 * (i)>())
enum { I_XP = 0, I_XS, I_CK, I_CV, I_CLF, I_SRE, I_SIM, I_PT, I_G1, I_WIN, I_BF, I_GQ, I_GK, I_ARE, I_AIM, I_LDT, I_BRE, I_BIM, I_CRE, I_CIM, I_DSSM, I_WGLU, I_BGLU, I_WBRS, I_WBRA, I_WOUT, I_G2, I_WFG, I_WFU, I_WFD };
#define WSP(T, off) ((T*)(F.ws + (off)))

__device__ __forceinline__ float wave_sum(float v) {
#pragma unroll
    for (int o = 1; o < 64; o <<= 1) v += __shfl_xor(v, o);
    return v;
}
__device__ __forceinline__ unsigned cvtpk(float lo, float hi) { unsigned r; asm volatile("v_cvt_pk_bf16_f32 %0, %1, %2" : "=v"(r) : "v"(lo), "v"(hi)); return r; }

__device__ __forceinline__ void sincos_d(double x, double& s, double& c) {
    const double k = __builtin_rint(x * 0.63661977236758134308);
    double r = __builtin_fma(-k, 1.57079632679489655800e+00, x); r = __builtin_fma(-k, 6.12323399573676603587e-17, r);
    const long long q = (long long)k; const double r2 = r * r;
    double sp = -1.0 / 1307674368000.0; sp = sp * r2 + 1.0 / 6227020800.0; sp = sp * r2 - 1.0 / 39916800.0; sp = sp * r2 + 1.0 / 362880.0; sp = sp * r2 - 1.0 / 5040.0; sp = sp * r2 + 1.0 / 120.0; sp = sp * r2 - 1.0 / 6.0; sp = sp * r2 + 1.0; sp *= r;
    double cp = 1.0 / 20922789888000.0; cp = cp * r2 - 1.0 / 87178291200.0; cp = cp * r2 + 1.0 / 479001600.0; cp = cp * r2 - 1.0 / 3628800.0; cp = cp * r2 + 1.0 / 40320.0; cp = cp * r2 - 1.0 / 720.0; cp = cp * r2 + 1.0 / 24.0; cp = cp * r2 - 0.5; cp = cp * r2 + 1.0;
    const int qq = (int)(q & 3);
    s = (qq == 0) ? sp : (qq == 1) ? cp : (qq == 2) ? -sp : -cp;
    c = (qq == 0) ? cp : (qq == 1) ? -sp : (qq == 2) ? -cp : sp;
}
__device__ __forceinline__ double exp_d(double x) {
    const double k = __builtin_rint(x * 1.44269504088896338700e+00);
    double r = __builtin_fma(-k, 6.93147180369123816490e-01, x); r = __builtin_fma(-k, 1.90821492927058770002e-10, r);
    double p = 1.0 / 6227020800.0; p = p * r + 1.0 / 479001600.0; p = p * r + 1.0 / 39916800.0; p = p * r + 1.0 / 3628800.0; p = p * r + 1.0 / 362880.0; p = p * r + 1.0 / 40320.0; p = p * r + 1.0 / 5040.0;
    p = p * r + 1.0 / 720.0; p = p * r + 1.0 / 120.0; p = p * r + 1.0 / 24.0; p = p * r + 1.0 / 6.0; p = p * r + 0.5; p = p * r + 1.0; p = p * r + 1.0;
    int ki = (int)k; if (ki < -1000) return 0.0;
    return __builtin_ldexp(p, ki);
}

constexpr int WI_IN = 32 * 8, WI_GLU = 16 * 2, WI_BR = 16 * 4, WI_OUT = 32 * 4, WI_FF1 = 32 * 11, WI_FF2 = 88 * 4;
constexpr int WI_GLU0 = 2 * WI_IN, WI_BR0 = WI_GLU0 + WI_GLU, WI_OUT0 = WI_BR0 + 2 * WI_BR, WI_FF10 = WI_OUT0 + WI_OUT, WI_FF20 = WI_FF10 + 2 * WI_FF1, WI_END = WI_FF20 + WI_FF2;
struct WItem { const float* src; bf16* dst; const float* gs; int ldw, ldd, ilv; };
__device__ __forceinline__ void weight_copies(Frame& F, int it_lo, int it_hi, int bi, int nb, int prb = 0) {
    const float* const g1 = INP(float, I_G1); const float* const w_in = INP(float, I_WIN);
    const float* const w_glu = INP(float, I_WGLU); const float* const w_brs = INP(float, I_WBRS); const float* const w_bra = INP(float, I_WBRA); const float* const w_out = INP(float, I_WOUT);
    const float* const g2 = INP(float, I_G2); const float* const w_fg = INP(float, I_WFG); const float* const w_fu = INP(float, I_WFU); const float* const w_fd = INP(float, I_WFD);
    int drow0 = 0, n0g = 0;
    auto decode = [&](int it, WItem& t) { int r = it;
#define WC_SET(W_, ldw_, scol_, WT_, ldd_, drow_, k0_, dk0_, gs_, ilv_) do { t.src = (W_) + (size_t)(k0_) * (ldw_) + (scol_); t.dst = (WT_) + (dk0_) + (k0_); t.gs = (gs_) ? (gs_) + (k0_) : nullptr; t.ldw = (ldw_); t.ldd = (ldd_); t.ilv = (ilv_); drow0 = (drow_); n0g = (scol_); } while (0)
        if (r < 2 * WI_IN) { const int part = r / WI_IN; r -= part * WI_IN; const int kb = r / 8, nbk = r % 8; WC_SET(w_in, NIN, (part ? 4104 : 0) + 512 * nbk, WSP(bf16, WS_W1T), 2048, part * 4096 + 512 * nbk, 64 * kb, 0, g1, -1); return; } r -= 2 * WI_IN;
        if (r < WI_GLU) { const int kb = r / 2, nbk = r % 2; WC_SET(w_glu, 1024, 512 * nbk, WSP(bf16, WS_WGLU), 1024, 512 * nbk, 64 * kb, 0, (const float*)nullptr, -1); return; } r -= WI_GLU;
        if (r < 2 * WI_BR) { const int part = r / WI_BR; r -= part * WI_BR; const int kb = r / 4, nbk = r % 4; WC_SET(part ? w_bra : w_brs, 2048, 512 * nbk, WSP(bf16, WS_WBR), 2048, 512 * nbk, 64 * kb, part * 1024, (const float*)nullptr, -1); return; } r -= 2 * WI_BR;
        if (r < WI_OUT) { const int kb = r / 4, nbk = r % 4; WC_SET(w_out, 2048, 512 * nbk, WSP(bf16, WS_WOUT), 2048, 512 * nbk, 64 * kb, 0, (const float*)nullptr, -1); return; } r -= WI_OUT;
        if (r < 2 * WI_FF1) { const int part = r / WI_FF1; r -= part * WI_FF1; const int kb = r / 11, nbk = r % 11; WC_SET(part ? w_fu : w_fg, DFF, 512 * nbk, WSP(bf16, WS_WFF1), 2048, 0, 64 * kb, 0, g2, part); return; } r -= 2 * WI_FF1;
        { const int kb = r / 4, nbk = r % 4; WC_SET(w_fd, 2048, 512 * nbk, WSP(bf16, WS_WFF2), DFF, 512 * nbk, 64 * kb, 0, (const float*)nullptr, -1); }
#undef WC_SET
    };
    float* T = (float*)F.lds;
    f32x4 nx[16]; WItem tn; int it = it_lo + bi;
#define WC_LOAD() do { _Pragma("unroll") for (int i = 0; i < 16; ++i) nx[i] = *(const f32x4*)(tn.src + (size_t)(8 * F.wave + (i >> 1)) * tn.ldw + 256 * (i & 1) + 4 * F.lane); } while (0)
    if (it < it_hi) { decode(it, tn); WC_LOAD(); }
    for (; it < it_hi; it += nb) { const WItem t = tn; const int dr0 = drow0, n0 = n0g;
        __syncthreads();
#pragma unroll
        for (int i = 0; i < 16; ++i) { f32x4 v = nx[i]; if (t.gs) v = v * t.gs[8 * F.wave + (i >> 1)]; *(f32x4*)(T + (8 * F.wave + (i >> 1)) * 512 + 256 * (i & 1) + 4 * F.lane) = v; }
        if (it + nb < it_hi) { decode(it + nb, tn); WC_LOAD(); }
        __syncthreads();
        const int n = 64 * F.wave + F.lane, nsrc = n0 + n; const int row = t.ilv < 0 ? dr0 + n : 256 * (nsrc >> 7) + (nsrc & 127) + 128 * t.ilv;
        bf16* op = t.dst + (size_t)row * t.ldd; const float* tc = T + n;
#pragma unroll
        for (int c = 0; c < 8; ++c) { v4u o; o.x = cvtpk(tc[(8 * c) * 512], tc[(8 * c + 1) * 512]); o.y = cvtpk(tc[(8 * c + 2) * 512], tc[(8 * c + 3) * 512]); o.z = cvtpk(tc[(8 * c + 4) * 512], tc[(8 * c + 5) * 512]); o.w = cvtpk(tc[(8 * c + 6) * 512], tc[(8 * c + 7) * 512]);
            if (!(prb & 32) || o.x == 0x12345678u) *(v4u*)(op + 8 * c) = o; } }
#undef WC_LOAD
    __syncthreads();
}
__device__ __forceinline__ void phase0(Frame& F, int prb) {
    const float* const g1 = INP(float, I_G1); const float* const w_in = INP(float, I_WIN);
    float* WF = (float*)F.lds;
    for (int k = F.tid; k < DM; k += NWAVES * 64) { const float g = g1[k]; const float* wp = w_in + (size_t)k * NIN + 4096; const f32x4 a = *(const f32x4*)wp, b = *(const f32x4*)(wp + 4);
        WF[0 * DM + k] = g * a[0]; WF[1 * DM + k] = g * a[1]; WF[2 * DM + k] = g * a[2]; WF[3 * DM + k] = g * a[3];
        WF[4 * DM + k] = g * b[0]; WF[5 * DM + k] = g * b[1]; WF[6 * DM + k] = g * b[2]; WF[7 * DM + k] = g * b[3]; }
    __syncthreads();
    bf16* XA = WSP(bf16, WS_XA); float* R1 = WSP(float, WS_R1); const float* const xp = INP(float, I_XP); const float* const xs = INP(float, I_XS); const float* const b_f = INP(float, I_BF);
    if (!(prb & 64)) for (int m = MR + F.gw; m < MPAD; m += F.NGW) { unsigned long long* o8 = (unsigned long long*)(XA + (size_t)m * DM) + F.lane;
#pragma unroll
        for (int j = 0; j < 8; ++j) o8[64 * j] = 0ull;
        if (F.lane == 0) R1[m] = 0.f; }
    {
#define P0_ROWPTR(m_) ((const f32x4*)((m_) < MPR ? xp + (size_t)(m_) * DM : xs + (size_t)((m_) - MPR) * DM) + F.lane)
        f32x4 nx[8]; int m = (prb & 64) ? MR : F.gw;
        if (m < MR) { const f32x4* xr = P0_ROWPTR(m);
#pragma unroll
            for (int j = 0; j < 8; ++j) nx[j] = xr[64 * j]; }
        for (; m < MR; m += F.NGW) {
            f32x4 v[8];
#pragma unroll
            for (int j = 0; j < 8; ++j) v[j] = nx[j];
            const int mn = m + F.NGW;
            if (mn < MR) { const f32x4* xr = P0_ROWPTR(mn);
#pragma unroll
                for (int j = 0; j < 8; ++j) nx[j] = xr[64 * j]; }
            float ss = 0.f;
#pragma unroll
            for (int j = 0; j < 8; ++j) ss += (v[j][0] * v[j][0] + v[j][1] * v[j][1]) + (v[j][2] * v[j][2] + v[j][3] * v[j][3]);
            unsigned long long* o8 = (unsigned long long*)(XA + (size_t)m * DM) + F.lane;
#pragma unroll
            for (int j = 0; j < 8; ++j) o8[64 * j] = (unsigned long long)cvtpk(v[j][0], v[j][1]) | ((unsigned long long)cvtpk(v[j][2], v[j][3]) << 32);
            float a[8];
#pragma unroll
            for (int h = 0; h < 8; ++h) { float t = 0.f;
#pragma unroll
                for (int j = 0; j < 8; ++j) { const f32x4 w = *(const f32x4*)(WF + h * DM + 256 * j + 4 * F.lane); t += (v[j][0] * w[0] + v[j][1] * w[1]) + (v[j][2] * w[2] + v[j][3] * w[3]); }
                a[h] = t; }
            const bool b5 = (F.lane & 32) != 0, b4 = (F.lane & 16) != 0, b3 = (F.lane & 8) != 0; float w4[4], w2[2];
#pragma unroll
            for (int i = 0; i < 4; ++i) { const float snd = b5 ? a[i] : a[i + 4], kp = b5 ? a[i + 4] : a[i]; w4[i] = kp + __shfl_xor(snd, 32); }
#pragma unroll
            for (int i = 0; i < 2; ++i) { const float snd = b4 ? w4[i] : w4[i + 2], kp = b4 ? w4[i + 2] : w4[i]; w2[i] = kp + __shfl_xor(snd, 16); }
            float fl; { const float snd = b3 ? w2[0] : w2[1], kp = b3 ? w2[1] : w2[0]; fl = kp + __shfl_xor(snd, 8); }
            fl += __shfl_xor(fl, 1); fl += __shfl_xor(fl, 2); fl += __shfl_xor(fl, 4);
            ss = wave_sum(ss);
            const float r1 = 1.0f / sqrtf(ss * (1.0f / DM) + RMS_EPS);
            if (F.lane == 0) R1[m] = r1;
            if ((F.lane & 7) == 0) { const int h = ((F.lane >> 5) & 1) * 4 + ((F.lane >> 4) & 1) * 2 + ((F.lane >> 3) & 1); const float z = fl * r1 + b_f[h]; const float lf = fminf(z, 0.f) - log1pf(expf(-fabsf(z)));
                if (m < MPR) F.out[O_LFP + (size_t)m * NH + h] = lf; else F.out[O_LFS + (size_t)(m - MPR) * NH + h] = lf; }
        }
#undef P0_ROWPTR
    }
    for (int i = F.gw * 64 + F.lane; i < MPAD; i += F.NGW * 64) WSP(float, WS_SSR)[i] = 0.f;
    { const float* const ldt = INP(float, I_LDT); const float* const a_re = INP(float, I_ARE); const float* const a_im = INP(float, I_AIM); const float* const b_re = INP(float, I_BRE); const float* const b_im = INP(float, I_BIM);
    for (int g = F.gw; g < NG; g += F.NGW) { const int p = F.lane, gp = g * NST + p;
        const double dt = exp_d((double)ldt[g]), are = (double)a_re[gp], aim = (double)a_im[gp];
        double sn, cs; sincos_d(dt * aim, sn, cs); const double mag = exp_d(dt * are); const double abr = mag * cs, abi = mag * sn;
        float* AB = WSP(float, WS_AB); AB[2 * gp] = (float)abr; AB[2 * gp + 1] = (float)abi;
        { float* PW = WSP(float, WS_PW) + (size_t)g * 17 * NST * 2 + 2 * p; double pr = 1.0, pi = 0.0;
#pragma unroll 1
          for (int tau = 0; tau <= 16; ++tau) { PW[tau * NST * 2] = (float)pr; PW[tau * NST * 2 + 1] = (float)pi; const double nr = pr * abr - pi * abi, ni = pr * abi + pi * abr; pr = nr; pi = ni; } }
        const double er = abr - 1.0, ei = abi, inv = 1.0 / (are * are + aim * aim), fr = (er * are + ei * aim) * inv, fi = (ei * are - er * aim) * inv;
        float* BBR = WSP(float, WS_BBR) + (size_t)gp * GC; float* BBI = WSP(float, WS_BBI) + (size_t)gp * GC;
#pragma unroll
        for (int c = 0; c < GC; ++c) { const double br = (double)b_re[(size_t)gp * GC + c], bi = (double)b_im[(size_t)gp * GC + c]; BBR[c] = (float)(fr * br - fi * bi); BBI[c] = (float)(fr * bi + fi * br); }
    } }
    { const int* const pt = INP(int, I_PT); const float* const clf = INP(float, I_CLF);
    for (int it = F.gw; it < DBT * NPAGES; it += F.NGW) { const int b = it >> 7, j = it & 127, phys = pt[it]; const int seg = F.lane >> 3, h = F.lane & 7;
        const float* lp = clf + ((size_t)phys * PAGE + 16 * seg) * NH + h; float v[16];
#pragma unroll
        for (int i = 0; i < 16; ++i) v[i] = lp[i * NH];
        float s[16]; float run = 0.f;
#pragma unroll
        for (int i = 15; i >= 0; --i) { s[i] = run; run += v[i]; }
        float off = 0.f;
#pragma unroll
        for (int d = 1; d < 8; ++d) { const float t = __shfl(run, (F.lane + 8 * d) & 63); if (seg + d < 8) off += t; }
        float* rp = WSP(float, WS_RP) + ((size_t)(b * NH + h) * PAST) + j * PAGE + 16 * seg;
#pragma unroll
        for (int i = 0; i < 16; ++i) rp[i] = s[i] + off;
        if (seg == 0) WSP(float, WS_TPG)[(b * NH + h) * NPAGES + j] = off + run; } }
    __syncthreads();
    weight_copies(F, 0, WI_BR0, (int)blockIdx.x, F.G, prb);
}
__device__ __forceinline__ void rowpass(Frame& F) {
    const int h = F.lane >> 3, sub = F.lane & 7, off = h * HD + sub * 16;
    float gq[16], gk[16]; { const float* const gqp = INP(float, I_GQ); const float* const gkp = INP(float, I_GK);
#pragma unroll
    for (int i = 0; i < 16; ++i) { gq[i] = gqp[sub * 16 + i]; gk[i] = gkp[sub * 16 + i]; } }
    const float* Z = WSP(float, WS_Z);
    for (int m = MPR + F.gw; m < MR; m += F.NGW) {
        const float* z = Z + (size_t)m * 4096 + off; float q[16], k[16], v[16];
#pragma unroll
        for (int i = 0; i < 4; ++i) { const f32x4 a = *(const f32x4*)(z + 1024 + 4 * i), b = *(const f32x4*)(z + 2048 + 4 * i), c = *(const f32x4*)(z + 3072 + 4 * i);
#pragma unroll
            for (int e = 0; e < 4; ++e) { q[4 * i + e] = a[e]; k[4 * i + e] = b[e]; v[4 * i + e] = c[e]; } }
        float sq = 0.f, sk = 0.f;
#pragma unroll
        for (int i = 0; i < 16; ++i) { sq += q[i] * q[i]; sk += k[i] * k[i]; }
        sq += __shfl_xor(sq, 1); sq += __shfl_xor(sq, 2); sq += __shfl_xor(sq, 4); sk += __shfl_xor(sk, 1); sk += __shfl_xor(sk, 2); sk += __shfl_xor(sk, 4);
        const float rq = 1.0f / sqrtf(sq * (1.0f / HD) + RMS_EPS), rk = 1.0f / sqrtf(sk * (1.0f / HD) + RMS_EPS);
#pragma unroll
        for (int i = 0; i < 16; ++i) { q[i] = q[i] * rq * gq[i]; k[i] = k[i] * rk * gk[i]; }
        float* ko; float* vo;
        if (m < MPR) { const int b = m >> 12, s = m & (SEQ - 1); const size_t ao = ((size_t)(b * NH + h) * SEQ + s) * HD + sub * 16;
            v4u w;
            w.x = cvtpk(q[0], q[1]); w.y = cvtpk(q[2], q[3]); w.z = cvtpk(q[4], q[5]); w.w = cvtpk(q[6], q[7]); *(v4u*)(WSP(bf16, WS_QB) + ao) = w;
            w.x = cvtpk(q[8], q[9]); w.y = cvtpk(q[10], q[11]); w.z = cvtpk(q[12], q[13]); w.w = cvtpk(q[14], q[15]); *(v4u*)(WSP(bf16, WS_QB) + ao + 8) = w;
            w.x = cvtpk(k[0], k[1]); w.y = cvtpk(k[2], k[3]); w.z = cvtpk(k[4], k[5]); w.w = cvtpk(k[6], k[7]); *(v4u*)(WSP(bf16, WS_KB) + ao) = w;
            w.x = cvtpk(k[8], k[9]); w.y = cvtpk(k[10], k[11]); w.z = cvtpk(k[12], k[13]); w.w = cvtpk(k[14], k[15]); *(v4u*)(WSP(bf16, WS_KB) + ao + 8) = w;
            w.x = cvtpk(v[0], v[1]); w.y = cvtpk(v[2], v[3]); w.z = cvtpk(v[4], v[5]); w.w = cvtpk(v[6], v[7]); *(v4u*)(WSP(bf16, WS_VB) + ao) = w;
            w.x = cvtpk(v[8], v[9]); w.y = cvtpk(v[10], v[11]); w.z = cvtpk(v[12], v[13]); w.w = cvtpk(v[14], v[15]); *(v4u*)(WSP(bf16, WS_VB) + ao + 8) = w;
            ko = F.out + O_KP + (size_t)m * DATT + off; vo = F.out + O_VP + (size_t)m * DATT + off;
        } else { const int ms = m - MPR, b = ms >> 2, t = ms & 3; float* qs = WSP(float, WS_QS) + ((size_t)((b * NH + h) * DSQ + t)) * HD + sub * 16;
#pragma unroll
            for (int i = 0; i < 4; ++i) *(f32x4*)(qs + 4 * i) = (f32x4){q[4 * i], q[4 * i + 1], q[4 * i + 2], q[4 * i + 3]};
            ko = F.out + O_KS + (size_t)ms * DATT + off; vo = F.out + O_VS + (size_t)ms * DATT + off; }
#pragma unroll
        for (int i = 0; i < 4; ++i) { *(f32x4*)(ko + 4 * i) = (f32x4){k[4 * i], k[4 * i + 1], k[4 * i + 2], k[4 * i + 3]}; *(f32x4*)(vo + 4 * i) = (f32x4){v[4 * i], v[4 * i + 1], v[4 * i + 2], v[4 * i + 3]}; }
    }
}
__device__ __forceinline__ void logf_cumsum(Frame& F, int it) {
    const float* const gqp = INP(float, I_GQ); const float* const gkp = INP(float, I_GK);
    const int b = it >> 3, h = it & 7, pos0 = 512 * F.wave + 8 * F.lane;
    const float* lf = F.out + O_LFP + ((size_t)b * SEQ + pos0) * NH + h; bf16* o = WSP(bf16, WS_NCK) + ((size_t)it * SEQ + pos0) * 16; float* xf = WSP(float, WS_XF) + (size_t)it * SEQ + pos0;
    double* WT = (double*)F.lds; float* TG = (float*)(F.lds + 128); int* CN = (int*)(F.lds + 256);
    float v[8];
#pragma unroll
    for (int i = 0; i < 8; ++i) v[i] = lf[(size_t)i * NH];
    double tot = 0.0;
#pragma unroll
    for (int i = 0; i < 8; ++i) tot += (double)v[i];
    double ex = tot;
#pragma unroll
    for (int d = 1; d < 64; d <<= 1) { const double t = __shfl_up(ex, d); if (F.lane >= d) ex += t; }
    if (F.lane == 63) WT[F.wave] = ex;
    if (F.tid < 16) CN[F.tid] = 0;
    __syncthreads();
    double run = ex - tot;
    for (int w = 0; w < F.wave; ++w) run += WT[w];
    float xs_[8];
#pragma unroll
    for (int i = 0; i < 8; ++i) { run += (double)v[i];
        const float x = (float)(-run * 11.313708498984761);
        xs_[i] = x; xf[i] = x;
        const unsigned h16 = cvtpk(x, 0.f) & 0xffffu; const float r1 = x - __uint_as_float(h16 << 16); const unsigned m16 = cvtpk(r1, 0.f) & 0xffffu; const float r2 = r1 - __uint_as_float(m16 << 16); const unsigned l16 = cvtpk(r2, 0.f) & 0xffffu;
        v4u w; w.x = h16 | (m16 << 16); w.y = l16; w.z = 0u; w.w = 0u; *(v4u*)(o + (size_t)i * 16) = w; *(v4u*)(o + (size_t)i * 16 + 8) = (v4u){0u, 0u, 0u, 0u}; }
    if ((F.lane & 31) == 0) TG[2 * F.wave + (F.lane >> 5)] = xs_[0];
    __syncthreads();
    { float mq = fmaxf(fabsf(gqp[F.lane]), fabsf(gqp[F.lane + 64])), mk = fmaxf(fabsf(gkp[F.lane]), fabsf(gkp[F.lane + 64]));
#pragma unroll
      for (int od = 1; od < 64; od <<= 1) { mq = fmaxf(mq, __shfl_xor(mq, od)); mk = fmaxf(mk, __shfl_xor(mk, od)); }
      const float bq2 = 11.313708498984761f * 1.4426950408889634f * mq * mk, thr = (2.f * bq2 + 40.f) * (1.0f / (1.4426950408889634f * 0.08838834764831845f));
#pragma unroll 4
      for (int qb = 0; qb < 16; ++qb) { const float tgt = TG[qb] - thr; int cnt = 0;
#pragma unroll
          for (int i = 0; i < 8; ++i) cnt += (xs_[i] < tgt) ? 1 : 0;
#pragma unroll
          for (int od = 1; od < 64; od <<= 1) cnt += __shfl_xor(cnt, od);
          if (F.lane == 0 && cnt) atomicAdd(CN + qb, cnt); } }
    __syncthreads();
    if (F.tid < 16) WSP(int, WS_JLO)[it * 16 + F.tid] = CN[F.tid] >> 6;
    __syncthreads();
}
__device__ __forceinline__ void rpast_fix(Frame& F) {
    for (int it = F.gw; it < DBT * NH * NPAGES; it += F.NGW) { const int bh = it >> 7, j = it & 127; const float* tp = WSP(float, WS_TPG) + bh * NPAGES;
        float a = (F.lane > j ? tp[F.lane] : 0.f) + (F.lane + 64 > j ? tp[F.lane + 64] : 0.f); a = wave_sum(a);
        float* rp = WSP(float, WS_RP) + (size_t)bh * PAST + j * PAGE; rp[F.lane] = (rp[F.lane] + a) * LOG2E; rp[F.lane + 64] = (rp[F.lane + 64] + a) * LOG2E; }
}

namespace s5 {
constexpr int HS_STRIDE = 132, US_F = 256, HS_F = 16 * HS_STRIDE, CS_F = 64 * 32, WLDS_F = US_F + HS_F + CS_F;
__device__ __forceinline__ float gelu_erf(float y) { return 0.5f * y * (1.0f + erff(y * 0.70710678118654752440f)); }
template <int MODE>
__device__ __forceinline__ void unit(const float* U, int T, float& hre, float& him, const float* bbr, const float* bbi, float are, float aim, float* wl, int lane, bf16* YPr, const float* dv) {
    float br[16], bi[16];
#pragma unroll
    for (int i = 0; i < 4; ++i) { const f32x4 a = *(const f32x4*)(bbr + 4 * i), b = *(const f32x4*)(bbi + 4 * i);
#pragma unroll
        for (int e = 0; e < 4; ++e) { br[4 * i + e] = a[e]; bi[4 * i + e] = b[e]; } }
    float* Us = wl; float* Hs = wl + US_F; const float* Cs = wl + US_F + HS_F;
    for (int t0 = 0; t0 < T; t0 += 16) { const int nst = (T - t0) < 16 ? (T - t0) : 16;
        { const int row = lane >> 2, quad = lane & 3; f32x4 v = (f32x4){0.f, 0.f, 0.f, 0.f}; if (row < nst) v = *(const f32x4*)(U + (size_t)(t0 + row) * 4096 + quad * 4); *(f32x4*)(Us + row * 16 + quad * 4) = v; }
        LDS_WAIT(); asm volatile("" ::: "memory");
#pragma unroll 1
        for (int t = 0; t < nst; ++t) { float bur = 0.f, bui = 0.f;
#pragma unroll
            for (int i = 0; i < 4; ++i) { const f32x4 u = *(const f32x4*)(Us + t * 16 + 4 * i);
#pragma unroll
                for (int e = 0; e < 4; ++e) { bur = fmaf(br[4 * i + e], u[e], bur); bui = fmaf(bi[4 * i + e], u[e], bui); } }
            const float nre = fmaf(are, hre, fmaf(-aim, him, bur)), nim = fmaf(are, him, fmaf(aim, hre, bui)); hre = nre; him = nim;
            if (MODE == 1) { typedef float f32x2 __attribute__((ext_vector_type(2))); *(f32x2*)(Hs + t * HS_STRIDE + 2 * lane) = (f32x2){hre, him}; } }
        if (MODE == 1) { LDS_WAIT(); asm volatile("" ::: "memory");
            const int tl = lane >> 2, cq = lane & 3; float a0 = 0.f, a1 = 0.f, a2 = 0.f, a3 = 0.f;
#pragma unroll 4
            for (int pp = 0; pp < 32; ++pp) { const f32x4 h4 = *(const f32x4*)(Hs + tl * HS_STRIDE + 4 * pp);
                const f32x4 cA0 = *(const f32x4*)(Cs + (2 * pp) * 32 + cq * 8), cA1 = *(const f32x4*)(Cs + (2 * pp) * 32 + cq * 8 + 4);
                const f32x4 cB0 = *(const f32x4*)(Cs + (2 * pp + 1) * 32 + cq * 8), cB1 = *(const f32x4*)(Cs + (2 * pp + 1) * 32 + cq * 8 + 4);
                a0 += (cA0[0] * h4[0] - cA0[1] * h4[1]) + (cB0[0] * h4[2] - cB0[1] * h4[3]); a1 += (cA0[2] * h4[0] - cA0[3] * h4[1]) + (cB0[2] * h4[2] - cB0[3] * h4[3]);
                a2 += (cA1[0] * h4[0] - cA1[1] * h4[1]) + (cB1[0] * h4[2] - cB1[1] * h4[3]); a3 += (cA1[2] * h4[0] - cA1[3] * h4[1]) + (cB1[2] * h4[2] - cB1[3] * h4[3]); }
            if (tl < nst) { const f32x4 u = *(const f32x4*)(Us + tl * 16 + cq * 4), d = *(const f32x4*)(dv + cq * 4);
                const float y0 = gelu_erf(fmaf(d[0], u[0], a0)), y1 = gelu_erf(fmaf(d[1], u[1], a1)), y2 = gelu_erf(fmaf(d[2], u[2], a2)), y3 = gelu_erf(fmaf(d[3], u[3], a3));
                *(unsigned long long*)(YPr + (size_t)(t0 + tl) * 1024 + cq * 4) = (unsigned long long)cvtpk(y0, y1) | ((unsigned long long)cvtpk(y2, y3) << 32); }
            LDS_WAIT(); asm volatile("" ::: "memory"); }
    }
}
typedef float f32x16 __attribute__((ext_vector_type(16)));
__device__ __forceinline__ void gen_tables(Frame& F) {
    const float* PW = WSP(float, WS_PW); const float* BBR = WSP(float, WS_BBR); const float* BBI = WSP(float, WS_BBI);
    const float* const c_re = INP(float, I_CRE); const float* const c_im = INP(float, I_CIM); const float* const dssm = INP(float, I_DSSM);
    for (int it = F.gw; it < 3 * 1024; it += F.NGW) { const int kind = it >> 10, g = (it >> 4) & 63, x = it & 15, p = F.lane;
        if (kind == 0) {
            const float wr = PW[((size_t)(g * 17 + (15 - x)) * NST + p) * 2], wi = PW[((size_t)(g * 17 + (15 - x)) * NST + p) * 2 + 1]; float re[16], im[16];
#pragma unroll
            for (int i = 0; i < 4; ++i) { const f32x4 br = *(const f32x4*)(BBR + (size_t)(g * NST + p) * GC + 4 * i), bi = *(const f32x4*)(BBI + (size_t)(g * NST + p) * GC + 4 * i);
#pragma unroll
                for (int e = 0; e < 4; ++e) { re[4 * i + e] = wr * br[e] - wi * bi[e]; im[4 * i + e] = wr * bi[e] + wi * br[e]; } }
            bf16* o = WSP(bf16, WS_M3) + ((size_t)(g * 128 + p) * 256 + x * 16);
#pragma unroll
            for (int hf = 0; hf < 2; ++hf) { v4u w; w.x = cvtpk(re[8 * hf], re[8 * hf + 1]); w.y = cvtpk(re[8 * hf + 2], re[8 * hf + 3]); w.z = cvtpk(re[8 * hf + 4], re[8 * hf + 5]); w.w = cvtpk(re[8 * hf + 6], re[8 * hf + 7]); *(v4u*)(o + 8 * hf) = w;
                w.x = cvtpk(im[8 * hf], im[8 * hf + 1]); w.y = cvtpk(im[8 * hf + 2], im[8 * hf + 3]); w.z = cvtpk(im[8 * hf + 4], im[8 * hf + 5]); w.w = cvtpk(im[8 * hf + 6], im[8 * hf + 7]); *(v4u*)(o + (size_t)64 * 256 + 8 * hf) = w; }
        } else if (kind == 1) {
            const float wr = PW[((size_t)(g * 17 + x + 1) * NST + p) * 2], wi = PW[((size_t)(g * 17 + x + 1) * NST + p) * 2 + 1]; bf16* o = WSP(bf16, WS_M2) + (size_t)(g * 256 + x * 16) * 128 + p;
#pragma unroll 4
            for (int c = 0; c < GC; ++c) { const float cr = c_re[(size_t)(g * GC + c) * NST + p], ci = c_im[(size_t)(g * GC + c) * NST + p];
                o[(size_t)c * 128] = (bf16)(cvtpk(cr * wr - ci * wi, 0.f) & 0xffffu); o[(size_t)c * 128 + 64] = (bf16)(cvtpk(-(cr * wi + ci * wr), 0.f) & 0xffffu); }
        } else {
            const int c = F.lane >> 2, c4 = 4 * (F.lane & 3); float a0 = 0.f, a1 = 0.f, a2 = 0.f, a3 = 0.f;
#pragma unroll 4
            for (int pp = 0; pp < NST; ++pp) { const float wr = PW[((size_t)(g * 17 + x) * NST + pp) * 2], wi = PW[((size_t)(g * 17 + x) * NST + pp) * 2 + 1];
                const float cr = c_re[(size_t)(g * GC + c) * NST + pp], ci = c_im[(size_t)(g * GC + c) * NST + pp]; const float tr = cr * wr - ci * wi, ti = cr * wi + ci * wr;
                const f32x4 br = *(const f32x4*)(BBR + (size_t)(g * NST + pp) * GC + c4), bi = *(const f32x4*)(BBI + (size_t)(g * NST + pp) * GC + c4);
                a0 += tr * br[0] - ti * bi[0]; a1 += tr * br[1] - ti * bi[1]; a2 += tr * br[2] - ti * bi[2]; a3 += tr * br[3] - ti * bi[3]; }
            if (x == 0) { const float d = dssm[g * GC + c]; if (c4 == (c & 12)) { const int e = c & 3; if (e == 0) a0 += d; else if (e == 1) a1 += d; else if (e == 2) a2 += d; else a3 += d; } }
            *(unsigned long long*)(WSP(bf16, WS_KT) + ((size_t)(g * 16 + x) * 16 + c) * 16 + c4) = (unsigned long long)cvtpk(a0, a1) | ((unsigned long long)cvtpk(a2, a3) << 32);
        } }
}
__device__ __forceinline__ void passE(Frame& F) {
    const bf16* UB = WSP(bf16, WS_UB); const bf16* M3 = WSP(bf16, WS_M3); float* E = WSP(float, WS_E); const float* PW = WSP(float, WS_PW); const int r = F.lane & 31, kh = F.lane >> 5;
    for (int it = F.gw; it < NG * 16; it += F.NGW) { const int g = it >> 4, nt = it & 15;
        f32x16 acc[4];
#pragma unroll
        for (int m = 0; m < 4; ++m) acc[m] = (f32x16){0.f, 0.f, 0.f, 0.f, 0.f, 0.f, 0.f, 0.f, 0.f, 0.f, 0.f, 0.f, 0.f, 0.f, 0.f, 0.f};
        const bf16* bp = UB + (size_t)(g * 512 + 32 * nt + r) * 256 + 8 * kh; const bf16* ap = M3 + (size_t)(g * 128 + r) * 256 + 8 * kh;
#pragma unroll 4
        for (int s = 0; s < 16; ++s) { const bf16x8 bfr = *(const bf16x8*)(bp + 16 * s);
#pragma unroll
            for (int m = 0; m < 4; ++m) { const bf16x8 afr = *(const bf16x8*)(ap + (size_t)m * 32 * 256 + 16 * s); acc[m] = __builtin_amdgcn_mfma_f32_32x32x16_bf16(afr, bfr, acc[m], 0, 0, 0); } }
        float* ep = E + (size_t)(g * 512 + 32 * nt + r) * 128 + 4 * kh;
#pragma unroll
        for (int m = 0; m < 4; ++m)
#pragma unroll
            for (int qq = 0; qq < 4; ++qq) *(f32x4*)(ep + 32 * m + 8 * qq) = (f32x4){acc[m][4 * qq], acc[m][4 * qq + 1], acc[m][4 * qq + 2], acc[m][4 * qq + 3]};
        asm volatile("s_waitcnt vmcnt(0)" ::: "memory"); __builtin_amdgcn_fence(__ATOMIC_SEQ_CST, "workgroup");
        { const float tr = PW[((size_t)(g * 17 + 16) * NST + F.lane) * 2], ti = PW[((size_t)(g * 17 + 16) * NST + F.lane) * 2 + 1]; float hre = 0.f, him = 0.f;
          const unsigned* eq = (const unsigned*)(E + (size_t)(g * 512 + 32 * nt) * 128 + F.lane); float er[32], ei[32];
#pragma unroll
          for (int ch = 0; ch < 32; ++ch) { er[ch] = __uint_as_float(__hip_atomic_load(eq + (size_t)ch * 128, __ATOMIC_RELAXED, __HIP_MEMORY_SCOPE_AGENT)); ei[ch] = __uint_as_float(__hip_atomic_load(eq + (size_t)ch * 128 + 64, __ATOMIC_RELAXED, __HIP_MEMORY_SCOPE_AGENT)); }
#pragma unroll
          for (int ch = 0; ch < 32; ++ch) { const float nr = fmaf(tr, hre, fmaf(-ti, him, er[ch])), ni = fmaf(tr, him, fmaf(ti, hre, ei[ch])); hre = nr; him = ni; }
          float* ag = WSP(float, WS_AG) + (size_t)(g * 16 + nt) * 128; ag[F.lane] = hre; ag[64 + F.lane] = him; } }
}
constexpr int SL_STRIDE = 136;
__device__ __forceinline__ void passY(Frame& F, int it0, int itstep) {
    const bf16* UB = WSP(bf16, WS_UB); const bf16* M2 = WSP(bf16, WS_M2); const bf16* KT = WSP(bf16, WS_KT); const float* E = WSP(float, WS_E); const float* PW = WSP(float, WS_PW); const float* AG = WSP(float, WS_AG);
    bf16* Sl = (bf16*)F.lds + (size_t)F.wave * 32 * SL_STRIDE; const int r = F.lane & 31, kh = F.lane >> 5, tl = r >> 4, cc = r & 15;
    for (int it = it0; it < NG * 32; it += itstep) { const int g = it >> 5, b = (it >> 4) & 1, j = (it >> 1) & 7, mh = it & 1;
        { const float tr = PW[((size_t)(g * 17 + 16) * NST + F.lane) * 2], ti = PW[((size_t)(g * 17 + 16) * NST + F.lane) * 2 + 1];
          float t2r = tr, t2i = ti;
#pragma unroll
          for (int k = 0; k < 5; ++k) { const float nr = t2r * t2r - t2i * t2i, ni = 2.f * t2r * t2i; t2r = nr; t2i = ni; }
          float hre = 0.f, him = 0.f; const float* ag = AG + (size_t)(g * 16 + b * 8) * 128 + F.lane;
          for (int i = 0; i < j; ++i) { const float ar = ag[(size_t)i * 128], ai = ag[(size_t)i * 128 + 64]; const float nr = fmaf(t2r, hre, fmaf(-t2i, him, ar)), ni = fmaf(t2r, him, fmaf(t2i, hre, ai)); hre = nr; him = ni; }
          const float* ep = E + (size_t)(g * 512 + b * CPB + 32 * j) * 128 + F.lane; float er[32], ei[32];
#pragma unroll
          for (int ch = 0; ch < 32; ++ch) { er[ch] = ep[(size_t)ch * 128]; ei[ch] = ep[(size_t)ch * 128 + 64]; }
#pragma unroll
          for (int ch = 0; ch < 32; ++ch) { Sl[ch * SL_STRIDE + F.lane] = (bf16)(cvtpk(hre, 0.f) & 0xffffu); Sl[ch * SL_STRIDE + 64 + F.lane] = (bf16)(cvtpk(him, 0.f) & 0xffffu);
              const float nr = fmaf(tr, hre, fmaf(-ti, him, er[ch])), ni = fmaf(tr, him, fmaf(ti, hre, ei[ch])); hre = nr; him = ni; }
          if (j == 7 && mh == 0) { F.out[O_HRP + (size_t)(b * NG + g) * NST + F.lane] = hre; F.out[O_HIP + (size_t)(b * NG + g) * NST + F.lane] = him; } }
        LDS_WAIT(); asm volatile("" ::: "memory");
        f32x16 acc[4];
#pragma unroll
        for (int m = 0; m < 4; ++m) acc[m] = (f32x16){0.f, 0.f, 0.f, 0.f, 0.f, 0.f, 0.f, 0.f, 0.f, 0.f, 0.f, 0.f, 0.f, 0.f, 0.f, 0.f};
        const bf16* bp = UB + (size_t)(g * 512 + b * CPB + 32 * j + r) * 256 + 8 * kh; const bf16* kp = KT + (size_t)g * 4096 + cc * 16 + 8 * kh;
        const int t0 = 8 * mh;
#pragma unroll
        for (int s = 0; s < 16; ++s) { if (s > t0 + 7) break;
            const bf16x8 bfr = *(const bf16x8*)(bp + 16 * s);
#pragma unroll
            for (int mm = 0; mm < 4; ++mm) { const int tau = t0 + 2 * mm + tl - s; if (t0 + 2 * mm + 1 < s) continue;
                bf16x8 afr = (bf16x8){0, 0, 0, 0, 0, 0, 0, 0}; if (tau >= 0) afr = *(const bf16x8*)(kp + tau * 256);
                acc[mm] = __builtin_amdgcn_mfma_f32_32x32x16_bf16(afr, bfr, acc[mm], 0, 0, 0); } }
        const bf16* mp = M2 + (size_t)(g * 256 + 32 * (4 * mh) + r) * 128 + 8 * kh;
#pragma unroll 2
        for (int ks = 0; ks < 8; ++ks) { const bf16x8 bfr = *(const bf16x8*)(Sl + r * SL_STRIDE + 16 * ks + 8 * kh);
#pragma unroll
            for (int mm = 0; mm < 4; ++mm) { const bf16x8 afr = *(const bf16x8*)(mp + (size_t)mm * 32 * 128 + 16 * ks); acc[mm] = __builtin_amdgcn_mfma_f32_32x32x16_bf16(afr, bfr, acc[mm], 0, 0, 0); } }
        bf16* yp = WSP(bf16, WS_YP) + ((size_t)b * SEQ + (size_t)(32 * j + r) * CT + t0) * 1024 + g * GC + 4 * kh;
#pragma unroll
        for (int mm = 0; mm < 4; ++mm)
#pragma unroll
            for (int qq = 0; qq < 4; ++qq) { const float y0 = gelu_erf(acc[mm][4 * qq]), y1 = gelu_erf(acc[mm][4 * qq + 1]), y2 = gelu_erf(acc[mm][4 * qq + 2]), y3 = gelu_erf(acc[mm][4 * qq + 3]);
                *(unsigned long long*)(yp + (size_t)(2 * mm + (qq >> 1)) * 1024 + 8 * (qq & 1)) = (unsigned long long)cvtpk(y0, y1) | ((unsigned long long)cvtpk(y2, y3) << 32); }
        LDS_WAIT(); asm volatile("" ::: "memory"); }
}
__device__ __forceinline__ void passB(Frame& F, int it0, int itstep) {
    float* wl = (float*)F.lds + F.wave * WLDS_F; const float* Z = WSP(float, WS_Z); const float* AB = WSP(float, WS_AB); float* Cs = wl + US_F + HS_F;
    const float* const c_re = INP(float, I_CRE); const float* const c_im = INP(float, I_CIM); const float* const sre = INP(float, I_SRE); const float* const sim = INP(float, I_SIM); const float* const dssm = INP(float, I_DSSM);
    for (int it = it0; it < DBT * NG; it += itstep) { const int g = it & 63, bs = it >> 6, gp = g * NST + F.lane;
#pragma unroll 4
        for (int c = 0; c < GC; ++c) { typedef float f32x2 __attribute__((ext_vector_type(2))); *(f32x2*)(Cs + F.lane * 32 + c * 2) = (f32x2){c_re[(size_t)(g * GC + c) * NST + F.lane], c_im[(size_t)(g * GC + c) * NST + F.lane]}; }
        float hre = sre[(size_t)bs * NG * NST + gp], him = sim[(size_t)bs * NG * NST + gp]; const int row0 = MPR + bs * DSQ;
        unit<1>(Z + (size_t)row0 * 4096 + g * GC, DSQ, hre, him, WSP(float, WS_BBR) + (size_t)gp * GC, WSP(float, WS_BBI) + (size_t)gp * GC, AB[2 * gp], AB[2 * gp + 1], wl, F.lane, WSP(bf16, WS_YP) + (size_t)row0 * 1024 + g * GC, dssm + g * GC);
        F.out[O_HRS + (size_t)bs * NG * NST + gp] = hre; F.out[O_HIS + (size_t)bs * NG * NST + gp] = him; }
}
}
namespace sattn {
constexpr int D = 128, SPG = 16, WAVES = 4, GE = 4, NSPLIT = 32, NSUB = PAST / SPG, PPS = NSUB / NSPLIT, PPW = PPS / WAVES, TOK_STRIDE = NH * HD;
constexpr int LDS_P = 0, LDS_MRG = WAVES * 64, MRG_REC = 4 + D, HALF_FLOATS = 2560;
constexpr float SCALE = 0.088388347648318440f;
using bf16x2 = __attribute__((ext_vector_type(2))) __bf16;
using u32x4  = __attribute__((ext_vector_type(4))) unsigned;
using f32x4  = __attribute__((ext_vector_type(4))) float;
using f32x8  = __attribute__((ext_vector_type(8))) float;
__device__ __forceinline__ float dot2(unsigned k, unsigned q, float acc) { return __builtin_amdgcn_fdot2_f32_bf16(__builtin_bit_cast(bf16x2, k), __builtin_bit_cast(bf16x2, q), acc, false); }
template <int CTRL> __device__ __forceinline__ float dpp(float x) { return __builtin_bit_cast(float, __builtin_amdgcn_mov_dpp(__builtin_bit_cast(int, x), CTRL, 0xf, 0xf, true)); }
constexpr int XOR1 = 0xB1, XOR2 = 0x4E, XOR7 = 0x141, XOR8 = 0x128, ROR4 = 0x124;
__device__ __forceinline__ float xrow16_max(float x) {
  auto s = __builtin_amdgcn_permlane16_swap(__float_as_uint(x), __float_as_uint(x), false, false); x = fmaxf(__uint_as_float(s[0]), __uint_as_float(s[1]));
  auto t = __builtin_amdgcn_permlane32_swap(__float_as_uint(x), __float_as_uint(x), false, false); return fmaxf(__uint_as_float(t[0]), __uint_as_float(t[1])); }
__device__ __forceinline__ float xrow16_sum(float x) {
  auto s = __builtin_amdgcn_permlane16_swap(__float_as_uint(x), __float_as_uint(x), false, false); x = __uint_as_float(s[0]) + __uint_as_float(s[1]);
  auto t = __builtin_amdgcn_permlane32_swap(__float_as_uint(x), __float_as_uint(x), false, false); return __uint_as_float(t[0]) + __uint_as_float(t[1]); }
__device__ __forceinline__ u32x4 tobf(f32x8 x) { u32x4 w = {cvtpk(x[0], x[1]), cvtpk(x[2], x[3]), cvtpk(x[4], x[5]), cvtpk(x[6], x[7])}; return w; }

__device__ __forceinline__ void split_unit(int unit, float* lds, int wave, int lane, const float* QS, const float* ck, const float* cv, const int* pt, const float* RP, float* PML, float* PO, int prb = 0) {
  const bool pad = (unsigned)unit >> 31; const int bh = pad ? 0 : (unit >> 5), s = pad ? 0 : (unit & 31), kvh = bh & 7, b = bh >> 3, r = lane >> 4, c = lane & 15;
  constexpr float C2 = SCALE * 1.4426950408889634f;
  const int p0 = s * PPS;
  const int npg = (pad || (prb & 4096)) ? 0 : PPW;
  int btv = 0;
  if (lane < PPW) { const int pg = p0 + wave + 4 * lane; btv = pt[b * NPAGES + (pg >> 3)] * PAGE + (pg & 7) * SPG; }
  u32x4 qpk[GE];
#pragma unroll
  for (int g = 0; g < GE; ++g) qpk[g] = tobf(*reinterpret_cast<const f32x8*>(QS + ((size_t)((b * NH + kvh) * DSQ + g)) * D + 8 * c));
  const size_t loff = (size_t)r * TOK_STRIDE + (size_t)kvh * D + 8 * c;
  const float* rpb = RP + (size_t)(b * NH + kvh) * PAST + r + 4 * (c >> 2);
#define SA_ISSUE(i_) do { const int tb_ = __builtin_amdgcn_readlane(btv, (i_)); const float* kb_ = ck + (size_t)tb_ * TOK_STRIDE + loff; const float* vb_ = cv + (size_t)tb_ * TOK_STRIDE + loff; \
    _Pragma("unroll") for (int t_ = 0; t_ < 4; ++t_) { Kn[t_] = __builtin_nontemporal_load(reinterpret_cast<const f32x8*>(kb_ + (size_t)t_ * 4 * TOK_STRIDE)); Vn[t_] = __builtin_nontemporal_load(reinterpret_cast<const f32x8*>(vb_ + (size_t)t_ * 4 * TOK_STRIDE)); } \
    Bn = rpb[(p0 + wave + 4 * (i_)) * SPG]; } while (0)
  f32x8 Kn[4], Vn[4]; float Bn;
  float m = -INFINITY, l = 0.f, acc[GE * 8];
#pragma unroll
  for (int k = 0; k < GE * 8; ++k) acc[k] = 0.f;
  if (npg > 0) SA_ISSUE(0);
  for (int i = 0; i < npg; ++i) {
    u32x4 Kc[4], Vc[4];
#pragma unroll
    for (int t = 0; t < 4; ++t) { Kc[t] = tobf(Kn[t]); Vc[t] = tobf(Vn[t]); }
    const float Bc = Bn;
    if (i + 1 < npg) SA_ISSUE(i + 1);
    float x[4 * GE];
#pragma unroll
    for (int t = 0; t < 4; ++t)
#pragma unroll
      for (int g = 0; g < GE; ++g) { float d = 0.f;
#pragma unroll
        for (int k = 0; k < 4; ++k) d = dot2(Kc[t][k], qpk[g][k], d);
        x[t * GE + g] = d; }
#define SA_TR(HALF, CTRL, BIT) _Pragma("unroll") for (int h = 0; h < (HALF); ++h) { \
      const float lo_ = x[h], hi_ = x[h + (HALF)]; const float t1_ = lo_ + dpp<CTRL>(lo_), t2_ = hi_ + dpp<CTRL>(hi_); x[h] = (c & (BIT)) ? t2_ : t1_; }
    SA_TR(8, XOR8, 8) SA_TR(4, XOR7, 4) SA_TR(2, XOR2, 2) SA_TR(1, XOR1, 1)
#undef SA_TR
    const float sc = fmaf(x[0], C2, Bc);
    float pm = sc; pm = fmaxf(pm, dpp<ROR4>(pm)); pm = fmaxf(pm, dpp<XOR8>(pm)); pm = xrow16_max(pm);
    const float mn = fmaxf(m, pm), msub = (mn == -INFINITY) ? 0.f : mn;
    const float alpha = __builtin_amdgcn_exp2f(m - msub), p = __builtin_amdgcn_exp2f(sc - msub);
    l = fmaf(l, alpha, p); m = mn;
#pragma unroll
    for (int q4 = 0; q4 < 4; ++q4) { const float al = q4 == 0 ? dpp<0x00>(alpha) : q4 == 1 ? dpp<0x55>(alpha) : q4 == 2 ? dpp<0xAA>(alpha) : dpp<0xFF>(alpha);
#pragma unroll
      for (int k = 0; k < 8; ++k) acc[q4 * 8 + k] *= al; }
    float* prow = lds + LDS_P + (wave * 4 + r) * 16;
    prow[c] = p;
    asm volatile("s_waitcnt lgkmcnt(0)" ::: "memory");
    f32x4 pr[GE];
#pragma unroll
    for (int u = 0; u < GE; ++u) pr[u] = *reinterpret_cast<const f32x4*>(prow + 4 * u);
#pragma unroll
    for (int t = 0; t < 4; ++t) { float vf[8];
#pragma unroll
      for (int k = 0; k < 4; ++k) { vf[2 * k] = __builtin_bit_cast(float, Vc[t][k] << 16); vf[2 * k + 1] = __builtin_bit_cast(float, Vc[t][k] & 0xffff0000u); }
#pragma unroll
      for (int g = 0; g < GE; ++g) { const float pg_ = pr[t][g];
#pragma unroll
        for (int k = 0; k < 8; ++k) acc[g * 8 + k] = fmaf(pg_, vf[k], acc[g * 8 + k]); } }
  }
#undef SA_ISSUE
#pragma unroll
  for (int k = 0; k < GE * 8; ++k) acc[k] = xrow16_sum(acc[k]);
  { float t = l; t += dpp<ROR4>(t); t += dpp<XOR8>(t); l = xrow16_sum(t); }
  float* mrg = lds + LDS_MRG;
  if (r == 0) {
#pragma unroll
    for (int g = 0; g < GE; ++g) { float* rec = mrg + (wave * GE + g) * MRG_REC;
#pragma unroll
      for (int k = 0; k < 8; k += 4) *reinterpret_cast<f32x4*>(rec + 4 + 8 * c + k) = f32x4{acc[g * 8 + k], acc[g * 8 + k + 1], acc[g * 8 + k + 2], acc[g * 8 + k + 3]};
      if (c == g) { rec[0] = m; rec[1] = l; } } }
  __syncthreads();
  { const int g = wave, d0 = 2 * lane; const size_t row = (size_t)(b * NH + kvh) * DSQ + g;
    float M = -INFINITY;
#pragma unroll
    for (int w = 0; w < WAVES; ++w) M = fmaxf(M, mrg[(w * GE + g) * MRG_REC]);
    float L = 0.f, o0 = 0.f, o1 = 0.f;
#pragma unroll
    for (int w = 0; w < WAVES; ++w) { const float* rec = mrg + (w * GE + g) * MRG_REC; const float lw = rec[1]; const float wt = (lw > 0.f) ? __builtin_amdgcn_exp2f(rec[0] - M) : 0.f;
      L = fmaf(wt, lw, L); o0 = fmaf(wt, rec[4 + d0], o0); o1 = fmaf(wt, rec[4 + d0 + 1], o1); }
    const size_t slot = row * NSPLIT + s;
    if (!pad && !(prb & 4096)) { *reinterpret_cast<float2*>(PO + slot * D + d0) = make_float2(o0, o1);
    if (lane == 0) *reinterpret_cast<float2*>(PML + 2 * slot) = make_float2(M, L); } }
  __syncthreads();
}
}

__device__ __forceinline__ void sample_combine(Frame& F) {
    const float* PML = WSP(float, WS_PML); const float* PO = WSP(float, WS_PO); const float* QS = WSP(float, WS_QS);
    constexpr float C2 = 0.088388347648318440f * 1.4426950408889634f;
    for (int row = (F.G == 256 ? F.gw - 96 * NWAVES : F.gw); row >= 0 && row < DBT * NH * DSQ; row += F.NGW) { const int t = row & 3, h = (row >> 2) & 7, b = row >> 5, d0 = 2 * F.lane; const unsigned live = WSP(unsigned, WS_LIST)[64 + (row >> 2)];
        const float2 q = *(const float2*)(QS + (size_t)row * HD + d0);
        float sn[DSQ]; float run = 0.f;
#pragma unroll
        for (int j = 0; j < DSQ; ++j) { const float2 k = *(const float2*)(F.out + O_KS + ((size_t)(b * DSQ + j) * NH + h) * HD + d0); const float d = wave_sum(q.x * k.x + q.y * k.y);
            run += F.out[O_LFS + (size_t)(b * DSQ + j) * NH + h]; sn[j] = (j <= t) ? fmaf(d, C2, -run * LOG2E) : -INFINITY; }
        float M = -INFINITY;
#pragma unroll 8
        for (int s = 0; s < sattn::NSPLIT; ++s) if ((live >> s) & 1u) M = fmaxf(M, PML[2 * ((size_t)row * sattn::NSPLIT + s)]);
#pragma unroll
        for (int j = 0; j < DSQ; ++j) M = fmaxf(M, sn[j]);
        float L = 0.f, o0 = 0.f, o1 = 0.f;
#pragma unroll 8
        for (int s = 0; s < sattn::NSPLIT; ++s) { if (!((live >> s) & 1u)) continue; const size_t slot = (size_t)row * sattn::NSPLIT + s; const float ls = PML[2 * slot + 1], w = (ls > 0.f) ? __builtin_amdgcn_exp2f(PML[2 * slot] - M) : 0.f;
            const float2 a = *(const float2*)(PO + slot * HD + d0); L = fmaf(w, ls, L); o0 = fmaf(w, a.x, o0); o1 = fmaf(w, a.y, o1); }
#pragma unroll
        for (int j = 0; j < DSQ; ++j) { const float p = __builtin_amdgcn_exp2f(sn[j] - M); const float2 v = *(const float2*)(F.out + O_VS + ((size_t)(b * DSQ + j) * NH + h) * HD + d0);
            L += p; o0 = fmaf(p, v.x, o0); o1 = fmaf(p, v.y, o1); }
        const float inv = 1.0f / L;
        *(unsigned*)(WSP(bf16, WS_YY) + (size_t)(MPR + b * DSQ + t) * 2048 + 1024 + h * HD + d0) = cvtpk(o0 * inv, o1 * inv); }
}
namespace sk {
typedef float f32x16 __attribute__((ext_vector_type(16)));
__device__ __forceinline__ void st_bf16(bf16* p, float x) { *p = (bf16)(cvtpk(x, 0.f) & 0xffffu); }
__device__ __forceinline__ float ld_bf16(const bf16* p) { return __uint_as_float((unsigned)(*p) << 16); }
__device__ __forceinline__ float sigm(float x) { return 1.0f / (1.0f + __expf(-x)); }
template <int NBLK, class Epi>
__device__ __forceinline__ void run(Frame& F, const bf16* A, int lda, const bf16* Bt, int ldb, int K, int nunits, const Epi& E, int ustart = -1, int ustride = 0) {
    float* P = (float*)F.lds;
    const int r = F.lane & 31, kh = F.lane >> 5, kw = K >> 3, nb4 = kw >> 6;
    if (ustart < 0) { ustart = F.G - 1 - (int)blockIdx.x; ustride = F.G; }
    for (int u = ustart; u < nunits; u += ustride) {
        f32x16 acc[NBLK];
#pragma unroll
        for (int b = 0; b < NBLK; ++b) acc[b] = (f32x16){0.f, 0.f, 0.f, 0.f, 0.f, 0.f, 0.f, 0.f, 0.f, 0.f, 0.f, 0.f, 0.f, 0.f, 0.f, 0.f};
        const bf16* ap[NBLK]; const bf16* bp[NBLK];
#pragma unroll
        for (int b = 0; b < NBLK; ++b) { ap[b] = A + (size_t)r * lda + E.koff(b) + F.wave * kw + 8 * kh; bp[b] = Bt + (size_t)(E.brow(u, b) + r) * ldb + E.koff(b) + F.wave * kw + 8 * kh; }
#define SK_LOAD(AF, BF, s_) do { _Pragma("unroll") for (int i = 0; i < 4; ++i) { _Pragma("unroll") for (int b = 0; b < NBLK; ++b) { \
            AF[b][i] = (b == 0 || Epi::SPLIT_A) ? *(const bf16x8*)(ap[b] + 64 * (s_) + 16 * i) : AF[0][i]; BF[b][i] = *(const bf16x8*)(bp[b] + 64 * (s_) + 16 * i); } } } while (0)
        bf16x8 af[NBLK][4], bf[NBLK][4], an[NBLK][4], bn[NBLK][4];
        SK_LOAD(af, bf, 0);
#pragma unroll 1
        for (int s = 0; s < nb4; ++s) {
            if (s + 1 < nb4) SK_LOAD(an, bn, s + 1);
#pragma unroll
            for (int i = 0; i < 4; ++i)
#pragma unroll
                for (int b = 0; b < NBLK; ++b) acc[b] = __builtin_amdgcn_mfma_f32_32x32x16_bf16(af[b][i], bf[b][i], acc[b], 0, 0, 0);
#pragma unroll
            for (int i = 0; i < 4; ++i)
#pragma unroll
                for (int b = 0; b < NBLK; ++b) { af[b][i] = an[b][i]; bf[b][i] = bn[b][i]; } }
#undef SK_LOAD
#pragma unroll
        for (int b = 0; b < NBLK; ++b)
#pragma unroll
            for (int q = 0; q < 16; ++q) P[((F.wave * NBLK + b) * 32 + ((q & 3) + 8 * (q >> 2) + 4 * kh)) * 32 + r] = acc[b][q];
        __syncthreads();
#pragma unroll
        for (int e2 = 0; e2 < 2; ++e2) { const int e = F.tid + 512 * e2, row = e >> 5, col = e & 31; float v[NBLK];
#pragma unroll
            for (int b = 0; b < NBLK; ++b) { float t = 0.f;
#pragma unroll
                for (int w = 0; w < 8; ++w) t += P[((w * NBLK + b) * 32 + row) * 32 + col];
                v[b] = t; }
            E.apply(u, row, col, v); }
        __syncthreads();
    }
}
struct In { float* Z; bf16* G; const float* R1;
    static constexpr bool SPLIT_A = false; __device__ __forceinline__ int koff(int) const { return 0; }
    __device__ __forceinline__ int brow(int u, int) const { return 32 * u; }
    __device__ __forceinline__ void apply(int u, int row, int col, const float* v) const { const int c = 32 * u + col; const size_t gr = MPR + row; const float z = v[0] * R1[gr];
        if (c < 4096) Z[gr * 4096 + c] = z; else st_bf16(G + gr * 4096 + (c - 4096), sigm(z)); } };
struct Glu { const bf16* YP; bf16* YY; const float* bias;
    static constexpr bool SPLIT_A = false; __device__ __forceinline__ int koff(int) const { return 0; }
    __device__ __forceinline__ int brow(int u, int) const { return 32 * u; }
    __device__ __forceinline__ void apply(int u, int row, int col, const float* v) const { const int c = 32 * u + col; const size_t gr = MPR + row; st_bf16(YY + gr * 2048 + c, ld_bf16(YP + gr * 1024 + c) * sigm(v[0] + bias[c])); } };
struct Merge { const bf16* G; bf16* MG;
    static constexpr bool SPLIT_A = true; __device__ __forceinline__ int koff(int b) const { return 1024 * b; }
    __device__ __forceinline__ int brow(int u, int) const { return 32 * u; }
    __device__ __forceinline__ void apply(int u, int row, int col, const float* v) const { const int c = 32 * u + col; const size_t gr = MPR + row;
        st_bf16(MG + gr * 2048 + c, ld_bf16(G + gr * 4096 + c) * v[0] + ld_bf16(G + gr * 4096 + 2048 + c) * v[1]); } };
struct Out { const float* xs; bf16* XB; float* SSR;
    static constexpr bool SPLIT_A = false; __device__ __forceinline__ int koff(int) const { return 0; }
    __device__ __forceinline__ int brow(int u, int) const { return 32 * u; }
    __device__ __forceinline__ void apply(int u, int row, int col, const float* v) const { const int c = 32 * u + col; const size_t gr = MPR + row; const float x1 = xs[(size_t)row * 2048 + c] + v[0];
        st_bf16(XB + gr * 2048 + c, x1); float s = x1 * x1;
        s += __shfl_xor(s, 1); s += __shfl_xor(s, 2); s += __shfl_xor(s, 4); s += __shfl_xor(s, 8); s += __shfl_xor(s, 16);
        if (col == 0) __hip_atomic_fetch_add(SSR + MPR + row, s, __ATOMIC_RELAXED, __HIP_MEMORY_SCOPE_AGENT); } };
struct FF1 { const float* SSR; bf16* H;
    static constexpr bool SPLIT_A = false; __device__ __forceinline__ int koff(int) const { return 0; }
    __device__ __forceinline__ int brow(int u, int b) const { const int h0 = 32 * u; return 256 * (h0 >> 7) + (h0 & 127) + 128 * b; }
    __device__ __forceinline__ void apply(int u, int row, int col, const float* v) const {
        const float r2 = 1.0f / sqrtf(SSR[MPR + row] * (1.0f / 2048.0f) + RMS_EPS), g = v[0] * r2, up = v[1] * r2;
        st_bf16(H + (size_t)(MPR + row) * DFF + 32 * u + col, g * sigm(g) * up); } };
struct FF2 { const bf16* XB; float* ys;
    static constexpr bool SPLIT_A = false; __device__ __forceinline__ int koff(int) const { return 0; }
    __device__ __forceinline__ int brow(int u, int) const { return 32 * u; }
    __device__ __forceinline__ void apply(int u, int row, int col, const float* v) const { const int c = 32 * u + col; ys[(size_t)row * 2048 + c] = ld_bf16(XB + (size_t)(MPR + row) * 2048 + c) + v[0]; } };
}
__device__ __forceinline__ pattn::BlockRef<__hip_bfloat16, __hip_bfloat16> attn_ref(unsigned char* ws, int u) {
    constexpr int NQB = SEQ / pattn::QB;
    const int qb = NQB - 1 - (u >> 4), bh = u & 15; const size_t hb = (size_t)bh * SEQ * HD;
    pattn::BlockRef<__hip_bfloat16, __hip_bfloat16> r;
    r.Q = (const __hip_bfloat16*)(ws + WS_QB) + hb + (size_t)qb * pattn::QB * HD; r.K = (const __hip_bfloat16*)(ws + WS_KB) + hb; r.V = (const __hip_bfloat16*)(ws + WS_VB) + hb;
    r.CK = (const unsigned short*)(ws + WS_NCK) + (size_t)bh * SEQ * 16; r.P0 = qb * pattn::QB; r.XF = (const float*)(ws + WS_XF) + (size_t)bh * SEQ;
    r.jlo = __builtin_amdgcn_readfirstlane(((const int*)(ws + WS_JLO))[bh * 16 + qb]); r.negb2 = -__uint_as_float(__builtin_amdgcn_readfirstlane(__float_as_uint(((const float*)(ws + WS_SS2))[0])));
    r.O = (__hip_bfloat16*)(ws + WS_YY) + ((size_t)(bh >> 3) * SEQ + (size_t)qb * pattn::QB) * 2048 + 1024 + (bh & 7) * HD;
    return r;
}
__device__ __forceinline__ void refresh_lane(Frame& F) {
    int l; asm volatile("v_mbcnt_lo_u32_b32 %0, -1, 0\n\tv_mbcnt_hi_u32_b32 %0, -1, %0" : "=v"(l)); F.lane = l; F.tid = F.wave * 64 + l;
    unsigned long long w_ = (unsigned long long)F.ws, o_ = (unsigned long long)F.out; asm volatile("" : "+s"(w_), "+s"(o_));
    F.ws = (unsigned char*)(__attribute__((address_space(1))) unsigned char*)w_; F.out = (float*)(__attribute__((address_space(1))) float*)o_;
}

__device__ __forceinline__ int pull(Frame& F, int qword) {
    volatile LAS unsigned* w = (volatile LAS unsigned*)(F.lds + MISC_OFF + 64);
    if (F.tid == 0) *w = __hip_atomic_fetch_add((unsigned*)(F.ws + WS_CTL) + CW_Q + qword, 1u, __ATOMIC_RELAXED, __HIP_MEMORY_SCOPE_AGENT);
    __syncthreads(); const unsigned v = *w; __syncthreads(); return __builtin_amdgcn_readfirstlane((int)v);
}
__device__ __forceinline__ int pull8(Frame& F, int qword0, int nunits) {
    volatile LAS unsigned* w = (volatile LAS unsigned*)(F.lds + MISC_OFF + 64);
    if (F.tid == 0) { unsigned* heads = (unsigned*)(F.ws + WS_CTL) + CW_Q + qword0; const unsigned per = (unsigned)nunits >> 3; unsigned r = (unsigned)nunits;
        for (unsigned t = 0; t < 8u; ++t) { const unsigned q = (blockIdx.x + t) & 7u;
            if (__hip_atomic_load(heads + 64 * q, __ATOMIC_RELAXED, __HIP_MEMORY_SCOPE_AGENT) >= per) continue;
            const unsigned i = __hip_atomic_fetch_add(heads + 64 * q, 1u, __ATOMIC_RELAXED, __HIP_MEMORY_SCOPE_AGENT);
            if (i < per) { r = i * 8u + q; break; } }
        *w = r; }
    __syncthreads(); const unsigned v = *w; __syncthreads(); return __builtin_amdgcn_readfirstlane((int)v);
}
__device__ __forceinline__ void attn_prompt_phase(Frame& F) {
    using BR = pattn::BlockRef<__hip_bfloat16, __hip_bfloat16>;
    constexpr int NU = NB * NH * (SEQ / pattn::QB);
    char* lds = (char*)F.lds;
    int u = pull(F, 64); if (u >= NU) return;
    BR cur = attn_ref(F.ws, u);
    pattn::Seam<__hip_bfloat16> S;
    pattn::causal_swa_prime<__hip_bfloat16, __hip_bfloat16>(cur, SEQ, lds, S, F.wave, F.lane);
    for (;;) { const int un = pull(F, 64); const bool last = un >= NU;
        const BR nxt = last ? cur : attn_ref(F.ws, un);
        pattn::causal_swa_block<__hip_bfloat16, __hip_bfloat16>(cur, nxt, SEQ, SEQ, lds, S, F.wave, F.lane);
        if (last) break;
        cur = nxt; }
}

constexpr int N_PHASES = 9;
__global__ void __launch_bounds__(NWAVES * 64, 2) fwd(Args args) {
    extern __shared__ __attribute__((aligned(16))) unsigned char lds[];
    Frame F;
    F.lds = lds; F.wave = __builtin_amdgcn_readfirstlane(threadIdx.x >> 6); refresh_lane(F); F.G = gridDim.x;
    F.gw = blockIdx.x * NWAVES + F.wave; F.NGW = F.G * NWAVES;
    F.out = args.out; F.ws = args.ws;
    volatile LAS unsigned* MISC = (volatile LAS unsigned*)((LAS unsigned char*)lds + MISC_OFF);
    for (int u = F.tid; u < 128; u += NWAVES * 64) MISC[u] = 0u;
    __syncthreads();
    const int lo = args.ph_lo, hi = args.ph_hi;
    XcdBarrier bar; bar.bar = (unsigned*)(F.ws + WS_CTL) + CW_BAR; bar.x = 0; bar.st = nullptr;
    if (hi - lo > 1) bar = xcd_barrier_post((unsigned*)(F.ws + WS_CTL) + CW_BAR, MISC + 8, F.tid == 0);
#ifndef PH_MASK
#define PH_MASK 0x1ff
#endif
#define IN(k) (((PH_MASK >> (k)) & 1) && lo <= (k) && (k) < hi)
#define SEAM(k) do { if (IN(k) && IN((k) + 1)) { xcd_barrier(bar, F.tid == 0); refresh_lane(F); } } while (0)
#ifndef PH_DUP
#define PH_DUP 0
#endif
#ifndef SUB_DUP
#define SUB_DUP 0
#endif
#define SUBREP(k) _Pragma("unroll") for (int srep = 0; srep < 1 + ((SUB_DUP >> (k)) & 1); ++srep)
#define REP(k) _Pragma("unroll") for (int rep = 0; rep < 1 + ((PH_DUP >> (k)) & 1); ++rep)
#define REPBAR() do { if (rep) xcd_barrier(bar, F.tid == 0); } while (0)
    LAS unsigned char* ring = (LAS unsigned char*)lds;

    if (IN(0)) REP(0) { REPBAR(); phase0(F, args.probe); } SEAM(0);
    if (IN(1)) REP(1) { REPBAR();
        s5::gen_tables(F); __syncthreads();
        pg8::Gemm g{(const pg8::bf16_t*)WSP(bf16, WS_XA), (const pg8::bf16_t*)WSP(bf16, WS_W1T), MPR, 8192, 2048, 2048, 2048}; pg8::StaticOrder S; S.init(MPR, 8192, F.G, (int)blockIdx.x);
        pg8::EpiIn E{(pg8::bf16_t*)WSP(bf16, WS_G), WSP(float, WS_R1), (pg8::bf16_t*)WSP(bf16, WS_UB), (pg8::bf16_t*)WSP(bf16, WS_QB), (pg8::bf16_t*)WSP(bf16, WS_KB), (pg8::bf16_t*)WSP(bf16, WS_VB),
                      F.out + O_KP, F.out + O_VP, INP(float, I_GQ), INP(float, I_GK), (LAS float*)(ring + 131072)};
        pg8::gemm_phase<pg8::EpiIn, pg8::StaticOrder, true, true>(ring, g, S, E, F.wave, F.lane);
        __syncthreads();
        sk::run<1>(F, WSP(bf16, WS_XA) + (size_t)MPR * 2048, 2048, WSP(bf16, WS_W1T), 2048, 2048, 256, sk::In{WSP(float, WS_Z), WSP(bf16, WS_G), WSP(float, WS_R1)}); } SEAM(1);
    #ifndef PH2_MASK
#define PH2_MASK 15
#endif
    if (IN(2)) REP(2) { REPBAR(); if (PH2_MASK & 1) SUBREP(0) rowpass(F); if (PH2_MASK & 2) SUBREP(1) s5::passE(F); if (PH2_MASK & 4) SUBREP(2) { __syncthreads(); if (F.G == 256) { if ((int)blockIdx.x >= 240) logf_cumsum(F, (int)blockIdx.x - 240); } else for (int it = (int)blockIdx.x; it < NB * NH; it += F.G) logf_cumsum(F, it); }     if ((PH2_MASK & 8) && rep == 0) rpast_fix(F);
        if (F.gw == (F.G == 256 ? 200 * NWAVES : 0)) { const float* const gqp = INP(float, I_GQ); const float* const gkp = INP(float, I_GK);
            float mq = fmaxf(fabsf(gqp[F.lane]), fabsf(gqp[F.lane + 64])), mk = fmaxf(fabsf(gkp[F.lane]), fabsf(gkp[F.lane + 64]));
#pragma unroll
            for (int o = 1; o < 64; o <<= 1) { mq = fmaxf(mq, __shfl_xor(mq, o)); mk = fmaxf(mk, __shfl_xor(mk, o)); }
            const float bq2 = 11.313708498984761f * 1.4426950408889634f * mq * mk;
            const float thr = -(3.f * bq2 + 40.f); const float* tp = WSP(float, WS_TPG) + F.lane * NPAGES; float suf = 0.f; unsigned flags = 0u;
            for (int pgi = NPAGES - 1; pgi >= 0; --pgi) { if ((pgi & 3) == 3 && !(suf * LOG2E < thr)) flags |= 1u << (pgi >> 2); suf += tp[pgi]; }
            unsigned* L = WSP(unsigned, WS_LIST); L[64 + F.lane] = flags; unsigned base = 0u;
            for (int s = 0; s < 32; ++s) { const bool lv = (flags >> s) & 1u; const unsigned long long mk2 = __ballot(lv);
                if (lv) L[256 + base + __builtin_popcountll(mk2 & ((1ull << F.lane) - 1ull))] = ((unsigned)F.lane << 5) | (unsigned)s;
                base += (unsigned)__builtin_popcountll(mk2); }
            if (F.lane == 0) { L[0] = base; if (base & 1u) L[256 + base] = 0x80000000u; } }
  __syncthreads(); if ((int)blockIdx.x >= 128 && F.G == 256) weight_copies(F, WI_FF10, WI_FF10 + WI_FF1, (int)blockIdx.x - 128, 128); else if (F.G != 256) weight_copies(F, WI_FF10, WI_FF10 + WI_FF1, (int)blockIdx.x, F.G); } SEAM(2);
    if (IN(3)) REP(3) { REPBAR(); refresh_lane(F);
        constexpr int NSTREAM = 128; const bool stream = (int)blockIdx.x < NSTREAM;
        const int prb = args.probe;
#define P3_STREAM_LOOP() do { const int half = F.wave >> 2; const unsigned* const L = WSP(unsigned, WS_LIST); const int nbu_ = (int)((__builtin_amdgcn_readfirstlane((int)L[0]) + 1) >> 1); const int nbu = (prb & 512) ? (nbu_ < 256 ? nbu_ : 256) : ((prb & 1024) ? (nbu_ < 128 ? nbu_ : 128) : ((prb & 2048) ? 16 : nbu_)); \
            volatile LAS unsigned* qw = (volatile LAS unsigned*)(F.lds + MISC_OFF + 64); unsigned* qh = (unsigned*)(F.ws + WS_CTL) + CW_Q; \
            int bu = pull(F, 0); \
            while (bu < nbu) { unsigned pend = 0u; if (F.tid == 0) pend = __hip_atomic_fetch_add(qh, 1u, __ATOMIC_RELAXED, __HIP_MEMORY_SCOPE_AGENT); \
                const float* const ckp = INP(float, I_CK); const float* const cvp = INP(float, I_CV); const int* const ptp = INP(int, I_PT); \
                sattn::split_unit(__builtin_amdgcn_readfirstlane((int)L[256 + 2 * bu + half]), (float*)F.lds + half * sattn::HALF_FLOATS, F.wave & 3, F.lane, WSP(float, WS_QS), ckp, cvp, ptp, WSP(float, WS_RP), WSP(float, WS_PML), WSP(float, WS_PO), prb); \
                if (F.tid == 0) *qw = pend; __syncthreads(); bu = __builtin_amdgcn_readfirstlane((int)*qw); __syncthreads(); } \
            __syncthreads(); refresh_lane(F); } while (0)
        if (stream && !(prb & 1)) P3_STREAM_LOOP();
        if (!(prb & 2)) attn_prompt_phase(F);
        __syncthreads(); refresh_lane(F);
        if (!(prb & 4)) { for (int bu = pull(F, 128); bu < 256; bu = pull(F, 128)) s5::passY(F, bu * 8 + F.wave, 1 << 30);
        for (int bu = pull(F, 192); bu < 64; bu = pull(F, 192)) s5::passB(F, bu * 8 + F.wave, 1 << 30); }
        __syncthreads(); refresh_lane(F);
        if (!stream && !(prb & 17)) P3_STREAM_LOOP();
#undef P3_STREAM_LOOP
    } SEAM(3);
    if (IN(4)) REP(4) { REPBAR();
        sample_combine(F);
        if ((int)blockIdx.x >= 128 && F.G == 256) { weight_copies(F, WI_BR0, WI_FF10, (int)blockIdx.x - 128, 128); weight_copies(F, WI_FF10 + WI_FF1, WI_FF10 + WI_FF1 + 256, (int)blockIdx.x - 128, 128); }
        else if (F.G != 256) { weight_copies(F, WI_BR0, WI_FF10, (int)blockIdx.x, F.G); weight_copies(F, WI_FF10 + WI_FF1, WI_FF20, (int)blockIdx.x, F.G); }
        __syncthreads(); refresh_lane(F);
        { pg8::Gemm g{(const pg8::bf16_t*)WSP(bf16, WS_YP), (const pg8::bf16_t*)WSP(bf16, WS_WGLU), MPR, 1024, 1024, 1024, 1024}; pg8::StaticOrder S; S.init(MPR, 1024, F.G, (int)blockIdx.x);
          pg8::EpiGlu E{(const pg8::bf16_t*)WSP(bf16, WS_YP), (pg8::bf16_t*)WSP(bf16, WS_YY), INP(float, I_BGLU)};
          pg8::gemm_phase<pg8::EpiGlu, pg8::StaticOrder, true, true>(ring, g, S, E, F.wave, F.lane); }
        __syncthreads(); refresh_lane(F);
        if ((int)blockIdx.x < 96 && F.G == 256) weight_copies(F, WI_FF10 + WI_FF1 + 256, WI_FF20, (int)blockIdx.x, 96);
        __syncthreads();
        sk::run<1>(F, WSP(bf16, WS_YP) + (size_t)MPR * 1024, 1024, WSP(bf16, WS_WGLU), 1024, 1024, 32, sk::Glu{WSP(bf16, WS_YP), WSP(bf16, WS_YY), INP(float, I_BGLU)}); } SEAM(4);
    if (IN(5)) REP(5) { REPBAR();
        pg8::Gemm g{(const pg8::bf16_t*)WSP(bf16, WS_YY), (const pg8::bf16_t*)WSP(bf16, WS_WBR), MPR, 2048, 2048, 2048, 2048}; pg8::StaticOrder S; S.init(MPR, 2048, F.G, (int)blockIdx.x);
        pg8::EpiMerge E{(const pg8::bf16_t*)WSP(bf16, WS_G), (pg8::bf16_t*)WSP(bf16, WS_MG)};
        pg8::gemm_phase<pg8::EpiMerge, pg8::StaticOrder, true, true>(ring, g, S, E, F.wave, F.lane);
        __syncthreads();
        sk::run<2>(F, WSP(bf16, WS_YY) + (size_t)MPR * 2048, 2048, WSP(bf16, WS_WBR), 2048, 1024, 64, sk::Merge{WSP(bf16, WS_G), WSP(bf16, WS_MG)}); } SEAM(5);
    if (IN(6)) REP(6) { REPBAR();
        pg8::Gemm g{(const pg8::bf16_t*)WSP(bf16, WS_MG), (const pg8::bf16_t*)WSP(bf16, WS_WOUT), MPR, 2048, 2048, 2048, 2048}; pg8::StaticOrder S; S.init(MPR, 2048, F.G, (int)blockIdx.x);
        pg8::EpiOut E{INP(float, I_XP), INP(float, I_XS), (pg8::bf16_t*)WSP(bf16, WS_XB), WSP(float, WS_SSR)};
        pg8::gemm_phase<pg8::EpiOut, pg8::StaticOrder, true, true>(ring, g, S, E, F.wave, F.lane);
        __syncthreads();
        sk::run<1>(F, WSP(bf16, WS_MG) + (size_t)MPR * 2048, 2048, WSP(bf16, WS_WOUT), 2048, 2048, 64, sk::Out{INP(float, I_XS), WSP(bf16, WS_XB), WSP(float, WS_SSR)}); } SEAM(6);
    if (IN(7)) REP(7) { REPBAR();
        pg8::Gemm g{(const pg8::bf16_t*)WSP(bf16, WS_XB), (const pg8::bf16_t*)WSP(bf16, WS_WFF1), MPR, 2 * DFF, 2048, 2048, 2048}; pg8::StaticOrder S; S.init(MPR, 2 * DFF, F.G, (int)blockIdx.x);
        pg8::EpiFF1 E{WSP(float, WS_SSR), (pg8::bf16_t*)WSP(bf16, WS_H), args.probe};
        pg8::gemm_phase<pg8::EpiFF1, pg8::StaticOrder, true, true>(ring, g, S, E, F.wave, F.lane);
        __syncthreads();
        if (F.G == 256) sk::run<2>(F, WSP(bf16, WS_XB) + (size_t)MPR * 2048, 2048, WSP(bf16, WS_WFF1), 2048, 2048, DFF / 32, sk::FF1{WSP(float, WS_SSR), WSP(bf16, WS_H)}, (int)blockIdx.x >= 128 ? 255 - (int)blockIdx.x : DFF / 32, 128);
        else sk::run<2>(F, WSP(bf16, WS_XB) + (size_t)MPR * 2048, 2048, WSP(bf16, WS_WFF1), 2048, 2048, DFF / 32, sk::FF1{WSP(float, WS_SSR), WSP(bf16, WS_H)});
        __syncthreads(); refresh_lane(F);
        if ((int)blockIdx.x >= 128 && F.G == 256) weight_copies(F, WI_FF20, WI_END, (int)blockIdx.x - 128, 128);
        else if (F.G != 256) weight_copies(F, WI_FF20, WI_END, (int)blockIdx.x, F.G); } SEAM(7);
    if (IN(8)) REP(8) { REPBAR();
        pg8::Gemm g{(const pg8::bf16_t*)WSP(bf16, WS_H), (const pg8::bf16_t*)WSP(bf16, WS_WFF2), MPR, 2048, DFF, DFF, DFF}; pg8::StaticOrder S; S.init(MPR, 2048, F.G, (int)blockIdx.x);
        pg8::EpiFF2 E{(const pg8::bf16_t*)WSP(bf16, WS_XB), F.out + O_YP, F.out + O_YS};
        pg8::gemm_phase<pg8::EpiFF2, pg8::StaticOrder, true, true>(ring, g, S, E, F.wave, F.lane);
        __syncthreads();
        sk::run<1>(F, WSP(bf16, WS_H) + (size_t)MPR * DFF, DFF, WSP(bf16, WS_WFF2), DFF, DFF, 64, sk::FF2{WSP(bf16, WS_XB), F.out + O_YS}); }
#undef IN
#undef SEAM
}

extern "C" void kernel_launch(void* const* d_in, const int* in_sizes, int n_in, void* d_out, int out_size, void* d_ws, size_t ws_size, hipStream_t stream) {
    static int grid = 0;
    if (grid == 0) {
        if (n_in != 30 || out_size != (int)O_END || ws_size < WS_END) { fprintf(stderr, "kernel_launch: unexpected shapes (n_in %d out %d ws %zu)\n", n_in, out_size, ws_size); grid = -1; return; }
        int dev = 0, cus = 0, per_cu = 0;
        if (hipGetDevice(&dev) != hipSuccess || hipDeviceGetAttribute(&cus, hipDeviceAttributeMultiprocessorCount, dev) != hipSuccess) { grid = -1; return; }
        if (hipFuncSetAttribute((const void*)fwd, hipFuncAttributeMaxDynamicSharedMemorySize, LDS_BYTES) != hipSuccess) { fprintf(stderr, "kernel_launch: hipFuncSetAttribute failed\n"); grid = -1; return; }
        if (hipOccupancyMaxActiveBlocksPerMultiprocessor(&per_cu, (const void*)fwd, NWAVES * 64, LDS_BYTES) != hipSuccess || per_cu < 1) fprintf(stderr, "kernel_launch: occupancy query reports %d\n", per_cu);
        (void)hipGetLastError();
        grid = cus;
    }
    if (grid < 0) return;
    if (hipMemsetAsync((char*)d_ws + WS_CTL, 0, CTL_ZERO_BYTES, stream) != hipSuccess) return;
    Args a{};
    for (int i = 0; i < 30; ++i) a.in[i] = d_in[i];
    a.out = (float*)d_out; a.ws = (unsigned char*)d_ws;
#if MK_SPLIT
    for (int p = 0; p < N_PHASES; ++p) { a.ph_lo = p; a.ph_hi = p + 1; hipLaunchKernelGGL(fwd, dim3(grid), dim3(NWAVES * 64), LDS_BYTES, stream, a); }
#else
    a.ph_lo = 0; a.ph_hi = N_PHASES; hipLaunchKernelGGL(fwd, dim3(grid), dim3(NWAVES * 64), LDS_BYTES, stream, a);
#endif
#ifdef PROBE_EXTRA_PHASE
    a.ph_lo = PROBE_EXTRA_PHASE; a.ph_hi = PROBE_EXTRA_PHASE + 1;
#ifdef PROBE_SKIP
    a.probe = PROBE_SKIP;
#endif
    hipLaunchKernelGGL(fwd, dim3(grid), dim3(NWAVES * 64), LDS_BYTES, stream, a);
#endif
#ifdef PROBE_EXTRA_LO
    (void)hipMemsetAsync((char*)d_ws + WS_CTL, 0, CTL_ZERO_BYTES, stream);
    a.ph_lo = PROBE_EXTRA_LO; a.ph_hi = PROBE_EXTRA_HI;
#ifdef PROBE_SKIP
    a.probe = PROBE_SKIP;
#endif
    hipLaunchKernelGGL(fwd, dim3(grid), dim3(NWAVES * 64), LDS_BYTES, stream, a);
#endif
}
```

```cpp
#include <hip/hip_runtime.h>
#include <hip/hip_bf16.h>
#include <cstdio>
#include <cstdint>

#ifndef MK_SPLIT
#define MK_SPLIT 0
#endif

constexpr int DM = 2048, NB = 2, SEQ = 4096, MPR = NB * SEQ, DBT = 8, DSQ = 4, MSM = DBT * DSQ, MR = MPR + MSM, MPAD = 8448;
constexpr int DSSM = 1024, NG = 64, NST = 64, GC = 16, NH = 8, HD = 128, DATT = 1024, DFF = 5632, NIN = 8200;
constexpr int PAST = 16384, PAGE = 128, NPAGES = 128;
constexpr float RMS_EPS = 1e-6f;
constexpr float LOG2E = 1.4426950408889634f;
constexpr int CT = 16, NCHK = MPR / CT, CPB = SEQ / CT;

namespace pg8 {
#define PG8_LAS __attribute__((address_space(3)))
typedef unsigned short bf16_t;
typedef short bf16x8 __attribute__((ext_vector_type(8)));
typedef float f32x4 __attribute__((ext_vector_type(4)));
typedef unsigned u32x4 __attribute__((ext_vector_type(4)));
constexpr int BM = 256, BK = 64, HALF = 128, HTB = HALF * BK * 2  , STAGE_BYTES = 8 * HTB, NXCD = 8, WGM = 8;

__host__ __device__ __forceinline__ int lds_byte(int r, int c) { const int st = (r >> 4) * 2 + (c >> 5), rr = r & 15, cc = c & 31, ob = rr * 64 + cc * 2; return st * 1024 + (ob ^ (((ob >> 9) & 1) << 5)); }
__host__ __device__ __forceinline__ void stage_rc(int b, int& R, int& C) { const int st = b / 1024, sb = b % 1024, swz = sb ^ (((sb >> 9) & 1) << 5); R = (st >> 1) * 16 + swz / 64; C = (st & 1) * 32 + (swz % 64) / 2; }
__host__ __device__ __forceinline__ int perm32(int rho) { const int n = rho >> 4, i = rho & 15; return 8 * (i >> 2) + 4 * n + (i & 3); }

struct Unit { int pm, pn; };
struct Gemm { const bf16_t* A; const bf16_t* Bt; int M, N, K, lda, ldb; };

struct StaticOrder {
    int nM, nN, nwg, G, c;
    __host__ __device__ void init(int M, int N, int G_, int c_) { nM = M / BM; nN = N / BM; nwg = nM * nN; G = G_; c = c_; }
    __host__ __device__ bool next(int i, Unit& u) const {
        const long L = (long)i * G + c; if (L >= nwg) return false;
        int wgid = (int)L; { const int q = nwg / NXCD, r = nwg % NXCD, xcd = wgid % NXCD, off = wgid / NXCD; wgid = (xcd < r ? xcd * (q + 1) : r * (q + 1) + (xcd - r) * q) + off; }
        const int nig = WGM * nN, gid = wgid / nig, fm = gid * WGM, gsz = (nM - fm) < WGM ? (nM - fm) : WGM;
        u.pm = fm + ((wgid % nig) % gsz); u.pn = (wgid % nig) / gsz; return true;
    }
    __device__ __forceinline__ void a_ready(const Unit&) const {}
    __device__ __forceinline__ void done(const Unit&) const {}
};

__device__ __forceinline__ unsigned cvt_pk_bf16(float lo, float hi) { unsigned r; asm volatile("v_cvt_pk_bf16_f32 %0, %1, %2" : "=v"(r) : "v"(lo), "v"(hi)); return r; }
typedef float f32x2 __attribute__((ext_vector_type(2)));
__device__ __forceinline__ f32x2 gelu_pk(f32x2 v) {
    const f32x2 av = __builtin_elementwise_abs(v), d = av * 0.2316418882f + 1.0f;
    f32x2 t; t.x = __builtin_amdgcn_rcpf(d.x); t.y = __builtin_amdgcn_rcpf(d.y);
    f32x2 q = t * 0.5307027145f + (-0.7265760135f); q = q * t + 0.7107068705f; q = q * t + (-0.142248368f); q = q * t + 0.127414796f; q = q * t;
    const f32x2 s = (v * v) * (-0.72134752044f);
    f32x2 e; e.x = __builtin_amdgcn_exp2f(s.x); e.y = __builtin_amdgcn_exp2f(s.y);
    const f32x2 m = v * (q * e), r = v - m;
    f32x2 o; o.x = v.x < 0.f ? m.x : r.x; o.y = v.y < 0.f ? m.y : r.y; return o;
}

__device__ __forceinline__ float sigm(float x) { return __builtin_amdgcn_rcpf(1.0f + __builtin_amdgcn_exp2f(-1.4426950408889634f * x)); }
__device__ __forceinline__ float bflo(unsigned w) { return __uint_as_float(w << 16); }
__device__ __forceinline__ float bfhi(unsigned w) { return __uint_as_float(w & 0xffff0000u); }
__device__ __forceinline__ u32x4 pack8(f32x4 a, f32x4 b) { u32x4 w; w.x = cvt_pk_bf16(a[0], a[1]); w.y = cvt_pk_bf16(a[2], a[3]); w.z = cvt_pk_bf16(b[0], b[1]); w.w = cvt_pk_bf16(b[2], b[3]); return w; }
__device__ __forceinline__ void unpack8(u32x4 w, f32x4& a, f32x4& b) { a = (f32x4){bflo(w.x), bfhi(w.x), bflo(w.y), bfhi(w.y)}; b = (f32x4){bflo(w.z), bfhi(w.z), bflo(w.w), bfhi(w.w)}; }
#define PG8_EPI_ROWS  for (int ai = 0; ai < 2; ++ai) _Pragma("unroll") for (int m = 0; m < 4; ++m)

struct EpiIn {
    static constexpr bool PERM = true, AFTER_DRAIN = false, MIDK = false;
    bf16_t* G; const float* R1; bf16_t* UB; bf16_t* QB; bf16_t* KB; bf16_t* VB; float* outK; float* outV; const float* gq; const float* gk; PG8_LAS float* P;
    __device__ __forceinline__ void operator()(const f32x4 (&acc)[2][2][4][2], const Unit& u, int wr, int wc, int fr, int fq) const {
        const int row0 = u.pm * BM + wr * 64 + fr, col0 = u.pn * BM + wc * 32 + 8 * fq, pn = u.pn;
        if (pn >= 4 && pn < 12) {
            const bool isk = pn >= 8; const int d = wc * 32 + 8 * fq;
#pragma unroll
            PG8_EPI_ROWS { const int rl = ai * HALF + wr * 64 + m * 16 + fr; const float r1 = R1[row0 + ai * HALF + m * 16];
#pragma unroll
                for (int bj = 0; bj < 2; ++bj) { const f32x4 v0 = acc[ai][bj][m][0] * r1, v1 = acc[ai][bj][m][1] * r1;
                    float ss = (v0[0] * v0[0] + v0[1] * v0[1]) + (v0[2] * v0[2] + v0[3] * v0[3]) + (v1[0] * v1[0] + v1[1] * v1[1]) + (v1[2] * v1[2] + v1[3] * v1[3]);
                    ss += __shfl_xor(ss, 16); ss += __shfl_xor(ss, 32);
                    if (fq == 0) P[(rl * 2 + bj) * 4 + wc] = ss; } }
            asm volatile("s_waitcnt lgkmcnt(0)" ::: "memory"); __builtin_amdgcn_s_barrier(); asm volatile("" ::: "memory");
            const float* gp = isk ? gk : gq; const f32x4 g0 = *(const f32x4*)(gp + d), g1 = *(const f32x4*)(gp + d + 4);
            bf16_t* ob = isk ? KB : QB;
#pragma unroll
            PG8_EPI_ROWS { const int row = row0 + ai * HALF + m * 16, rl = ai * HALF + wr * 64 + m * 16 + fr; const float r1 = R1[row];
#pragma unroll
                for (int bj = 0; bj < 2; ++bj) { const f32x4 t = *(const PG8_LAS f32x4*)(P + (rl * 2 + bj) * 4);
                    const float sc = r1 * __builtin_amdgcn_rsqf(((t[0] + t[1]) + (t[2] + t[3])) * (1.0f / 128.0f) + RMS_EPS); const int head = (pn & 3) * 2 + bj;
                    const f32x4 o0 = acc[ai][bj][m][0] * sc * g0, o1 = acc[ai][bj][m][1] * sc * g1;
                    *(u32x4*)(ob + ((size_t)((row >> 12) * NH + head) * SEQ + (row & (SEQ - 1))) * HD + d) = pack8(o0, o1);
                    if (isk) { float* p = outK + (size_t)row * DATT + head * HD + d; *(f32x4*)p = o0; *(f32x4*)(p + 4) = o1; } } }
            return; }
#pragma unroll
        PG8_EPI_ROWS { const int row = row0 + ai * HALF + m * 16; const float r1 = R1[row];
#pragma unroll
            for (int bj = 0; bj < 2; ++bj) { const int c = col0 + bj * HALF; f32x4 v0 = acc[ai][bj][m][0] * r1, v1 = acc[ai][bj][m][1] * r1;
                if (pn < 4) { *(u32x4*)(UB + ((size_t)((c >> 4) * 512 + (row >> 4)) * 16 + (row & 15)) * 16 + (c & 15)) = pack8(v0, v1); }
                else if (pn < 16) { const int head = (pn & 3) * 2 + bj, d = wc * 32 + 8 * fq;
                    *(u32x4*)(VB + ((size_t)((row >> 12) * NH + head) * SEQ + (row & (SEQ - 1))) * HD + d) = pack8(v0, v1);
                    float* p = outV + (size_t)row * DATT + head * HD + d; *(f32x4*)p = v0; *(f32x4*)(p + 4) = v1; }
                else { v0 = (f32x4){sigm(v0[0]), sigm(v0[1]), sigm(v0[2]), sigm(v0[3])}; v1 = (f32x4){sigm(v1[0]), sigm(v1[1]), sigm(v1[2]), sigm(v1[3])};
                       *(u32x4*)(G + (size_t)row * 4096 + (c - 4096)) = pack8(v0, v1); } } }
    }
};
struct EpiGlu {
    static constexpr bool PERM = true, AFTER_DRAIN = false, MIDK = false;
    const bf16_t* YP; bf16_t* YY; const float* bias;
    __device__ __forceinline__ void operator()(const f32x4 (&acc)[2][2][4][2], const Unit& u, int wr, int wc, int fr, int fq) const {
        const int row0 = u.pm * BM + wr * 64 + fr, col0 = u.pn * BM + wc * 32 + 8 * fq;
#pragma unroll
        PG8_EPI_ROWS { const int row = row0 + ai * HALF + m * 16;
#pragma unroll
            for (int bj = 0; bj < 2; ++bj) { const int c = col0 + bj * HALF; const f32x4 b0 = *(const f32x4*)(bias + c), b1 = *(const f32x4*)(bias + c + 4);
                f32x4 y0, y1; unpack8(*(const u32x4*)(YP + (size_t)row * 1024 + c), y0, y1);
                const f32x4 a0 = acc[ai][bj][m][0] + b0, a1 = acc[ai][bj][m][1] + b1;
                y0 = (f32x4){y0[0] * sigm(a0[0]), y0[1] * sigm(a0[1]), y0[2] * sigm(a0[2]), y0[3] * sigm(a0[3])};
                y1 = (f32x4){y1[0] * sigm(a1[0]), y1[1] * sigm(a1[1]), y1[2] * sigm(a1[2]), y1[3] * sigm(a1[3])};
                *(u32x4*)(YY + (size_t)row * 2048 + c) = pack8(y0, y1); } }
    }
};
struct EpiMerge {
    static constexpr bool PERM = true, AFTER_DRAIN = false, MIDK = true;
    const bf16_t* G; bf16_t* MG;
    __device__ __forceinline__ void mid(f32x4 (&acc)[2][2][4][2], const Unit& u, int wr, int wc, int fr, int fq) const {
        int off = (u.pm * BM + wr * 64 + fr) * 4096 + u.pn * BM + wc * 32 + 8 * fq;
        asm volatile("" : "+v"(off));
#pragma unroll
        PG8_EPI_ROWS {
#pragma unroll
            for (int bj = 0; bj < 2; ++bj) { const bf16_t* gp = G + (off + bj * HALF); f32x4 a0, a1, b0, b1; unpack8(*(const u32x4*)gp, a0, a1); unpack8(*(const u32x4*)(gp + 2048), b0, b1);
                acc[ai][bj][m][0] = acc[ai][bj][m][0] * (f32x4){a0[0] * __builtin_amdgcn_rcpf(b0[0]), a0[1] * __builtin_amdgcn_rcpf(b0[1]), a0[2] * __builtin_amdgcn_rcpf(b0[2]), a0[3] * __builtin_amdgcn_rcpf(b0[3])};
                acc[ai][bj][m][1] = acc[ai][bj][m][1] * (f32x4){a1[0] * __builtin_amdgcn_rcpf(b1[0]), a1[1] * __builtin_amdgcn_rcpf(b1[1]), a1[2] * __builtin_amdgcn_rcpf(b1[2]), a1[3] * __builtin_amdgcn_rcpf(b1[3])}; }
            off += (m == 3) ? (HALF - 48) * 4096 : 16 * 4096; asm volatile("" : "+v"(off)); }
    }
    __device__ __forceinline__ void operator()(const f32x4 (&acc)[2][2][4][2], const Unit& u, int wr, int wc, int fr, int fq) const {
        const int row0 = u.pm * BM + wr * 64 + fr, col0 = u.pn * BM + wc * 32 + 8 * fq;
#pragma unroll
        PG8_EPI_ROWS { const int row = row0 + ai * HALF + m * 16;
#pragma unroll
            for (int bj = 0; bj < 2; ++bj) { const int c = col0 + bj * HALF; f32x4 g0, g1; unpack8(*(const u32x4*)(G + (size_t)row * 4096 + 2048 + c), g0, g1);
                *(u32x4*)(MG + (size_t)row * 2048 + c) = pack8(acc[ai][bj][m][0] * g0, acc[ai][bj][m][1] * g1); } }
    }
};
struct EpiOut {
    static constexpr bool PERM = true, AFTER_DRAIN = false, MIDK = false;
    const float* xp; const float* xs; bf16_t* XB; float* SSR; PG8_LAS float* P;
    __device__ __forceinline__ void operator()(const f32x4 (&acc)[2][2][4][2], const Unit& u, int wr, int wc, int fr, int fq) const {
        const int row0 = u.pm * BM + wr * 64 + fr, col0 = u.pn * BM + wc * 32 + 8 * fq;
#pragma unroll
        PG8_EPI_ROWS { const int row = row0 + ai * HALF + m * 16;
            const float* xr = row < MPR ? xp + (size_t)row * 2048 : xs + (size_t)(row < MR ? row - MPR : 0) * 2048; const bool live = row < MR; float s = 0.f;
#pragma unroll
            for (int bj = 0; bj < 2; ++bj) { const int c = col0 + bj * HALF; f32x4 x0 = (f32x4){0.f, 0.f, 0.f, 0.f}, x1 = x0;
                if (live) { x0 = *(const f32x4*)(xr + c); x1 = *(const f32x4*)(xr + c + 4); }
                x0 = x0 + acc[ai][bj][m][0]; x1 = x1 + acc[ai][bj][m][1];
                s += (x0[0] * x0[0] + x0[1] * x0[1]) + (x0[2] * x0[2] + x0[3] * x0[3]) + (x1[0] * x1[0] + x1[1] * x1[1]) + (x1[2] * x1[2] + x1[3] * x1[3]);
                *(u32x4*)(XB + (size_t)row * 2048 + c) = pack8(x0, x1); }
            s += __shfl_xor(s, 16); s += __shfl_xor(s, 32);
            if (fq == 0) P[(ai * HALF + wr * 64 + m * 16 + fr) * 4 + wc] = s; }
        asm volatile("s_waitcnt lgkmcnt(0)" ::: "memory"); __builtin_amdgcn_s_barrier(); asm volatile("" ::: "memory");
        { const int t = (wr * 4 + wc) * 64 + fq * 16 + fr; if (t < 256) { const f32x4 v = *(const PG8_LAS f32x4*)(P + t * 4); __hip_atomic_fetch_add(SSR + u.pm * BM + t, (v[0] + v[1]) + (v[2] + v[3]), __ATOMIC_RELAXED, __HIP_MEMORY_SCOPE_AGENT); } }
    }
};
struct EpiFF1 {
    static constexpr bool PERM = true, AFTER_DRAIN = false, MIDK = false;
    const float* SSR; bf16_t* H; int probe;
    __device__ __forceinline__ void operator()(const f32x4 (&acc)[2][2][4][2], const Unit& u, int wr, int wc, int fr, int fq) const {
        if (probe & 8) { if (acc[0][0][0][0][0] == 123.456f) H[0] = 0; return; }
        const int row0 = u.pm * BM + wr * 64 + fr, col0 = u.pn * HALF + wc * 32 + 8 * fq;
#pragma unroll
        PG8_EPI_ROWS { const int row = row0 + ai * HALF + m * 16;
            const float r2 = __builtin_amdgcn_rsqf(SSR[row] * (1.0f / 2048.0f) + RMS_EPS);
            f32x4 o[2];
#pragma unroll
            for (int n = 0; n < 2; ++n) { const f32x4 g = acc[ai][0][m][n] * r2, up = acc[ai][1][m][n] * r2;
                o[n] = (f32x4){g[0] * sigm(g[0]) * up[0], g[1] * sigm(g[1]) * up[1], g[2] * sigm(g[2]) * up[2], g[3] * sigm(g[3]) * up[3]}; }
            *(u32x4*)(H + (size_t)row * DFF + col0) = pack8(o[0], o[1]); }
    }
};
struct EpiFF2 {
    static constexpr bool PERM = true, AFTER_DRAIN = false, MIDK = false;
    const bf16_t* XB; float* yp; float* ys;
    __device__ __forceinline__ void operator()(const f32x4 (&acc)[2][2][4][2], const Unit& u, int wr, int wc, int fr, int fq) const {
        const int row0 = u.pm * BM + wr * 64 + fr, col0 = u.pn * BM + wc * 32 + 8 * fq;
#pragma unroll
        PG8_EPI_ROWS { const int row = row0 + ai * HALF + m * 16; if (row >= MR) continue;
            float* orow = row < MPR ? yp + (size_t)row * 2048 : ys + (size_t)(row - MPR) * 2048;
#pragma unroll
            for (int bj = 0; bj < 2; ++bj) { const int c = col0 + bj * HALF; f32x4 x0, x1; unpack8(*(const u32x4*)(XB + (size_t)row * 2048 + c), x0, x1);
                *(f32x4*)(orow + c) = x0 + acc[ai][bj][m][0]; *(f32x4*)(orow + c + 4) = x1 + acc[ai][bj][m][1]; } }
    }
};
template <class Epi, class Sched, bool ALIGN_EPI = false, bool SP2 = false>
__device__ __forceinline__ void gemm_phase(PG8_LAS unsigned char* lds, const Gemm g, const Sched& S, const Epi& E, int wid_in, int lane_in) {
    const int wid = wid_in, lane = lane_in, tid = wid * 64 + lane, wr = wid >> 2, wc = wid & 3, fr = lane & 15, fq = lane >> 4;
    const int K = g.K, nt = K / BK;
    unsigned voffA[2], voffB[2];
#pragma unroll
    for (int i = 0; i < 2; ++i) { int R, C; stage_rc(tid * 16 + i * 8192, R, C); const int Rb = Epi::PERM ? ((R & ~31) + perm32(R & 31)) : R;
        voffA[i] = (unsigned)(R * g.lda + C) * 2u; voffB[i] = (unsigned)(Rb * g.ldb + C) * 2u; }
    const size_t kstep = (size_t)(BK * 2);
    const size_t hsA = (size_t)HALF * g.lda * 2, hsB = (size_t)HALF * g.ldb * 2;
    const size_t tsA = 2 * hsA, tsB = 2 * hsB;
    const unsigned ldsw = (unsigned)wid * 1024u;
    const int aoff = lds_byte(wr * 64 + fr, fq * 8), boff = lds_byte(wc * 32 + fr, fq * 8);
#define PG8_SA(b, h) (((b) * 2 + (h)) * HTB)
#define PG8_SB(b, h) ((4 + (b) * 2 + (h)) * HTB)
#define PG8_STAGE(bufoff, gbase, voff) do { _Pragma("unroll") for (int _i = 0; _i < 2; ++_i) \
        __builtin_amdgcn_global_load_lds((const unsigned*)((const char*)(gbase) + (voff)[_i]), (PG8_LAS unsigned*)(lds + (bufoff) + ldsw + _i * 8192), 16, 0, 0); } while (0)
#define PG8_LDA(dst, b, h) do { _Pragma("unroll") for (int m = 0; m < 4; ++m) _Pragma("unroll") for (int k = 0; k < 2; ++k) dst[m][k] = *(const PG8_LAS bf16x8*)(lds + PG8_SA(b, h) + aoff + m * 2048 + k * 1024); } while (0)
#define PG8_LDB(dst, b, h) do { _Pragma("unroll") for (int n = 0; n < 2; ++n) _Pragma("unroll") for (int k = 0; k < 2; ++k) dst[n][k] = *(const PG8_LAS bf16x8*)(lds + PG8_SB(b, h) + boff + n * 2048 + k * 1024); } while (0)
#define PG8_MMA(ai, bj, At, Bt) do { __builtin_amdgcn_s_setprio(1); _Pragma("unroll") for (int m = 0; m < 4; ++m) _Pragma("unroll") for (int n = 0; n < 2; ++n) _Pragma("unroll") for (int k = 0; k < 2; ++k) \
        acc[ai][bj][m][n] = __builtin_amdgcn_mfma_f32_16x16x32_bf16(Bt[n][k], At[m][k], acc[ai][bj][m][n], 0, 0, 0); __builtin_amdgcn_s_setprio(0); } while (0)
#define PG8_WAIT_V(n) asm volatile("s_waitcnt vmcnt(" #n ")" ::: "memory")
#define PG8_WAIT_L(n) asm volatile("s_waitcnt lgkmcnt(" #n ")" ::: "memory")
#define PG8_BAR __builtin_amdgcn_s_barrier()
#define PG8_SCHED __builtin_amdgcn_sched_barrier(0)
    Unit cur, nxt; int ui = 0;
    if (!S.next(0, cur)) return;
    f32x4 acc[2][2][4][2];
#pragma unroll
    for (int a = 0; a < 2; ++a)
#pragma unroll
        for (int b = 0; b < 2; ++b)
#pragma unroll
            for (int m = 0; m < 4; ++m)
#pragma unroll
                for (int n = 0; n < 2; ++n) acc[a][b][m][n] = (f32x4){0.f, 0.f, 0.f, 0.f};
    bf16x8 At[4][2], B0[2][2], B1[2][2];
    const char* cA = (const char*)g.A + (size_t)cur.pm * tsA; const char* cB = (const char*)g.Bt + (size_t)cur.pn * tsB;
    S.a_ready(cur);
    if constexpr (SP2) {
        PG8_STAGE(PG8_SB(0, 0), cB, voffB); PG8_STAGE(PG8_SB(0, 1), cB + hsB, voffB); PG8_STAGE(PG8_SA(0, 0), cA, voffA); PG8_STAGE(PG8_SA(0, 1), cA + hsA, voffA);
        if (wr == 1) PG8_BAR;
        PG8_WAIT_V(2); PG8_BAR;
        PG8_STAGE(PG8_SB(1, 0), cB + kstep, voffB); PG8_STAGE(PG8_SA(1, 0), cA + kstep, voffA); PG8_STAGE(PG8_SB(1, 1), cB + hsB + kstep, voffB);
        PG8_WAIT_V(6); PG8_BAR;
    } else {
        PG8_STAGE(PG8_SB(0, 0), cB, voffB); PG8_STAGE(PG8_SA(0, 0), cA, voffA); PG8_STAGE(PG8_SB(0, 1), cB + hsB, voffB); PG8_STAGE(PG8_SA(0, 1), cA + hsA, voffA);
        if (wr == 1) PG8_BAR;
        PG8_WAIT_V(4); PG8_BAR;
        PG8_STAGE(PG8_SB(1, 0), cB + kstep, voffB); PG8_STAGE(PG8_SA(1, 0), cA + kstep, voffA); PG8_STAGE(PG8_SB(1, 1), cB + hsB + kstep, voffB);
        PG8_WAIT_V(6); PG8_BAR;
    }
    for (;;) {
        const bool has_next = S.next(ui + 1, nxt);
        const char* nA = has_next ? (const char*)g.A + (size_t)nxt.pm * tsA : cA; const char* nB = has_next ? (const char*)g.Bt + (size_t)nxt.pn * tsB : cB;
        for (int t = 0; t < nt; t += 2) {
            if constexpr (Epi::MIDK) { if (t == (nt >> 1)) E.mid(acc, cur, wr, wc, fr, fq); }
            const bool last = (t == nt - 2);
            const char* a1 = cA + (size_t)(t + 1) * kstep;
            const char* a2 = last ? nA : cA + (size_t)(t + 2) * kstep; const char* b2 = last ? nB : cB + (size_t)(t + 2) * kstep;
            const char* a3 = a2 + kstep; const char* b3 = b2 + kstep;
            if (last && has_next) S.a_ready(nxt);
            if constexpr (SP2) {
            PG8_LDB(B0, 0, 0); PG8_LDB(B1, 0, 1); PG8_SCHED; PG8_LDA(At, 0, 0); PG8_STAGE(PG8_SA(1, 1), a1 + hsA, voffA);
            PG8_WAIT_V(8); PG8_WAIT_L(0); PG8_BAR; PG8_MMA(0, 0, At, B0); PG8_MMA(0, 1, At, B1); PG8_BAR; PG8_SCHED;
            PG8_LDA(At, 0, 1); PG8_STAGE(PG8_SB(0, 0), b2, voffB); PG8_STAGE(PG8_SB(0, 1), b2 + hsB, voffB); PG8_STAGE(PG8_SA(0, 0), a2, voffA);
            PG8_WAIT_V(8); PG8_WAIT_L(0); PG8_BAR; PG8_MMA(1, 0, At, B0); PG8_MMA(1, 1, At, B1); PG8_BAR; PG8_SCHED;
            PG8_LDB(B0, 1, 0); PG8_LDB(B1, 1, 1); PG8_SCHED; PG8_LDA(At, 1, 0); PG8_STAGE(PG8_SA(0, 1), a2 + hsA, voffA);
            PG8_WAIT_V(8); PG8_WAIT_L(0); PG8_BAR; PG8_MMA(0, 0, At, B0); PG8_MMA(0, 1, At, B1); PG8_BAR; PG8_SCHED;
            PG8_LDA(At, 1, 1); PG8_STAGE(PG8_SB(1, 0), b3, voffB); PG8_STAGE(PG8_SB(1, 1), b3 + hsB, voffB); PG8_STAGE(PG8_SA(1, 0), a3, voffA);
            PG8_WAIT_V(8); PG8_WAIT_L(0); PG8_BAR; PG8_MMA(1, 0, At, B0); PG8_MMA(1, 1, At, B1); PG8_BAR; PG8_SCHED;
            } else {
            PG8_LDB(B0, 0, 0); PG8_SCHED; PG8_LDA(At, 0, 0); PG8_STAGE(PG8_SA(1, 1), a1 + hsA, voffA);
            PG8_WAIT_L(8); PG8_BAR; PG8_WAIT_L(0); PG8_MMA(0, 0, At, B0); PG8_BAR; PG8_SCHED;
            PG8_LDB(B1, 0, 1); PG8_STAGE(PG8_SB(0, 0), b2, voffB);
            PG8_BAR; PG8_WAIT_L(0); PG8_MMA(0, 1, At, B1); PG8_BAR;
            PG8_LDA(At, 0, 1); PG8_STAGE(PG8_SA(0, 0), a2, voffA);
            PG8_BAR; PG8_WAIT_L(0); PG8_MMA(1, 0, At, B0); PG8_BAR; PG8_SCHED;
            PG8_STAGE(PG8_SB(0, 1), b2 + hsB, voffB);
            PG8_WAIT_V(6); PG8_BAR; PG8_MMA(1, 1, At, B1); PG8_BAR;
            PG8_LDB(B0, 1, 0); PG8_SCHED; PG8_LDA(At, 1, 0); PG8_STAGE(PG8_SA(0, 1), a2 + hsA, voffA);
            PG8_WAIT_L(8); PG8_BAR; PG8_WAIT_L(0); PG8_MMA(0, 0, At, B0); PG8_BAR; PG8_SCHED;
            PG8_LDB(B1, 1, 1); PG8_STAGE(PG8_SB(1, 0), b3, voffB);
            PG8_BAR; PG8_WAIT_L(0); PG8_MMA(0, 1, At, B1); PG8_BAR;
            PG8_LDA(At, 1, 1); PG8_STAGE(PG8_SA(1, 0), a3, voffA);
            PG8_BAR; PG8_WAIT_L(0); PG8_MMA(1, 0, At, B0); PG8_BAR; PG8_SCHED;
            PG8_STAGE(PG8_SB(1, 1), b3 + hsB, voffB);
            PG8_WAIT_V(6); PG8_BAR; PG8_MMA(1, 1, At, B1); PG8_BAR;
            }
        }
        if constexpr (ALIGN_EPI) { if (wr == 0) PG8_BAR; }
        if constexpr (!Epi::AFTER_DRAIN) { E(acc, cur, wr, wc, fr, fq); S.done(cur); }
        if (!has_next) break;
#pragma unroll
        for (int a = 0; a < 2; ++a)
#pragma unroll
            for (int b = 0; b < 2; ++b)
#pragma unroll
                for (int m = 0; m < 4; ++m)
#pragma unroll
                    for (int n = 0; n < 2; ++n) acc[a][b][m][n] = (f32x4){0.f, 0.f, 0.f, 0.f};
        cur = nxt; cA = nA; cB = nB; ++ui;
        if constexpr (ALIGN_EPI) { if (wr == 1) PG8_BAR; }
    }
    PG8_WAIT_V(0);
    if constexpr (!ALIGN_EPI) { if (wr == 0) PG8_BAR; }
    PG8_BAR;
    if constexpr (Epi::AFTER_DRAIN) { E.fused(acc, cur, wr, wc, fr, fq, lds, wid, lane); S.done(cur); }
#undef PG8_SA
#undef PG8_SB
#undef PG8_STAGE
#undef PG8_LDA
#undef PG8_LDB
#undef PG8_MMA
#undef PG8_WAIT_V
#undef PG8_WAIT_L
#undef PG8_BAR
#undef PG8_SCHED
}
}
namespace pattn {
constexpr int D = 128; constexpr float THR = 8.f; constexpr bool WSKIP = false;
constexpr float SCALE = 0.08838834764831845f;
constexpr int NW = 8, QBLK = 32, KVBLK = 64, QB = NW * QBLK;
constexpr int SHM_V = KVBLK * D * 2, SHM_K = KVBLK * D * 2;
constexpr int LDS_CK = 2 * SHM_V + 2 * SHM_K + NW * 64 * 4;
constexpr int LDS_BYTES = LDS_CK + 2 * 2048;
constexpr int OSTR = 2048;
using bf16 = __hip_bfloat16;
typedef short bf16x8 __attribute__((ext_vector_type(8)));
typedef short s16x4 __attribute__((ext_vector_type(4)));
typedef float f32x16 __attribute__((ext_vector_type(16)));
typedef float f32x4 __attribute__((ext_vector_type(4)));
typedef unsigned u32x4 __attribute__((ext_vector_type(4)));
template <class A, class Bt> struct same_t { static constexpr bool v = false; };
template <class A> struct same_t<A, A> { static constexpr bool v = true; };

#define KSWZ(row, colB) ((row) * 256 + ((colB) ^ (((row) & 7) << 4)))
#define SBAR() __builtin_amdgcn_sched_barrier(0)
__device__ __forceinline__ int v_st(int k, int c) { const int kk = (k & ~0xC) | ((k & 4) << 1) | ((k & 8) >> 1); return ((kk >> 3) * 4 + (c >> 5)) * 512 + ((kk & 7) * 32 + (c & 31)) * 2; }
__device__ __forceinline__ int v_rd_base(int lane) { return ((lane & 3) << 3) | (((lane >> 2) & 3) << 6) | (((lane >> 4) & 1) << 5) | (((lane >> 5) & 1) << 8); }
constexpr int v_rd_off(int d0, int ks, int half) { return d0 * 512 + ks * 4096 + half * 2048; }
__device__ __forceinline__ int crow(int r, int hi) { return (r & 3) + 8 * (r >> 2) + 4 * hi; }
__device__ __forceinline__ unsigned cvtpk(float lo, float hi) {
    unsigned r; asm volatile("v_cvt_pk_bf16_f32 %0, %1, %2" : "=v"(r) : "v"(lo), "v"(hi)); return r;
}
__device__ __forceinline__ bf16x8 pack8(f32x4 a, f32x4 b) {
    u32x4 w = {cvtpk(a[0], a[1]), cvtpk(a[2], a[3]), cvtpk(b[0], b[1]), cvtpk(b[2], b[3])};
    return *reinterpret_cast<bf16x8*>(&w);
}
template <class T> __device__ __forceinline__ bf16x8 load8(const T* p) {
    if constexpr (same_t<T, float>::v) { return pack8(*(const f32x4*)p, *(const f32x4*)(p + 4)); }
    else { return *reinterpret_cast<const bf16x8*>(p); }
}
__device__ __forceinline__ void mask_tile(f32x16& p0, f32x16& p1, int dq, unsigned W) {
    const float NEG = -__builtin_inff();
#pragma unroll
    for (int r = 0; r < 16; ++r) {
        const int c = (r & 3) + 8 * (r >> 2);
        if ((unsigned)(dq - c) >= W) p0[r] = NEG;
        if ((unsigned)(dq - c - 32) >= W) p1[r] = NEG;
    }
}
__device__ __forceinline__ void partialSM(f32x16& p0, f32x16& p1, float& m_reg, float& mn, float& alpha) {
    constexpr float C2 = 1.4426950408889634f * SCALE; mn = 0.f; alpha = 1.f;
    for (int r = 0; r < 16; ++r) p0[r] = fmaf(p0[r], C2, m_reg); for (int r = 0; r < 16; ++r) p1[r] = fmaf(p1[r], C2, m_reg);
    for (int r = 0; r < 16; ++r) p0[r] = __builtin_amdgcn_exp2f(p0[r]);
}
__device__ __forceinline__ void finishSM(f32x16& p0, f32x16& p1, float alpha, float& l_reg, bf16x8& pa0, bf16x8& pa1, bf16x8& pa2, bf16x8& pa3) {
    for (int r = 0; r < 16; ++r) p1[r] = __builtin_amdgcn_exp2f(p1[r]);
    float ps = 0; for (int r = 0; r < 16; ++r) ps += p0[r]; for (int r = 0; r < 16; ++r) ps += p1[r];
    { auto rr = __builtin_amdgcn_permlane32_swap(__float_as_uint(ps), __float_as_uint(ps), false, false);
      ps = __uint_as_float(rr[0]) + __uint_as_float(rr[1]); }
    l_reg = l_reg * alpha + ps;
#define PK4(P, B_, OUT) do { unsigned a0 = cvtpk(P[B_+0], P[B_+1]), a1 = cvtpk(P[B_+2], P[B_+3]);                          \
        unsigned b0 = cvtpk(P[B_+4], P[B_+5]), b1 = cvtpk(P[B_+6], P[B_+7]);                                             \
        auto r0 = __builtin_amdgcn_permlane32_swap(a0, b0, false, false); auto r1 = __builtin_amdgcn_permlane32_swap(a1, b1, false, false); \
        u32x4 w = {r0[0], r1[0], r0[1], r1[1]}; OUT = *reinterpret_cast<bf16x8*>(&w); } while (0)
    PK4(p0, 0, pa0); PK4(p0, 8, pa1); PK4(p1, 0, pa2); PK4(p1, 8, pa3);
#undef PK4
}
template <int KB, bool SK>
__device__ __forceinline__ void qkt(f32x16& p0, f32x16& p1, const char* K_lds, const char* CK_lds, int r32, int hi, const bf16x8* qr, bool act) {
    if (SK && !act) { const float NEG = -__builtin_inff();
#pragma unroll
        for (int r = 0; r < 16; ++r) { p0[r] = NEG; p1[r] = NEG; } return; }
    p0 = f32x16{}; p1 = f32x16{};
    const char* kb[4];
#pragma unroll
    for (int dd = 0; dd < 4; ++dd) kb[dd] = K_lds + KB * SHM_K + KSWZ(r32, (dd * 16 + hi * 8) * 2);
#pragma unroll
    for (int d0 = 0; d0 < 8; ++d0) { const char* a = kb[d0 & 3] + (d0 >> 2) * 128;
        bf16x8 b0 = *reinterpret_cast<const bf16x8*>(a);
        bf16x8 b1 = *reinterpret_cast<const bf16x8*>(a + 32 * 256);
        p0 = __builtin_amdgcn_mfma_f32_32x32x16_bf16(b0, qr[d0], p0, 0, 0, 0);
        p1 = __builtin_amdgcn_mfma_f32_32x32x16_bf16(b1, qr[d0], p1, 0, 0, 0); }
#ifndef NO_FOX
    {
        const char* a = CK_lds + KB * 2048 + r32 * 32 + hi * 16; const bf16x8 c0 = *reinterpret_cast<const bf16x8*>(a), c1 = *reinterpret_cast<const bf16x8*>(a + 1024);
        const short one = (short)0x3F80; const bf16x8 ones = {one, one, one, one, one, one, one, one};
        p0 = __builtin_amdgcn_mfma_f32_32x32x16_bf16(c0, ones, p0, 0, 0, 0); p1 = __builtin_amdgcn_mfma_f32_32x32x16_bf16(c1, ones, p1, 0, 0, 0); }
#endif
}
template <int VB, bool SK>
__device__ __forceinline__ void pv_tile(f32x16* o, int vb0, bf16x8 pa0, bf16x8 pa1, bf16x8 pa2, bf16x8 pa3, bool act) {
    if (SK && !act) return;
#define TRRD(dst, off) asm volatile("ds_read_b64_tr_b16 %0, %1 offset:%2" : "=&v"(dst) : "v"(vb0), "i"(off) : "memory")
#define PV_D0(d0) do { s16x4 l0, l1, l2, l3, h0, h1, h2, h3; constexpr int b_ = VB * SHM_V + v_rd_off(d0, 0, 0);     \
        TRRD(l0, b_); TRRD(h0, b_ + 2048); TRRD(l1, b_ + 4096); TRRD(h1, b_ + 6144); TRRD(l2, b_ + 8192); TRRD(h2, b_ + 10240); TRRD(l3, b_ + 12288); TRRD(h3, b_ + 14336); \
        asm volatile("s_waitcnt lgkmcnt(0)" ::: "memory"); SBAR();                 \
        o[d0] = __builtin_amdgcn_mfma_f32_32x32x16_bf16(pa0, (bf16x8){l0[0], l0[1], l0[2], l0[3], h0[0], h0[1], h0[2], h0[3]}, o[d0], 0, 0, 0);   \
        o[d0] = __builtin_amdgcn_mfma_f32_32x32x16_bf16(pa1, (bf16x8){l1[0], l1[1], l1[2], l1[3], h1[0], h1[1], h1[2], h1[3]}, o[d0], 0, 0, 0);   \
        o[d0] = __builtin_amdgcn_mfma_f32_32x32x16_bf16(pa2, (bf16x8){l2[0], l2[1], l2[2], l2[3], h2[0], h2[1], h2[2], h2[3]}, o[d0], 0, 0, 0);   \
        o[d0] = __builtin_amdgcn_mfma_f32_32x32x16_bf16(pa3, (bf16x8){l3[0], l3[1], l3[2], l3[3], h3[0], h3[1], h3[2], h3[3]}, o[d0], 0, 0, 0); } while (0)
    PV_D0(0); PV_D0(1); PV_D0(2); PV_D0(3);
#undef PV_D0
#undef TRRD
}

template <class TIn, class TOut> struct BlockRef { const TIn* Q; const TIn* K; const TIn* V; TOut* O; const unsigned short* CK; const float* XF; int P0, jlo; float negb2; };
template <class TIn> struct Seam {
    bf16x8 qr[8];
    bf16x8 st_v0, st_v1, st_k0, st_k1; f32x4 sf0, sf1, sf2, sf3;
    f32x4 tq[16];
};
__device__ __forceinline__ int swa_jlo(int P0, int W) { const int lowk = P0 - W + 1; return lowk > 0 ? lowk / KVBLK : 0; }
#define ROW(p, k0, rr) ((p) + (int)(((k0) + (rr)) * D + sc))
#define VMW() asm volatile("s_waitcnt vmcnt(0)" ::: "memory")
#define VMWN(n) asm volatile("s_waitcnt vmcnt(%0)" :: "i"(n) : "memory")
#define SLOAD_H(Kp, Vp, CKp, k0, bf) do { S.st_v0 = load8<TIn>(ROW(Vp, k0, sr)); S.st_v1 = load8<TIn>(ROW(Vp, k0, 32 + sr));              \
                         S.st_k0 = load8<TIn>(ROW(Kp, k0, sr)); S.st_k1 = load8<TIn>(ROW(Kp, k0, 32 + sr)); if (wid < 2) __builtin_amdgcn_global_load_lds((const unsigned*)((CKp) + (int)(((k0) + wid * 32) * 16 + lane * 8)), (__attribute__((address_space(3))) unsigned*)(CK_lds + (bf) * 2048 + wid * 1024), 16, 0, 0); } while (0)
#define SWRITE_HK(bf) do { *(bf16x8*)(K_lds + (bf) * SHM_K + kws) = S.st_k0; *(bf16x8*)(K_lds + (bf) * SHM_K + kws + 32 * 256) = S.st_k1; } while (0)
#define SWRITE_HV(bf) do { *(bf16x8*)(V_lds + (bf) * SHM_V + vst0) = S.st_v0; *(bf16x8*)(V_lds + (bf) * SHM_V + vst1) = S.st_v1; } while (0)
#define SWRITE_H(bf) do { SWRITE_HV(bf); SWRITE_HK(bf); } while (0)
#define SLOAD_F(p, k0) do { S.sf0 = *(const f32x4*)ROW(p, k0, sr); S.sf1 = *(const f32x4*)(ROW(p, k0, sr) + 4);                \
                            S.sf2 = *(const f32x4*)ROW(p, k0, 32 + sr); S.sf3 = *(const f32x4*)(ROW(p, k0, 32 + sr) + 4); } while (0)
#define SWRITE_KF(bf) do { *(bf16x8*)(K_lds + (bf) * SHM_K + kws) = pack8(S.sf0, S.sf1); *(bf16x8*)(K_lds + (bf) * SHM_K + kws + 32 * 256) = pack8(S.sf2, S.sf3); } while (0)
#define SWRITE_VF(bf) do { *(bf16x8*)(V_lds + (bf) * SHM_V + vst0) = pack8(S.sf0, S.sf1); *(bf16x8*)(V_lds + (bf) * SHM_V + vst1) = pack8(S.sf2, S.sf3); } while (0)
template <class TIn, class TOut>
__device__ __forceinline__ void causal_swa_prime(const BlockRef<TIn, TOut>& cur, int W, char* lds, Seam<TIn>& S, int wid_in, int lane_in) {
    constexpr bool F32 = same_t<TIn, float>::v;
    const int wid = wid_in, lane = lane_in, tid = wid * 64 + lane, r32 = lane & 31, hi = lane >> 5;
    const int sr = tid >> 4, sc = (tid & 15) * 8, kws = KSWZ(sr, sc * 2); char* K_lds = lds + 2 * SHM_V; char* CK_lds = lds + LDS_CK;
    const int kb0 = cur.jlo * KVBLK;
    for (int d0 = 0; d0 < 8; ++d0) S.qr[d0] = load8<TIn>(cur.Q + ((wid * QBLK + r32) * D + hi * 8) + d0 * 16);
    if constexpr (F32) { SLOAD_F((const float*)cur.K, kb0); VMW(); SWRITE_KF(0); SBAR(); SLOAD_F((const float*)cur.V, kb0); }
    else { SLOAD_H(cur.K, cur.V, cur.CK, kb0, 0); VMW(); SWRITE_HK(0); }
    __syncthreads();
}
template <class TIn, class TOut>
__device__ __forceinline__ void causal_swa_block(const BlockRef<TIn, TOut>& cur, const BlockRef<TIn, TOut>& nxt, int skv, int W, char* lds, Seam<TIn>& S, int wid_in, int lane_in) {
    constexpr bool F32 = same_t<TIn, float>::v;
    const int wid = wid_in, lane = lane_in, tid = wid * 64 + lane, r32 = lane & 31, hi = lane >> 5;
    const int j_lo = cur.jlo;
    int j_hi = (cur.P0 + QB - 1) / KVBLK + 1; if (j_hi > skv / KVBLK) j_hi = skv / KVBLK;
    const int NT = j_hi - j_lo;
    const int kbn = nxt.jlo * KVBLK;
    const int qlo = cur.P0 + wid * QBLK, qm = qlo + r32 - 4 * hi;
    char* V_lds = lds; char* K_lds = lds + 2 * SHM_V; char* CK_lds = lds + LDS_CK;
    float* ws = (float*)(lds + 2 * SHM_V + 2 * SHM_K) + wid * 64; float* li_l = ws, * al_l = ws + 32;
    float m_reg = cur.negb2 - (1.4426950408889634f * SCALE) * cur.XF[cur.P0 + wid * QBLK + r32], l_reg = 0; f32x16 o[4] = {};
    const int sr = tid >> 4, sc = (tid & 15) * 8, vst0 = v_st(sr, sc), vst1 = v_st(32 + sr, sc), kws = KSWZ(sr, sc * 2);
    const int vb0 = (int)(uintptr_t)V_lds + v_rd_base(lane);
    const TIn* Kh = cur.K; const TIn* Vh = cur.V; const unsigned short* CKh = cur.CK;
#define RESC(a) do { if (__any((a) < 1.f)) { if (hi == 0) al_l[r32] = (a); asm volatile("s_waitcnt lgkmcnt(0)" ::: "memory");              \
                     for (int d_ = 0; d_ < 4; ++d_) for (int r = 0; r < 16; ++r) o[d_][r] *= al_l[crow(r, hi)]; } } while (0)
#define KBASE(t) ((j_lo + (t)) * KVBLK)
#define ACT(t) (KBASE(t) <= qlo + QBLK - 1 && KBASE(t) + KVBLK - 1 >= qlo - W + 1)
#define MASKT(P0_, P1_, t) do { const int kb_ = KBASE(t); if ((!SK || ACT(t)) && (kb_ + KVBLK - 1 > qlo || kb_ <= qlo + QBLK - 1 - W)) mask_tile(P0_, P1_, qm - kb_, (unsigned)W); } while (0)
    constexpr int NQL = F32 ? 16 : 8;
    constexpr bool SK = WSKIP && !F32;
#define SEAM_K0() do { VMWN(NQL); if constexpr (F32) { SWRITE_KF(0); SBAR(); SLOAD_F((const float*)nxt.V, kbn); } else { SWRITE_HK(0); } SBAR(); } while (0)
    f32x16 pA0, pA1, pB0, pB1; float mnA, mnB, alA, alB; bf16x8 pa0, pa1, pa2, pa3;
    if constexpr (F32) { VMW(); SWRITE_VF(0); SBAR(); } else { SWRITE_HV(0); SBAR(); }
    if (NT > 1) { if constexpr (F32) SLOAD_F((const float*)Kh, KBASE(1)); else SLOAD_H(Kh, Vh, CKh, KBASE(1), 1); }
    SBAR(); qkt<0, SK>(pA0, pA1, K_lds, CK_lds, r32, hi, S.qr, ACT(0));
    if constexpr (F32) { if (NT > 1) { VMW(); SWRITE_KF(1); SBAR(); SLOAD_F((const float*)Vh, KBASE(1)); } }
    MASKT(pA0, pA1, 0); partialSM(pA0, pA1, m_reg, mnA, alA);
    if (NT > 1) { VMW(); if constexpr (F32) { SWRITE_VF(1); SBAR(); if (NT > 2) SLOAD_F((const float*)Kh, KBASE(2)); } else SWRITE_H(1); }
    __syncthreads();
#define HALF_STEP(PX0, PX1, mnX, alX, PY0, PY1, alY, t, KB, VB, SB) do {                                                      \
        SBAR(); qkt<KB, SK>(PX0, PX1, K_lds, CK_lds, r32, hi, S.qr, ACT(t));                                             \
        finishSM(PY0, PY1, alY, l_reg, pa0, pa1, pa2, pa3); SBAR();                                                           \
        if ((t) + 1 < NT) { if constexpr (F32) { VMW(); SWRITE_KF(SB); SBAR(); SLOAD_F((const float*)Vh, KBASE((t) + 1)); }  \
                            else { SLOAD_H(Kh, Vh, CKh, KBASE((t) + 1), SB); } SBAR(); }                                               \
        pv_tile<VB, SK>(o, vb0, pa0, pa1, pa2, pa3, ACT((t) - 1)); MASKT(PX0, PX1, (t)); partialSM(PX0, PX1, m_reg, mnX, alX);                                        \
        __syncthreads();                                                                                                      \
        if ((t) + 1 < NT) { VMW(); if constexpr (F32) { SWRITE_VF(SB); SBAR(); if ((t) + 2 < NT) SLOAD_F((const float*)Kh, KBASE((t) + 2)); } \
                            else { SWRITE_H(SB); } }                                                                          \
        RESC(alX); __syncthreads(); } while (0)
    for (int t = 1; t + 1 < NT; t += 2) {
        HALF_STEP(pB0, pB1, mnB, alB, pA0, pA1, alA, t, 1, 0, 0);
        HALF_STEP(pA0, pA1, mnA, alA, pB0, pB1, alB, t + 1, 0, 1, 1);
    }
    const bool even = (NT & 1) == 0;
    if (even) { SBAR(); qkt<1, SK>(pB0, pB1, K_lds, CK_lds, r32, hi, S.qr, ACT(NT - 1)); SBAR(); }
#define QROW(e) (nxt.Q + (size_t)(wid * QBLK + r32) * D + ((e) >> 1) * 16 + hi * 8 + ((e) & 1) * 4)
    if constexpr (F32) { SLOAD_F((const float*)nxt.K, kbn); SBAR();
#pragma unroll
        for (int e = 0; e < 8; ++e) S.tq[e] = *(const f32x4*)QROW(e); }
    else { SLOAD_H(nxt.K, nxt.V, nxt.CK, kbn, 0); SBAR();
#pragma unroll
        for (int d0 = 0; d0 < 8; ++d0) S.qr[d0] = load8<TIn>(nxt.Q + ((wid * QBLK + r32) * D + hi * 8) + d0 * 16); }
    SBAR();
    finishSM(pA0, pA1, alA, l_reg, pa0, pa1, pa2, pa3); SBAR();
    if constexpr (F32) {
#pragma unroll
        for (int e = 8; e < 16; ++e) S.tq[e] = *(const f32x4*)QROW(e); SBAR(); }
#undef QROW
    pv_tile<0, SK>(o, vb0, pa0, pa1, pa2, pa3, ACT(even ? NT - 2 : NT - 1));
    if (even) { MASKT(pB0, pB1, NT - 1); partialSM(pB0, pB1, m_reg, mnB, alB); __syncthreads(); RESC(alB);
        finishSM(pB0, pB1, alB, l_reg, pa0, pa1, pa2, pa3); SBAR(); pv_tile<1, SK>(o, vb0, pa0, pa1, pa2, pa3, ACT(NT - 1)); }
    SBAR(); SEAM_K0();
    if (hi == 0) li_l[r32] = l_reg; asm volatile("s_waitcnt lgkmcnt(0)" ::: "memory");
    float rli[16];
#pragma unroll
    for (int r = 0; r < 16; ++r) rli[r] = __builtin_amdgcn_rcpf(li_l[crow(r, hi)]);
    int oo = (wid * QBLK + 4 * hi) * OSTR + r32;
#pragma unroll
    for (int r = 0; r < 16; ++r) {
        asm volatile("" : "+v"(oo));
#pragma unroll
        for (int d0 = 0; d0 < 4; ++d0) { const float v = o[d0][r] * rli[r];
            if constexpr (same_t<TOut, float>::v) { cur.O[oo + d0 * 32] = v; }
            else { const float vn = __shfl_xor(v, 1);
                   if ((r32 & 1) == 0) *(unsigned*)(cur.O + (oo + d0 * 32)) = cvtpk(v, vn); } }
        oo += ((r & 3) == 3) ? 5 * OSTR : OSTR; }
    if constexpr (F32) {
#pragma unroll
        for (int d0 = 0; d0 < 8; ++d0) S.qr[d0] = pack8(S.tq[2 * d0], S.tq[2 * d0 + 1]); }
    __syncthreads();
#undef RESC
#undef KBASE
#undef ACT
#undef MASKT
#undef SEAM_K0
#undef HALF_STEP
}
#undef ROW
#undef VMW
#undef VMWN
#undef SLOAD_H
#undef SWRITE_HK
#undef SWRITE_HV
#undef SWRITE_H
#undef SLOAD_F
#undef SWRITE_KF
#undef SWRITE_VF
}
#define GAS __attribute__((address_space(1)))
#define LAS __attribute__((address_space(3)))
typedef unsigned short bf16;
typedef unsigned v4u __attribute__((ext_vector_type(4)));
typedef float f32x4 __attribute__((ext_vector_type(4)));
typedef short bf16x8 __attribute__((ext_vector_type(8)));
typedef GAS unsigned gu32;
typedef GAS unsigned long long gu64;
#define RLX_AGENT __ATOMIC_RELAXED, __HIP_MEMORY_SCOPE_AGENT
#define LDS_WAIT() asm volatile("s_waitcnt lgkmcnt(0)" ::: "memory")
#define VM_WAIT() asm volatile("s_waitcnt vmcnt(0)" ::: "memory")
__device__ __forceinline__ unsigned long long rt() { return __builtin_amdgcn_s_memrealtime(); }
__device__ __forceinline__ unsigned f2bf(float f) { unsigned u = __builtin_bit_cast(unsigned, f); return (u + 0x7fffu + ((u >> 16) & 1u)) >> 16; }
__device__ __forceinline__ unsigned pk2(float lo, float hi) { return f2bf(lo) | (f2bf(hi) << 16); }

#define XB_TMO      128
#define XB_XCNT(j)  (256  + 64 * (j))
#define XB_XSUB(j)  (1280 + 64 * (j))
#define XB_XGEN(j)  (2304 + 64 * (j))
#define XB_TOP      3328
#define XB_TOPGEN   3392
#define XCD_BAR_WORDS 3456
#define XB_SPIN_CAP (1u << 18)

__device__ __forceinline__ unsigned xb_ld(unsigned* p)              { return __hip_atomic_load(p, __ATOMIC_RELAXED, __HIP_MEMORY_SCOPE_AGENT); }
__device__ __forceinline__ unsigned xb_add(unsigned* p, unsigned v) { return __hip_atomic_fetch_add(p, v, __ATOMIC_RELAXED, __HIP_MEMORY_SCOPE_AGENT); }
__device__ __forceinline__ unsigned xb_xcc_id() { return (unsigned)__builtin_amdgcn_s_getreg((3 << 11) | 20) & 0xFu; }
#define XB_SPIN(cond, bar) do { unsigned _sp = 0; while (cond) { __builtin_amdgcn_s_sleep(1); \
    if ((++_sp & 255u) == 0u) { if (xb_ld(&(bar)[XB_TMO])) break; if (_sp > XB_SPIN_CAP) { atomicAdd(&(bar)[XB_TMO], 1u); break; } } } } while (0)

struct XcdBarrier {
    unsigned* bar; unsigned x;
    volatile LAS unsigned* st;
};

__device__ __forceinline__ XcdBarrier xcd_barrier_post(unsigned* bar, volatile LAS unsigned* st, bool t0) {
    XcdBarrier b; b.bar = bar; b.x = xb_xcc_id(); b.st = st;
    if (t0) (void)xb_add(&bar[XB_XCNT(b.x)], 1u);
    return b;
}
__device__ __forceinline__ void xcd_barrier_complete(unsigned* bar, unsigned x, unsigned& nloc, unsigned& nx) {
    const unsigned G = gridDim.x * gridDim.y * gridDim.z;
    unsigned sum, cnt, mine, sp = 0u;
    for (;;) {
        sum = 0u; cnt = 0u; mine = 0u;
#pragma unroll
        for (unsigned j = 0; j < 16; ++j) { const unsigned c = xb_ld(&bar[XB_XCNT(j)]); sum += c; cnt += (c > 0u) ? 1u : 0u; mine = (j == x) ? c : mine; }
        if (sum == G) break;
        __builtin_amdgcn_s_sleep(1);
        if ((++sp & 255u) == 0u) { if (xb_ld(&bar[XB_TMO])) break; if (sp > XB_SPIN_CAP) { atomicAdd(&bar[XB_TMO], 1u); break; } }
    }
    nloc = mine > 0u ? mine : 1u; nx = cnt > 0u ? cnt : 1u;
}

__device__ __forceinline__ void xcd_barrier(const XcdBarrier& b, bool t0) {
    asm volatile("s_waitcnt vmcnt(0)" ::: "memory");
    __syncthreads();
    if (t0) {
        unsigned* bar = b.bar;
        __builtin_amdgcn_s_waitcnt(0);
        unsigned nloc = b.st[0], nx = b.st[1];
        if (nloc == 0u) { xcd_barrier_complete(bar, b.x, nloc, nx); b.st[0] = nloc; b.st[1] = nx; }
        const unsigned old = xb_add(&bar[XB_XSUB(b.x)], 1u);
        const unsigned gen = old / nloc;
        if (old + 1u == (gen + 1u) * nloc) {
            __builtin_amdgcn_fence(__ATOMIC_RELEASE, "agent");
            asm volatile("s_waitcnt vmcnt(0)" ::: "memory");
            const unsigned og = xb_add(&bar[XB_TOP], 1u);
            const unsigned tg = og / nx;
            if (og + 1u == (tg + 1u) * nx) xb_add(&bar[XB_TOPGEN], 1u);
            else XB_SPIN(xb_ld(&bar[XB_TOPGEN]) == tg, bar);
            __builtin_amdgcn_fence(__ATOMIC_ACQUIRE, "agent");
            xb_add(&bar[XB_XGEN(b.x)], 1u);
            asm volatile("s_waitcnt vmcnt(0)" ::: "memory");
        } else {
            XB_SPIN(xb_ld(&bar[XB_XGEN(b.x)]) == gen, bar);
            __builtin_amdgcn_fence(__ATOMIC_ACQUIRE, "agent");
            asm volatile("s_waitcnt vmcnt(0)" ::: "memory");
        }
    }
    __syncthreads();
}
constexpr size_t O_YP = 0, O_YS = O_YP + (size_t)MPR * DM, O_KP = O_YS + (size_t)MSM * DM, O_VP = O_KP + (size_t)MPR * DATT, O_LFP = O_VP + (size_t)MPR * DATT,
                 O_HRP = O_LFP + (size_t)MPR * NH, O_HIP = O_HRP + (size_t)NB * NG * NST, O_KS = O_HIP + (size_t)NB * NG * NST, O_VS = O_KS + (size_t)MSM * DATT,
                 O_LFS = O_VS + (size_t)MSM * DATT, O_HRS = O_LFS + (size_t)MSM * NH, O_HIS = O_HRS + (size_t)DBT * NG * NST, O_END = O_HIS + (size_t)DBT * NG * NST;
static_assert(O_END == 33833216, "output size");

constexpr size_t al256(size_t x) { return (x + 255) & ~(size_t)255; }
constexpr size_t WS_CTL = 0, CTL_ZERO_BYTES = 64u << 10;
constexpr size_t WS_W1T  = 1u << 20;
constexpr size_t WS_WGLU = WS_W1T  + (size_t)8192 * 2048 * 2;
constexpr size_t WS_WBR  = WS_WGLU + (size_t)1024 * 1024 * 2;
constexpr size_t WS_WOUT = WS_WBR  + (size_t)2048 * 2048 * 2;
constexpr size_t WS_WFF1 = WS_WOUT + (size_t)2048 * 2048 * 2;
constexpr size_t WS_WFF2 = WS_WFF1 + (size_t)11264 * 2048 * 2;
constexpr size_t WS_XA   = WS_WFF2 + (size_t)2048 * 5632 * 2;
constexpr size_t WS_R1   = WS_XA   + (size_t)MPAD * 2048 * 2;
constexpr size_t WS_Z    = al256(WS_R1 + (size_t)MPAD * 4);
constexpr size_t WS_G    = WS_Z    + (size_t)MPAD * 4096 * 4;
constexpr size_t WS_YP   = WS_G    + (size_t)MPAD * 4096 * 2;
constexpr size_t WS_YY   = WS_YP   + (size_t)MPAD * 1024 * 2;
constexpr size_t WS_T1   = WS_YY   + (size_t)MPAD * 2048 * 2;
constexpr size_t WS_MG   = WS_T1   + (size_t)MPAD * 2048 * 4;
constexpr size_t WS_X1   = WS_MG   + (size_t)MPAD * 2048 * 2;
constexpr size_t WS_XB   = WS_X1   + (size_t)MPAD * 2048 * 4;
constexpr size_t WS_SS   = WS_XB   + (size_t)MPAD * 2048 * 2;
constexpr size_t WS_H    = WS_SS   + (size_t)MPAD * 32 * 4;
constexpr size_t WS_QB   = WS_H    + (size_t)MPAD * DFF * 2;
constexpr size_t WS_KB   = WS_QB   + (size_t)MPR * 1024 * 2;
constexpr size_t WS_VB   = WS_KB   + (size_t)MPR * 1024 * 2;
constexpr size_t WS_NCK  = WS_VB   + (size_t)MPR * 1024 * 2;
constexpr size_t WS_QS   = WS_NCK  + (size_t)NB * NH * SEQ * 16 * 2;
constexpr size_t WS_AB   = WS_QS   + (size_t)DBT * NH * DSQ * HD * 4;
constexpr size_t WS_AT   = WS_AB   + (size_t)NG * NST * 2 * 4;
constexpr size_t WS_BBR  = WS_AT   + (size_t)NG * NST * 2 * 4;
constexpr size_t WS_BBI  = WS_BBR  + (size_t)NG * NST * GC * 4;
constexpr size_t WS_E    = WS_BBI  + (size_t)NG * NST * GC * 4;
constexpr size_t WS_PW   = WS_E    + (size_t)NG * 512 * 128 * 4;
constexpr size_t WS_M3   = al256(WS_PW + (size_t)NG * 17 * NST * 2 * 4);
constexpr size_t WS_M2   = WS_M3   + (size_t)NG * 128 * 256 * 2;
constexpr size_t WS_KT   = WS_M2   + (size_t)NG * 256 * 128 * 2;
constexpr size_t WS_UB   = WS_KT   + (size_t)NG * 16 * 256 * 2;
constexpr size_t WS_AG   = WS_UB   + (size_t)NG * 512 * 256 * 2;
constexpr size_t WS_RP   = WS_AG   + (size_t)NG * 16 * 128 * 4;
constexpr size_t WS_TPG  = WS_RP   + (size_t)DBT * NH * PAST * 4;
constexpr size_t WS_PML  = WS_TPG  + (size_t)DBT * NH * NPAGES * 4;
constexpr size_t WS_PO   = WS_PML  + (size_t)256 * 64 * 2 * 4;
constexpr size_t WS_SS2  = WS_PO   + (size_t)256 * 64 * 128 * 4;
constexpr size_t WS_SSR  = WS_SS2  + (size_t)32 * 64 * 4;
constexpr size_t WS_LIST = al256(WS_SSR + (size_t)MPAD * 4);
constexpr size_t WS_XF   = al256(WS_LIST + (size_t)(256 + 2048 + 64) * 4);
constexpr size_t WS_JLO  = WS_XF   + (size_t)NB * NH * SEQ * 4;
constexpr size_t WS_END  = WS_JLO  + (size_t)256 * 4;
constexpr int CW_Q = 8192;
constexpr int CW_BAR = 4096;

constexpr int LDS_BYTES = 147456;
constexpr int MISC_OFF = LDS_BYTES - 512;
constexpr int NWAVES = 8;
struct Args { const void* in[30]; float* out; unsigned char* ws; int ph_lo, ph_hi, probe, pad; };
struct Frame {
    unsigned char* lds;
    int tid, lane, wave, G, gw, NGW;
    float* out; unsigned char* ws;
};
template <int OFF> __device__ __forceinline__ unsigned long long karg_load() {
    unsigned long long v; auto kp = __builtin_amdgcn_kernarg_segment_ptr();
    asm volatile("s_load_dwordx2 %0, %1, %2\n\ts_waitcnt lgkmcnt(0)" : "=s"(v) : "s"(kp), "n"(OFF) : "memory"); return v; }
#define INP(T, i) ((const T*)(const __attribute__((address_space(1))) T*)karg_load<8 * (i)>())
enum { I_XP = 0, I_XS, I_CK, I_CV, I_CLF, I_SRE, I_SIM, I_PT, I_G1, I_WIN, I_BF, I_GQ, I_GK, I_ARE, I_AIM, I_LDT, I_BRE, I_BIM, I_CRE, I_CIM, I_DSSM, I_WGLU, I_BGLU, I_WBRS, I_WBRA, I_WOUT, I_G2, I_WFG, I_WFU, I_WFD };
#define WSP(T, off) ((T*)(F.ws + (off)))

__device__ __forceinline__ float wave_sum(float v) {
#pragma unroll
    for (int o = 1; o < 64; o <<= 1) v += __shfl_xor(v, o);
    return v;
}
__device__ __forceinline__ unsigned cvtpk(float lo, float hi) { unsigned r; asm volatile("v_cvt_pk_bf16_f32 %0, %1, %2" : "=v"(r) : "v"(lo), "v"(hi)); return r; }

__device__ __forceinline__ void sincos_d(double x, double& s, double& c) {
    const double k = __builtin_rint(x * 0.63661977236758134308);
    double r = __builtin_fma(-k, 1.57079632679489655800e+00, x); r = __builtin_fma(-k, 6.12323399573676603587e-17, r);
    const long long q = (long long)k; const double r2 = r * r;
    double sp = -1.0 / 1307674368000.0; sp = sp * r2 + 1.0 / 6227020800.0; sp = sp * r2 - 1.0 / 39916800.0; sp = sp * r2 + 1.0 / 362880.0; sp = sp * r2 - 1.0 / 5040.0; sp = sp * r2 + 1.0 / 120.0; sp = sp * r2 - 1.0 / 6.0; sp = sp * r2 + 1.0; sp *= r;
    double cp = 1.0 / 20922789888000.0; cp = cp * r2 - 1.0 / 87178291200.0; cp = cp * r2 + 1.0 / 479001600.0; cp = cp * r2 - 1.0 / 3628800.0; cp = cp * r2 + 1.0 / 40320.0; cp = cp * r2 - 1.0 / 720.0; cp = cp * r2 + 1.0 / 24.0; cp = cp * r2 - 0.5; cp = cp * r2 + 1.0;
    const int qq = (int)(q & 3);
    s = (qq == 0) ? sp : (qq == 1) ? cp : (qq == 2) ? -sp : -cp;
    c = (qq == 0) ? cp : (qq == 1) ? -sp : (qq == 2) ? -cp : sp;
}
__device__ __forceinline__ double exp_d(double x) {
    const double k = __builtin_rint(x * 1.44269504088896338700e+00);
    double r = __builtin_fma(-k, 6.93147180369123816490e-01, x); r = __builtin_fma(-k, 1.90821492927058770002e-10, r);
    double p = 1.0 / 6227020800.0; p = p * r + 1.0 / 479001600.0; p = p * r + 1.0 / 39916800.0; p = p * r + 1.0 / 3628800.0; p = p * r + 1.0 / 362880.0; p = p * r + 1.0 / 40320.0; p = p * r + 1.0 / 5040.0;
    p = p * r + 1.0 / 720.0; p = p * r + 1.0 / 120.0; p = p * r + 1.0 / 24.0; p = p * r + 1.0 / 6.0; p = p * r + 0.5; p = p * r + 1.0; p = p * r + 1.0;
    int ki = (int)k; if (ki < -1000) return 0.0;
    return __builtin_ldexp(p, ki);
}

constexpr int WI_IN = 32 * 8, WI_GLU = 16 * 2, WI_BR = 16 * 4, WI_OUT = 32 * 4, WI_FF1 = 32 * 11, WI_FF2 = 88 * 4;
constexpr int WI_GLU0 = 2 * WI_IN, WI_BR0 = WI_GLU0 + WI_GLU, WI_OUT0 = WI_BR0 + 2 * WI_BR, WI_FF10 = WI_OUT0 + WI_OUT, WI_FF20 = WI_FF10 + 2 * WI_FF1, WI_END = WI_FF20 + WI_FF2;
struct WItem { const float* src; bf16* dst; const float* gs; int ldw, ldd, ilv; };
__device__ __forceinline__ void weight_copies(Frame& F, int it_lo, int it_hi, int bi, int nb, int prb = 0) {
    const float* const g1 = INP(float, I_G1); const float* const w_in = INP(float, I_WIN);
    const float* const w_glu = INP(float, I_WGLU); const float* const w_brs = INP(float, I_WBRS); const float* const w_bra = INP(float, I_WBRA); const float* const w_out = INP(float, I_WOUT);
    const float* const g2 = INP(float, I_G2); const float* const w_fg = INP(float, I_WFG); const float* const w_fu = INP(float, I_WFU); const float* const w_fd = INP(float, I_WFD);
    int drow0 = 0, n0g = 0;
    auto decode = [&](int it, WItem& t) { int r = it;
#define WC_SET(W_, ldw_, scol_, WT_, ldd_, drow_, k0_, dk0_, gs_, ilv_) do { t.src = (W_) + (size_t)(k0_) * (ldw_) + (scol_); t.dst = (WT_) + (dk0_) + (k0_); t.gs = (gs_) ? (gs_) + (k0_) : nullptr; t.ldw = (ldw_); t.ldd = (ldd_); t.ilv = (ilv_); drow0 = (drow_); n0g = (scol_); } while (0)
        if (r < 2 * WI_IN) { const int part = r / WI_IN; r -= part * WI_IN; const int kb = r / 8, nbk = r % 8; WC_SET(w_in, NIN, (part ? 4104 : 0) + 512 * nbk, WSP(bf16, WS_W1T), 2048, part * 4096 + 512 * nbk, 64 * kb, 0, g1, -1); return; } r -= 2 * WI_IN;
        if (r < WI_GLU) { const int kb = r / 2, nbk = r % 2; WC_SET(w_glu, 1024, 512 * nbk, WSP(bf16, WS_WGLU), 1024, 512 * nbk, 64 * kb, 0, (const float*)nullptr, -1); return; } r -= WI_GLU;
        if (r < 2 * WI_BR) { const int part = r / WI_BR; r -= part * WI_BR; const int kb = r / 4, nbk = r % 4; WC_SET(part ? w_bra : w_brs, 2048, 512 * nbk, WSP(bf16, WS_WBR), 2048, 512 * nbk, 64 * kb, part * 1024, (const float*)nullptr, -1); return; } r -= 2 * WI_BR;
        if (r < WI_OUT) { const int kb = r / 4, nbk = r % 4; WC_SET(w_out, 2048, 512 * nbk, WSP(bf16, WS_WOUT), 2048, 512 * nbk, 64 * kb, 0, (const float*)nullptr, -1); return; } r -= WI_OUT;
        if (r < 2 * WI_FF1) { const int part = r / WI_FF1; r -= part * WI_FF1; const int kb = r / 11, nbk = r % 11; WC_SET(part ? w_fu : w_fg, DFF, 512 * nbk, WSP(bf16, WS_WFF1), 2048, 0, 64 * kb, 0, g2, part); return; } r -= 2 * WI_FF1;
        { const int kb = r / 4, nbk = r % 4; WC_SET(w_fd, 2048, 512 * nbk, WSP(bf16, WS_WFF2), DFF, 512 * nbk, 64 * kb, 0, (const float*)nullptr, -1); }
#undef WC_SET
    };
    float* T = (float*)F.lds;
    f32x4 nx[16]; WItem tn; int it = it_lo + bi;
#define WC_LOAD() do { _Pragma("unroll") for (int i = 0; i < 16; ++i) nx[i] = __builtin_nontemporal_load((const f32x4*)(tn.src + (size_t)(8 * F.wave + (i >> 1)) * tn.ldw + 256 * (i & 1) + 4 * F.lane)); } while (0)
    if (it < it_hi) { decode(it, tn); WC_LOAD(); }
    for (; it < it_hi; it += nb) { const WItem t = tn; const int dr0 = drow0, n0 = n0g;
        __syncthreads();
#pragma unroll
        for (int i = 0; i < 16; ++i) { f32x4 v = nx[i]; if (t.gs) v = v * t.gs[8 * F.wave + (i >> 1)]; *(f32x4*)(T + (8 * F.wave + (i >> 1)) * 512 + 256 * (i & 1) + 4 * F.lane) = v; }
        if (it + nb < it_hi) { decode(it + nb, tn); WC_LOAD(); }
        __syncthreads();
        const int n = 64 * F.wave + F.lane, nsrc = n0 + n; const int row = t.ilv < 0 ? dr0 + n : 256 * (nsrc >> 7) + (nsrc & 127) + 128 * t.ilv;
        bf16* op = t.dst + (size_t)row * t.ldd; const float* tc = T + n;
#pragma unroll
        for (int c = 0; c < 8; ++c) { v4u o; o.x = cvtpk(tc[(8 * c) * 512], tc[(8 * c + 1) * 512]); o.y = cvtpk(tc[(8 * c + 2) * 512], tc[(8 * c + 3) * 512]); o.z = cvtpk(tc[(8 * c + 4) * 512], tc[(8 * c + 5) * 512]); o.w = cvtpk(tc[(8 * c + 6) * 512], tc[(8 * c + 7) * 512]);
            if (!(prb & 32) || o.x == 0x12345678u) *(v4u*)(op + 8 * c) = o; } }
#undef WC_LOAD
    __syncthreads();
}
__device__ __forceinline__ void phase0(Frame& F, int prb) {
    const float* const g1 = INP(float, I_G1); const float* const w_in = INP(float, I_WIN);
    float* WF = (float*)F.lds;
    for (int k = F.tid; k < DM; k += NWAVES * 64) { const float g = g1[k]; const float* wp = w_in + (size_t)k * NIN + 4096; const f32x4 a = *(const f32x4*)wp, b = *(const f32x4*)(wp + 4);
        WF[0 * DM + k] = g * a[0]; WF[1 * DM + k] = g * a[1]; WF[2 * DM + k] = g * a[2]; WF[3 * DM + k] = g * a[3];
        WF[4 * DM + k] = g * b[0]; WF[5 * DM + k] = g * b[1]; WF[6 * DM + k] = g * b[2]; WF[7 * DM + k] = g * b[3]; }
    __syncthreads();
    bf16* XA = WSP(bf16, WS_XA); float* R1 = WSP(float, WS_R1); const float* const xp = INP(float, I_XP); const float* const xs = INP(float, I_XS); const float* const b_f = INP(float, I_BF);
    if (!(prb & 64)) for (int m = MR + F.gw; m < MPAD; m += F.NGW) { unsigned long long* o8 = (unsigned long long*)(XA + (size_t)m * DM) + F.lane;
#pragma unroll
        for (int j = 0; j < 8; ++j) o8[64 * j] = 0ull;
        if (F.lane == 0) R1[m] = 0.f; }
    {
#define P0_ROWPTR(m_) ((const f32x4*)((m_) < MPR ? xp + (size_t)(m_) * DM : xs + (size_t)((m_) - MPR) * DM) + F.lane)
        f32x4 nx[8]; int m = (prb & 64) ? MR : F.gw;
        if (m < MR) { const f32x4* xr = P0_ROWPTR(m);
#pragma unroll
            for (int j = 0; j < 8; ++j) nx[j] = __builtin_nontemporal_load(xr + 64 * j); }
        for (; m < MR; m += F.NGW) {
            f32x4 v[8];
#pragma unroll
            for (int j = 0; j < 8; ++j) v[j] = nx[j];
            const int mn = m + F.NGW;
            if (mn < MR) { const f32x4* xr = P0_ROWPTR(mn);
#pragma unroll
                for (int j = 0; j < 8; ++j) nx[j] = __builtin_nontemporal_load(xr + 64 * j); }
            float ss = 0.f;
#pragma unroll
            for (int j = 0; j < 8; ++j) ss += (v[j][0] * v[j][0] + v[j][1] * v[j][1]) + (v[j][2] * v[j][2] + v[j][3] * v[j][3]);
            unsigned long long* o8 = (unsigned long long*)(XA + (size_t)m * DM) + F.lane;
#pragma unroll
            for (int j = 0; j < 8; ++j) o8[64 * j] = (unsigned long long)cvtpk(v[j][0], v[j][1]) | ((unsigned long long)cvtpk(v[j][2], v[j][3]) << 32);
            float a[8];
#pragma unroll
            for (int h = 0; h < 8; ++h) { float t = 0.f;
#pragma unroll
                for (int j = 0; j < 8; ++j) { const f32x4 w = *(const f32x4*)(WF + h * DM + 256 * j + 4 * F.lane); t += (v[j][0] * w[0] + v[j][1] * w[1]) + (v[j][2] * w[2] + v[j][3] * w[3]); }
                a[h] = t; }
            const bool b5 = (F.lane & 32) != 0, b4 = (F.lane & 16) != 0, b3 = (F.lane & 8) != 0; float w4[4], w2[2];
#pragma unroll
            for (int i = 0; i < 4; ++i) { const float snd = b5 ? a[i] : a[i + 4], kp = b5 ? a[i + 4] : a[i]; w4[i] = kp + __shfl_xor(snd, 32); }
#pragma unroll
            for (int i = 0; i < 2; ++i) { const float snd = b4 ? w4[i] : w4[i + 2], kp = b4 ? w4[i + 2] : w4[i]; w2[i] = kp + __shfl_xor(snd, 16); }
            float fl; { const float snd = b3 ? w2[0] : w2[1], kp = b3 ? w2[1] : w2[0]; fl = kp + __shfl_xor(snd, 8); }
            fl += __shfl_xor(fl, 1); fl += __shfl_xor(fl, 2); fl += __shfl_xor(fl, 4);
            ss = wave_sum(ss);
            const float r1 = 1.0f / sqrtf(ss * (1.0f / DM) + RMS_EPS);
            if (F.lane == 0) R1[m] = r1;
            if ((F.lane & 7) == 0) { const int h = ((F.lane >> 5) & 1) * 4 + ((F.lane >> 4) & 1) * 2 + ((F.lane >> 3) & 1); const float z = fl * r1 + b_f[h]; const float lf = fminf(z, 0.f) - log1pf(expf(-fabsf(z)));
                if (m < MPR) F.out[O_LFP + (size_t)m * NH + h] = lf; else F.out[O_LFS + (size_t)(m - MPR) * NH + h] = lf; }
        }
#undef P0_ROWPTR
    }
    for (int i = F.gw * 64 + F.lane; i < MPAD; i += F.NGW * 64) WSP(float, WS_SSR)[i] = 0.f;
    { const float* const ldt = INP(float, I_LDT); const float* const a_re = INP(float, I_ARE); const float* const a_im = INP(float, I_AIM); const float* const b_re = INP(float, I_BRE); const float* const b_im = INP(float, I_BIM);
    for (int g = F.gw; g < NG; g += F.NGW) { const int p = F.lane, gp = g * NST + p;
        const double dt = exp_d((double)ldt[g]), are = (double)a_re[gp], aim = (double)a_im[gp];
        double sn, cs; sincos_d(dt * aim, sn, cs); const double mag = exp_d(dt * are); const double abr = mag * cs, abi = mag * sn;
        float* AB = WSP(float, WS_AB); AB[2 * gp] = (float)abr; AB[2 * gp + 1] = (float)abi;
        { float* PW = WSP(float, WS_PW) + (size_t)g * 17 * NST * 2 + 2 * p; double pr = 1.0, pi = 0.0;
#pragma unroll 1
          for (int tau = 0; tau <= 16; ++tau) { PW[tau * NST * 2] = (float)pr; PW[tau * NST * 2 + 1] = (float)pi; const double nr = pr * abr - pi * abi, ni = pr * abi + pi * abr; pr = nr; pi = ni; } }
        const double er = abr - 1.0, ei = abi, inv = 1.0 / (are * are + aim * aim), fr = (er * are + ei * aim) * inv, fi = (ei * are - er * aim) * inv;
        float* BBR = WSP(float, WS_BBR) + (size_t)gp * GC; float* BBI = WSP(float, WS_BBI) + (size_t)gp * GC;
#pragma unroll
        for (int c = 0; c < GC; ++c) { const double br = (double)b_re[(size_t)gp * GC + c], bi = (double)b_im[(size_t)gp * GC + c]; BBR[c] = (float)(fr * br - fi * bi); BBI[c] = (float)(fr * bi + fi * br); }
    } }
    { const int* const pt = INP(int, I_PT); const float* const clf = INP(float, I_CLF);
    for (int it = (F.NGW >= 2048 ? F.gw - 1024 : F.gw); it >= 0 && it < DBT * NPAGES; it += F.NGW) { const int b = it >> 7, j = it & 127, phys = pt[it];     const int seg = F.lane >> 3, h = F.lane & 7;
        const float* lp = clf + ((size_t)phys * PAGE + 16 * seg) * NH + h; float v[16];
#pragma unroll
        for (int i = 0; i < 16; ++i) v[i] = lp[i * NH];
        float s[16]; float run = 0.f;
#pragma unroll
        for (int i = 15; i >= 0; --i) { s[i] = run; run += v[i]; }
        float off = 0.f;
#pragma unroll
        for (int d = 1; d < 8; ++d) { const float t = __shfl(run, (F.lane + 8 * d) & 63); if (seg + d < 8) off += t; }
        float* rp = WSP(float, WS_RP) + ((size_t)(b * NH + h) * PAST) + j * PAGE + 16 * seg;
#pragma unroll
        for (int i = 0; i < 16; ++i) rp[i] = s[i] + off;
        if (seg == 0) WSP(float, WS_TPG)[(b * NH + h) * NPAGES + j] = off + run; } }
    __syncthreads();
    weight_copies(F, 0, WI_BR0, (int)blockIdx.x, F.G, prb);
}
__device__ __forceinline__ void rowpass(Frame& F) {
    const int h = F.lane >> 3, sub = F.lane & 7, off = h * HD + sub * 16;
    float gq[16], gk[16]; { const float* const gqp = INP(float, I_GQ); const float* const gkp = INP(float, I_GK);
#pragma unroll
    for (int i = 0; i < 16; ++i) { gq[i] = gqp[sub * 16 + i]; gk[i] = gkp[sub * 16 + i]; } }
    const float* Z = WSP(float, WS_Z);
    for (int m = MPR + F.gw; m < MR; m += F.NGW) {
        const float* z = Z + (size_t)m * 4096 + off; float q[16], k[16], v[16];
#pragma unroll
        for (int i = 0; i < 4; ++i) { const f32x4 a = *(const f32x4*)(z + 1024 + 4 * i), b = *(const f32x4*)(z + 2048 + 4 * i), c = *(const f32x4*)(z + 3072 + 4 * i);
#pragma unroll
            for (int e = 0; e < 4; ++e) { q[4 * i + e] = a[e]; k[4 * i + e] = b[e]; v[4 * i + e] = c[e]; } }
        float sq = 0.f, sk = 0.f;
#pragma unroll
        for (int i = 0; i < 16; ++i) { sq += q[i] * q[i]; sk += k[i] * k[i]; }
        sq += __shfl_xor(sq, 1); sq += __shfl_xor(sq, 2); sq += __shfl_xor(sq, 4); sk += __shfl_xor(sk, 1); sk += __shfl_xor(sk, 2); sk += __shfl_xor(sk, 4);
        const float rq = 1.0f / sqrtf(sq * (1.0f / HD) + RMS_EPS), rk = 1.0f / sqrtf(sk * (1.0f / HD) + RMS_EPS);
#pragma unroll
        for (int i = 0; i < 16; ++i) { q[i] = q[i] * rq * gq[i]; k[i] = k[i] * rk * gk[i]; }
        float* ko; float* vo;
        if (m < MPR) { const int b = m >> 12, s = m & (SEQ - 1); const size_t ao = ((size_t)(b * NH + h) * SEQ + s) * HD + sub * 16;
            v4u w;
            w.x = cvtpk(q[0], q[1]); w.y = cvtpk(q[2], q[3]); w.z = cvtpk(q[4], q[5]); w.w = cvtpk(q[6], q[7]); *(v4u*)(WSP(bf16, WS_QB) + ao) = w;
            w.x = cvtpk(q[8], q[9]); w.y = cvtpk(q[10], q[11]); w.z = cvtpk(q[12], q[13]); w.w = cvtpk(q[14], q[15]); *(v4u*)(WSP(bf16, WS_QB) + ao + 8) = w;
            w.x = cvtpk(k[0], k[1]); w.y = cvtpk(k[2], k[3]); w.z = cvtpk(k[4], k[5]); w.w = cvtpk(k[6], k[7]); *(v4u*)(WSP(bf16, WS_KB) + ao) = w;
            w.x = cvtpk(k[8], k[9]); w.y = cvtpk(k[10], k[11]); w.z = cvtpk(k[12], k[13]); w.w = cvtpk(k[14], k[15]); *(v4u*)(WSP(bf16, WS_KB) + ao + 8) = w;
            w.x = cvtpk(v[0], v[1]); w.y = cvtpk(v[2], v[3]); w.z = cvtpk(v[4], v[5]); w.w = cvtpk(v[6], v[7]); *(v4u*)(WSP(bf16, WS_VB) + ao) = w;
            w.x = cvtpk(v[8], v[9]); w.y = cvtpk(v[10], v[11]); w.z = cvtpk(v[12], v[13]); w.w = cvtpk(v[14], v[15]); *(v4u*)(WSP(bf16, WS_VB) + ao + 8) = w;
            ko = F.out + O_KP + (size_t)m * DATT + off; vo = F.out + O_VP + (size_t)m * DATT + off;
        } else { const int ms = m - MPR, b = ms >> 2, t = ms & 3; float* qs = WSP(float, WS_QS) + ((size_t)((b * NH + h) * DSQ + t)) * HD + sub * 16;
#pragma unroll
            for (int i = 0; i < 4; ++i) *(f32x4*)(qs + 4 * i) = (f32x4){q[4 * i], q[4 * i + 1], q[4 * i + 2], q[4 * i + 3]};
            ko = F.out + O_KS + (size_t)ms * DATT + off; vo = F.out + O_VS + (size_t)ms * DATT + off; }
#pragma unroll
        for (int i = 0; i < 4; ++i) { *(f32x4*)(ko + 4 * i) = (f32x4){k[4 * i], k[4 * i + 1], k[4 * i + 2], k[4 * i + 3]}; *(f32x4*)(vo + 4 * i) = (f32x4){v[4 * i], v[4 * i + 1], v[4 * i + 2], v[4 * i + 3]}; }
    }
}
__device__ __forceinline__ void logf_cumsum(Frame& F, int it) {
    const float* const gqp = INP(float, I_GQ); const float* const gkp = INP(float, I_GK);
    const int b = it >> 3, h = it & 7, pos0 = 512 * F.wave + 8 * F.lane;
    const float* lf = F.out + O_LFP + ((size_t)b * SEQ + pos0) * NH + h; bf16* o = WSP(bf16, WS_NCK) + ((size_t)it * SEQ + pos0) * 16; float* xf = WSP(float, WS_XF) + (size_t)it * SEQ + pos0;
    double* WT = (double*)F.lds; float* TG = (float*)(F.lds + 128); int* CN = (int*)(F.lds + 256);
    float v[8];
#pragma unroll
    for (int i = 0; i < 8; ++i) v[i] = lf[(size_t)i * NH];
    double tot = 0.0;
#pragma unroll
    for (int i = 0; i < 8; ++i) tot += (double)v[i];
    double ex = tot;
#pragma unroll
    for (int d = 1; d < 64; d <<= 1) { const double t = __shfl_up(ex, d); if (F.lane >= d) ex += t; }
    if (F.lane == 63) WT[F.wave] = ex;
    if (F.tid < 16) CN[F.tid] = 0;
    __syncthreads();
    double run = ex - tot;
    for (int w = 0; w < F.wave; ++w) run += WT[w];
    float xs_[8];
#pragma unroll
    for (int i = 0; i < 8; ++i) { run += (double)v[i];
        const float x = (float)(-run * 11.313708498984761);
        xs_[i] = x; xf[i] = x;
        const unsigned h16 = cvtpk(x, 0.f) & 0xffffu; const float r1 = x - __uint_as_float(h16 << 16); const unsigned m16 = cvtpk(r1, 0.f) & 0xffffu; const float r2 = r1 - __uint_as_float(m16 << 16); const unsigned l16 = cvtpk(r2, 0.f) & 0xffffu;
        v4u w; w.x = h16 | (m16 << 16); w.y = l16; w.z = 0u; w.w = 0u; *(v4u*)(o + (size_t)i * 16) = w; *(v4u*)(o + (size_t)i * 16 + 8) = (v4u){0u, 0u, 0u, 0u}; }
    if ((F.lane & 31) == 0) TG[2 * F.wave + (F.lane >> 5)] = xs_[0];
    __syncthreads();
    { float mq = fmaxf(fabsf(gqp[F.lane]), fabsf(gqp[F.lane + 64])), mk = fmaxf(fabsf(gkp[F.lane]), fabsf(gkp[F.lane + 64]));
#pragma unroll
      for (int od = 1; od < 64; od <<= 1) { mq = fmaxf(mq, __shfl_xor(mq, od)); mk = fmaxf(mk, __shfl_xor(mk, od)); }
      const float bq2 = 11.313708498984761f * 1.4426950408889634f * mq * mk, thr = (2.f * bq2 + 40.f) * (1.0f / (1.4426950408889634f * 0.08838834764831845f));
#pragma unroll 4
      for (int qb = 0; qb < 16; ++qb) { const float tgt = TG[qb] - thr; int cnt = 0;
#pragma unroll
          for (int i = 0; i < 8; ++i) cnt += (xs_[i] < tgt) ? 1 : 0;
#pragma unroll
          for (int od = 1; od < 64; od <<= 1) cnt += __shfl_xor(cnt, od);
          if (F.lane == 0 && cnt) atomicAdd(CN + qb, cnt); } }
    __syncthreads();
    if (F.tid < 16) WSP(int, WS_JLO)[it * 16 + F.tid] = CN[F.tid] >> 6;
    __syncthreads();
}
__device__ __forceinline__ void rpast_fix(Frame& F) {
    for (int it = F.gw; it < DBT * NH * NPAGES; it += F.NGW) { const int bh = it >> 7, j = it & 127; const float* tp = WSP(float, WS_TPG) + bh * NPAGES;
        float a = (F.lane > j ? tp[F.lane] : 0.f) + (F.lane + 64 > j ? tp[F.lane + 64] : 0.f); a = wave_sum(a);
        float* rp = WSP(float, WS_RP) + (size_t)bh * PAST + j * PAGE; rp[F.lane] = (rp[F.lane] + a) * LOG2E; rp[F.lane + 64] = (rp[F.lane + 64] + a) * LOG2E; }
}

namespace s5 {
constexpr int HS_STRIDE = 132, US_F = 256, HS_F = 16 * HS_STRIDE, CS_F = 64 * 32, WLDS_F = US_F + HS_F + CS_F;
__device__ __forceinline__ float gelu_erf(float v) {
    const float d = fmaf(fabsf(v), 0.2316418882f, 1.0f), t = __builtin_amdgcn_rcpf(d);
    float q = fmaf(t, 0.5307027145f, -0.7265760135f); q = fmaf(q, t, 0.7107068705f); q = fmaf(q, t, -0.142248368f); q = fmaf(q, t, 0.127414796f); q = q * t;
    const float e = __builtin_amdgcn_exp2f(v * v * -0.72134752044f), m = v * (q * e);
    return v < 0.f ? m : v - m;
}
template <int MODE>
__device__ __forceinline__ void unit(const float* U, int T, float& hre, float& him, const float* bbr, const float* bbi, float are, float aim, float* wl, int lane, bf16* YPr, const float* dv) {
    float br[16], bi[16];
#pragma unroll
    for (int i = 0; i < 4; ++i) { const f32x4 a = *(const f32x4*)(bbr + 4 * i), b = *(const f32x4*)(bbi + 4 * i);
#pragma unroll
        for (int e = 0; e < 4; ++e) { br[4 * i + e] = a[e]; bi[4 * i + e] = b[e]; } }
    float* Us = wl; float* Hs = wl + US_F; const float* Cs = wl + US_F + HS_F;
    for (int t0 = 0; t0 < T; t0 += 16) { const int nst = (T - t0) < 16 ? (T - t0) : 16;
        { const int row = lane >> 2, quad = lane & 3; f32x4 v = (f32x4){0.f, 0.f, 0.f, 0.f}; if (row < nst) v = *(const f32x4*)(U + (size_t)(t0 + row) * 4096 + quad * 4); *(f32x4*)(Us + row * 16 + quad * 4) = v; }
        LDS_WAIT(); asm volatile("" ::: "memory");
#pragma unroll 1
        for (int t = 0; t < nst; ++t) { float bur = 0.f, bui = 0.f;
#pragma unroll
            for (int i = 0; i < 4; ++i) { const f32x4 u = *(const f32x4*)(Us + t * 16 + 4 * i);
#pragma unroll
                for (int e = 0; e < 4; ++e) { bur = fmaf(br[4 * i + e], u[e], bur); bui = fmaf(bi[4 * i + e], u[e], bui); } }
            const float nre = fmaf(are, hre, fmaf(-aim, him, bur)), nim = fmaf(are, him, fmaf(aim, hre, bui)); hre = nre; him = nim;
            if (MODE == 1) { typedef float f32x2 __attribute__((ext_vector_type(2))); *(f32x2*)(Hs + t * HS_STRIDE + 2 * lane) = (f32x2){hre, him}; } }
        if (MODE == 1) { LDS_WAIT(); asm volatile("" ::: "memory");
            const int tl = lane >> 2, cq = lane & 3; float a0 = 0.f, a1 = 0.f, a2 = 0.f, a3 = 0.f;
#pragma unroll 4
            for (int pp = 0; pp < 32; ++pp) { const f32x4 h4 = *(const f32x4*)(Hs + tl * HS_STRIDE + 4 * pp);
                const f32x4 cA0 = *(const f32x4*)(Cs + (2 * pp) * 32 + cq * 8), cA1 = *(const f32x4*)(Cs + (2 * pp) * 32 + cq * 8 + 4);
                const f32x4 cB0 = *(const f32x4*)(Cs + (2 * pp + 1) * 32 + cq * 8), cB1 = *(const f32x4*)(Cs + (2 * pp + 1) * 32 + cq * 8 + 4);
                a0 += (cA0[0] * h4[0] - cA0[1] * h4[1]) + (cB0[0] * h4[2] - cB0[1] * h4[3]); a1 += (cA0[2] * h4[0] - cA0[3] * h4[1]) + (cB0[2] * h4[2] - cB0[3] * h4[3]);
                a2 += (cA1[0] * h4[0] - cA1[1] * h4[1]) + (cB1[0] * h4[2] - cB1[1] * h4[3]); a3 += (cA1[2] * h4[0] - cA1[3] * h4[1]) + (cB1[2] * h4[2] - cB1[3] * h4[3]); }
            if (tl < nst) { const f32x4 u = *(const f32x4*)(Us + tl * 16 + cq * 4), d = *(const f32x4*)(dv + cq * 4);
                const float y0 = gelu_erf(fmaf(d[0], u[0], a0)), y1 = gelu_erf(fmaf(d[1], u[1], a1)), y2 = gelu_erf(fmaf(d[2], u[2], a2)), y3 = gelu_erf(fmaf(d[3], u[3], a3));
                *(unsigned long long*)(YPr + (size_t)(t0 + tl) * 1024 + cq * 4) = (unsigned long long)cvtpk(y0, y1) | ((unsigned long long)cvtpk(y2, y3) << 32); }
            LDS_WAIT(); asm volatile("" ::: "memory"); }
    }
}
typedef float f32x16 __attribute__((ext_vector_type(16)));
__device__ __forceinline__ void gen_tables(Frame& F, int w0, int nw) {
    const float* PW = WSP(float, WS_PW); const float* BBR = WSP(float, WS_BBR); const float* BBI = WSP(float, WS_BBI);
    const float* const c_re = INP(float, I_CRE); const float* const c_im = INP(float, I_CIM); const float* const dssm = INP(float, I_DSSM);
    for (int it = w0; it < 3 * 1024; it += nw) { const int kind = it >> 10, g = (it >> 4) & 63, x = it & 15, p = F.lane;
        if (kind == 0) {
            const float wr = PW[((size_t)(g * 17 + (15 - x)) * NST + p) * 2], wi = PW[((size_t)(g * 17 + (15 - x)) * NST + p) * 2 + 1]; float re[16], im[16];
#pragma unroll
            for (int i = 0; i < 4; ++i) { const f32x4 br = *(const f32x4*)(BBR + (size_t)(g * NST + p) * GC + 4 * i), bi = *(const f32x4*)(BBI + (size_t)(g * NST + p) * GC + 4 * i);
#pragma unroll
                for (int e = 0; e < 4; ++e) { re[4 * i + e] = wr * br[e] - wi * bi[e]; im[4 * i + e] = wr * bi[e] + wi * br[e]; } }
            bf16* o = WSP(bf16, WS_M3) + ((size_t)(g * 128 + p) * 256 + x * 16);
#pragma unroll
            for (int hf = 0; hf < 2; ++hf) { v4u w; w.x = cvtpk(re[8 * hf], re[8 * hf + 1]); w.y = cvtpk(re[8 * hf + 2], re[8 * hf + 3]); w.z = cvtpk(re[8 * hf + 4], re[8 * hf + 5]); w.w = cvtpk(re[8 * hf + 6], re[8 * hf + 7]); *(v4u*)(o + 8 * hf) = w;
                w.x = cvtpk(im[8 * hf], im[8 * hf + 1]); w.y = cvtpk(im[8 * hf + 2], im[8 * hf + 3]); w.z = cvtpk(im[8 * hf + 4], im[8 * hf + 5]); w.w = cvtpk(im[8 * hf + 6], im[8 * hf + 7]); *(v4u*)(o + (size_t)64 * 256 + 8 * hf) = w; }
        } else if (kind == 1) {
            const float wr = PW[((size_t)(g * 17 + x + 1) * NST + p) * 2], wi = PW[((size_t)(g * 17 + x + 1) * NST + p) * 2 + 1]; bf16* o = WSP(bf16, WS_M2) + (size_t)(g * 256 + x * 16) * 128 + p;
#pragma unroll 4
            for (int c = 0; c < GC; ++c) { const float cr = c_re[(size_t)(g * GC + c) * NST + p], ci = c_im[(size_t)(g * GC + c) * NST + p];
                o[(size_t)c * 128] = (bf16)(cvtpk(cr * wr - ci * wi, 0.f) & 0xffffu); o[(size_t)c * 128 + 64] = (bf16)(cvtpk(-(cr * wi + ci * wr), 0.f) & 0xffffu); }
        } else {
            const int c = F.lane >> 2, c4 = 4 * (F.lane & 3); float a0 = 0.f, a1 = 0.f, a2 = 0.f, a3 = 0.f;
#pragma unroll 4
            for (int pp = 0; pp < NST; ++pp) { const float wr = PW[((size_t)(g * 17 + x) * NST + pp) * 2], wi = PW[((size_t)(g * 17 + x) * NST + pp) * 2 + 1];
                const float cr = c_re[(size_t)(g * GC + c) * NST + pp], ci = c_im[(size_t)(g * GC + c) * NST + pp]; const float tr = cr * wr - ci * wi, ti = cr * wi + ci * wr;
                const f32x4 br = *(const f32x4*)(BBR + (size_t)(g * NST + pp) * GC + c4), bi = *(const f32x4*)(BBI + (size_t)(g * NST + pp) * GC + c4);
                a0 += tr * br[0] - ti * bi[0]; a1 += tr * br[1] - ti * bi[1]; a2 += tr * br[2] - ti * bi[2]; a3 += tr * br[3] - ti * bi[3]; }
            if (x == 0) { const float d = dssm[g * GC + c]; if (c4 == (c & 12)) { const int e = c & 3; if (e == 0) a0 += d; else if (e == 1) a1 += d; else if (e == 2) a2 += d; else a3 += d; } }
            *(unsigned long long*)(WSP(bf16, WS_KT) + ((size_t)(g * 16 + x) * 16 + c) * 16 + c4) = (unsigned long long)cvtpk(a0, a1) | ((unsigned long long)cvtpk(a2, a3) << 32);
        } }
}
__device__ __forceinline__ void passE(Frame& F) {
    const bf16* UB = WSP(bf16, WS_UB); const bf16* M3 = WSP(bf16, WS_M3); float* E = WSP(float, WS_E); const float* PW = WSP(float, WS_PW); const int r = F.lane & 31, kh = F.lane >> 5;
    for (int it = F.gw; it < NG * 16; it += F.NGW) { const int g = it >> 4, nt = it & 15;
        f32x16 acc[4];
#pragma unroll
        for (int m = 0; m < 4; ++m) acc[m] = (f32x16){0.f, 0.f, 0.f, 0.f, 0.f, 0.f, 0.f, 0.f, 0.f, 0.f, 0.f, 0.f, 0.f, 0.f, 0.f, 0.f};
        const bf16* bp = UB + (size_t)(g * 512 + 32 * nt + r) * 256 + 8 * kh; const bf16* ap = M3 + (size_t)(g * 128 + r) * 256 + 8 * kh;
#pragma unroll 4
        for (int s = 0; s < 16; ++s) { const bf16x8 bfr = *(const bf16x8*)(bp + 16 * s);
#pragma unroll
            for (int m = 0; m < 4; ++m) { const bf16x8 afr = *(const bf16x8*)(ap + (size_t)m * 32 * 256 + 16 * s); acc[m] = __builtin_amdgcn_mfma_f32_32x32x16_bf16(afr, bfr, acc[m], 0, 0, 0); } }
        float* ep = E + (size_t)(g * 512 + 32 * nt + r) * 128 + 4 * kh;
#pragma unroll
        for (int m = 0; m < 4; ++m)
#pragma unroll
            for (int qq = 0; qq < 4; ++qq) *(f32x4*)(ep + 32 * m + 8 * qq) = (f32x4){acc[m][4 * qq], acc[m][4 * qq + 1], acc[m][4 * qq + 2], acc[m][4 * qq + 3]};
        asm volatile("s_waitcnt vmcnt(0)" ::: "memory"); __builtin_amdgcn_fence(__ATOMIC_SEQ_CST, "workgroup");
        { const float tr = PW[((size_t)(g * 17 + 16) * NST + F.lane) * 2], ti = PW[((size_t)(g * 17 + 16) * NST + F.lane) * 2 + 1]; float hre = 0.f, him = 0.f;
          const unsigned* eq = (const unsigned*)(E + (size_t)(g * 512 + 32 * nt) * 128 + F.lane); float er[32], ei[32];
#pragma unroll
          for (int ch = 0; ch < 32; ++ch) { er[ch] = __uint_as_float(__hip_atomic_load(eq + (size_t)ch * 128, __ATOMIC_RELAXED, __HIP_MEMORY_SCOPE_AGENT)); ei[ch] = __uint_as_float(__hip_atomic_load(eq + (size_t)ch * 128 + 64, __ATOMIC_RELAXED, __HIP_MEMORY_SCOPE_AGENT)); }
#pragma unroll
          for (int ch = 0; ch < 32; ++ch) { const float nr = fmaf(tr, hre, fmaf(-ti, him, er[ch])), ni = fmaf(tr, him, fmaf(ti, hre, ei[ch])); hre = nr; him = ni; }
          float* ag = WSP(float, WS_AG) + (size_t)(g * 16 + nt) * 128; ag[F.lane] = hre; ag[64 + F.lane] = him; } }
}
constexpr int SL_STRIDE = 136;
__device__ __forceinline__ void passY(Frame& F, int it0, int itstep) {
    const bf16* UB = WSP(bf16, WS_UB); const bf16* M2 = WSP(bf16, WS_M2); const bf16* KT = WSP(bf16, WS_KT); const float* E = WSP(float, WS_E); const float* PW = WSP(float, WS_PW); const float* AG = WSP(float, WS_AG);
    bf16* Sl = (bf16*)F.lds + (size_t)F.wave * 32 * SL_STRIDE; const int r = F.lane & 31, kh = F.lane >> 5, tl = r >> 4, cc = r & 15;
    for (int it = it0; it < NG * 32; it += itstep) { const int g = it >> 5, b = (it >> 4) & 1, j = (it >> 1) & 7, mh = it & 1;
        { const float tr = PW[((size_t)(g * 17 + 16) * NST + F.lane) * 2], ti = PW[((size_t)(g * 17 + 16) * NST + F.lane) * 2 + 1];
          float t2r = tr, t2i = ti;
#pragma unroll
          for (int k = 0; k < 5; ++k) { const float nr = t2r * t2r - t2i * t2i, ni = 2.f * t2r * t2i; t2r = nr; t2i = ni; }
          float hre = 0.f, him = 0.f; const float* ag = AG + (size_t)(g * 16 + b * 8) * 128 + F.lane;
          float ar[7], ai[7];
#pragma unroll
          for (int i = 0; i < 7; ++i) { const int ii = i < j ? i : 0; ar[i] = ag[(size_t)ii * 128]; ai[i] = ag[(size_t)ii * 128 + 64]; }
          const float* ep = E + (size_t)(g * 512 + b * CPB + 32 * j) * 128 + F.lane; float er[32], ei[32];
#pragma unroll
          for (int ch = 0; ch < 32; ++ch) { er[ch] = ep[(size_t)ch * 128]; ei[ch] = ep[(size_t)ch * 128 + 64]; }
#pragma unroll
          for (int i = 0; i < 7; ++i) if (i < j) { const float nr = fmaf(t2r, hre, fmaf(-t2i, him, ar[i])), ni = fmaf(t2r, him, fmaf(t2i, hre, ai[i])); hre = nr; him = ni; }
#pragma unroll
          for (int ch = 0; ch < 32; ++ch) { Sl[ch * SL_STRIDE + F.lane] = (bf16)(cvtpk(hre, 0.f) & 0xffffu); Sl[ch * SL_STRIDE + 64 + F.lane] = (bf16)(cvtpk(him, 0.f) & 0xffffu);
              const float nr = fmaf(tr, hre, fmaf(-ti, him, er[ch])), ni = fmaf(tr, him, fmaf(ti, hre, ei[ch])); hre = nr; him = ni; }
          if (j == 7 && mh == 0) { F.out[O_HRP + (size_t)(b * NG + g) * NST + F.lane] = hre; F.out[O_HIP + (size_t)(b * NG + g) * NST + F.lane] = him; } }
        LDS_WAIT(); asm volatile("" ::: "memory");
        f32x16 acc[4];
#pragma unroll
        for (int m = 0; m < 4; ++m) acc[m] = (f32x16){0.f, 0.f, 0.f, 0.f, 0.f, 0.f, 0.f, 0.f, 0.f, 0.f, 0.f, 0.f, 0.f, 0.f, 0.f, 0.f};
        const bf16* bp = UB + (size_t)(g * 512 + b * CPB + 32 * j + r) * 256 + 8 * kh; const bf16* kp = KT + (size_t)g * 4096 + cc * 16 + 8 * kh;
        const int t0 = 8 * mh;
#pragma unroll
        for (int s = 0; s < 16; ++s) { if (s > t0 + 7) break;
            const bf16x8 bfr = *(const bf16x8*)(bp + 16 * s);
#pragma unroll
            for (int mm = 0; mm < 4; ++mm) { const int tau = t0 + 2 * mm + tl - s; if (t0 + 2 * mm + 1 < s) continue;
                bf16x8 afr = (bf16x8){0, 0, 0, 0, 0, 0, 0, 0}; if (tau >= 0) afr = *(const bf16x8*)(kp + tau * 256);
                acc[mm] = __builtin_amdgcn_mfma_f32_32x32x16_bf16(afr, bfr, acc[mm], 0, 0, 0); } }
        const bf16* mp = M2 + (size_t)(g * 256 + 32 * (4 * mh) + r) * 128 + 8 * kh;
#pragma unroll 4
        for (int ks = 0; ks < 8; ++ks) { const bf16x8 bfr = *(const bf16x8*)(Sl + r * SL_STRIDE + 16 * ks + 8 * kh);
#pragma unroll
            for (int mm = 0; mm < 4; ++mm) { const bf16x8 afr = *(const bf16x8*)(mp + (size_t)mm * 32 * 128 + 16 * ks); acc[mm] = __builtin_amdgcn_mfma_f32_32x32x16_bf16(afr, bfr, acc[mm], 0, 0, 0); } }
        bf16* yp = WSP(bf16, WS_YP) + ((size_t)b * SEQ + (size_t)(32 * j + r) * CT + t0) * 1024 + g * GC + 4 * kh;
#pragma unroll
        for (int mm = 0; mm < 4; ++mm)
#pragma unroll
            for (int qq = 0; qq < 4; ++qq) { const float y0 = gelu_erf(acc[mm][4 * qq]), y1 = gelu_erf(acc[mm][4 * qq + 1]), y2 = gelu_erf(acc[mm][4 * qq + 2]), y3 = gelu_erf(acc[mm][4 * qq + 3]);
                *(unsigned long long*)(yp + (size_t)(2 * mm + (qq >> 1)) * 1024 + 8 * (qq & 1)) = (unsigned long long)cvtpk(y0, y1) | ((unsigned long long)cvtpk(y2, y3) << 32); }
        LDS_WAIT(); asm volatile("" ::: "memory"); }
}
__device__ __forceinline__ void passB(Frame& F, int it0, int itstep) {
    float* wl = (float*)F.lds + F.wave * WLDS_F; const float* Z = WSP(float, WS_Z); const float* AB = WSP(float, WS_AB); float* Cs = wl + US_F + HS_F;
    const float* const c_re = INP(float, I_CRE); const float* const c_im = INP(float, I_CIM); const float* const sre = INP(float, I_SRE); const float* const sim = INP(float, I_SIM); const float* const dssm = INP(float, I_DSSM);
    for (int it = it0; it < DBT * NG; it += itstep) { const int g = it & 63, bs = it >> 6, gp = g * NST + F.lane;
#pragma unroll 4
        for (int c = 0; c < GC; ++c) { typedef float f32x2 __attribute__((ext_vector_type(2))); *(f32x2*)(Cs + F.lane * 32 + c * 2) = (f32x2){c_re[(size_t)(g * GC + c) * NST + F.lane], c_im[(size_t)(g * GC + c) * NST + F.lane]}; }
        float hre = sre[(size_t)bs * NG * NST + gp], him = sim[(size_t)bs * NG * NST + gp]; const int row0 = MPR + bs * DSQ;
        unit<1>(Z + (size_t)row0 * 4096 + g * GC, DSQ, hre, him, WSP(float, WS_BBR) + (size_t)gp * GC, WSP(float, WS_BBI) + (size_t)gp * GC, AB[2 * gp], AB[2 * gp + 1], wl, F.lane, WSP(bf16, WS_YP) + (size_t)row0 * 1024 + g * GC, dssm + g * GC);
        F.out[O_HRS + (size_t)bs * NG * NST + gp] = hre; F.out[O_HIS + (size_t)bs * NG * NST + gp] = him; }
}
}
namespace sattn {
constexpr int D = 128, SPG = 16, WAVES = 4, GE = 4, NSPLIT = 32, NSUB = PAST / SPG, PPS = NSUB / NSPLIT, PPW = PPS / WAVES, TOK_STRIDE = NH * HD;
constexpr int LDS_P = 0, LDS_MRG = WAVES * 64, MRG_REC = 4 + D, HALF_FLOATS = 2560;
constexpr float SCALE = 0.088388347648318440f;
using bf16x2 = __attribute__((ext_vector_type(2))) __bf16;
using u32x4  = __attribute__((ext_vector_type(4))) unsigned;
using f32x4  = __attribute__((ext_vector_type(4))) float;
using f32x8  = __attribute__((ext_vector_type(8))) float;
__device__ __forceinline__ float dot2(unsigned k, unsigned q, float acc) { return __builtin_amdgcn_fdot2_f32_bf16(__builtin_bit_cast(bf16x2, k), __builtin_bit_cast(bf16x2, q), acc, false); }
template <int CTRL> __device__ __forceinline__ float dpp(float x) { return __builtin_bit_cast(float, __builtin_amdgcn_mov_dpp(__builtin_bit_cast(int, x), CTRL, 0xf, 0xf, true)); }
constexpr int XOR1 = 0xB1, XOR2 = 0x4E, XOR7 = 0x141, XOR8 = 0x128, ROR4 = 0x124;
__device__ __forceinline__ float xrow16_max(float x) {
  auto s = __builtin_amdgcn_permlane16_swap(__float_as_uint(x), __float_as_uint(x), false, false); x = fmaxf(__uint_as_float(s[0]), __uint_as_float(s[1]));
  auto t = __builtin_amdgcn_permlane32_swap(__float_as_uint(x), __float_as_uint(x), false, false); return fmaxf(__uint_as_float(t[0]), __uint_as_float(t[1])); }
__device__ __forceinline__ float xrow16_sum(float x) {
  auto s = __builtin_amdgcn_permlane16_swap(__float_as_uint(x), __float_as_uint(x), false, false); x = __uint_as_float(s[0]) + __uint_as_float(s[1]);
  auto t = __builtin_amdgcn_permlane32_swap(__float_as_uint(x), __float_as_uint(x), false, false); return __uint_as_float(t[0]) + __uint_as_float(t[1]); }
__device__ __forceinline__ u32x4 tobf(f32x8 x) { u32x4 w = {cvtpk(x[0], x[1]), cvtpk(x[2], x[3]), cvtpk(x[4], x[5]), cvtpk(x[6], x[7])}; return w; }

__device__ __forceinline__ void split_unit(int unit, float* lds, int wave, int lane, const float* QS, const float* ck, const float* cv, const int* pt, const float* RP, float* PML, float* PO, int prb = 0) {
  const bool pad = (unsigned)unit >> 31; const int bh = pad ? 0 : (unit >> 5), s = pad ? 0 : (unit & 31), kvh = bh & 7, b = bh >> 3, r = lane >> 4, c = lane & 15;
  constexpr float C2 = SCALE * 1.4426950408889634f;
  const int p0 = s * PPS;
  const int npg = (pad || (prb & 4096)) ? 0 : PPW;
  int btv = 0;
  if (lane < PPW) { const int pg = p0 + wave + 4 * lane; btv = pt[b * NPAGES + (pg >> 3)] * PAGE + (pg & 7) * SPG; }
  u32x4 qpk[GE];
#pragma unroll
  for (int g = 0; g < GE; ++g) qpk[g] = tobf(*reinterpret_cast<const f32x8*>(QS + ((size_t)((b * NH + kvh) * DSQ + g)) * D + 8 * c));
  const size_t loff = (size_t)r * TOK_STRIDE + (size_t)kvh * D + 8 * c;
  const float* rpb = RP + (size_t)(b * NH + kvh) * PAST + r + 4 * (c >> 2);
#define SA_ISSUE(i_) do { const int tb_ = __builtin_amdgcn_readlane(btv, (i_)); const float* kb_ = ck + (size_t)tb_ * TOK_STRIDE + loff; const float* vb_ = cv + (size_t)tb_ * TOK_STRIDE + loff; \
    _Pragma("unroll") for (int t_ = 0; t_ < 4; ++t_) { Kn[t_] = __builtin_nontemporal_load(reinterpret_cast<const f32x8*>(kb_ + (size_t)t_ * 4 * TOK_STRIDE)); Vn[t_] = __builtin_nontemporal_load(reinterpret_cast<const f32x8*>(vb_ + (size_t)t_ * 4 * TOK_STRIDE)); } \
    Bn = rpb[(p0 + wave + 4 * (i_)) * SPG]; } while (0)
  f32x8 Kn[4], Vn[4]; float Bn;
  float m = -INFINITY, l = 0.f, acc[GE * 8];
#pragma unroll
  for (int k = 0; k < GE * 8; ++k) acc[k] = 0.f;
  if (npg > 0) SA_ISSUE(0);
  for (int i = 0; i < npg; ++i) {
    u32x4 Kc[4], Vc[4];
#pragma unroll
    for (int t = 0; t < 4; ++t) { Kc[t] = tobf(Kn[t]); Vc[t] = tobf(Vn[t]); }
    const float Bc = Bn;
    if (i + 1 < npg) SA_ISSUE(i + 1);
    float x[4 * GE];
#pragma unroll
    for (int t = 0; t < 4; ++t)
#pragma unroll
      for (int g = 0; g < GE; ++g) { float d = 0.f;
#pragma unroll
        for (int k = 0; k < 4; ++k) d = dot2(Kc[t][k], qpk[g][k], d);
        x[t * GE + g] = d; }
#define SA_TR(HALF, CTRL, BIT) _Pragma("unroll") for (int h = 0; h < (HALF); ++h) { \
      const float lo_ = x[h], hi_ = x[h + (HALF)]; const float t1_ = lo_ + dpp<CTRL>(lo_), t2_ = hi_ + dpp<CTRL>(hi_); x[h] = (c & (BIT)) ? t2_ : t1_; }
    SA_TR(8, XOR8, 8) SA_TR(4, XOR7, 4) SA_TR(2, XOR2, 2) SA_TR(1, XOR1, 1)
#undef SA_TR
    const float sc = fmaf(x[0], C2, Bc);
    float pm = sc; pm = fmaxf(pm, dpp<ROR4>(pm)); pm = fmaxf(pm, dpp<XOR8>(pm)); pm = xrow16_max(pm);
    const float mn = fmaxf(m, pm), msub = (mn == -INFINITY) ? 0.f : mn;
    const float alpha = __builtin_amdgcn_exp2f(m - msub), p = __builtin_amdgcn_exp2f(sc - msub);
    l = fmaf(l, alpha, p); m = mn;
#pragma unroll
    for (int q4 = 0; q4 < 4; ++q4) { const float al = q4 == 0 ? dpp<0x00>(alpha) : q4 == 1 ? dpp<0x55>(alpha) : q4 == 2 ? dpp<0xAA>(alpha) : dpp<0xFF>(alpha);
#pragma unroll
      for (int k = 0; k < 8; ++k) acc[q4 * 8 + k] *= al; }
    float* prow = lds + LDS_P + (wave * 4 + r) * 16;
    prow[c] = p;
    asm volatile("s_waitcnt lgkmcnt(0)" ::: "memory");
    f32x4 pr[GE];
#pragma unroll
    for (int u = 0; u < GE; ++u) pr[u] = *reinterpret_cast<const f32x4*>(prow + 4 * u);
#pragma unroll
    for (int t = 0; t < 4; ++t) { float vf[8];
#pragma unroll
      for (int k = 0; k < 4; ++k) { vf[2 * k] = __builtin_bit_cast(float, Vc[t][k] << 16); vf[2 * k + 1] = __builtin_bit_cast(float, Vc[t][k] & 0xffff0000u); }
#pragma unroll
      for (int g = 0; g < GE; ++g) { const float pg_ = pr[t][g];
#pragma unroll
        for (int k = 0; k < 8; ++k) acc[g * 8 + k] = fmaf(pg_, vf[k], acc[g * 8 + k]); } }
  }
#undef SA_ISSUE
#pragma unroll
  for (int k = 0; k < GE * 8; ++k) acc[k] = xrow16_sum(acc[k]);
  { float t = l; t += dpp<ROR4>(t); t += dpp<XOR8>(t); l = xrow16_sum(t); }
  float* mrg = lds + LDS_MRG;
  if (r == 0) {
#pragma unroll
    for (int g = 0; g < GE; ++g) { float* rec = mrg + (wave * GE + g) * MRG_REC;
#pragma unroll
      for (int k = 0; k < 8; k += 4) *reinterpret_cast<f32x4*>(rec + 4 + 8 * c + k) = f32x4{acc[g * 8 + k], acc[g * 8 + k + 1], acc[g * 8 + k + 2], acc[g * 8 + k + 3]};
      if (c == g) { rec[0] = m; rec[1] = l; } } }
  __syncthreads();
  { const int g = wave, d0 = 2 * lane; const size_t row = (size_t)(b * NH + kvh) * DSQ + g;
    float M = -INFINITY;
#pragma unroll
    for (int w = 0; w < WAVES; ++w) M = fmaxf(M, mrg[(w * GE + g) * MRG_REC]);
    float L = 0.f, o0 = 0.f, o1 = 0.f;
#pragma unroll
    for (int w = 0; w < WAVES; ++w) { const float* rec = mrg + (w * GE + g) * MRG_REC; const float lw = rec[1]; const float wt = (lw > 0.f) ? __builtin_amdgcn_exp2f(rec[0] - M) : 0.f;
      L = fmaf(wt, lw, L); o0 = fmaf(wt, rec[4 + d0], o0); o1 = fmaf(wt, rec[4 + d0 + 1], o1); }
    const size_t slot = row * NSPLIT + s;
    if (!pad && !(prb & 4096)) { *reinterpret_cast<float2*>(PO + slot * D + d0) = make_float2(o0, o1);
    if (lane == 0) *reinterpret_cast<float2*>(PML + 2 * slot) = make_float2(M, L); } }
  __syncthreads();
}
}

__device__ __forceinline__ void sample_combine(Frame& F) {
    const float* PML = WSP(float, WS_PML); const float* PO = WSP(float, WS_PO); const float* QS = WSP(float, WS_QS);
    constexpr float C2 = 0.088388347648318440f * 1.4426950408889634f;
    for (int row = (F.G == 256 ? F.gw - 96 * NWAVES : F.gw); row >= 0 && row < DBT * NH * DSQ; row += F.NGW) { const int t = row & 3, h = (row >> 2) & 7, b = row >> 5, d0 = 2 * F.lane; const unsigned live = WSP(unsigned, WS_LIST)[64 + (row >> 2)];
        const float2 q = *(const float2*)(QS + (size_t)row * HD + d0);
        float sn[DSQ]; float run = 0.f;
#pragma unroll
        for (int j = 0; j < DSQ; ++j) { const float2 k = *(const float2*)(F.out + O_KS + ((size_t)(b * DSQ + j) * NH + h) * HD + d0); const float d = wave_sum(q.x * k.x + q.y * k.y);
            run += F.out[O_LFS + (size_t)(b * DSQ + j) * NH + h]; sn[j] = (j <= t) ? fmaf(d, C2, -run * LOG2E) : -INFINITY; }
        float M = -INFINITY;
#pragma unroll 8
        for (int s = 0; s < sattn::NSPLIT; ++s) if ((live >> s) & 1u) M = fmaxf(M, PML[2 * ((size_t)row * sattn::NSPLIT + s)]);
#pragma unroll
        for (int j = 0; j < DSQ; ++j) M = fmaxf(M, sn[j]);
        float L = 0.f, o0 = 0.f, o1 = 0.f;
#pragma unroll 8
        for (int s = 0; s < sattn::NSPLIT; ++s) { if (!((live >> s) & 1u)) continue; const size_t slot = (size_t)row * sattn::NSPLIT + s; const float ls = PML[2 * slot + 1], w = (ls > 0.f) ? __builtin_amdgcn_exp2f(PML[2 * slot] - M) : 0.f;
            const float2 a = *(const float2*)(PO + slot * HD + d0); L = fmaf(w, ls, L); o0 = fmaf(w, a.x, o0); o1 = fmaf(w, a.y, o1); }
#pragma unroll
        for (int j = 0; j < DSQ; ++j) { const float p = __builtin_amdgcn_exp2f(sn[j] - M); const float2 v = *(const float2*)(F.out + O_VS + ((size_t)(b * DSQ + j) * NH + h) * HD + d0);
            L += p; o0 = fmaf(p, v.x, o0); o1 = fmaf(p, v.y, o1); }
        const float inv = 1.0f / L;
        *(unsigned*)(WSP(bf16, WS_YY) + (size_t)(MPR + b * DSQ + t) * 2048 + 1024 + h * HD + d0) = cvtpk(o0 * inv, o1 * inv); }
}
namespace sk {
typedef float f32x16 __attribute__((ext_vector_type(16)));
__device__ __forceinline__ void st_bf16(bf16* p, float x) { *p = (bf16)(cvtpk(x, 0.f) & 0xffffu); }
__device__ __forceinline__ float ld_bf16(const bf16* p) { return __uint_as_float((unsigned)(*p) << 16); }
__device__ __forceinline__ float sigm(float x) { return 1.0f / (1.0f + __expf(-x)); }
template <int NBLK, class Epi>
__device__ __forceinline__ void run(Frame& F, const bf16* A, int lda, const bf16* Bt, int ldb, int K, int nunits, const Epi& E, int ustart = -1, int ustride = 0) {
    float* P = (float*)F.lds;
    const int r = F.lane & 31, kh = F.lane >> 5, kw = K >> 3, nb4 = kw >> 6;
    if (ustart < 0) { ustart = F.G - 1 - (int)blockIdx.x; ustride = F.G; }
    for (int u = ustart; u < nunits; u += ustride) {
        f32x16 acc[NBLK];
#pragma unroll
        for (int b = 0; b < NBLK; ++b) acc[b] = (f32x16){0.f, 0.f, 0.f, 0.f, 0.f, 0.f, 0.f, 0.f, 0.f, 0.f, 0.f, 0.f, 0.f, 0.f, 0.f, 0.f};
        const bf16* ap[NBLK]; const bf16* bp[NBLK];
#pragma unroll
        for (int b = 0; b < NBLK; ++b) { ap[b] = A + (size_t)r * lda + E.koff(b) + F.wave * kw + 8 * kh; bp[b] = Bt + (size_t)(E.brow(u, b) + r) * ldb + E.koff(b) + F.wave * kw + 8 * kh; }
#define SK_LOAD(AF, BF, s_) do { _Pragma("unroll") for (int i = 0; i < 4; ++i) { _Pragma("unroll") for (int b = 0; b < NBLK; ++b) { \
            AF[b][i] = (b == 0 || Epi::SPLIT_A) ? *(const bf16x8*)(ap[b] + 64 * (s_) + 16 * i) : AF[0][i]; BF[b][i] = *(const bf16x8*)(bp[b] + 64 * (s_) + 16 * i); } } } while (0)
        bf16x8 af[NBLK][4], bf[NBLK][4], an[NBLK][4], bn[NBLK][4];
        SK_LOAD(af, bf, 0);
#pragma unroll 1
        for (int s = 0; s < nb4; ++s) {
            if (s + 1 < nb4) SK_LOAD(an, bn, s + 1);
#pragma unroll
            for (int i = 0; i < 4; ++i)
#pragma unroll
                for (int b = 0; b < NBLK; ++b) acc[b] = __builtin_amdgcn_mfma_f32_32x32x16_bf16(af[b][i], bf[b][i], acc[b], 0, 0, 0);
#pragma unroll
            for (int i = 0; i < 4; ++i)
#pragma unroll
                for (int b = 0; b < NBLK; ++b) { af[b][i] = an[b][i]; bf[b][i] = bn[b][i]; } }
#undef SK_LOAD
#pragma unroll
        for (int b = 0; b < NBLK; ++b)
#pragma unroll
            for (int q = 0; q < 16; ++q) P[((F.wave * NBLK + b) * 32 + ((q & 3) + 8 * (q >> 2) + 4 * kh)) * 32 + r] = acc[b][q];
        __syncthreads();
#pragma unroll
        for (int e2 = 0; e2 < 2; ++e2) { const int e = F.tid + 512 * e2, row = e >> 5, col = e & 31; float v[NBLK];
#pragma unroll
            for (int b = 0; b < NBLK; ++b) { float t = 0.f;
#pragma unroll
                for (int w = 0; w < 8; ++w) t += P[((w * NBLK + b) * 32 + row) * 32 + col];
                v[b] = t; }
            E.apply(u, row, col, v); }
        __syncthreads();
    }
}
struct In { float* Z; bf16* G; const float* R1;
    static constexpr bool SPLIT_A = false; __device__ __forceinline__ int koff(int) const { return 0; }
    __device__ __forceinline__ int brow(int u, int) const { return 32 * u; }
    __device__ __forceinline__ void apply(int u, int row, int col, const float* v) const { const int c = 32 * u + col; const size_t gr = MPR + row; const float z = v[0] * R1[gr];
        if (c < 4096) Z[gr * 4096 + c] = z; else st_bf16(G + gr * 4096 + (c - 4096), sigm(z)); } };
struct Glu { const bf16* YP; bf16* YY; const float* bias;
    static constexpr bool SPLIT_A = false; __device__ __forceinline__ int koff(int) const { return 0; }
    __device__ __forceinline__ int brow(int u, int) const { return 32 * u; }
    __device__ __forceinline__ void apply(int u, int row, int col, const float* v) const { const int c = 32 * u + col; const size_t gr = MPR + row; st_bf16(YY + gr * 2048 + c, ld_bf16(YP + gr * 1024 + c) * sigm(v[0] + bias[c])); } };
struct Merge { const bf16* G; bf16* MG;
    static constexpr bool SPLIT_A = true; __device__ __forceinline__ int koff(int b) const { return 1024 * b; }
    __device__ __forceinline__ int brow(int u, int) const { return 32 * u; }
    __device__ __forceinline__ void apply(int u, int row, int col, const float* v) const { const int c = 32 * u + col; const size_t gr = MPR + row;
        st_bf16(MG + gr * 2048 + c, ld_bf16(G + gr * 4096 + c) * v[0] + ld_bf16(G + gr * 4096 + 2048 + c) * v[1]); } };
struct Out { const float* xs; bf16* XB; float* SSR;
    static constexpr bool SPLIT_A = false; __device__ __forceinline__ int koff(int) const { return 0; }
    __device__ __forceinline__ int brow(int u, int) const { return 32 * u; }
    __device__ __forceinline__ void apply(int u, int row, int col, const float* v) const { const int c = 32 * u + col; const size_t gr = MPR + row; const float x1 = xs[(size_t)row * 2048 + c] + v[0];
        st_bf16(XB + gr * 2048 + c, x1); float s = x1 * x1;
        s += __shfl_xor(s, 1); s += __shfl_xor(s, 2); s += __shfl_xor(s, 4); s += __shfl_xor(s, 8); s += __shfl_xor(s, 16);
        if (col == 0) __hip_atomic_fetch_add(SSR + MPR + row, s, __ATOMIC_RELAXED, __HIP_MEMORY_SCOPE_AGENT); } };
struct FF1 { const float* SSR; bf16* H;
    static constexpr bool SPLIT_A = false; __device__ __forceinline__ int koff(int) const { return 0; }
    __device__ __forceinline__ int brow(int u, int b) const { const int h0 = 32 * u; return 256 * (h0 >> 7) + (h0 & 127) + 128 * b; }
    __device__ __forceinline__ void apply(int u, int row, int col, const float* v) const {
        const float r2 = 1.0f / sqrtf(SSR[MPR + row] * (1.0f / 2048.0f) + RMS_EPS), g = v[0] * r2, up = v[1] * r2;
        st_bf16(H + (size_t)(MPR + row) * DFF + 32 * u + col, g * sigm(g) * up); } };
struct FF2 { const bf16* XB; float* ys;
    static constexpr bool SPLIT_A = false; __device__ __forceinline__ int koff(int) const { return 0; }
    __device__ __forceinline__ int brow(int u, int) const { return 32 * u; }
    __device__ __forceinline__ void apply(int u, int row, int col, const float* v) const { const int c = 32 * u + col; ys[(size_t)row * 2048 + c] = ld_bf16(XB + (size_t)(MPR + row) * 2048 + c) + v[0]; } };
}
__device__ __forceinline__ pattn::BlockRef<__hip_bfloat16, __hip_bfloat16> attn_ref(unsigned char* ws, int u) {
    constexpr int NQB = SEQ / pattn::QB;
    const int qb = NQB - 1 - (u >> 4), bh = u & 15; const size_t hb = (size_t)bh * SEQ * HD;
    pattn::BlockRef<__hip_bfloat16, __hip_bfloat16> r;
    r.Q = (const __hip_bfloat16*)(ws + WS_QB) + hb + (size_t)qb * pattn::QB * HD; r.K = (const __hip_bfloat16*)(ws + WS_KB) + hb; r.V = (const __hip_bfloat16*)(ws + WS_VB) + hb;
    r.CK = (const unsigned short*)(ws + WS_NCK) + (size_t)bh * SEQ * 16; r.P0 = qb * pattn::QB; r.XF = (const float*)(ws + WS_XF) + (size_t)bh * SEQ;
    r.jlo = __builtin_amdgcn_readfirstlane(((const int*)(ws + WS_JLO))[bh * 16 + qb]); r.negb2 = -__uint_as_float(__builtin_amdgcn_readfirstlane(__float_as_uint(((const float*)(ws + WS_SS2))[0])));
    r.O = (__hip_bfloat16*)(ws + WS_YY) + ((size_t)(bh >> 3) * SEQ + (size_t)qb * pattn::QB) * 2048 + 1024 + (bh & 7) * HD;
    return r;
}
__device__ __forceinline__ void refresh_lane(Frame& F) {
    int l; asm volatile("v_mbcnt_lo_u32_b32 %0, -1, 0\n\tv_mbcnt_hi_u32_b32 %0, -1, %0" : "=v"(l)); F.lane = l; F.tid = F.wave * 64 + l;
    unsigned long long w_ = (unsigned long long)F.ws, o_ = (unsigned long long)F.out; asm volatile("" : "+s"(w_), "+s"(o_));
    F.ws = (unsigned char*)(__attribute__((address_space(1))) unsigned char*)w_; F.out = (float*)(__attribute__((address_space(1))) float*)o_;
}

__device__ __forceinline__ int pull(Frame& F, int qword) {
    volatile LAS unsigned* w = (volatile LAS unsigned*)(F.lds + MISC_OFF + 64);
    if (F.tid == 0) *w = __hip_atomic_fetch_add((unsigned*)(F.ws + WS_CTL) + CW_Q + qword, 1u, __ATOMIC_RELAXED, __HIP_MEMORY_SCOPE_AGENT);
    __syncthreads(); const unsigned v = *w; __syncthreads(); return __builtin_amdgcn_readfirstlane((int)v);
}
__device__ __forceinline__ int pull8(Frame& F, int qword0, int nunits) {
    volatile LAS unsigned* w = (volatile LAS unsigned*)(F.lds + MISC_OFF + 64);
    if (F.tid == 0) { unsigned* heads = (unsigned*)(F.ws + WS_CTL) + CW_Q + qword0; const unsigned per = (unsigned)nunits >> 3; unsigned r = (unsigned)nunits;
        for (unsigned t = 0; t < 8u; ++t) { const unsigned q = (blockIdx.x + t) & 7u;
            if (__hip_atomic_load(heads + 64 * q, __ATOMIC_RELAXED, __HIP_MEMORY_SCOPE_AGENT) >= per) continue;
            const unsigned i = __hip_atomic_fetch_add(heads + 64 * q, 1u, __ATOMIC_RELAXED, __HIP_MEMORY_SCOPE_AGENT);
            if (i < per) { r = i * 8u + q; break; } }
        *w = r; }
    __syncthreads(); const unsigned v = *w; __syncthreads(); return __builtin_amdgcn_readfirstlane((int)v);
}
__device__ __forceinline__ int pull_attn(Frame& F) {
    const int x = (int)blockIdx.x & 7; const int l = pull(F, 768 + 64 * x);
    if (l >= 32) return NB * NH * (SEQ / pattn::QB);
    return ((l >> 1) << 4) | ((l & 1) ? 15 - x : x);
}
__device__ __forceinline__ void attn_prompt_phase(Frame& F) {
    using BR = pattn::BlockRef<__hip_bfloat16, __hip_bfloat16>;
    constexpr int NU = NB * NH * (SEQ / pattn::QB);
    char* lds = (char*)F.lds;
    int u = pull_attn(F); if (u >= NU) return;
    BR cur = attn_ref(F.ws, u);
    pattn::Seam<__hip_bfloat16> S;
    pattn::causal_swa_prime<__hip_bfloat16, __hip_bfloat16>(cur, SEQ, lds, S, F.wave, F.lane);
    for (;;) { const int un = pull_attn(F); const bool last = un >= NU;
        const BR nxt = last ? cur : attn_ref(F.ws, un);
        pattn::causal_swa_block<__hip_bfloat16, __hip_bfloat16>(cur, nxt, SEQ, SEQ, lds, S, F.wave, F.lane);
        if (last) break;
        cur = nxt; }
}

constexpr int N_PHASES = 9;
__global__ void __launch_bounds__(NWAVES * 64, 2) fwd(Args args) {
    extern __shared__ __attribute__((aligned(16))) unsigned char lds[];
    Frame F;
    F.lds = lds; F.wave = __builtin_amdgcn_readfirstlane(threadIdx.x >> 6); refresh_lane(F); F.G = gridDim.x;
    F.gw = blockIdx.x * NWAVES + F.wave; F.NGW = F.G * NWAVES;
    F.out = args.out; F.ws = args.ws;
    volatile LAS unsigned* MISC = (volatile LAS unsigned*)((LAS unsigned char*)lds + MISC_OFF);
    for (int u = F.tid; u < 128; u += NWAVES * 64) MISC[u] = 0u;
    __syncthreads();
    const int lo = args.ph_lo, hi = args.ph_hi;
    XcdBarrier bar; bar.bar = (unsigned*)(F.ws + WS_CTL) + CW_BAR; bar.x = 0; bar.st = nullptr;
    if (hi - lo > 1) bar = xcd_barrier_post((unsigned*)(F.ws + WS_CTL) + CW_BAR, MISC + 8, F.tid == 0);
#ifndef PH_MASK
#define PH_MASK 0x1ff
#endif
#define IN(k) (((PH_MASK >> (k)) & 1) && lo <= (k) && (k) < hi)
#define SEAM(k) do { if (IN(k) && IN((k) + 1)) { xcd_barrier(bar, F.tid == 0); refresh_lane(F); } } while (0)
#ifndef PH_DUP
#define PH_DUP 0
#endif
#ifndef SUB_DUP
#define SUB_DUP 0
#endif
#define SUBREP(k) _Pragma("unroll") for (int srep = 0; srep < 1 + ((SUB_DUP >> (k)) & 1); ++srep)
#define REP(k) _Pragma("unroll") for (int rep = 0; rep < 1 + ((PH_DUP >> (k)) & 1); ++rep)
#define REPBAR() do { if (rep) xcd_barrier(bar, F.tid == 0); } while (0)
    LAS unsigned char* ring = (LAS unsigned char*)lds;

    if (IN(0)) REP(0) { REPBAR(); phase0(F, args.probe); } SEAM(0);
    if (IN(1)) REP(1) { REPBAR();
        if (F.G == 256) { if ((int)blockIdx.x < 128) s5::gen_tables(F, F.gw, 128 * NWAVES); } else s5::gen_tables(F, F.gw, F.NGW);
        __syncthreads();
        pg8::Gemm g{(const pg8::bf16_t*)WSP(bf16, WS_XA), (const pg8::bf16_t*)WSP(bf16, WS_W1T), MPR, 8192, 2048, 2048, 2048}; pg8::StaticOrder S; S.init(MPR, 8192, F.G, (int)blockIdx.x);
        pg8::EpiIn E{(pg8::bf16_t*)WSP(bf16, WS_G), WSP(float, WS_R1), (pg8::bf16_t*)WSP(bf16, WS_UB), (pg8::bf16_t*)WSP(bf16, WS_QB), (pg8::bf16_t*)WSP(bf16, WS_KB), (pg8::bf16_t*)WSP(bf16, WS_VB),
                      F.out + O_KP, F.out + O_VP, INP(float, I_GQ), INP(float, I_GK), (LAS float*)(ring + 131072)};
        pg8::gemm_phase<pg8::EpiIn, pg8::StaticOrder, true, true>(ring, g, S, E, F.wave, F.lane);
        __syncthreads();
        if (F.G == 256) sk::run<1>(F, WSP(bf16, WS_XA) + (size_t)MPR * 2048, 2048, WSP(bf16, WS_W1T), 2048, 2048, 256, sk::In{WSP(float, WS_Z), WSP(bf16, WS_G), WSP(float, WS_R1)}, (int)blockIdx.x >= 128 ? 255 - (int)blockIdx.x : 256, 128);
        else sk::run<1>(F, WSP(bf16, WS_XA) + (size_t)MPR * 2048, 2048, WSP(bf16, WS_W1T), 2048, 2048, 256, sk::In{WSP(float, WS_Z), WSP(bf16, WS_G), WSP(float, WS_R1)}); } SEAM(1);
    #ifndef PH2_MASK
#define PH2_MASK 15
#endif
    if (IN(2)) REP(2) { REPBAR(); if (PH2_MASK & 1) SUBREP(0) rowpass(F); if (PH2_MASK & 2) SUBREP(1) s5::passE(F); if (PH2_MASK & 4) SUBREP(2) { __syncthreads(); if (F.G == 256) { if ((int)blockIdx.x >= 240) logf_cumsum(F, (int)blockIdx.x - 240); } else for (int it = (int)blockIdx.x; it < NB * NH; it += F.G) logf_cumsum(F, it); }     if ((PH2_MASK & 8) && rep == 0) rpast_fix(F);
        if (F.gw == (F.G == 256 ? 200 * NWAVES : 0)) { const float* const gqp = INP(float, I_GQ); const float* const gkp = INP(float, I_GK);
            float mq = fmaxf(fabsf(gqp[F.lane]), fabsf(gqp[F.lane + 64])), mk = fmaxf(fabsf(gkp[F.lane]), fabsf(gkp[F.lane + 64]));
#pragma unroll
            for (int o = 1; o < 64; o <<= 1) { mq = fmaxf(mq, __shfl_xor(mq, o)); mk = fmaxf(mk, __shfl_xor(mk, o)); }
            const float bq2 = 11.313708498984761f * 1.4426950408889634f * mq * mk;
            const float thr = -(3.f * bq2 + 40.f); const float* tp = WSP(float, WS_TPG) + F.lane * NPAGES; float suf = 0.f; unsigned flags = 0u;
            for (int pgi = NPAGES - 1; pgi >= 0; --pgi) { if ((pgi & 3) == 3 && !(suf * LOG2E < thr)) flags |= 1u << (pgi >> 2); suf += tp[pgi]; }
            unsigned* L = WSP(unsigned, WS_LIST); L[64 + F.lane] = flags; unsigned base = 0u;
            for (int s = 0; s < 32; ++s) { const bool lv = (flags >> s) & 1u; const unsigned long long mk2 = __ballot(lv);
                if (lv) L[256 + base + __builtin_popcountll(mk2 & ((1ull << F.lane) - 1ull))] = ((unsigned)F.lane << 5) | (unsigned)s;
                base += (unsigned)__builtin_popcountll(mk2); }
            if (F.lane == 0) { L[0] = base; if (base & 1u) L[256 + base] = 0x80000000u; } }
  __syncthreads(); if ((int)blockIdx.x >= 128 && F.G == 256) weight_copies(F, WI_FF10, WI_FF10 + WI_FF1, (int)blockIdx.x - 128, 128); else if (F.G != 256) weight_copies(F, WI_FF10, WI_FF10 + WI_FF1, (int)blockIdx.x, F.G); } SEAM(2);
    if (IN(3)) REP(3) { REPBAR(); refresh_lane(F);
        constexpr int NSTREAM = 128; const bool stream = (int)blockIdx.x < NSTREAM;
        const int prb = args.probe;
#define P3_STREAM_LOOP() do { const int half = F.wave >> 2; const unsigned* const L = WSP(unsigned, WS_LIST); const int nbu_ = (int)((__builtin_amdgcn_readfirstlane((int)L[0]) + 1) >> 1); const int nbu = (prb & 512) ? (nbu_ < 256 ? nbu_ : 256) : ((prb & 1024) ? (nbu_ < 128 ? nbu_ : 128) : ((prb & 2048) ? 16 : nbu_)); \
            volatile LAS unsigned* qw = (volatile LAS unsigned*)(F.lds + MISC_OFF + 64); unsigned* qh = (unsigned*)(F.ws + WS_CTL) + CW_Q; \
            int bu = pull(F, 0); \
            while (bu < nbu) { unsigned pend = 0u; if (F.tid == 0) pend = __hip_atomic_fetch_add(qh, 1u, __ATOMIC_RELAXED, __HIP_MEMORY_SCOPE_AGENT); \
                const float* const ckp = INP(float, I_CK); const float* const cvp = INP(float, I_CV); const int* const ptp = INP(int, I_PT); \
                sattn::split_unit(__builtin_amdgcn_readfirstlane((int)L[256 + 2 * bu + half]), (float*)F.lds + half * sattn::HALF_FLOATS, F.wave & 3, F.lane, WSP(float, WS_QS), ckp, cvp, ptp, WSP(float, WS_RP), WSP(float, WS_PML), WSP(float, WS_PO), prb); \
                if (F.tid == 0) *qw = pend; __syncthreads(); bu = __builtin_amdgcn_readfirstlane((int)*qw); __syncthreads(); } \
            __syncthreads(); refresh_lane(F); } while (0)
        if (stream && !(prb & 1)) P3_STREAM_LOOP();
        if (!(prb & 2)) attn_prompt_phase(F);
        __syncthreads(); refresh_lane(F);
        if (!(prb & 4)) { if (!(prb & 16384)) for (int bu = pull(F, 128); bu < 256; bu = pull(F, 128)) s5::passY(F, bu * 8 + F.wave, 1 << 30);
        if (!(prb & 8192)) for (int bu = pull(F, 192); bu < 64; bu = pull(F, 192)) s5::passB(F, bu * 8 + F.wave, 1 << 30); }
        __syncthreads(); refresh_lane(F);
        if (!stream && !(prb & 17)) P3_STREAM_LOOP();
#undef P3_STREAM_LOOP
    } SEAM(3);
    if (IN(4)) REP(4) { REPBAR();
        sample_combine(F);
        if ((int)blockIdx.x >= 128 && F.G == 256) { weight_copies(F, WI_BR0, WI_FF10, (int)blockIdx.x - 128, 128); weight_copies(F, WI_FF10 + WI_FF1, WI_FF10 + WI_FF1 + 256, (int)blockIdx.x - 128, 128); }
        else if (F.G != 256) { weight_copies(F, WI_BR0, WI_FF10, (int)blockIdx.x, F.G); weight_copies(F, WI_FF10 + WI_FF1, WI_FF20, (int)blockIdx.x, F.G); }
        __syncthreads(); refresh_lane(F);
        { pg8::Gemm g{(const pg8::bf16_t*)WSP(bf16, WS_YP), (const pg8::bf16_t*)WSP(bf16, WS_WGLU), MPR, 1024, 1024, 1024, 1024}; pg8::StaticOrder S; S.init(MPR, 1024, F.G, (int)blockIdx.x);
          pg8::EpiGlu E{(const pg8::bf16_t*)WSP(bf16, WS_YP), (pg8::bf16_t*)WSP(bf16, WS_YY), INP(float, I_BGLU)};
          pg8::gemm_phase<pg8::EpiGlu, pg8::StaticOrder, true, true>(ring, g, S, E, F.wave, F.lane); }
        __syncthreads(); refresh_lane(F);
        if ((int)blockIdx.x < 96 && F.G == 256) weight_copies(F, WI_FF10 + WI_FF1 + 256, WI_FF20, (int)blockIdx.x, 96);
        __syncthreads();
        sk::run<1>(F, WSP(bf16, WS_YP) + (size_t)MPR * 1024, 1024, WSP(bf16, WS_WGLU), 1024, 1024, 32, sk::Glu{WSP(bf16, WS_YP), WSP(bf16, WS_YY), INP(float, I_BGLU)}); } SEAM(4);
    if (IN(5)) REP(5) { REPBAR();
        pg8::Gemm g{(const pg8::bf16_t*)WSP(bf16, WS_YY), (const pg8::bf16_t*)WSP(bf16, WS_WBR), MPR, 2048, 2048, 2048, 2048}; pg8::StaticOrder S; S.init(MPR, 2048, F.G, (int)blockIdx.x);
        pg8::EpiMerge E{(const pg8::bf16_t*)WSP(bf16, WS_G), (pg8::bf16_t*)WSP(bf16, WS_MG)};
        pg8::gemm_phase<pg8::EpiMerge, pg8::StaticOrder, true, true>(ring, g, S, E, F.wave, F.lane);
        __syncthreads();
        sk::run<2>(F, WSP(bf16, WS_YY) + (size_t)MPR * 2048, 2048, WSP(bf16, WS_WBR), 2048, 1024, 64, sk::Merge{WSP(bf16, WS_G), WSP(bf16, WS_MG)}); } SEAM(5);
    if (IN(6)) REP(6) { REPBAR();
        pg8::Gemm g{(const pg8::bf16_t*)WSP(bf16, WS_MG), (const pg8::bf16_t*)WSP(bf16, WS_WOUT), MPR, 2048, 2048, 2048, 2048}; pg8::StaticOrder S; S.init(MPR, 2048, F.G, (int)blockIdx.x);
        pg8::EpiOut E{INP(float, I_XP), INP(float, I_XS), (pg8::bf16_t*)WSP(bf16, WS_XB), WSP(float, WS_SSR), (LAS float*)(ring + 131072)};
        pg8::gemm_phase<pg8::EpiOut, pg8::StaticOrder, true, true>(ring, g, S, E, F.wave, F.lane);
        __syncthreads();
        sk::run<1>(F, WSP(bf16, WS_MG) + (size_t)MPR * 2048, 2048, WSP(bf16, WS_WOUT), 2048, 2048, 64, sk::Out{INP(float, I_XS), WSP(bf16, WS_XB), WSP(float, WS_SSR)}); } SEAM(6);
    if (IN(7)) REP(7) { REPBAR();
        const bool lite = (int)blockIdx.x >= 128 && F.G == 256;
        if (lite) { sk::run<2>(F, WSP(bf16, WS_XB) + (size_t)MPR * 2048, 2048, WSP(bf16, WS_WFF1), 2048, 2048, DFF / 32, sk::FF1{WSP(float, WS_SSR), WSP(bf16, WS_H)}, 255 - (int)blockIdx.x, 128);
            __syncthreads(); refresh_lane(F);
            weight_copies(F, WI_FF20, WI_END, (int)blockIdx.x - 128, 128);
            __syncthreads(); refresh_lane(F); }
        { pg8::Gemm g{(const pg8::bf16_t*)WSP(bf16, WS_XB), (const pg8::bf16_t*)WSP(bf16, WS_WFF1), MPR, 2 * DFF, 2048, 2048, 2048}; pg8::StaticOrder S; S.init(MPR, 2 * DFF, F.G, (int)blockIdx.x);
          pg8::EpiFF1 E{WSP(float, WS_SSR), (pg8::bf16_t*)WSP(bf16, WS_H), args.probe};
          pg8::gemm_phase<pg8::EpiFF1, pg8::StaticOrder, true, true>(ring, g, S, E, F.wave, F.lane); }
        if (F.G != 256) { __syncthreads();
            sk::run<2>(F, WSP(bf16, WS_XB) + (size_t)MPR * 2048, 2048, WSP(bf16, WS_WFF1), 2048, 2048, DFF / 32, sk::FF1{WSP(float, WS_SSR), WSP(bf16, WS_H)});
            __syncthreads(); refresh_lane(F);
            weight_copies(F, WI_FF20, WI_END, (int)blockIdx.x, F.G); } } SEAM(7);
    if (IN(8)) REP(8) { REPBAR();
        pg8::Gemm g{(const pg8::bf16_t*)WSP(bf16, WS_H), (const pg8::bf16_t*)WSP(bf16, WS_WFF2), MPR, 2048, DFF, DFF, DFF}; pg8::StaticOrder S; S.init(MPR, 2048, F.G, (int)blockIdx.x);
        pg8::EpiFF2 E{(const pg8::bf16_t*)WSP(bf16, WS_XB), F.out + O_YP, F.out + O_YS};
        pg8::gemm_phase<pg8::EpiFF2, pg8::StaticOrder, true, true>(ring, g, S, E, F.wave, F.lane);
        __syncthreads();
        sk::run<1>(F, WSP(bf16, WS_H) + (size_t)MPR * DFF, DFF, WSP(bf16, WS_WFF2), DFF, DFF, 64, sk::FF2{WSP(bf16, WS_XB), F.out + O_YS}); }
#undef IN
#undef SEAM
}

extern "C" void kernel_launch(void* const* d_in, const int* in_sizes, int n_in, void* d_out, int out_size, void* d_ws, size_t ws_size, hipStream_t stream) {
    static int grid = 0;
    if (grid == 0) {
        if (n_in != 30 || out_size != (int)O_END || ws_size < WS_END) { fprintf(stderr, "kernel_launch: unexpected shapes (n_in %d out %d ws %zu)\n", n_in, out_size, ws_size); grid = -1; return; }
        int dev = 0, cus = 0, per_cu = 0;
        if (hipGetDevice(&dev) != hipSuccess || hipDeviceGetAttribute(&cus, hipDeviceAttributeMultiprocessorCount, dev) != hipSuccess) { grid = -1; return; }
        if (hipFuncSetAttribute((const void*)fwd, hipFuncAttributeMaxDynamicSharedMemorySize, LDS_BYTES) != hipSuccess) { fprintf(stderr, "kernel_launch: hipFuncSetAttribute failed\n"); grid = -1; return; }
        if (hipOccupancyMaxActiveBlocksPerMultiprocessor(&per_cu, (const void*)fwd, NWAVES * 64, LDS_BYTES) != hipSuccess || per_cu < 1) fprintf(stderr, "kernel_launch: occupancy query reports %d\n", per_cu);
        (void)hipGetLastError();
        grid = cus;
    }
    if (grid < 0) return;
    if (hipMemsetAsync((char*)d_ws + WS_CTL, 0, CTL_ZERO_BYTES, stream) != hipSuccess) return;
    Args a{};
    for (int i = 0; i < 30; ++i) a.in[i] = d_in[i];
    a.out = (float*)d_out; a.ws = (unsigned char*)d_ws;
#if MK_SPLIT
    for (int p = 0; p < N_PHASES; ++p) { a.ph_lo = p; a.ph_hi = p + 1; hipLaunchKernelGGL(fwd, dim3(grid), dim3(NWAVES * 64), LDS_BYTES, stream, a); }
#else
    a.ph_lo = 0; a.ph_hi = N_PHASES; hipLaunchKernelGGL(fwd, dim3(grid), dim3(NWAVES * 64), LDS_BYTES, stream, a);
#endif
#ifdef PROBE_EXTRA_PHASE
    a.ph_lo = PROBE_EXTRA_PHASE; a.ph_hi = PROBE_EXTRA_PHASE + 1;
#ifdef PROBE_SKIP
    a.probe = PROBE_SKIP;
#endif
    hipLaunchKernelGGL(fwd, dim3(grid), dim3(NWAVES * 64), LDS_BYTES, stream, a);
#endif
#ifdef PROBE_EXTRA_LO
    (void)hipMemsetAsync((char*)d_ws + WS_CTL, 0, CTL_ZERO_BYTES, stream);
    a.ph_lo = PROBE_EXTRA_LO; a.ph_hi = PROBE_EXTRA_HI;
#ifdef PROBE_SKIP
    a.probe = PROBE_SKIP;
#endif
    hipLaunchKernelGGL(fwd, dim3(grid), dim3(NWAVES * 64), LDS_BYTES, stream, a);
#endif
}
```
